# Optimizing an MI355X kernel written in HIP

```python
import jax, jax.numpy as jnp
from jax import lax
import numpy as np

D_MODEL = 1024
BATCH = 2
SEQ = 8192
DEPTH = 2

HEAD_DIM = 64
POOL_WINDOWS = (2, 4, 8, 16)
POOL_WIDTH = D_MODEL // 4
POOL_GROUP = POOL_WIDTH // len(POOL_WINDOWS)
RWKV_WIDTH = 3 * D_MODEL // 8
RWKV_HEADS = RWKV_WIDTH // HEAD_DIM
DECAY_LORA = 64
ICLR_LORA = 64
GATE_LORA = 128
VRES_LORA = 32
RWKV_GN_EPS = 64e-5
RWKV_COLS = 3 * RWKV_WIDTH + DECAY_LORA + ICLR_LORA + GATE_LORA
MLSTM_WIDTH = D_MODEL - POOL_WIDTH - RWKV_WIDTH
MLSTM_HEADS = MLSTM_WIDTH // HEAD_DIM
MLSTM_CONV = 4
MLSTM_CHUNK = 64
MLSTM_COLS = 4 * MLSTM_WIDTH + 2 * MLSTM_HEADS
D_MIX = POOL_WIDTH + RWKV_WIDTH + MLSTM_WIDTH
D_IN = POOL_WIDTH + RWKV_COLS + MLSTM_COLS
N_EXPERTS = 32
TOP_K = 4
D_FF = D_MODEL
SWIGLU_LIMIT = 7.0
SWIGLU_ALPHA = 1.702
MOE_BLOCK = 256
LN_EPS = 1e-5
DEEPNORM_ALPHA = (2 * DEPTH) ** 0.25
DEEPNORM_BETA = (8 * DEPTH) ** -0.25

kernel_name = 'hybrid_pool_rwkv7_mlstm_moe_deepnorm'

F32 = jnp.float32


def layer_norm(x, g, b):
    xf = x.astype(F32)
    mu = xf.mean(-1, keepdims=True)
    var = jnp.square(xf - mu).mean(-1, keepdims=True)
    return ((xf - mu) * lax.rsqrt(var + LN_EPS) * g + b).astype(x.dtype)


def token_shift(x):
    return jnp.pad(x, ((0, 0), (1, 0), (0, 0)))[:, :x.shape[1]]


def causal_depthwise_conv(x, w):
    k_taps, s = w.shape[0], x.shape[1]
    xp = jnp.pad(x, ((0, 0), (k_taps - 1, 0), (0, 0)))
    return sum(xp[:, i:i + s] * w[i] for i in range(k_taps))


def pool_mixer(u, pool_w, pool_scale):
    b, s, _ = u.shape
    uf = u.astype(F32)
    cs = jnp.pad(jnp.cumsum(uf, axis=1), ((0, 0), (1, 0), (0, 0)))
    t = jnp.arange(s)
    outs = []
    for gi, win in enumerate(POOL_WINDOWS):
        sl = slice(gi * POOL_GROUP, (gi + 1) * POOL_GROUP)
        lo = jnp.maximum(t + 1 - win, 0)
        cnt = jnp.minimum(t + 1, win).astype(F32)
        outs.append((cs[:, 1:, sl] - cs[:, lo, sl]) / cnt[None, :, None] - uf[..., sl])
    d = jnp.stack(outs, axis=2)
    y = jnp.einsum('bsgc,gcd->bsgd', d, pool_w.astype(F32)).reshape(b, s, POOL_WIDTH)
    return (y * pool_scale).astype(u.dtype)


def rwkv7_recurrence(r, decay, k, v, a_vec, b_vec):
    b, s, h, n = r.shape

    def step(state, inp):
        r_t, w_t, k_t, v_t, a_t, b_t = inp
        sa = jnp.einsum('bhvk,bhk->bhv', state, a_t)
        state = state * w_t[:, :, None, :] + sa[..., None] * b_t[:, :, None, :] + v_t[..., None] * k_t[:, :, None, :]
        return state, jnp.einsum('bhvk,bhk->bhv', state, r_t)

    xs = tuple(jnp.moveaxis(z, 1, 0) for z in (r, decay, k, v, a_vec, b_vec))
    _, ys = lax.scan(step, jnp.zeros((b, h, n, n), F32), xs)
    return jnp.moveaxis(ys, 0, 1)


def rwkv7_mixer(p, mu, w0, w2, a0, a2, g2, kk_scale, ka, rk, lnx_g, lnx_b, v_first, v_gate):
    b, s, _ = p.shape
    pf = p.astype(F32)
    pf = pf + mu * (token_shift(pf) - pf)
    W = RWKV_WIDTH
    r, k, v, wd, ad, gd = jnp.split(pf, [W, 2 * W, 3 * W, 3 * W + DECAY_LORA, 3 * W + DECAY_LORA + ICLR_LORA], axis=-1)
    w_log = -jax.nn.softplus(-(w0 + jnp.tanh(wd) @ w2)) - 0.5
    decay = jnp.exp(-jnp.exp(w_log))
    a = jax.nn.sigmoid(a0 + ad @ a2)
    g = jax.nn.sigmoid(gd) @ g2
    if v_first is None:
        v_first = v
    else:
        v = v + (v_first - v) * v_gate

    def heads(z):
        return z.reshape(b, s, RWKV_HEADS, HEAD_DIM)

    kk = heads(k * kk_scale)
    kk = kk / jnp.maximum(jnp.sqrt(jnp.sum(kk * kk, -1, keepdims=True)), 1e-12)
    k = k * (1.0 + (a - 1.0) * ka)
    rh, kh, vh = heads(r), heads(k), heads(v)
    y = rwkv7_recurrence(rh, heads(decay), kh, vh, -kk, kk * heads(a))
    ym = y.mean(-1, keepdims=True)
    yv = jnp.square(y - ym).mean(-1, keepdims=True)
    y = ((y - ym) * lax.rsqrt(yv + RWKV_GN_EPS)).reshape(b, s, W) * lnx_g + lnx_b
    bonus = jnp.sum(rh * kh * rk, -1, keepdims=True) * vh
    y = y + bonus.reshape(b, s, W)
    return (y * g).astype(p.dtype), v_first


def mlstm_mixer(p, conv_w, conv_b, b_i, b_f, norm_g):
    b, s, _ = p.shape
    H, Dh, L = MLSTM_HEADS, HEAD_DIM, MLSTM_CHUNK
    nc = s // L
    W = MLSTM_WIDTH
    pf = p.astype(F32)
    qk, v, o, ig, fg = jnp.split(pf, [2 * W, 3 * W, 4 * W, 4 * W + H], axis=-1)
    qk = jax.nn.silu(causal_depthwise_conv(qk, conv_w) + conv_b)
    q, k = qk[..., :W], qk[..., W:]

    def chunks(z):
        return z.reshape(b, nc, L, H, Dh).transpose(0, 3, 1, 2, 4)

    def gchunks(z):
        return z.reshape(b, nc, L, H).transpose(0, 3, 1, 2)

    q = chunks(q) * (Dh ** -0.5)
    k = chunks(k)
    v = chunks(v)
    ig = gchunks(ig + b_i)
    g = jnp.cumsum(jax.nn.log_sigmoid(gchunks(fg + b_f)), axis=-1)
    g_last = g[..., -1]
    e = g_last[..., None] - g + ig
    m_loc = e.max(-1)
    w_e = jnp.exp(e - m_loc[..., None])
    kv_loc = jnp.einsum('bhcs,bhcsk,bhcsv->bhckv', w_e, k, v)
    n_loc = jnp.einsum('bhcs,bhcsk->bhck', w_e, k)

    def step(carry, inp):
        c_st, n_st, m_st = carry
        gl, ml, kvl, nl = inp
        m_new = jnp.maximum(gl + m_st, ml)
        a_old = jnp.exp(gl + m_st - m_new)
        a_new = jnp.exp(ml - m_new)
        c_new = a_old[..., None, None] * c_st + a_new[..., None, None] * kvl
        n_new = a_old[..., None] * n_st + a_new[..., None] * nl
        return (c_new, n_new, m_new), (c_st, n_st, m_st)

    init = (jnp.zeros((b, H, Dh, Dh), F32), jnp.zeros((b, H, Dh), F32), jnp.zeros((b, H), F32))
    xs = (jnp.moveaxis(g_last, 2, 0), jnp.moveaxis(m_loc, 2, 0), jnp.moveaxis(kv_loc, 2, 0), jnp.moveaxis(n_loc, 2, 0))
    _, (c_prev, n_prev, m_prev) = lax.scan(step, init, xs)
    c_prev = jnp.moveaxis(c_prev, 0, 2)
    n_prev = jnp.moveaxis(n_prev, 0, 2)
    m_prev = jnp.moveaxis(m_prev, 0, 2)
    causal = jnp.tril(jnp.ones((L, L), bool))
    d_log = jnp.where(causal, g[..., :, None] - g[..., None, :] + ig[..., None, :], -jnp.inf)
    inter_log = g + m_prev[..., None]
    m_j = jnp.maximum(d_log.max(-1), inter_log)
    w_intra = jnp.exp(d_log - m_j[..., None]) * jnp.einsum('bhcjd,bhcsd->bhcjs', q, k)
    w_inter = jnp.exp(inter_log - m_j)
    num = jnp.einsum('bhcjs,bhcsv->bhcjv', w_intra, v) + w_inter[..., None] * jnp.einsum('bhcjd,bhcdv->bhcjv', q, c_prev)
    den = w_intra.sum(-1) + w_inter * jnp.einsum('bhcjd,bhcd->bhcj', q, n_prev)
    h = num / jnp.maximum(jnp.abs(den), jnp.exp(-m_j))[..., None]
    h = h.transpose(0, 2, 3, 1, 4).reshape(b, s, H, Dh)
    hm = h.mean(-1, keepdims=True)
    hv = jnp.square(h - hm).mean(-1, keepdims=True)
    hn = ((h - hm) * lax.rsqrt(hv + LN_EPS)).reshape(b, s, W) * norm_g
    return (jax.nn.sigmoid(o) * hn).astype(p.dtype)


def moe_ffn(h, router_w, router_b, w_gu, b_gu, w_dn, b_dn):
    bsz, s, d = h.shape
    xt = h.reshape(-1, d)
    t = xt.shape[0]
    logits = (xt @ router_w + router_b).astype(F32)
    top_val, top_idx = lax.top_k(logits, TOP_K)
    gate = jax.nn.softmax(top_val, axis=-1)
    flat_e = top_idx.reshape(-1)
    order = jnp.argsort(flat_e)
    e_sorted = flat_e[order]
    tok_sorted = order // TOP_K
    counts = jnp.bincount(flat_e, length=N_EXPERTS)
    padded = (counts + MOE_BLOCK - 1) // MOE_BLOCK * MOE_BLOCK
    pad_end = jnp.cumsum(padded)
    pad_start = pad_end - padded
    start = jnp.cumsum(counts) - counts
    dest = pad_start[e_sorted] + jnp.arange(t * TOP_K) - start[e_sorted]
    n_blocks = -(-(t * TOP_K) // MOE_BLOCK) + N_EXPERTS
    buf = jnp.zeros((n_blocks * MOE_BLOCK, d), h.dtype).at[dest].set(xt[tok_sorted])
    block_e = jnp.minimum(jnp.searchsorted(pad_end, jnp.arange(n_blocks) * MOE_BLOCK, side='right'), N_EXPERTS - 1)

    def expert_block(args):
        xb, e = args
        gu = xb @ w_gu[e] + b_gu[e]
        glu = jnp.minimum(gu[:, :D_FF], SWIGLU_LIMIT)
        lin = jnp.clip(gu[:, D_FF:], -SWIGLU_LIMIT, SWIGLU_LIMIT)
        act = glu * jax.nn.sigmoid(SWIGLU_ALPHA * glu) * (lin + 1.0)
        return act @ w_dn[e] + b_dn[e]

    out = lax.map(expert_block, (buf.reshape(n_blocks, MOE_BLOCK, d), block_e)).reshape(-1, d)
    y_sorted = out[dest] * gate.reshape(-1)[order][:, None].astype(h.dtype)
    y = jnp.zeros_like(xt).at[tok_sorted].add(y_sorted)
    return y.reshape(bsz, s, d)


def setup_inputs(seed: int = 0) -> dict:
    key = jax.random.key(seed)
    ks = iter(jax.random.split(key, 48))
    Lr = DEPTH

    def nrm(shape, scale):
        return jax.random.normal(next(ks), shape, F32) * scale

    W, H = RWKV_WIDTH, RWKV_HEADS
    return {
        'x': nrm((BATCH, SEQ, D_MODEL), 1.0),
        'w_in': nrm((Lr, D_MODEL, D_IN), D_MODEL ** -0.5),
        'pool_w': nrm((Lr, len(POOL_WINDOWS), POOL_GROUP, POOL_GROUP), POOL_GROUP ** -0.5),
        'pool_scale': 1.0 + nrm((Lr, POOL_WIDTH), 0.1),
        'rwkv_mu': jax.random.uniform(next(ks), (Lr, RWKV_COLS), F32),
        'rwkv_w0': jnp.linspace(-6.0, -1.0, W, dtype=F32)[None] + nrm((Lr, W), 0.1),
        'rwkv_w2': nrm((Lr, DECAY_LORA, W), 0.1),
        'rwkv_a0': nrm((Lr, W), 0.1),
        'rwkv_a2': nrm((Lr, ICLR_LORA, W), 0.1),
        'rwkv_g2': nrm((Lr, GATE_LORA, W), GATE_LORA ** -0.5),
        'rwkv_kk_scale': 0.85 + nrm((Lr, W), 0.05),
        'rwkv_ka': 1.0 + nrm((Lr, W), 0.05),
        'rwkv_rk': nrm((Lr, H, HEAD_DIM), 0.1),
        'rwkv_lnx_g': 1.0 + nrm((Lr, W), 0.1),
        'rwkv_lnx_b': nrm((Lr, W), 0.01),
        'rwkv_v0': 1.0 + nrm((Lr - 1, W), 0.1),
        'rwkv_v1': nrm((Lr - 1, D_MODEL, VRES_LORA), D_MODEL ** -0.5),
        'rwkv_v2': nrm((Lr - 1, VRES_LORA, W), VRES_LORA ** -0.5),
        'mlstm_conv_w': nrm((Lr, MLSTM_CONV, 2 * MLSTM_WIDTH), MLSTM_CONV ** -0.5),
        'mlstm_conv_b': nrm((Lr, 2 * MLSTM_WIDTH), 0.01),
        'mlstm_b_i': nrm((Lr, MLSTM_HEADS), 0.1),
        'mlstm_b_f': jnp.linspace(3.0, 6.0, MLSTM_HEADS, dtype=F32)[None] + nrm((Lr, MLSTM_HEADS), 0.1),
        'mlstm_norm_g': 1.0 + nrm((Lr, MLSTM_WIDTH), 0.1),
        'w_out': nrm((Lr, D_MIX, D_MODEL), D_MIX ** -0.5 * DEEPNORM_BETA),
        'ln1_g': 1.0 + nrm((Lr, D_MODEL), 0.1),
        'ln1_b': nrm((Lr, D_MODEL), 0.01),
        'router_w': nrm((Lr, D_MODEL, N_EXPERTS), D_MODEL ** -0.5),
        'router_b': nrm((Lr, N_EXPERTS), 0.01),
        'w_gate_up': nrm((Lr, N_EXPERTS, D_MODEL, 2 * D_FF), D_MODEL ** -0.5),
        'b_gate_up': nrm((Lr, N_EXPERTS, 2 * D_FF), 0.01),
        'w_down': nrm((Lr, N_EXPERTS, D_FF, D_MODEL), D_FF ** -0.5 * DEEPNORM_BETA),
        'b_down': nrm((Lr, N_EXPERTS, D_MODEL), 0.01),
        'ln2_g': 1.0 + nrm((Lr, D_MODEL), 0.1),
        'ln2_b': nrm((Lr, D_MODEL), 0.01),
    }


def reference(x, w_in, pool_w, pool_scale, rwkv_mu, rwkv_w0, rwkv_w2, rwkv_a0, rwkv_a2, rwkv_g2,
              rwkv_kk_scale, rwkv_ka, rwkv_rk, rwkv_lnx_g, rwkv_lnx_b, rwkv_v0, rwkv_v1, rwkv_v2,
              mlstm_conv_w, mlstm_conv_b, mlstm_b_i, mlstm_b_f, mlstm_norm_g, w_out, ln1_g, ln1_b,
              router_w, router_b, w_gate_up, b_gate_up, w_down, b_down, ln2_g, ln2_b):
    h = x
    v_first = None
    for l in range(DEPTH):
        p = h @ w_in[l]
        p_pool = p[..., :POOL_WIDTH]
        p_rwkv = p[..., POOL_WIDTH:POOL_WIDTH + RWKV_COLS]
        p_mlstm = p[..., POOL_WIDTH + RWKV_COLS:]
        y_pool = pool_mixer(p_pool, pool_w[l], pool_scale[l])
        if l == 0:
            v_gate = None
        else:
            v_gate = jax.nn.sigmoid(rwkv_v0[l - 1] + (h @ rwkv_v1[l - 1]) @ rwkv_v2[l - 1]).astype(F32)
        y_rwkv, v_first = rwkv7_mixer(p_rwkv, rwkv_mu[l], rwkv_w0[l], rwkv_w2[l], rwkv_a0[l], rwkv_a2[l],
                                      rwkv_g2[l], rwkv_kk_scale[l], rwkv_ka[l], rwkv_rk[l],
                                      rwkv_lnx_g[l], rwkv_lnx_b[l], v_first, v_gate)
        y_mlstm = mlstm_mixer(p_mlstm, mlstm_conv_w[l], mlstm_conv_b[l], mlstm_b_i[l], mlstm_b_f[l], mlstm_norm_g[l])
        mix = jnp.concatenate([y_pool, y_rwkv, y_mlstm], axis=-1) @ w_out[l]
        h = layer_norm(DEEPNORM_ALPHA * h + mix, ln1_g[l], ln1_b[l])
        ffn = moe_ffn(h, router_w[l], router_b[l], w_gate_up[l], b_gate_up[l], w_down[l], b_down[l])
        h = layer_norm(DEEPNORM_ALPHA * h + ffn, ln2_g[l], ln2_b[l])
    return h
```

```cpp
#include <hip/hip_runtime.h>
#include <cstdio>
#include <cstdint>
namespace pg8 {
#define PG8_LAS __attribute__((address_space(3)))
typedef unsigned short bf16_t;
typedef short bf16x8 __attribute__((ext_vector_type(8)));
typedef float f32x4 __attribute__((ext_vector_type(4)));
typedef unsigned u32x4 __attribute__((ext_vector_type(4)));
constexpr int BM = 256, BK = 64, HALF = 128, HTB = HALF * BK * 2  , STAGE_BYTES = 8 * HTB, NXCD = 8, WGM = 8;

__host__ __device__ __forceinline__ int lds_byte(int r, int c) { const int st = (r >> 4) * 2 + (c >> 5), rr = r & 15, cc = c & 31, ob = rr * 64 + cc * 2; return st * 1024 + (ob ^ (((ob >> 9) & 1) << 5)); }
__host__ __device__ __forceinline__ void stage_rc(int b, int& R, int& C) { const int st = b / 1024, sb = b % 1024, swz = sb ^ (((sb >> 9) & 1) << 5); R = (st >> 1) * 16 + swz / 64; C = (st & 1) * 32 + (swz % 64) / 2; }
__host__ __device__ __forceinline__ int perm32(int rho) { const int n = rho >> 4, i = rho & 15; return 8 * (i >> 2) + 4 * n + (i & 3); }

struct Unit { int pm, pn, e; };
struct Gemm { const bf16_t* A; const bf16_t* Bt; int M, N, K; size_t bstride; };

struct StaticOrder {
    int nM, nN, nwg, G, c;
    __host__ __device__ void init(int M, int N, int G_, int c_) { nM = M / BM; nN = N / BM; nwg = nM * nN; G = G_; c = c_; }
    __host__ __device__ bool next(int i, Unit& u) const {
        const long L = (long)i * G + c; if (L >= nwg) return false;
        int wgid = (int)L; { const int q = nwg / NXCD, r = nwg % NXCD, xcd = wgid % NXCD, off = wgid / NXCD; wgid = (xcd < r ? xcd * (q + 1) : r * (q + 1) + (xcd - r) * q) + off; }
        const int nig = WGM * nN, gid = wgid / nig, fm = gid * WGM, gsz = (nM - fm) < WGM ? (nM - fm) : WGM;
        u.pm = fm + ((wgid % nig) % gsz); u.pn = (wgid % nig) / gsz; u.e = 0; return true;
    }
    __device__ __forceinline__ void a_ready(const Unit&) const {}
    __device__ __forceinline__ void done(const Unit&) const {}
};

__device__ __forceinline__ unsigned cvt_pk_bf16(float lo, float hi) { unsigned r; asm volatile("v_cvt_pk_bf16_f32 %0, %1, %2" : "=v"(r) : "v"(lo), "v"(hi)); return r; }

struct EpiF32 {
    static constexpr bool PERM = false, AFTER_DRAIN = false;
    float* C; int ldc;
    __device__ __forceinline__ void operator()(const f32x4 (&acc)[2][2][4][2], const Unit& u, int wr, int wc, int fr, int fq) const {
        const int row0 = u.pm * BM + wr * 64 + fr, col0 = u.pn * BM + wc * 32 + 4 * fq;
#pragma unroll
        for (int ai = 0; ai < 2; ++ai)
#pragma unroll
            for (int m = 0; m < 4; ++m) { float* rowp = C + (size_t)(row0 + ai * HALF + m * 16) * ldc + col0;
#pragma unroll
                for (int bj = 0; bj < 2; ++bj)
#pragma unroll
                    for (int n = 0; n < 2; ++n) *(f32x4*)(rowp + bj * HALF + n * 16) = acc[ai][bj][m][n]; }
    }
};
struct EpiSwiGLU {
    static constexpr bool PERM = true, AFTER_DRAIN = false;
    bf16_t* O; const float* bias;
    __device__ __forceinline__ void operator()(const f32x4 (&acc)[2][2][4][2], const Unit& u, int wr, int wc, int fr, int fq) const {
        const int row0 = u.pm * BM + wr * 64 + fr; const int c0 = u.pn * HALF + wc * 32 + 8 * fq;
        const float* bg = bias + (size_t)u.e * 2048 + c0; const float* bl = bg + 1024;
        f32x4 bgv[2], blv[2];
#pragma unroll
        for (int n = 0; n < 2; ++n) { bgv[n] = *(const f32x4*)(bg + 4 * n); blv[n] = *(const f32x4*)(bl + 4 * n); }
#pragma unroll
        for (int ai = 0; ai < 2; ++ai)
#pragma unroll
            for (int m = 0; m < 4; ++m) {
                float o[8];
#pragma unroll
                for (int n = 0; n < 2; ++n) {
                    const f32x4 gv = acc[ai][0][m][n] + bgv[n], lv = acc[ai][1][m][n] + blv[n];
#pragma unroll
                    for (int j = 0; j < 4; ++j) {
                        const float gl = fminf(gv[j], 7.0f); const float li = fminf(fmaxf(lv[j], -7.0f), 7.0f);
                        const float sg = __builtin_amdgcn_rcpf(1.0f + __builtin_amdgcn_exp2f(-1.702f * 1.4426950408889634f * gl));
                        o[4 * n + j] = gl * sg * (li + 1.0f);
                    }
                }
                u32x4 w; w.x = cvt_pk_bf16(o[0], o[1]); w.y = cvt_pk_bf16(o[2], o[3]); w.z = cvt_pk_bf16(o[4], o[5]); w.w = cvt_pk_bf16(o[6], o[7]);
                *(u32x4*)(O + (size_t)(row0 + ai * HALF + m * 16) * 1024 + c0) = w;
            }
    }
};
struct EpiDown {
    static constexpr bool PERM = true, AFTER_DRAIN = false;
    bf16_t* O; const float* bias; const float* gate;
    __device__ __forceinline__ void operator()(const f32x4 (&acc)[2][2][4][2], const Unit& u, int wr, int wc, int fr, int fq) const {
        const int row0 = u.pm * BM + wr * 64 + fr; const int c0 = u.pn * BM + wc * 32 + 8 * fq;
        const float* bb = bias + (size_t)u.e * 1024 + c0;
        f32x4 bv[2][2];
#pragma unroll
        for (int bj = 0; bj < 2; ++bj)
#pragma unroll
            for (int n = 0; n < 2; ++n) bv[bj][n] = *(const f32x4*)(bb + bj * HALF + 4 * n);
#pragma unroll
        for (int ai = 0; ai < 2; ++ai)
#pragma unroll
            for (int m = 0; m < 4; ++m) { const int row = row0 + ai * HALF + m * 16; const float gt = gate[row];
#pragma unroll
                for (int bj = 0; bj < 2; ++bj) { const f32x4 v0 = (acc[ai][bj][m][0] + bv[bj][0]) * gt, v1 = (acc[ai][bj][m][1] + bv[bj][1]) * gt;
                    u32x4 w; w.x = cvt_pk_bf16(v0[0], v0[1]); w.y = cvt_pk_bf16(v0[2], v0[3]); w.z = cvt_pk_bf16(v1[0], v1[1]); w.w = cvt_pk_bf16(v1[2], v1[3]);
                    *(u32x4*)(O + (size_t)row * 1024 + c0 + bj * HALF) = w; } }
    }
};

template <class Epi, class Sched, bool ALIGN_EPI = false, bool SP2 = false>
__device__ __forceinline__ void gemm_phase(PG8_LAS unsigned char* lds, const Gemm g, const Sched& S, const Epi& E) {
    int tid_ = threadIdx.x; asm volatile("" : "+v"(tid_));
    const int tid = tid_, wid = __builtin_amdgcn_readfirstlane(tid >> 6), lane = tid & 63, wr = wid >> 2, wc = wid & 3, fr = lane & 15, fq = lane >> 4;
    int K_ = g.K; asm volatile("" : "+s"(K_)); const int K = K_, nt = K / BK;
    unsigned voffA[2], voffB[2];
#pragma unroll
    for (int i = 0; i < 2; ++i) { int R, C; stage_rc(tid * 16 + i * 8192, R, C); const int Rb = Epi::PERM ? ((R & ~31) + perm32(R & 31)) : R;
        voffA[i] = (unsigned)(R * K + C) * 2u; voffB[i] = (unsigned)(Rb * K + C) * 2u; }
    const size_t kstep = (size_t)(BK * 2);
    const size_t hstep = (size_t)HALF * K * 2;
    const size_t tstep = 2 * hstep;
    const unsigned ldsw = (unsigned)wid * 1024u;
    const int aoff = lds_byte(wr * 64 + fr, fq * 8), boff = lds_byte(wc * 32 + fr, fq * 8);
#define PG8_SA(b, h) (((b) * 2 + (h)) * HTB)
#define PG8_SB(b, h) ((4 + (b) * 2 + (h)) * HTB)
#define PG8_STAGE(bufoff, gbase, voff) do { _Pragma("unroll") for (int _i = 0; _i < 2; ++_i) \
        __builtin_amdgcn_global_load_lds((const unsigned*)((const char*)(gbase) + (voff)[_i]), (PG8_LAS unsigned*)(lds + (bufoff) + ldsw + _i * 8192), 16, 0, 0); } while (0)
#define PG8_LDA(dst, b, h) do { _Pragma("unroll") for (int m = 0; m < 4; ++m) _Pragma("unroll") for (int k = 0; k < 2; ++k) dst[m][k] = *(const PG8_LAS bf16x8*)(lds + PG8_SA(b, h) + aoff + m * 2048 + k * 1024); } while (0)
#define PG8_LDB(dst, b, h) do { _Pragma("unroll") for (int n = 0; n < 2; ++n) _Pragma("unroll") for (int k = 0; k < 2; ++k) dst[n][k] = *(const PG8_LAS bf16x8*)(lds + PG8_SB(b, h) + boff + n * 2048 + k * 1024); } while (0)
#define PG8_MMA(ai, bj, At, Bt) do { __builtin_amdgcn_s_setprio(1); _Pragma("unroll") for (int m = 0; m < 4; ++m) _Pragma("unroll") for (int n = 0; n < 2; ++n) _Pragma("unroll") for (int k = 0; k < 2; ++k) \
        acc[ai][bj][m][n] = __builtin_amdgcn_mfma_f32_16x16x32_bf16(Bt[n][k], At[m][k], acc[ai][bj][m][n], 0, 0, 0); __builtin_amdgcn_s_setprio(0); } while (0)
#define PG8_WAIT_V(n) asm volatile("s_waitcnt vmcnt(" #n ")" ::: "memory")
#define PG8_WAIT_L(n) asm volatile("s_waitcnt lgkmcnt(" #n ")" ::: "memory")
#define PG8_BAR __builtin_amdgcn_s_barrier()
#define PG8_SCHED __builtin_amdgcn_sched_barrier(0)
    Unit cur, nxt; int ui = 0;
    if (!S.next(0, cur)) return;
    f32x4 acc[2][2][4][2];
#pragma unroll
    for (int a = 0; a < 2; ++a)
#pragma unroll
        for (int b = 0; b < 2; ++b)
#pragma unroll
            for (int m = 0; m < 4; ++m)
#pragma unroll
                for (int n = 0; n < 2; ++n) acc[a][b][m][n] = (f32x4){0.f, 0.f, 0.f, 0.f};
    bf16x8 At[4][2], B0[2][2], B1[2][2];
    const char* cA = (const char*)g.A + (size_t)cur.pm * tstep; const char* cB = (const char*)g.Bt + (size_t)cur.e * g.bstride + (size_t)cur.pn * tstep;
    S.a_ready(cur);
    if constexpr (SP2) {
        PG8_STAGE(PG8_SB(0, 0), cB, voffB); PG8_STAGE(PG8_SB(0, 1), cB + hstep, voffB); PG8_STAGE(PG8_SA(0, 0), cA, voffA); PG8_STAGE(PG8_SA(0, 1), cA + hstep, voffA);
        if (wr == 1) PG8_BAR;
        PG8_WAIT_V(2); PG8_BAR;
        PG8_STAGE(PG8_SB(1, 0), cB + kstep, voffB); PG8_STAGE(PG8_SA(1, 0), cA + kstep, voffA); PG8_STAGE(PG8_SB(1, 1), cB + hstep + kstep, voffB);
        PG8_WAIT_V(6); PG8_BAR;
    } else {
        PG8_STAGE(PG8_SB(0, 0), cB, voffB); PG8_STAGE(PG8_SA(0, 0), cA, voffA); PG8_STAGE(PG8_SB(0, 1), cB + hstep, voffB); PG8_STAGE(PG8_SA(0, 1), cA + hstep, voffA);
        if (wr == 1) PG8_BAR;
        PG8_WAIT_V(4); PG8_BAR;
        PG8_STAGE(PG8_SB(1, 0), cB + kstep, voffB); PG8_STAGE(PG8_SA(1, 0), cA + kstep, voffA); PG8_STAGE(PG8_SB(1, 1), cB + hstep + kstep, voffB);
        PG8_WAIT_V(6); PG8_BAR;
    }
    for (;;) {
        const bool has_next = S.next(ui + 1, nxt);
        const char* nA = has_next ? (const char*)g.A + (size_t)nxt.pm * tstep : cA; const char* nB = has_next ? (const char*)g.Bt + (size_t)nxt.e * g.bstride + (size_t)nxt.pn * tstep : cB;
        for (int t = 0; t < nt; t += 2) {
            const bool last = (t == nt - 2);
            const char* a1 = cA + (size_t)(t + 1) * kstep;
            const char* a2 = last ? nA : cA + (size_t)(t + 2) * kstep; const char* b2 = last ? nB : cB + (size_t)(t + 2) * kstep;
            const char* a3 = a2 + kstep; const char* b3 = b2 + kstep;
            if (last && has_next) S.a_ready(nxt);
            if constexpr (SP2) {
            PG8_LDB(B0, 0, 0); PG8_LDB(B1, 0, 1); PG8_SCHED; PG8_LDA(At, 0, 0); PG8_STAGE(PG8_SA(1, 1), a1 + hstep, voffA);
            PG8_WAIT_V(8); PG8_WAIT_L(0); PG8_BAR; PG8_MMA(0, 0, At, B0); PG8_MMA(0, 1, At, B1); PG8_BAR; PG8_SCHED;
            PG8_LDA(At, 0, 1); PG8_STAGE(PG8_SB(0, 0), b2, voffB); PG8_STAGE(PG8_SB(0, 1), b2 + hstep, voffB); PG8_STAGE(PG8_SA(0, 0), a2, voffA);
            PG8_WAIT_V(8); PG8_WAIT_L(0); PG8_BAR; PG8_MMA(1, 0, At, B0); PG8_MMA(1, 1, At, B1); PG8_BAR; PG8_SCHED;
            PG8_LDB(B0, 1, 0); PG8_LDB(B1, 1, 1); PG8_SCHED; PG8_LDA(At, 1, 0); PG8_STAGE(PG8_SA(0, 1), a2 + hstep, voffA);
            PG8_WAIT_V(8); PG8_WAIT_L(0); PG8_BAR; PG8_MMA(0, 0, At, B0); PG8_MMA(0, 1, At, B1); PG8_BAR; PG8_SCHED;
            PG8_LDA(At, 1, 1); PG8_STAGE(PG8_SB(1, 0), b3, voffB); PG8_STAGE(PG8_SB(1, 1), b3 + hstep, voffB); PG8_STAGE(PG8_SA(1, 0), a3, voffA);
            PG8_WAIT_V(8); PG8_WAIT_L(0); PG8_BAR; PG8_MMA(1, 0, At, B0); PG8_MMA(1, 1, At, B1); PG8_BAR; PG8_SCHED;
            } else {
            PG8_LDB(B0, 0, 0); PG8_SCHED; PG8_LDA(At, 0, 0); PG8_STAGE(PG8_SA(1, 1), a1 + hstep, voffA);
            PG8_WAIT_L(8); PG8_BAR; PG8_WAIT_L(0); PG8_MMA(0, 0, At, B0); PG8_BAR; PG8_SCHED;
            PG8_LDB(B1, 0, 1); PG8_STAGE(PG8_SB(0, 0), b2, voffB);
            PG8_BAR; PG8_WAIT_L(0); PG8_MMA(0, 1, At, B1); PG8_BAR;
            PG8_LDA(At, 0, 1); PG8_STAGE(PG8_SA(0, 0), a2, voffA);
            PG8_BAR; PG8_WAIT_L(0); PG8_MMA(1, 0, At, B0); PG8_BAR; PG8_SCHED;
            PG8_STAGE(PG8_SB(0, 1), b2 + hstep, voffB);
            PG8_WAIT_V(6); PG8_BAR; PG8_MMA(1, 1, At, B1); PG8_BAR;
            PG8_LDB(B0, 1, 0); PG8_SCHED; PG8_LDA(At, 1, 0); PG8_STAGE(PG8_SA(0, 1), a2 + hstep, voffA);
            PG8_WAIT_L(8); PG8_BAR; PG8_WAIT_L(0); PG8_MMA(0, 0, At, B0); PG8_BAR; PG8_SCHED;
            PG8_LDB(B1, 1, 1); PG8_STAGE(PG8_SB(1, 0), b3, voffB);
            PG8_BAR; PG8_WAIT_L(0); PG8_MMA(0, 1, At, B1); PG8_BAR;
            PG8_LDA(At, 1, 1); PG8_STAGE(PG8_SA(1, 0), a3, voffA);
            PG8_BAR; PG8_WAIT_L(0); PG8_MMA(1, 0, At, B0); PG8_BAR; PG8_SCHED;
            PG8_STAGE(PG8_SB(1, 1), b3 + hstep, voffB);
            PG8_WAIT_V(6); PG8_BAR; PG8_MMA(1, 1, At, B1); PG8_BAR;
            }
        }
        if constexpr (ALIGN_EPI) { if (wr == 0) PG8_BAR; }
        if constexpr (!Epi::AFTER_DRAIN) { E(acc, cur, wr, wc, fr, fq); S.done(cur); }
        if (!has_next) break;
#pragma unroll
        for (int a = 0; a < 2; ++a)
#pragma unroll
            for (int b = 0; b < 2; ++b)
#pragma unroll
                for (int m = 0; m < 4; ++m)
#pragma unroll
                    for (int n = 0; n < 2; ++n) acc[a][b][m][n] = (f32x4){0.f, 0.f, 0.f, 0.f};
        cur = nxt; cA = nA; cB = nB; ++ui;
        if constexpr (ALIGN_EPI) { if (wr == 1) PG8_BAR; }
    }
    PG8_WAIT_V(0);
    if constexpr (!ALIGN_EPI) { if (wr == 0) PG8_BAR; }
    PG8_BAR;
    if constexpr (Epi::AFTER_DRAIN) { E.fused(acc, cur, wr, wc, fr, fq, lds, wid, lane); S.done(cur); }
#undef PG8_SA
#undef PG8_SB
#undef PG8_STAGE
#undef PG8_LDA
#undef PG8_LDB
#undef PG8_MMA
#undef PG8_WAIT_V
#undef PG8_WAIT_L
#undef PG8_BAR
#undef PG8_SCHED
}
}
constexpr int NWAVES = 8;
constexpr int BATCH = 2, SEQ = 8192, D = 1024, T = BATCH * SEQ, DEPTH = 2;
constexpr int PC = 3328;
constexpr int DIN = 3212;
constexpr int P_RW = 256, P_ML = 1664, P_V1 = 3212;
constexpr int RW = 384, RWC = 1408;
constexpr int NE = 32, TOPK = 4, FF = 1024;
constexpr int MAXBLK = T * TOPK / 256 + NE;
constexpr int NSLOT = MAXBLK * 256;
constexpr float LN_EPS = 1e-5f, GN_EPS = 64e-5f;
constexpr float DN_ALPHA = 1.41421356237f;
constexpr int NCH = SEQ / 64;
constexpr int NITEM = BATCH * NCH * 6;

constexpr size_t MiB = 1u << 20;
constexpr size_t WS_CTL = 0, CTL_ZERO_BYTES = 1 * MiB;
constexpr size_t WS_WIN = 1 * MiB;
constexpr size_t WIN_L = (size_t)PC * D * 2;
constexpr size_t WS_WOUT = WS_WIN + 2 * WIN_L;
constexpr size_t WOUT_L = (size_t)D * D * 2;
constexpr size_t WS_WGU = WS_WOUT + 2 * WOUT_L;
constexpr size_t WGU_E = (size_t)2048 * D * 2;
constexpr size_t WS_WDN = WS_WGU + 64 * WGU_E;
constexpr size_t WDN_E = (size_t)D * D * 2;
constexpr size_t WS_H16 = WS_WDN + 64 * WDN_E;
constexpr size_t WS_HA = WS_H16 + (size_t)T * D * 2;
constexpr size_t WS_HB = WS_HA + (size_t)T * D * 4;
constexpr size_t WS_P = WS_HB + (size_t)T * D * 4;
constexpr size_t WS_MIX = WS_P + (size_t)T * PC * 4;
constexpr size_t WS_YCAT = WS_MIX + (size_t)T * D * 4;
constexpr size_t RWARR = (size_t)T * RW * 4;
constexpr size_t WS_VFIRST = WS_YCAT + (size_t)T * D * 2;
constexpr size_t WS_RR = WS_VFIRST + RWARR, WS_RLW = WS_RR + RWARR, WS_RK = WS_RLW + RWARR, WS_RV = WS_RK + RWARR;
constexpr size_t WS_RNA = WS_RV + RWARR, WS_RBB = WS_RNA + RWARR, WS_RG = WS_RBB + RWARR, WS_RY = WS_RG + RWARR;
constexpr size_t WS_RSB = WS_RY + RWARR;
constexpr size_t WS_MKV = WS_RSB + (size_t)T * 8 * 4;
constexpr size_t WS_MCP = WS_MKV + (size_t)NITEM * 4096 * 4;
constexpr size_t WS_MNL = WS_MCP + (size_t)NITEM * 4096 * 4;
constexpr size_t WS_MNP = WS_MNL + (size_t)NITEM * 64 * 4;
constexpr size_t WS_MSC = WS_MNP + (size_t)NITEM * 64 * 4;
constexpr size_t WS_MLG = WS_MSC + (size_t)NITEM * 4 * 4;
constexpr size_t WS_MLI = WS_MLG + (size_t)T * 8 * 4;
constexpr size_t WS_XG = ((WS_MLI + (size_t)T * 8 * 4 + MiB - 1) / MiB) * MiB;
constexpr size_t WS_ACT = WS_XG + (size_t)NSLOT * D * 2;
constexpr size_t WS_OSL = WS_ACT + (size_t)NSLOT * FF * 2;
constexpr size_t WS_TKE = WS_OSL + (size_t)NSLOT * D * 2;
constexpr size_t WS_TKG = WS_TKE + (size_t)T * 4 * 4;
constexpr size_t WS_SLOT = WS_TKG + (size_t)T * 4 * 4;
constexpr size_t WS_GSL = WS_SLOT + (size_t)T * 4 * 4;
constexpr size_t WS_END = WS_GSL + (size_t)NSLOT * 4;
constexpr int CW_BAR = 4096;
constexpr int CW_CNT = 8192;
constexpr int CW_CUR = 8192 + 64;
constexpr int CW_NB = 8192 + 128;
constexpr int CW_BLKE = 8192 + 256;

constexpr int RING_OFF = 0, RING_BYTES = 131072;
constexpr int LDSCTL_OFF = RING_BYTES, PTR_OFF = LDSCTL_OFF + 512, MISC_OFF = LDSCTL_OFF + 1024;
constexpr int LDS_BYTES = 147456;

#define GAS __attribute__((address_space(1)))
#define LAS __attribute__((address_space(3)))
typedef unsigned short bf16;
typedef unsigned v4u __attribute__((ext_vector_type(4)));
typedef unsigned v2u __attribute__((ext_vector_type(2)));
typedef float f32x4 __attribute__((ext_vector_type(4)));
typedef GAS unsigned gu32;
#define RLX_AGENT __ATOMIC_RELAXED, __HIP_MEMORY_SCOPE_AGENT
#define LDS_WAIT() asm volatile("s_waitcnt lgkmcnt(0)" ::: "memory")
#define VM_WAIT() asm volatile("s_waitcnt vmcnt(0)" ::: "memory")
__device__ __forceinline__ unsigned f2bf(float f) { unsigned u = __builtin_bit_cast(unsigned, f); return (u + 0x7fffu + ((u >> 16) & 1u)) >> 16; }
__device__ __forceinline__ unsigned pk2(float lo, float hi) { return f2bf(lo) | (f2bf(hi) << 16); }
__device__ __forceinline__ float bf2f(unsigned b) { return __builtin_bit_cast(float, b << 16); }
__device__ __forceinline__ float wave_sum(float v) {
#pragma unroll
    for (int o = 1; o < 64; o <<= 1) v += __shfl_xor(v, o);
    return v;
}
__device__ __forceinline__ float wave_max(float v) {
#pragma unroll
    for (int o = 1; o < 64; o <<= 1) v = fmaxf(v, __shfl_xor(v, o));
    return v;
}
__device__ __forceinline__ float sigmoidf_(float x) { return 1.0f / (1.0f + __expf(-x)); }
__device__ __forceinline__ float softplusf_(float x) { return fmaxf(x, 0.f) + log1pf(__expf(-fabsf(x))); }
__device__ __forceinline__ float logsigmoidf_(float x) { return fminf(x, 0.f) - log1pf(__expf(-fabsf(x))); }

#define XB_TMO      128
#define XB_XCNT(j)  (256  + 64 * (j))
#define XB_XSUB(j)  (1280 + 64 * (j))
#define XB_XGEN(j)  (2304 + 64 * (j))
#define XB_TOP      3328
#define XB_TOPGEN   3392
#define XCD_BAR_WORDS 3456
#define XB_SPIN_CAP (1u << 18)

__device__ __forceinline__ unsigned xb_ld(unsigned* p)              { return __hip_atomic_load(p, __ATOMIC_RELAXED, __HIP_MEMORY_SCOPE_AGENT); }
__device__ __forceinline__ unsigned xb_add(unsigned* p, unsigned v) { return __hip_atomic_fetch_add(p, v, __ATOMIC_RELAXED, __HIP_MEMORY_SCOPE_AGENT); }
__device__ __forceinline__ unsigned xb_xcc_id() { return (unsigned)__builtin_amdgcn_s_getreg((3 << 11) | 20) & 0xFu; }
#define XB_SPIN(cond, bar) do { unsigned _sp = 0; while (cond) { __builtin_amdgcn_s_sleep(1); \
    if ((++_sp & 255u) == 0u) { if (xb_ld(&(bar)[XB_TMO])) break; if (_sp > XB_SPIN_CAP) { atomicAdd(&(bar)[XB_TMO], 1u); break; } } } } while (0)

struct XcdBarrier {
    unsigned* bar; unsigned x;
    volatile LAS unsigned* st;
};

__device__ __forceinline__ XcdBarrier xcd_barrier_post(unsigned* bar, volatile LAS unsigned* st) {
    XcdBarrier b; b.bar = bar; b.x = xb_xcc_id(); b.st = st;
    if (threadIdx.x == 0) (void)xb_add(&bar[XB_XCNT(b.x)], 1u);
    return b;
}
__device__ __forceinline__ void xcd_barrier_complete(unsigned* bar, unsigned x, unsigned& nloc, unsigned& nx) {
    const unsigned G = gridDim.x * gridDim.y * gridDim.z;
    unsigned sum, cnt, mine, sp = 0u;
    for (;;) {
        sum = 0u; cnt = 0u; mine = 0u;
#pragma unroll
        for (unsigned j = 0; j < 16; ++j) { const unsigned c = xb_ld(&bar[XB_XCNT(j)]); sum += c; cnt += (c > 0u) ? 1u : 0u; mine = (j == x) ? c : mine; }
        if (sum == G) break;
        __builtin_amdgcn_s_sleep(1);
        if ((++sp & 255u) == 0u) { if (xb_ld(&bar[XB_TMO])) break; if (sp > XB_SPIN_CAP) { atomicAdd(&bar[XB_TMO], 1u); break; } }
    }
    nloc = mine > 0u ? mine : 1u; nx = cnt > 0u ? cnt : 1u;
}

__device__ __forceinline__ void xcd_barrier(const XcdBarrier& b) {
    asm volatile("s_waitcnt vmcnt(0)" ::: "memory");
    __syncthreads();
    if (threadIdx.x == 0) {
        unsigned* bar = b.bar;
        __builtin_amdgcn_s_waitcnt(0);
        unsigned nloc = b.st[0], nx = b.st[1];
        if (nloc == 0u) { xcd_barrier_complete(bar, b.x, nloc, nx); b.st[0] = nloc; b.st[1] = nx; }
        const unsigned old = xb_add(&bar[XB_XSUB(b.x)], 1u);
        const unsigned gen = old / nloc;
        if (old + 1u == (gen + 1u) * nloc) {
            __builtin_amdgcn_fence(__ATOMIC_RELEASE, "agent");
            asm volatile("s_waitcnt vmcnt(0)" ::: "memory");
            const unsigned og = xb_add(&bar[XB_TOP], 1u);
            const unsigned tg = og / nx;
            if (og + 1u == (tg + 1u) * nx) xb_add(&bar[XB_TOPGEN], 1u);
            else XB_SPIN(xb_ld(&bar[XB_TOPGEN]) == tg, bar);
            __builtin_amdgcn_fence(__ATOMIC_ACQUIRE, "agent");
            xb_add(&bar[XB_XGEN(b.x)], 1u);
            asm volatile("s_waitcnt vmcnt(0)" ::: "memory");
        } else {
            XB_SPIN(xb_ld(&bar[XB_XGEN(b.x)]) == gen, bar);
            __builtin_amdgcn_fence(__ATOMIC_ACQUIRE, "agent");
            asm volatile("s_waitcnt vmcnt(0)" ::: "memory");
        }
    }
    __syncthreads();
}


struct Frame {
    LAS unsigned char* lds;
    volatile LAS unsigned* MISC;
    gu32* ctl;
    unsigned char* ws;
    float* out;
    int tid, lane, wave;
    int vcu, G;
};
enum { I_X = 0, I_WIN, I_POOLW, I_POOLS, I_MU, I_W0, I_W2, I_A0, I_A2, I_G2, I_KKS, I_KA, I_RK, I_LNXG, I_LNXB, I_V0, I_V1, I_V2,
       I_CONVW, I_CONVB, I_BI, I_BF, I_NORMG, I_WOUT, I_LN1G, I_LN1B, I_RTW, I_RTB, I_WGU, I_BGU, I_WDN, I_BDN, I_LN2G, I_LN2B };

#define WSP(T_, off) ((T_*)(F.ws + (off)))
__device__ __forceinline__ const float* inp_(LAS unsigned char* lds, int i) {
    const unsigned long long v = *(const LAS unsigned long long*)(lds + PTR_OFF + 8 * i);
    const unsigned lo = __builtin_amdgcn_readfirstlane((unsigned)v), hi = __builtin_amdgcn_readfirstlane((unsigned)(v >> 32));
    return (const float*)(((unsigned long long)hi << 32) | lo);
}
#define INP(i) inp_(F.lds, (i))
__device__ __forceinline__ Frame launder(const Frame& G) {
    Frame F = G;
    asm volatile("" : "+v"(F.tid), "+v"(F.lane));
    asm volatile("" : "+s"(F.ws), "+s"(F.ctl), "+s"(F.out), "+s"(F.wave), "+s"(F.vcu), "+s"(F.G));
    return F;
}
__device__ __forceinline__ int launder_s(int x) { asm volatile("" : "+s"(x)); return x; }

template <int NN>
struct MoeOrder {
    int nb, c; const gu32* blke;
    __device__ __forceinline__ bool next(int i, pg8::Unit& u) const {
        constexpr int BPX = 32 / NN;
        const int x = c & 7, j = c >> 3;
        const int blk = i * (8 * BPX) + x * BPX + j / NN;
        if (blk >= nb) return false;
        u.pm = blk; u.pn = j % NN; u.e = (int)__builtin_amdgcn_readfirstlane(__hip_atomic_load(blke + blk, RLX_AGENT));
        return true;
    }
    __device__ __forceinline__ void a_ready(const pg8::Unit&) const {}
    __device__ __forceinline__ void done(const pg8::Unit&) const {}
};

__device__ __forceinline__ void transpose_item(const float* src, int ld, bool valid, int k0, bf16* dst  , LAS float* scr, int lane) {
    const float* s0 = src + (size_t)(k0 + (lane >> 5)) * ld;
#pragma unroll 8
    for (int i = 0; i < 32; ++i) { const int kk = 2 * i + (lane >> 5); scr[kk * 33 + (lane & 31)] = valid ? s0[(size_t)(2 * i) * ld] : 0.f; }
    LDS_WAIT(); asm volatile("" ::: "memory");
    const int c = lane & 7;
#pragma unroll
    for (int j = 0; j < 4; ++j) { const int n = (lane >> 3) + 8 * j; const LAS float* s = scr + (8 * c) * 33 + n;
        v4u o; o.x = pk2(s[0 * 33], s[1 * 33]); o.y = pk2(s[2 * 33], s[3 * 33]); o.z = pk2(s[4 * 33], s[5 * 33]); o.w = pk2(s[6 * 33], s[7 * 33]);
        *(GAS v4u*)(dst + (size_t)n * D + k0 + 8 * c) = o; }
    LDS_WAIT(); asm volatile("" ::: "memory");
}
__device__ __forceinline__ void phase_convert(Frame& F) {
    LAS float* scr = (LAS float*)(F.lds + RING_OFF + F.wave * 16384);
    const int gw = F.vcu * NWAVES + F.wave, NGW = F.G * NWAVES; const int lane = F.lane;
    { const float* x = INP(I_X); bf16* h16 = WSP(bf16, WS_H16);
      for (int m = gw; m < T; m += NGW) { const GAS f32x4* xr = (const GAS f32x4*)(x + (size_t)m * D) + lane; GAS v2u* o = (GAS v2u*)(h16 + (size_t)m * D) + lane;
#pragma unroll
          for (int j = 0; j < 4; ++j) { const f32x4 v = xr[64 * j]; v2u w; w.x = pk2(v.x, v.y); w.y = pk2(v.z, v.w); o[64 * j] = w; } } }
    constexpr int KB = D / 64;
    constexpr int I_IN = 2 * (PC / 32) * KB;
    constexpr int I_OUT = 2 * (D / 32) * KB;
    constexpr int I_GU = 64 * (2048 / 32) * KB;
    constexpr int I_DN = 64 * (D / 32) * KB;
    constexpr int NITEMS = I_IN + I_OUT + I_GU + I_DN;
    for (int it = gw; it < NITEMS; it += NGW) {
        int r = it;
        if (r < I_IN) { const int l = r / ((PC / 32) * KB); r -= l * ((PC / 32) * KB); const int nb = r / KB, kb = r % KB; const int n = nb * 32 + (lane & 31);
            const float* src; int ld; bool valid;
            if (n < DIN) { src = INP(I_WIN) + (size_t)l * D * DIN + n; ld = DIN; valid = true; }
            else if (l == 1 && n < DIN + 32) { src = INP(I_V1) + (n - DIN); ld = 32; valid = true; }
            else { src = INP(I_WIN); ld = 0; valid = false; }
            transpose_item(src, ld, valid, kb * 64, WSP(bf16, WS_WIN + l * WIN_L) + (size_t)(nb * 32) * D, scr, lane); continue; }
        r -= I_IN;
        if (r < I_OUT) { const int l = r / ((D / 32) * KB); r -= l * ((D / 32) * KB); const int nb = r / KB, kb = r % KB;
            transpose_item(INP(I_WOUT) + (size_t)l * D * D + nb * 32 + (lane & 31), D, true, kb * 64, WSP(bf16, WS_WOUT + l * WOUT_L) + (size_t)(nb * 32) * D, scr, lane); continue; }
        r -= I_OUT;
        if (r < I_GU) { const int le = r / (64 * KB); r -= le * (64 * KB); const int nb = r / KB, kb = r % KB; const int n0 = nb * 32;
            const int nn = n0 & 1023; const int drow = 256 * (nn >> 7) + (nn & 127) + ((n0 >= 1024) ? 128 : 0);
            transpose_item(INP(I_WGU) + (size_t)le * D * 2048 + n0 + (lane & 31), 2048, true, kb * 64, WSP(bf16, WS_WGU + le * WGU_E) + (size_t)drow * D, scr, lane); continue; }
        r -= I_GU;
        { const int le = r / (32 * KB); r -= le * (32 * KB); const int nb = r / KB, kb = r % KB;
            transpose_item(INP(I_WDN) + (size_t)le * D * D + nb * 32 + (lane & 31), D, true, kb * 64, WSP(bf16, WS_WDN + le * WDN_E) + (size_t)(nb * 32) * D, scr, lane); }
    }
}

__device__ __forceinline__ void pool_items(Frame& F, int l) {
    const float* p = WSP(float, WS_P); bf16* ycat = WSP(bf16, WS_YCAT);
    LAS float* dt = (LAS float*)(F.lds + RING_OFF + F.wave * 8192);
    const int gw = F.vcu * NWAVES + F.wave, NGW = F.G * NWAVES, lane = F.lane;
    for (int it = gw; it < (T / 32) * 4; it += NGW) {
        const int g = it & 3, tile = it >> 2, tok0 = tile * 32, t0 = tok0 & (SEQ - 1);
        const int win = 2 << g; const int col = 64 * g + lane;
        const float* pc = p + (size_t)tok0 * PC + col;
        float s = 0.f;
        for (int j = 1; j < win; ++j) if (t0 - j >= 0) s += pc[-(ptrdiff_t)j * PC];
        for (int t = 0; t < 32; ++t) {
            const float u = pc[(size_t)t * PC]; s += u;
            const int cnt = min(t0 + t + 1, win);
            dt[t * 64 + lane] = s / (float)cnt - u;
            const int tb = t0 + t - win + 1;
            if (tb >= 0) s -= pc[(ptrdiff_t)(t - win + 1) * PC];
        }
        LDS_WAIT(); asm volatile("" ::: "memory");
        float w[64];
        const float* pw = INP(I_POOLW) + ((size_t)(l * 4 + g) * 64) * 64 + lane;
#pragma unroll
        for (int i = 0; i < 64; ++i) w[i] = pw[i * 64];
        const float sc = INP(I_POOLS)[l * 256 + col];
        for (int t = 0; t < 32; ++t) {
            float a0 = 0.f, a1 = 0.f, a2 = 0.f, a3 = 0.f;
#pragma unroll
            for (int i = 0; i < 64; i += 4) { const f32x4 d = *(const LAS f32x4*)(dt + t * 64 + i); a0 += d.x * w[i]; a1 += d.y * w[i + 1]; a2 += d.z * w[i + 2]; a3 += d.w * w[i + 3]; }
            ycat[(size_t)(tok0 + t) * D + col] = (bf16)f2bf(((a0 + a1) + (a2 + a3)) * sc);
        }
        LDS_WAIT(); asm volatile("" ::: "memory");
    }
}

constexpr int XS_PITCH = 1440;
__device__ __forceinline__ void rwkv_prep(Frame& F, int l) {
    const float* p = WSP(float, WS_P);
    LAS float* xs = (LAS float*)(F.lds + RING_OFF);
    const float* mu = INP(I_MU) + l * RWC;
    float* vfirst = WSP(float, WS_VFIRST);
    float *oR = WSP(float, WS_RR), *oLW = WSP(float, WS_RLW), *oK = WSP(float, WS_RK), *oV = WSP(float, WS_RV), *oNA = WSP(float, WS_RNA), *oBB = WSP(float, WS_RBB), *oG = WSP(float, WS_RG), *oSB = WSP(float, WS_RSB);
    for (int grp = F.vcu; grp < T / 8; grp += F.G) {
        const int tok0 = grp * 8;
        for (int idx = F.tid; idx < 8 * RWC; idx += NWAVES * 64) {
            const int tk = idx / RWC, j = idx - tk * RWC; const int tok = tok0 + tk;
            const float cur = p[(size_t)tok * PC + P_RW + j];
            const float prev = ((tok & (SEQ - 1)) == 0) ? 0.f : p[(size_t)(tok - 1) * PC + P_RW + j];
            float x = cur + mu[j] * (prev - cur);
            if (j >= 1152 && j < 1216) x = tanhf(x);
            else if (j >= 1280) x = sigmoidf_(x);
            xs[tk * XS_PITCH + j] = x;
        }
        if (l == 1) for (int idx = F.tid; idx < 8 * 32; idx += NWAVES * 64) { const int tk = idx >> 5, j = idx & 31; xs[tk * XS_PITCH + RWC + j] = p[(size_t)(tok0 + tk) * PC + P_V1 + j]; }
        __syncthreads();
        if (F.wave < 6) {
            const int h = F.wave, ch = 64 * h + F.lane;
            float dw[8], da[8], dg[8], dv[8];
#pragma unroll
            for (int t = 0; t < 8; ++t) { dw[t] = 0.f; da[t] = 0.f; dg[t] = 0.f; dv[t] = 0.f; }
            const float* w2 = INP(I_W2) + (size_t)l * 64 * RW + ch; const float* a2 = INP(I_A2) + (size_t)l * 64 * RW + ch; const float* g2 = INP(I_G2) + (size_t)l * 128 * RW + ch;
#pragma unroll 1
            for (int j = 0; j < 64; j += 4) {
                float wv[4], av[4];
#pragma unroll
                for (int q = 0; q < 4; ++q) { wv[q] = w2[(size_t)(j + q) * RW]; av[q] = a2[(size_t)(j + q) * RW]; }
#pragma unroll
                for (int t = 0; t < 8; ++t) { const f32x4 xw = *(const LAS f32x4*)(xs + t * XS_PITCH + 1152 + j); const f32x4 xa = *(const LAS f32x4*)(xs + t * XS_PITCH + 1216 + j);
                    dw[t] += xw.x * wv[0] + xw.y * wv[1] + xw.z * wv[2] + xw.w * wv[3]; da[t] += xa.x * av[0] + xa.y * av[1] + xa.z * av[2] + xa.w * av[3]; }
            }
#pragma unroll 1
            for (int j = 0; j < 128; j += 4) {
                float gv[4];
#pragma unroll
                for (int q = 0; q < 4; ++q) gv[q] = g2[(size_t)(j + q) * RW];
#pragma unroll
                for (int t = 0; t < 8; ++t) { const f32x4 xg = *(const LAS f32x4*)(xs + t * XS_PITCH + 1280 + j); dg[t] += xg.x * gv[0] + xg.y * gv[1] + xg.z * gv[2] + xg.w * gv[3]; }
            }
            if (l == 1) { const float* v2 = INP(I_V2) + ch;
#pragma unroll 1
                for (int j = 0; j < 32; j += 4) {
                    float vv[4];
#pragma unroll
                    for (int q = 0; q < 4; ++q) vv[q] = v2[(size_t)(j + q) * RW];
#pragma unroll
                    for (int t = 0; t < 8; ++t) { const f32x4 xv = *(const LAS f32x4*)(xs + t * XS_PITCH + RWC + j); dv[t] += xv.x * vv[0] + xv.y * vv[1] + xv.z * vv[2] + xv.w * vv[3]; }
                } }
            LAS float* accl = (LAS float*)(F.lds + RING_OFF + 49152) + h * 2048;
#pragma unroll
            for (int t = 0; t < 8; ++t) { accl[(0 * 8 + t) * 64 + F.lane] = dw[t]; accl[(1 * 8 + t) * 64 + F.lane] = da[t]; accl[(2 * 8 + t) * 64 + F.lane] = dg[t]; accl[(3 * 8 + t) * 64 + F.lane] = dv[t]; }
            LDS_WAIT(); asm volatile("" ::: "memory");
            const float w0 = INP(I_W0)[l * RW + ch], a0 = INP(I_A0)[l * RW + ch], kks = INP(I_KKS)[l * RW + ch], ka = INP(I_KA)[l * RW + ch], rk = INP(I_RK)[l * RW + ch];
            const float v0 = (l == 1) ? INP(I_V0)[ch] : 0.f;
#pragma unroll 1
            for (int t = 0; t < 8; ++t) {
                const int tok = tok0 + t; const size_t o = (size_t)tok * RW + ch;
                const float dwt = accl[(0 * 8 + t) * 64 + F.lane], dat = accl[(1 * 8 + t) * 64 + F.lane], dgt = accl[(2 * 8 + t) * 64 + F.lane], dvt = accl[(3 * 8 + t) * 64 + F.lane];
                const float r = xs[t * XS_PITCH + ch], k = xs[t * XS_PITCH + 384 + ch]; float v = xs[t * XS_PITCH + 768 + ch];
                const float wlog = -softplusf_(-(w0 + dwt)) - 0.5f; const float lw = -__expf(wlog);
                const float ai = sigmoidf_(a0 + dat);
                if (l == 0) vfirst[o] = v; else { const float vg = sigmoidf_(v0 + dvt); v = v + (vfirst[o] - v) * vg; }
                const float kkv = k * kks; const float nrm = sqrtf(wave_sum(kkv * kkv)); const float kk = kkv / fmaxf(nrm, 1e-12f);
                const float kp = k * (1.0f + (ai - 1.0f) * ka);
                const float sb = wave_sum(r * kp * rk);
                oR[o] = r; oLW[o] = lw; oK[o] = kp; oV[o] = v; oNA[o] = -kk; oBB[o] = kk * ai; oG[o] = dgt;
                if (F.lane == 0) oSB[tok * 8 + h] = sb;
            }
        }
        __syncthreads();
    }
}

__device__ __forceinline__ void mlstm_qk_tile(Frame& F, int l, int b, int c, int h, int which, LAS float* tile) {
    const float* p = WSP(float, WS_P);
    const float* cw = INP(I_CONVW) + (size_t)l * 4 * 768 + which * 384 + 64 * h; const float* cb = INP(I_CONVB) + l * 768 + which * 384 + 64 * h;
    const int pcol = P_ML + which * 384 + 64 * h;
    for (int idx = F.tid; idx < 4096; idx += NWAVES * 64) {
        const int s = idx >> 6, d = idx & 63; const int tl = 64 * c + s; const size_t tok = (size_t)b * SEQ + tl;
        float acc = cb[d];
#pragma unroll
        for (int i = 0; i < 4; ++i) { const int tt = tl - 3 + i; if (tt >= 0) acc += cw[i * 768 + d] * p[(tok - 3 + i) * PC + pcol + d]; }
        float y = acc * sigmoidf_(acc); if (which == 0) y *= 0.125f;
        tile[s * 65 + d] = y;
    }
}
__device__ __forceinline__ void mlstm_summ(Frame& F, int l) {
    const float* p = WSP(float, WS_P);
    LAS float* kt = (LAS float*)(F.lds + RING_OFF);
    LAS float* vt = kt + 64 * 65;
    LAS float* we = vt + 64 * 64;
    float* kvloc = WSP(float, WS_MKV); float* nloc = WSP(float, WS_MNL); float* msc = WSP(float, WS_MSC); float* mlg = WSP(float, WS_MLG); float* mli = WSP(float, WS_MLI);
    for (int item = F.vcu; item < NITEM; item += F.G) {
        const int h = item % 6, bc = item / 6, c = bc % NCH, b = bc / NCH;
        const size_t tokb = (size_t)b * SEQ + 64 * c;
        if (F.wave == 0) {
            const size_t tok = tokb + F.lane;
            const float ig = p[tok * PC + P_ML + 1536 + h] + INP(I_BI)[l * 6 + h];
            const float lf = logsigmoidf_(p[tok * PC + P_ML + 1542 + h] + INP(I_BF)[l * 6 + h]);
            float g = lf;
#pragma unroll
            for (int o = 1; o < 64; o <<= 1) { const float t = __shfl_up(g, o); if (F.lane >= o) g += t; }
            const float glast = __shfl(g, 63);
            const float e = glast - g + ig; const float mloc = wave_max(e);
            we[F.lane] = __expf(e - mloc);
            mlg[tok * 8 + h] = g; mli[tok * 8 + h] = ig;
            if (F.lane == 0) { msc[item * 4 + 0] = mloc; msc[item * 4 + 1] = glast; }
        }
        mlstm_qk_tile(F, l, b, c, h, 1, kt);
        for (int idx = F.tid; idx < 4096; idx += NWAVES * 64) { const int s = idx >> 6, d = idx & 63; vt[idx] = p[(tokb + s) * PC + P_ML + 768 + 64 * h + d]; }
        __syncthreads();
        { const int kd = F.tid >> 3, v0 = (F.tid & 7) * 8;
          float acc[8]; float an = 0.f;
#pragma unroll
          for (int j = 0; j < 8; ++j) acc[j] = 0.f;
          for (int s = 0; s < 64; ++s) { const float kw = we[s] * kt[s * 65 + kd]; an += kw; const f32x4 va = *(const LAS f32x4*)(vt + s * 64 + v0), vb = *(const LAS f32x4*)(vt + s * 64 + v0 + 4);
              acc[0] += kw * va.x; acc[1] += kw * va.y; acc[2] += kw * va.z; acc[3] += kw * va.w; acc[4] += kw * vb.x; acc[5] += kw * vb.y; acc[6] += kw * vb.z; acc[7] += kw * vb.w; }
          float* o = kvloc + (size_t)item * 4096 + kd * 64 + v0;
          *(f32x4*)o = (f32x4){acc[0], acc[1], acc[2], acc[3]}; *(f32x4*)(o + 4) = (f32x4){acc[4], acc[5], acc[6], acc[7]};
          if ((F.tid & 7) == 0) nloc[item * 64 + kd] = an; }
        __syncthreads();
    }
}

__device__ __forceinline__ void rwkv_scan_seq(Frame& F) {
    if (F.vcu >= 12) return;
    const int b = F.vcu / 6, h = F.vcu % 6;
    LAS float* L = (LAS float*)(F.lds + RING_OFF);
    LAS float* ybuf = L + 6 * 4096;
    const float* src[6] = {WSP(float, WS_RR), WSP(float, WS_RLW), WSP(float, WS_RK), WSP(float, WS_RV), WSP(float, WS_RNA), WSP(float, WS_RBB)};
    float* yraw = WSP(float, WS_RY);
    const int vrow = (F.tid >> 2) & 63, q = F.tid & 3;
    float S[16];
#pragma unroll
    for (int i = 0; i < 16; ++i) S[i] = 0.f;
    for (int blk = 0; blk < SEQ / 64; ++blk) {
        const size_t tokb = (size_t)b * SEQ + blk * 64;
#pragma unroll
        for (int a = 0; a < 6; ++a)
            for (int idx = F.tid; idx < 4096; idx += NWAVES * 64) { const int s = idx >> 6, d = idx & 63; float x = src[a][(tokb + s) * RW + 64 * h + d]; if (a == 1) x = __expf(x); L[a * 4096 + idx] = x; }
        __syncthreads();
        if (F.tid < 256) {
            for (int t = 0; t < 64; ++t) {
                const LAS float* base = L + t * 64 + 16 * q;
                float sa = 0.f;
#pragma unroll
                for (int i = 0; i < 16; ++i) sa += S[i] * base[4 * 4096 + i];
                sa += __shfl_xor(sa, 1); sa += __shfl_xor(sa, 2);
                const float vv = L[3 * 4096 + t * 64 + vrow];
                float y = 0.f;
#pragma unroll
                for (int i = 0; i < 16; ++i) { S[i] = S[i] * base[1 * 4096 + i] + sa * base[5 * 4096 + i] + vv * base[2 * 4096 + i]; y += S[i] * base[i]; }
                y += __shfl_xor(y, 1); y += __shfl_xor(y, 2);
                if (q == 0) ybuf[t * 64 + vrow] = y;
            }
        }
        __syncthreads();
        for (int idx = F.tid; idx < 4096; idx += NWAVES * 64) { const int s = idx >> 6, d = idx & 63; yraw[(tokb + s) * RW + 64 * h + d] = ybuf[idx]; }
        __syncthreads();
    }
}
__device__ __forceinline__ void mlstm_scan(Frame& F) {
    const int gt = F.vcu * (NWAVES * 64) + F.tid;
    const float* msc = WSP(float, WS_MSC);
    if (gt < 12 * 4096 + 12 * 64) {
        const bool isn = gt >= 12 * 4096;
        const int g2 = isn ? gt - 12 * 4096 : gt;
        const int bh = isn ? (g2 >> 6) : (g2 >> 12), el = isn ? (g2 & 63) : (g2 & 4095), b = bh / 6, h = bh % 6;
        const int es = isn ? 64 : 4096;
        const float* src = isn ? WSP(float, WS_MNL) : WSP(float, WS_MKV); float* dst = isn ? WSP(float, WS_MNP) : WSP(float, WS_MCP); float* mscw = WSP(float, WS_MSC);
        float C = 0.f, m = 0.f;
        for (int c0 = 0; c0 < NCH; c0 += 8) {
            float x[8], ml[8], gl[8];
#pragma unroll
            for (int i = 0; i < 8; ++i) { const int item = (b * NCH + c0 + i) * 6 + h; ml[i] = msc[item * 4 + 0]; gl[i] = msc[item * 4 + 1]; x[i] = src[(size_t)item * es + el]; }
#pragma unroll
            for (int i = 0; i < 8; ++i) { const int item = (b * NCH + c0 + i) * 6 + h;
                dst[(size_t)item * es + el] = C;
                if (!isn && el == 0) mscw[item * 4 + 2] = m;
                const float mn = fmaxf(gl[i] + m, ml[i]); const float ao = __expf(gl[i] + m - mn), an = __expf(ml[i] - mn);
                C = ao * C + an * x[i]; m = mn; }
        }
    }
}

__device__ __forceinline__ void rwkv_finish(Frame& F, int l) {
    const float* yraw = WSP(float, WS_RY); const float* v = WSP(float, WS_RV); const float* g = WSP(float, WS_RG); const float* sb = WSP(float, WS_RSB);
    bf16* ycat = WSP(bf16, WS_YCAT);
    const int gw = F.vcu * NWAVES + F.wave, NGW = F.G * NWAVES, lane = F.lane;
    for (int tok = gw; tok < T; tok += NGW) {
#pragma unroll
        for (int h = 0; h < 6; ++h) {
            const size_t o = (size_t)tok * RW + 64 * h + lane;
            const float y = yraw[o]; const float mean = wave_sum(y) * (1.f / 64.f); const float d = y - mean; const float var = wave_sum(d * d) * (1.f / 64.f);
            float r = d * (1.0f / sqrtf(var + GN_EPS)) * INP(I_LNXG)[l * RW + 64 * h + lane] + INP(I_LNXB)[l * RW + 64 * h + lane];
            r += sb[tok * 8 + h] * v[o];
            r *= g[o];
            ycat[(size_t)tok * D + 256 + 64 * h + lane] = (bf16)f2bf(r);
        }
    }
}
__device__ __forceinline__ void mlstm_out(Frame& F, int l) {
    const float* p = WSP(float, WS_P);
    LAS float* qt = (LAS float*)(F.lds + RING_OFF);
    LAS float* kt = qt + 64 * 65;
    LAS float* At = kt + 64 * 65;
    LAS float* vt = At + 64 * 65;
    LAS float* cpt = vt + 4096;
    LAS float* sm = cpt + 4096;
    const float* cp = WSP(float, WS_MCP); const float* np = WSP(float, WS_MNP); const float* msc = WSP(float, WS_MSC); const float* mlg = WSP(float, WS_MLG); const float* mli = WSP(float, WS_MLI);
    bf16* ycat = WSP(bf16, WS_YCAT);
    for (int item = F.vcu; item < NITEM; item += F.G) {
        const int h = item % 6, bc = item / 6, c = bc % NCH, b = bc / NCH;
        const size_t tokb = (size_t)b * SEQ + 64 * c;
        mlstm_qk_tile(F, l, b, c, h, 0, qt);
        mlstm_qk_tile(F, l, b, c, h, 1, kt);
        for (int idx = F.tid; idx < 4096; idx += NWAVES * 64) { const int s = idx >> 6, d = idx & 63; vt[idx] = p[(tokb + s) * PC + P_ML + 768 + 64 * h + d]; cpt[idx] = cp[(size_t)item * 4096 + idx]; }
        if (F.tid < 64) { sm[F.tid] = mlg[(tokb + F.tid) * 8 + h]; sm[64 + F.tid] = mli[(tokb + F.tid) * 8 + h]; sm[128 + F.tid] = np[item * 64 + F.tid]; }
        const float mprev = msc[item * 4 + 2];
        __syncthreads();
        const int j = F.tid >> 3, sub = F.tid & 7;
        { const int s0 = sub * 8;
          float acc[8];
#pragma unroll
          for (int i = 0; i < 8; ++i) acc[i] = 0.f;
          for (int d = 0; d < 64; ++d) { const float qv = qt[j * 65 + d];
#pragma unroll
              for (int i = 0; i < 8; ++i) acc[i] += qv * kt[(s0 + i) * 65 + d]; }
          const float gj = sm[j];
          float dl[8]; float mx = -INFINITY;
#pragma unroll
          for (int i = 0; i < 8; ++i) { const int s = s0 + i; dl[i] = (s <= j) ? (gj - sm[s] + sm[64 + s]) : -INFINITY; mx = fmaxf(mx, dl[i]); }
          mx = fmaxf(mx, __shfl_xor(mx, 1)); mx = fmaxf(mx, __shfl_xor(mx, 2)); mx = fmaxf(mx, __shfl_xor(mx, 4));
          const float il = gj + mprev; const float mj = fmaxf(mx, il);
          float dsum = 0.f;
#pragma unroll
          for (int i = 0; i < 8; ++i) { const int s = s0 + i; const float w = (s <= j) ? __expf(dl[i] - mj) * acc[i] : 0.f; At[j * 65 + s] = w; dsum += w; }
          dsum += __shfl_xor(dsum, 1); dsum += __shfl_xor(dsum, 2); dsum += __shfl_xor(dsum, 4);
          if (sub == 0) { float qn = 0.f; for (int d = 0; d < 64; ++d) qn += qt[j * 65 + d] * sm[128 + d];
              const float wi = __expf(il - mj); const float den = dsum + wi * qn;
              sm[192 + j] = wi; sm[256 + j] = 1.0f / fmaxf(fabsf(den), __expf(-mj)); } }
        __syncthreads();
        { const int v0 = sub * 8;
          float acc[8];
#pragma unroll
          for (int i = 0; i < 8; ++i) acc[i] = 0.f;
          for (int s = 0; s <= j; ++s) { const float a = At[j * 65 + s]; const f32x4 va = *(const LAS f32x4*)(vt + s * 64 + v0), vb = *(const LAS f32x4*)(vt + s * 64 + v0 + 4);
              acc[0] += a * va.x; acc[1] += a * va.y; acc[2] += a * va.z; acc[3] += a * va.w; acc[4] += a * vb.x; acc[5] += a * vb.y; acc[6] += a * vb.z; acc[7] += a * vb.w; }
          const float wi = sm[192 + j];
          for (int d = 0; d < 64; ++d) { const float a = qt[j * 65 + d] * wi; const f32x4 va = *(const LAS f32x4*)(cpt + d * 64 + v0), vb = *(const LAS f32x4*)(cpt + d * 64 + v0 + 4);
              acc[0] += a * va.x; acc[1] += a * va.y; acc[2] += a * va.z; acc[3] += a * va.w; acc[4] += a * vb.x; acc[5] += a * vb.y; acc[6] += a * vb.z; acc[7] += a * vb.w; }
          const float di = sm[256 + j];
          float sum = 0.f;
#pragma unroll
          for (int i = 0; i < 8; ++i) { acc[i] *= di; sum += acc[i]; }
          sum += __shfl_xor(sum, 1); sum += __shfl_xor(sum, 2); sum += __shfl_xor(sum, 4);
          const float mean = sum * (1.f / 64.f); float vs = 0.f;
#pragma unroll
          for (int i = 0; i < 8; ++i) { acc[i] -= mean; vs += acc[i] * acc[i]; }
          vs += __shfl_xor(vs, 1); vs += __shfl_xor(vs, 2); vs += __shfl_xor(vs, 4);
          const float rstd = 1.0f / sqrtf(vs * (1.f / 64.f) + LN_EPS);
          const size_t tok = tokb + j;
          const float* og = p + tok * PC + P_ML + 1152 + 64 * h + v0; const float* ng = INP(I_NORMG) + l * 384 + 64 * h + v0;
          float o[8];
#pragma unroll
          for (int i = 0; i < 8; ++i) o[i] = sigmoidf_(og[i]) * (acc[i] * rstd * ng[i]);
          v4u w; w.x = pk2(o[0], o[1]); w.y = pk2(o[2], o[3]); w.z = pk2(o[4], o[5]); w.w = pk2(o[6], o[7]);
          *(v4u*)(ycat + tok * D + 640 + 64 * h + v0) = w; }
        __syncthreads();
    }
}

__device__ __forceinline__ void ln_rows(Frame& F, const float* hin, const float* add, const float* gam, const float* bet, float* out32, bf16* h16) {
    const int gw = F.vcu * NWAVES + F.wave, NGW = F.G * NWAVES, lane = F.lane;
    for (int m = gw; m < T; m += NGW) {
        const GAS f32x4* hr = (const GAS f32x4*)(hin + (size_t)m * D) + lane; const GAS f32x4* ar = (const GAS f32x4*)(add + (size_t)m * D) + lane;
        f32x4 v[4]; float s = 0.f;
#pragma unroll
        for (int j = 0; j < 4; ++j) { v[j] = hr[64 * j] * DN_ALPHA + ar[64 * j]; s += (v[j].x + v[j].y) + (v[j].z + v[j].w); }
        const float mean = wave_sum(s) * (1.f / D); float s2 = 0.f;
#pragma unroll
        for (int j = 0; j < 4; ++j) { v[j] = v[j] - mean; s2 += (v[j].x * v[j].x + v[j].y * v[j].y) + (v[j].z * v[j].z + v[j].w * v[j].w); }
        const float rstd = 1.f / sqrtf(wave_sum(s2) * (1.f / D) + LN_EPS);
        GAS f32x4* o4 = (GAS f32x4*)(out32 + (size_t)m * D) + lane; GAS v2u* o2 = (GAS v2u*)(h16 + (size_t)m * D) + lane;
#pragma unroll
        for (int j = 0; j < 4; ++j) { const f32x4 gg = *((const f32x4*)gam + 64 * j + lane), bb = *((const f32x4*)bet + 64 * j + lane);
            const f32x4 r = v[j] * rstd * gg + bb; o4[64 * j] = r; v2u w; w.x = pk2(r.x, r.y); w.y = pk2(r.z, r.w); o2[64 * j] = w; }
    }
}
__device__ __forceinline__ void router_phase(Frame& F, int l, const float* h1) {
    LAS float* xs = (LAS float*)(F.lds + RING_OFF + F.wave * 16384);
    LAS unsigned* hist = (LAS unsigned*)(F.lds + LDSCTL_OFF);
    const float* rw = INP(I_RTW) + (size_t)l * D * NE; const float* rb = INP(I_RTB) + l * NE;
    int* tke = WSP(int, WS_TKE); float* tkg = WSP(float, WS_TKG);
    const int gw = F.vcu * NWAVES + F.wave, NGW = F.G * NWAVES, lane = F.lane;
    const int e = lane & 31, half = lane >> 5;
    for (int grp = gw; grp < T / 4; grp += NGW) {
        const int row0 = grp * 4;
#pragma unroll
        for (int r = 0; r < 4; ++r) { const GAS f32x4* xr = (const GAS f32x4*)(h1 + (size_t)(row0 + r) * D) + lane;
#pragma unroll
            for (int j = 0; j < 4; ++j) *(LAS f32x4*)(xs + r * 1024 + 4 * (64 * j + lane)) = xr[64 * j]; }
        LDS_WAIT(); asm volatile("" ::: "memory");
        float acc[4] = {0.f, 0.f, 0.f, 0.f};
        const float* wp = rw + (size_t)(512 * half) * NE + e;
        for (int k = 0; k < 512; k += 4) {
            const float w0 = wp[(size_t)(k + 0) * NE], w1 = wp[(size_t)(k + 1) * NE], w2 = wp[(size_t)(k + 2) * NE], w3 = wp[(size_t)(k + 3) * NE];
#pragma unroll
            for (int r = 0; r < 4; ++r) { const f32x4 x = *(const LAS f32x4*)(xs + r * 1024 + 512 * half + k); acc[r] += (x.x * w0 + x.y * w1) + (x.z * w2 + x.w * w3); }
        }
        const float bias = rb[e];
#pragma unroll
        for (int r = 0; r < 4; ++r) {
            float lg = acc[r] + __shfl_xor(acc[r], 32) + bias;
            float v = (lane < 32) ? lg : -INFINITY;
            float tv[4]; int ti[4];
#pragma unroll
            for (int i = 0; i < 4; ++i) { const float m = wave_max(v); const unsigned long long bal = __ballot(v == m); const int idx = __ffsll((long long)bal) - 1; tv[i] = m; ti[i] = idx; if (lane == idx) v = -INFINITY; }
            const float e1 = __expf(tv[1] - tv[0]), e2 = __expf(tv[2] - tv[0]), e3 = __expf(tv[3] - tv[0]); const float inv = 1.0f / (1.0f + e1 + e2 + e3);
            if (lane < 4) { const int ee = (lane == 0) ? ti[0] : (lane == 1) ? ti[1] : (lane == 2) ? ti[2] : ti[3]; const float gg = ((lane == 0) ? 1.0f : (lane == 1) ? e1 : (lane == 2) ? e2 : e3) * inv;
                tke[(row0 + r) * 4 + lane] = ee; tkg[(row0 + r) * 4 + lane] = gg; __hip_atomic_fetch_add(&hist[ee], 1u, __ATOMIC_RELAXED, __HIP_MEMORY_SCOPE_WORKGROUP); }
        }
        LDS_WAIT(); asm volatile("" ::: "memory");
    }
    __syncthreads();
    if (F.tid < NE) { const unsigned c = hist[F.tid]; if (c) __hip_atomic_fetch_add(F.ctl + CW_CNT + l * NE + F.tid, c, RLX_AGENT); }
    __syncthreads();
    if (F.tid < NE) hist[F.tid] = 0u;
    __syncthreads();
}
__device__ __forceinline__ void assign_phase(Frame& F, int l) {
    LAS unsigned* pst = (LAS unsigned*)(F.lds + RING_OFF);
    if (F.tid == 0) {
        unsigned run = 0;
        for (int e = 0; e < NE; ++e) { const unsigned c = __hip_atomic_load(F.ctl + CW_CNT + l * NE + e, RLX_AGENT); pst[e] = run; const unsigned nbk = (c + 255u) >> 8;
            if (blockIdx.x == 0) for (unsigned k = 0; k < nbk; ++k) __hip_atomic_store(F.ctl + CW_BLKE + l * 320 + (run >> 8) + k, (unsigned)e, RLX_AGENT);
            run += nbk << 8; }
        if (blockIdx.x == 0) __hip_atomic_store(F.ctl + CW_NB + l, run >> 8, RLX_AGENT);
    }
    __syncthreads();
    const int* tke = WSP(int, WS_TKE); const float* tkg = WSP(float, WS_TKG); int* slot_of = WSP(int, WS_SLOT); float* gsl = WSP(float, WS_GSL);
    const bf16* h16 = WSP(bf16, WS_H16); bf16* xg = WSP(bf16, WS_XG);
    const int gw = F.vcu * NWAVES + F.wave, NGW = F.G * NWAVES, lane = F.lane;
    for (int tok = gw; tok < T; tok += NGW) {
        int slot = 0;
        if (lane < 4) { const int e = tke[tok * 4 + lane]; const unsigned pos = __hip_atomic_fetch_add(F.ctl + CW_CUR + l * NE + e, 1u, RLX_AGENT); slot = (int)(pst[e] + pos);
            slot_of[tok * 4 + lane] = slot; gsl[slot] = tkg[tok * 4 + lane]; }
        const GAS v4u* src = (const GAS v4u*)(h16 + (size_t)tok * D) + lane; const v4u a = src[0], b = src[64];
#pragma unroll
        for (int i = 0; i < 4; ++i) { const int s = __shfl(slot, i); GAS v4u* dst = (GAS v4u*)(xg + (size_t)s * D) + lane; dst[0] = a; dst[64] = b; }
    }
}
__device__ __forceinline__ void combine_phase(Frame& F, const float* h1, const float* gam, const float* bet, float* out32, bf16* h16) {
    const int* slot_of = WSP(int, WS_SLOT); const bf16* osl = WSP(bf16, WS_OSL);
    const int gw = F.vcu * NWAVES + F.wave, NGW = F.G * NWAVES, lane = F.lane;
    for (int m = gw; m < T; m += NGW) {
        const GAS f32x4* hr = (const GAS f32x4*)(h1 + (size_t)m * D) + lane;
        f32x4 v[4];
#pragma unroll
        for (int j = 0; j < 4; ++j) v[j] = hr[64 * j] * DN_ALPHA;
        const int sl = (lane < 4) ? slot_of[m * 4 + lane] : 0;
#pragma unroll
        for (int i = 0; i < 4; ++i) { const int s = __shfl(sl, i); const GAS v2u* orow = (const GAS v2u*)(osl + (size_t)s * D) + lane;
#pragma unroll
            for (int j = 0; j < 4; ++j) { const v2u w = orow[64 * j]; v[j].x += bf2f(w.x & 0xffffu); v[j].y += bf2f(w.x >> 16); v[j].z += bf2f(w.y & 0xffffu); v[j].w += bf2f(w.y >> 16); } }
        float s = 0.f;
#pragma unroll
        for (int j = 0; j < 4; ++j) s += (v[j].x + v[j].y) + (v[j].z + v[j].w);
        const float mean = wave_sum(s) * (1.f / D); float s2 = 0.f;
#pragma unroll
        for (int j = 0; j < 4; ++j) { v[j] = v[j] - mean; s2 += (v[j].x * v[j].x + v[j].y * v[j].y) + (v[j].z * v[j].z + v[j].w * v[j].w); }
        const float rstd = 1.f / sqrtf(wave_sum(s2) * (1.f / D) + LN_EPS);
        GAS f32x4* o4 = (GAS f32x4*)(out32 + (size_t)m * D) + lane; GAS v2u* o2 = (GAS v2u*)(h16 + (size_t)m * D) + lane;
#pragma unroll
        for (int j = 0; j < 4; ++j) { const f32x4 gg = *((const f32x4*)gam + 64 * j + lane), bb = *((const f32x4*)bet + 64 * j + lane);
            const f32x4 r = v[j] * rstd * gg + bb; o4[64 * j] = r; v2u w; w.x = pk2(r.x, r.y); w.y = pk2(r.z, r.w); o2[64 * j] = w; }
    }
}

#ifndef MK_N_LAUNCHES
#define MK_N_LAUNCHES 1
#endif
constexpr int PH_PER_LAYER = 11, N_PHASES = 1 + DEPTH * PH_PER_LAYER;
struct Args { const float* in[34]; float* out; unsigned char* ws; int ph_lo, ph_hi; };
__global__ void __launch_bounds__(NWAVES * 64, 2) mk_fwd(Args args) {
    extern __shared__ __attribute__((aligned(16))) unsigned char lds[];
    Frame F0;
    F0.lds = (LAS unsigned char*)lds;
    F0.MISC = (volatile LAS unsigned*)(F0.lds + MISC_OFF);
    F0.tid = threadIdx.x; F0.lane = F0.tid & 63; F0.wave = __builtin_amdgcn_readfirstlane(F0.tid >> 6);
    F0.G = gridDim.x; { const int bx = blockIdx.x; F0.vcu = (F0.G % 8 == 0) ? (bx % 8) * (F0.G / 8) + bx / 8 : bx; }
    F0.ws = args.ws; F0.ctl = (gu32*)(args.ws + WS_CTL); F0.out = args.out;
    for (int u = F0.tid; u < (LDS_BYTES - LDSCTL_OFF) / 4; u += NWAVES * 64) ((LAS unsigned*)(F0.lds + LDSCTL_OFF))[u] = 0u;
    __syncthreads();
    if (F0.tid < 34) *(LAS unsigned long long*)(F0.lds + PTR_OFF + 8 * F0.tid) = (unsigned long long)args.in[F0.tid];
    __syncthreads();
    XcdBarrier bar; bar.bar = (unsigned*)(F0.ctl + CW_BAR); bar.x = 0; bar.st = nullptr;
    const int lo = args.ph_lo, hi = args.ph_hi;
    if (hi - lo > 1) bar = xcd_barrier_post((unsigned*)(F0.ctl + CW_BAR), F0.MISC + 8);
#define IN(k) (lo <= (k) && (k) < hi)
#define SEAM(k) do { if (IN(k) && IN((k) + 1)) xcd_barrier(bar); } while (0)

    if (IN(0)) { Frame F = launder(F0);
#ifndef SKIP_CONV
            phase_convert(F);
#endif
             } SEAM(0);

    for (int l_ = 0; l_ < DEPTH; ++l_) {
        const int l = launder_s(l_);
        const int pb = 1 + l * PH_PER_LAYER;
        if (IN(pb + 0)) { Frame F = launder(F0);
            pg8::Gemm g{WSP(pg8::bf16_t, WS_H16), WSP(pg8::bf16_t, WS_WIN + l * WIN_L), T, PC, D, 0};
            pg8::StaticOrder S; S.init(T, PC, F.G, (int)blockIdx.x);
            pg8::EpiF32 E{WSP(float, WS_P), PC};

#ifndef SKIP_G1
            pg8::gemm_phase<pg8::EpiF32, pg8::StaticOrder, true, true>(F.lds + RING_OFF, g, S, E);
#endif

        } SEAM(pb + 0);
        if (IN(pb + 1)) { Frame F = launder(F0);
#ifndef SKIP_PREP
            { Frame Fa = launder(F0); pool_items(Fa, launder_s(l)); } __syncthreads(); { Frame Fb = launder(F0); rwkv_prep(Fb, launder_s(l)); } { Frame Fc = launder(F0); mlstm_summ(Fc, launder_s(l)); }
#endif
             } SEAM(pb + 1);
        if (IN(pb + 2)) { Frame F = launder(F0);
#ifndef SKIP_SCAN
            { Frame Fa = launder(F0); mlstm_scan(Fa); } { Frame Fb = launder(F0); rwkv_scan_seq(Fb); }
#endif
             } SEAM(pb + 2);
        if (IN(pb + 3)) { Frame F = launder(F0);
#ifndef SKIP_FIN
            { Frame Fa = launder(F0); rwkv_finish(Fa, launder_s(l)); } { Frame Fb = launder(F0); mlstm_out(Fb, launder_s(l)); }
#endif
             } SEAM(pb + 3);
        if (IN(pb + 4)) { Frame F = launder(F0);
            pg8::Gemm g{WSP(pg8::bf16_t, WS_YCAT), WSP(pg8::bf16_t, WS_WOUT + l * WOUT_L), T, D, D, 0};
            pg8::StaticOrder S; S.init(T, D, F.G, (int)blockIdx.x);
            pg8::EpiF32 E{WSP(float, WS_MIX), D};

#ifndef SKIP_G2
            pg8::gemm_phase<pg8::EpiF32, pg8::StaticOrder, false, true>(F.lds + RING_OFF, g, S, E);
#endif

        } SEAM(pb + 4);
        if (IN(pb + 5)) { Frame F = launder(F0);
#ifndef SKIP_LN
            ln_rows(F, (l == 0) ? INP(I_X) : WSP(float, WS_HB), WSP(float, WS_MIX), INP(I_LN1G) + l * D, INP(I_LN1B) + l * D, WSP(float, WS_HA), WSP(bf16, WS_H16));
#endif
             } SEAM(pb + 5);
        if (IN(pb + 6)) { Frame F = launder(F0);
#ifndef SKIP_RT
            router_phase(F, l, WSP(float, WS_HA));
#endif
             } SEAM(pb + 6);
        if (IN(pb + 7)) { Frame F = launder(F0);
#ifndef SKIP_AS
            assign_phase(F, l);
#endif
             } SEAM(pb + 7);
        if (IN(pb + 8)) { Frame F = launder(F0);
            pg8::Gemm g{WSP(pg8::bf16_t, WS_XG), WSP(pg8::bf16_t, WS_WGU + (size_t)l * 32 * WGU_E), NSLOT, 2048, D, WGU_E};
            MoeOrder<8> S; S.nb = (int)__builtin_amdgcn_readfirstlane(__hip_atomic_load(F.ctl + CW_NB + l, RLX_AGENT)); S.c = (int)blockIdx.x; S.blke = F.ctl + CW_BLKE + l * 320;
            pg8::EpiSwiGLU E{WSP(pg8::bf16_t, WS_ACT), INP(I_BGU) + (size_t)l * NE * 2048};

#ifndef SKIP_GU
            pg8::gemm_phase<pg8::EpiSwiGLU, MoeOrder<8>, true, true>(F.lds + RING_OFF, g, S, E);
#endif

        } SEAM(pb + 8);
        if (IN(pb + 9)) { Frame F = launder(F0);
            pg8::Gemm g{WSP(pg8::bf16_t, WS_ACT), WSP(pg8::bf16_t, WS_WDN + (size_t)l * 32 * WDN_E), NSLOT, D, FF, WDN_E};
            MoeOrder<4> S; S.nb = (int)__builtin_amdgcn_readfirstlane(__hip_atomic_load(F.ctl + CW_NB + l, RLX_AGENT)); S.c = (int)blockIdx.x; S.blke = F.ctl + CW_BLKE + l * 320;
            pg8::EpiDown E{WSP(pg8::bf16_t, WS_OSL), INP(I_BDN) + (size_t)l * NE * D, WSP(float, WS_GSL)};

#ifndef SKIP_DN
            pg8::gemm_phase<pg8::EpiDown, MoeOrder<4>, true, true>(F.lds + RING_OFF, g, S, E);
#endif

        } SEAM(pb + 9);
        if (IN(pb + 10)) { Frame F = launder(F0);
#ifndef SKIP_CB
            combine_phase(F, WSP(float, WS_HA), INP(I_LN2G) + l * D, INP(I_LN2B) + l * D, (l == DEPTH - 1) ? F.out : WSP(float, WS_HB), WSP(bf16, WS_H16));
#endif
             } SEAM(pb + 10);
    }
#undef IN
#undef SEAM
}

extern "C" void kernel_launch(void* const* d_in, const int* in_sizes, int n_in, void* d_out, int out_size, void* d_ws, size_t ws_size, hipStream_t stream) {
    static int grid = 0;
    if (grid == 0) {
        if (n_in != 34 || in_sizes[0] != T * D || out_size != T * D || ws_size < WS_END) { fprintf(stderr, "kernel_launch: unexpected shapes / workspace (n_in %d, in0 %d, out %d, ws %zu, need %zu)\n", n_in, n_in > 0 ? in_sizes[0] : -1, out_size, ws_size, (size_t)WS_END); grid = -1; return; }
        int dev = 0, cus = 0, per_cu = 0;
        if (hipGetDevice(&dev) != hipSuccess || hipDeviceGetAttribute(&cus, hipDeviceAttributeMultiprocessorCount, dev) != hipSuccess) { grid = -1; return; }
        if (hipFuncSetAttribute((const void*)mk_fwd, hipFuncAttributeMaxDynamicSharedMemorySize, LDS_BYTES) != hipSuccess) { fprintf(stderr, "kernel_launch: hipFuncSetAttribute failed\n"); grid = -1; return; }
        if (hipOccupancyMaxActiveBlocksPerMultiprocessor(&per_cu, (const void*)mk_fwd, NWAVES * 64, LDS_BYTES) != hipSuccess || per_cu < 1) { fprintf(stderr, "kernel_launch: occupancy query says %d blocks per CU\n", per_cu); }
        (void)hipGetLastError();
        grid = cus;
        if (grid % 8 != 0 || grid > 256) grid = (grid > 256) ? 256 : (grid / 8) * 8;
    }
    if (grid <= 0) return;
    (void)hipMemsetAsync((char*)d_ws + WS_CTL, 0, CTL_ZERO_BYTES, stream);
    Args a{};
    for (int i = 0; i < 34; ++i) a.in[i] = (const float*)d_in[i];
    a.out = (float*)d_out; a.ws = (unsigned char*)d_ws;
#if MK_N_LAUNCHES == 1
    a.ph_lo = 0; a.ph_hi = N_PHASES;
    hipLaunchKernelGGL(mk_fwd, dim3(grid), dim3(NWAVES * 64), LDS_BYTES, stream, a);
#else
    for (int ph = 0; ph < N_PHASES; ++ph) { a.ph_lo = ph; a.ph_hi = ph + 1; hipLaunchKernelGGL(mk_fwd, dim3(grid), dim3(NWAVES * 64), LDS_BYTES, stream, a); }
#endif
}
```

```cpp
#include <hip/hip_runtime.h>
#include <cstdio>
#include <cstdint>
namespace pg8 {
#define PG8_LAS __attribute__((address_space(3)))
typedef unsigned short bf16_t;
typedef short bf16x8 __attribute__((ext_vector_type(8)));
typedef float f32x4 __attribute__((ext_vector_type(4)));
typedef unsigned u32x4 __attribute__((ext_vector_type(4)));
constexpr int BM = 256, BK = 64, HALF = 128, HTB = HALF * BK * 2  , STAGE_BYTES = 8 * HTB, NXCD = 8, WGM = 8;

__host__ __device__ __forceinline__ int lds_byte(int r, int c) { const int st = (r >> 4) * 2 + (c >> 5), rr = r & 15, cc = c & 31, ob = rr * 64 + cc * 2; return st * 1024 + (ob ^ (((ob >> 9) & 1) << 5)); }
__host__ __device__ __forceinline__ void stage_rc(int b, int& R, int& C) { const int st = b / 1024, sb = b % 1024, swz = sb ^ (((sb >> 9) & 1) << 5); R = (st >> 1) * 16 + swz / 64; C = (st & 1) * 32 + (swz % 64) / 2; }
__host__ __device__ __forceinline__ int perm32(int rho) { const int n = rho >> 4, i = rho & 15; return 8 * (i >> 2) + 4 * n + (i & 3); }

struct Unit { int pm, pn, e; };
struct Gemm { const bf16_t* A; const bf16_t* Bt; int M, N, K; size_t bstride; };

struct StaticOrder {
    int nM, nN, nwg, G, c;
    __host__ __device__ void init(int M, int N, int G_, int c_) { nM = M / BM; nN = N / BM; nwg = nM * nN; G = G_; c = c_; }
    __host__ __device__ bool next(int i, Unit& u) const {
        const long L = (long)i * G + c; if (L >= nwg) return false;
        int wgid = (int)L; { const int q = nwg / NXCD, r = nwg % NXCD, xcd = wgid % NXCD, off = wgid / NXCD; wgid = (xcd < r ? xcd * (q + 1) : r * (q + 1) + (xcd - r) * q) + off; }
        const int nig = WGM * nN, gid = wgid / nig, fm = gid * WGM, gsz = (nM - fm) < WGM ? (nM - fm) : WGM;
        u.pm = fm + ((wgid % nig) % gsz); u.pn = (wgid % nig) / gsz; u.e = 0; return true;
    }
    __device__ __forceinline__ void a_ready(const Unit&) const {}
    __device__ __forceinline__ void done(const Unit&) const {}
};

#define GAS_ __attribute__((address_space(1)))
__device__ __forceinline__ unsigned cvt_pk_bf16(float lo, float hi) { unsigned r; asm volatile("v_cvt_pk_bf16_f32 %0, %1, %2" : "=v"(r) : "v"(lo), "v"(hi)); return r; }

struct EpiF32 {
    static constexpr bool PERM = false, AFTER_DRAIN = false;
    GAS_ float* C; int ldc;
    __device__ __forceinline__ void operator()(const f32x4 (&acc)[2][2][4][2], const Unit& u, int wr, int wc, int fr, int fq) const {
        const int row0 = u.pm * BM + wr * 64 + fr, col0 = u.pn * BM + wc * 32 + 4 * fq;
#pragma unroll
        for (int ai = 0; ai < 2; ++ai)
#pragma unroll
            for (int m = 0; m < 4; ++m) { GAS_ float* rowp = C + (size_t)(row0 + ai * HALF + m * 16) * ldc + col0;
#pragma unroll
                for (int bj = 0; bj < 2; ++bj)
#pragma unroll
                    for (int n = 0; n < 2; ++n) *(GAS_ f32x4*)(rowp + bj * HALF + n * 16) = acc[ai][bj][m][n]; }
    }
};
struct EpiSwiGLU {
    static constexpr bool PERM = true, AFTER_DRAIN = false;
    GAS_ bf16_t* O; const GAS_ float* bias;
    __device__ __forceinline__ void operator()(const f32x4 (&acc)[2][2][4][2], const Unit& u, int wr, int wc, int fr, int fq) const {
        const int row0 = u.pm * BM + wr * 64 + fr; const int c0 = u.pn * HALF + wc * 32 + 8 * fq;
        const GAS_ float* bg = bias + (size_t)u.e * 2048 + c0; const GAS_ float* bl = bg + 1024;
        f32x4 bgv[2], blv[2];
#pragma unroll
        for (int n = 0; n < 2; ++n) { bgv[n] = *(const GAS_ f32x4*)(bg + 4 * n); blv[n] = *(const GAS_ f32x4*)(bl + 4 * n); }
#pragma unroll
        for (int ai = 0; ai < 2; ++ai)
#pragma unroll
            for (int m = 0; m < 4; ++m) {
                float o[8];
#pragma unroll
                for (int n = 0; n < 2; ++n) {
                    const f32x4 gv = acc[ai][0][m][n] + bgv[n], lv = acc[ai][1][m][n] + blv[n];
#pragma unroll
                    for (int j = 0; j < 4; ++j) {
                        const float gl = fminf(gv[j], 7.0f); const float li = fminf(fmaxf(lv[j], -7.0f), 7.0f);
                        const float sg = __builtin_amdgcn_rcpf(1.0f + __builtin_amdgcn_exp2f(-1.702f * 1.4426950408889634f * gl));
                        o[4 * n + j] = gl * sg * (li + 1.0f);
                    }
                }
                u32x4 w; w.x = cvt_pk_bf16(o[0], o[1]); w.y = cvt_pk_bf16(o[2], o[3]); w.z = cvt_pk_bf16(o[4], o[5]); w.w = cvt_pk_bf16(o[6], o[7]);
                *(GAS_ u32x4*)(O + (size_t)(row0 + ai * HALF + m * 16) * 1024 + c0) = w;
            }
    }
};
struct EpiDown {
    static constexpr bool PERM = true, AFTER_DRAIN = false;
    GAS_ bf16_t* O; const GAS_ float* bias; const GAS_ float* gate;
    __device__ __forceinline__ void operator()(const f32x4 (&acc)[2][2][4][2], const Unit& u, int wr, int wc, int fr, int fq) const {
        const int row0 = u.pm * BM + wr * 64 + fr; const int c0 = u.pn * BM + wc * 32 + 8 * fq;
        const GAS_ float* bb = bias + (size_t)u.e * 1024 + c0;
        f32x4 bv[2][2];
#pragma unroll
        for (int bj = 0; bj < 2; ++bj)
#pragma unroll
            for (int n = 0; n < 2; ++n) bv[bj][n] = *(const GAS_ f32x4*)(bb + bj * HALF + 4 * n);
#pragma unroll
        for (int ai = 0; ai < 2; ++ai)
#pragma unroll
            for (int m = 0; m < 4; ++m) { const int row = row0 + ai * HALF + m * 16; const float gt = gate[row];
#pragma unroll
                for (int bj = 0; bj < 2; ++bj) { const f32x4 v0 = (acc[ai][bj][m][0] + bv[bj][0]) * gt, v1 = (acc[ai][bj][m][1] + bv[bj][1]) * gt;
                    u32x4 w; w.x = cvt_pk_bf16(v0[0], v0[1]); w.y = cvt_pk_bf16(v0[2], v0[3]); w.z = cvt_pk_bf16(v1[0], v1[1]); w.w = cvt_pk_bf16(v1[2], v1[3]);
                    *(GAS_ u32x4*)(O + (size_t)row * 1024 + c0 + bj * HALF) = w; } }
    }
};

template <class Epi, class Sched, bool ALIGN_EPI = false, bool SP2 = false>
__device__ __forceinline__ void gemm_phase(PG8_LAS unsigned char* lds, const Gemm g, const Sched& S, const Epi& E) {
    int tid_ = threadIdx.x; asm volatile("" : "+v"(tid_));
    const int tid = tid_, wid = __builtin_amdgcn_readfirstlane(tid >> 6), lane = tid & 63, wr = wid >> 2, wc = wid & 3, fr = lane & 15, fq = lane >> 4;
    int K_ = g.K; asm volatile("" : "+s"(K_)); const int K = K_, nt = K / BK;
    unsigned voffA[2], voffB[2];
#pragma unroll
    for (int i = 0; i < 2; ++i) { int R, C; stage_rc(tid * 16 + i * 8192, R, C); const int Rb = Epi::PERM ? ((R & ~31) + perm32(R & 31)) : R;
        voffA[i] = (unsigned)(R * K + C) * 2u; voffB[i] = (unsigned)(Rb * K + C) * 2u; }
    const size_t kstep = (size_t)(BK * 2);
    const size_t hstep = (size_t)HALF * K * 2;
    const size_t tstep = 2 * hstep;
    const unsigned ldsw = (unsigned)wid * 1024u;
    const int aoff = lds_byte(wr * 64 + fr, fq * 8), boff = lds_byte(wc * 32 + fr, fq * 8);
#define PG8_SA(b, h) (((b) * 2 + (h)) * HTB)
#define PG8_SB(b, h) ((4 + (b) * 2 + (h)) * HTB)
#define PG8_STAGE(bufoff, gbase, voff) do { _Pragma("unroll") for (int _i = 0; _i < 2; ++_i) \
        __builtin_amdgcn_global_load_lds((const unsigned*)((const char*)(gbase) + (voff)[_i]), (PG8_LAS unsigned*)(lds + (bufoff) + ldsw + _i * 8192), 16, 0, 0); } while (0)
#define PG8_LDA(dst, b, h) do { _Pragma("unroll") for (int m = 0; m < 4; ++m) _Pragma("unroll") for (int k = 0; k < 2; ++k) dst[m][k] = *(const PG8_LAS bf16x8*)(lds + PG8_SA(b, h) + aoff + m * 2048 + k * 1024); } while (0)
#define PG8_LDB(dst, b, h) do { _Pragma("unroll") for (int n = 0; n < 2; ++n) _Pragma("unroll") for (int k = 0; k < 2; ++k) dst[n][k] = *(const PG8_LAS bf16x8*)(lds + PG8_SB(b, h) + boff + n * 2048 + k * 1024); } while (0)
#define PG8_MMA(ai, bj, At, Bt) do { __builtin_amdgcn_s_setprio(1); _Pragma("unroll") for (int m = 0; m < 4; ++m) _Pragma("unroll") for (int n = 0; n < 2; ++n) _Pragma("unroll") for (int k = 0; k < 2; ++k) \
        acc[ai][bj][m][n] = __builtin_amdgcn_mfma_f32_16x16x32_bf16(Bt[n][k], At[m][k], acc[ai][bj][m][n], 0, 0, 0); __builtin_amdgcn_s_setprio(0); } while (0)
#define PG8_WAIT_V(n) asm volatile("s_waitcnt vmcnt(" #n ")" ::: "memory")
#define PG8_WAIT_L(n) asm volatile("s_waitcnt lgkmcnt(" #n ")" ::: "memory")
#define PG8_BAR __builtin_amdgcn_s_barrier()
#define PG8_SCHED __builtin_amdgcn_sched_barrier(0)
    Unit cur, nxt; int ui = 0;
    if (!S.next(0, cur)) return;
    f32x4 acc[2][2][4][2];
#pragma unroll
    for (int a = 0; a < 2; ++a)
#pragma unroll
        for (int b = 0; b < 2; ++b)
#pragma unroll
            for (int m = 0; m < 4; ++m)
#pragma unroll
                for (int n = 0; n < 2; ++n) acc[a][b][m][n] = (f32x4){0.f, 0.f, 0.f, 0.f};
    bf16x8 At[4][2], B0[2][2], B1[2][2];
    const char* cA = (const char*)g.A + (size_t)cur.pm * tstep; const char* cB = (const char*)g.Bt + (size_t)cur.e * g.bstride + (size_t)cur.pn * tstep;
    S.a_ready(cur);
    if constexpr (SP2) {
        PG8_STAGE(PG8_SB(0, 0), cB, voffB); PG8_STAGE(PG8_SB(0, 1), cB + hstep, voffB); PG8_STAGE(PG8_SA(0, 0), cA, voffA); PG8_STAGE(PG8_SA(0, 1), cA + hstep, voffA);
        if (wr == 1) PG8_BAR;
        PG8_WAIT_V(2); PG8_BAR;
        PG8_STAGE(PG8_SB(1, 0), cB + kstep, voffB); PG8_STAGE(PG8_SA(1, 0), cA + kstep, voffA); PG8_STAGE(PG8_SB(1, 1), cB + hstep + kstep, voffB);
        PG8_WAIT_V(6); PG8_BAR;
    } else {
        PG8_STAGE(PG8_SB(0, 0), cB, voffB); PG8_STAGE(PG8_SA(0, 0), cA, voffA); PG8_STAGE(PG8_SB(0, 1), cB + hstep, voffB); PG8_STAGE(PG8_SA(0, 1), cA + hstep, voffA);
        if (wr == 1) PG8_BAR;
        PG8_WAIT_V(4); PG8_BAR;
        PG8_STAGE(PG8_SB(1, 0), cB + kstep, voffB); PG8_STAGE(PG8_SA(1, 0), cA + kstep, voffA); PG8_STAGE(PG8_SB(1, 1), cB + hstep + kstep, voffB);
        PG8_WAIT_V(6); PG8_BAR;
    }
    for (;;) {
        const bool has_next = S.next(ui + 1, nxt);
        const char* nA = has_next ? (const char*)g.A + (size_t)nxt.pm * tstep : cA; const char* nB = has_next ? (const char*)g.Bt + (size_t)nxt.e * g.bstride + (size_t)nxt.pn * tstep : cB;
        for (int t = 0; t < nt; t += 2) {
            const bool last = (t == nt - 2);
            const char* a1 = cA + (size_t)(t + 1) * kstep;
            const char* a2 = last ? nA : cA + (size_t)(t + 2) * kstep; const char* b2 = last ? nB : cB + (size_t)(t + 2) * kstep;
            const char* a3 = a2 + kstep; const char* b3 = b2 + kstep;
            if (last && has_next) S.a_ready(nxt);
            if constexpr (SP2) {
            PG8_LDB(B0, 0, 0); PG8_LDB(B1, 0, 1); PG8_SCHED; PG8_LDA(At, 0, 0); PG8_STAGE(PG8_SA(1, 1), a1 + hstep, voffA);
            PG8_WAIT_V(8); PG8_WAIT_L(0); PG8_BAR; PG8_MMA(0, 0, At, B0); PG8_MMA(0, 1, At, B1); PG8_BAR; PG8_SCHED;
            PG8_LDA(At, 0, 1); PG8_STAGE(PG8_SB(0, 0), b2, voffB); PG8_STAGE(PG8_SB(0, 1), b2 + hstep, voffB); PG8_STAGE(PG8_SA(0, 0), a2, voffA);
            PG8_WAIT_V(8); PG8_WAIT_L(0); PG8_BAR; PG8_MMA(1, 0, At, B0); PG8_MMA(1, 1, At, B1); PG8_BAR; PG8_SCHED;
            PG8_LDB(B0, 1, 0); PG8_LDB(B1, 1, 1); PG8_SCHED; PG8_LDA(At, 1, 0); PG8_STAGE(PG8_SA(0, 1), a2 + hstep, voffA);
            PG8_WAIT_V(8); PG8_WAIT_L(0); PG8_BAR; PG8_MMA(0, 0, At, B0); PG8_MMA(0, 1, At, B1); PG8_BAR; PG8_SCHED;
            PG8_LDA(At, 1, 1); PG8_STAGE(PG8_SB(1, 0), b3, voffB); PG8_STAGE(PG8_SB(1, 1), b3 + hstep, voffB); PG8_STAGE(PG8_SA(1, 0), a3, voffA);
            PG8_WAIT_V(8); PG8_WAIT_L(0); PG8_BAR; PG8_MMA(1, 0, At, B0); PG8_MMA(1, 1, At, B1); PG8_BAR; PG8_SCHED;
            } else {
            PG8_LDB(B0, 0, 0); PG8_SCHED; PG8_LDA(At, 0, 0); PG8_STAGE(PG8_SA(1, 1), a1 + hstep, voffA);
            PG8_WAIT_L(8); PG8_BAR; PG8_WAIT_L(0); PG8_MMA(0, 0, At, B0); PG8_BAR; PG8_SCHED;
            PG8_LDB(B1, 0, 1); PG8_STAGE(PG8_SB(0, 0), b2, voffB);
            PG8_BAR; PG8_WAIT_L(0); PG8_MMA(0, 1, At, B1); PG8_BAR;
            PG8_LDA(At, 0, 1); PG8_STAGE(PG8_SA(0, 0), a2, voffA);
            PG8_BAR; PG8_WAIT_L(0); PG8_MMA(1, 0, At, B0); PG8_BAR; PG8_SCHED;
            PG8_STAGE(PG8_SB(0, 1), b2 + hstep, voffB);
            PG8_WAIT_V(6); PG8_BAR; PG8_MMA(1, 1, At, B1); PG8_BAR;
            PG8_LDB(B0, 1, 0); PG8_SCHED; PG8_LDA(At, 1, 0); PG8_STAGE(PG8_SA(0, 1), a2 + hstep, voffA);
            PG8_WAIT_L(8); PG8_BAR; PG8_WAIT_L(0); PG8_MMA(0, 0, At, B0); PG8_BAR; PG8_SCHED;
            PG8_LDB(B1, 1, 1); PG8_STAGE(PG8_SB(1, 0), b3, voffB);
            PG8_BAR; PG8_WAIT_L(0); PG8_MMA(0, 1, At, B1); PG8_BAR;
            PG8_LDA(At, 1, 1); PG8_STAGE(PG8_SA(1, 0), a3, voffA);
            PG8_BAR; PG8_WAIT_L(0); PG8_MMA(1, 0, At, B0); PG8_BAR; PG8_SCHED;
            PG8_STAGE(PG8_SB(1, 1), b3 + hstep, voffB);
            PG8_WAIT_V(6); PG8_BAR; PG8_MMA(1, 1, At, B1); PG8_BAR;
            }
        }
        if constexpr (ALIGN_EPI) { if (wr == 0) PG8_BAR; }
        if constexpr (!Epi::AFTER_DRAIN) { E(acc, cur, wr, wc, fr, fq); S.done(cur); }
        if (!has_next) break;
#pragma unroll
        for (int a = 0; a < 2; ++a)
#pragma unroll
            for (int b = 0; b < 2; ++b)
#pragma unroll
                for (int m = 0; m < 4; ++m)
#pragma unroll
                    for (int n = 0; n < 2; ++n) acc[a][b][m][n] = (f32x4){0.f, 0.f, 0.f, 0.f};
        cur = nxt; cA = nA; cB = nB; ++ui;
        if constexpr (ALIGN_EPI) { if (wr == 1) PG8_BAR; }
    }
    PG8_WAIT_V(0);
    if constexpr (!ALIGN_EPI) { if (wr == 0) PG8_BAR; }
    PG8_BAR;
    if constexpr (Epi::AFTER_DRAIN) { E.fused(acc, cur, wr, wc, fr, fq, lds, wid, lane); S.done(cur); }
#undef PG8_SA
#undef PG8_SB
#undef PG8_STAGE
#undef PG8_LDA
#undef PG8_LDB
#undef PG8_MMA
#undef PG8_WAIT_V
#undef PG8_WAIT_L
#undef PG8_BAR
#undef PG8_SCHED
}
}
constexpr int NWAVES = 8;
constexpr int BATCH = 2, SEQ = 8192, D = 1024, T = BATCH * SEQ, DEPTH = 2;
constexpr int PC = 3328;
constexpr int DIN = 3212;
constexpr int P_RW = 256, P_ML = 1664, P_V1 = 3212;
constexpr int RW = 384, RWC = 1408;
constexpr int NE = 32, TOPK = 4, FF = 1024;
constexpr int MAXBLK = T * TOPK / 256 + NE;
constexpr int NSLOT = MAXBLK * 256;
constexpr float LN_EPS = 1e-5f, GN_EPS = 64e-5f;
constexpr float DN_ALPHA = 1.41421356237f;
constexpr int NCH = SEQ / 64;
constexpr int NITEM = BATCH * NCH * 6;

constexpr size_t MiB = 1u << 20;
constexpr size_t WS_CTL = 0, CTL_ZERO_BYTES = 1 * MiB;
constexpr size_t WS_WIN = 1 * MiB;
constexpr size_t WIN_L = (size_t)PC * D * 2;
constexpr size_t WS_WOUT = WS_WIN + 2 * WIN_L;
constexpr size_t WOUT_L = (size_t)D * D * 2;
constexpr size_t WS_WGU = WS_WOUT + 2 * WOUT_L;
constexpr size_t WGU_E = (size_t)2048 * D * 2;
constexpr size_t WS_WDN = WS_WGU + 64 * WGU_E;
constexpr size_t WDN_E = (size_t)D * D * 2;
constexpr size_t WS_H16 = WS_WDN + 64 * WDN_E;
constexpr size_t WS_HA = WS_H16 + (size_t)T * D * 2;
constexpr size_t WS_HB = WS_HA + (size_t)T * D * 4;
constexpr size_t WS_P = WS_HB + (size_t)T * D * 4;
constexpr size_t WS_MIX = WS_P + (size_t)T * PC * 4;
constexpr size_t WS_YCAT = WS_MIX + (size_t)T * D * 4;
constexpr size_t RWARR = (size_t)T * RW * 4;
constexpr size_t WS_VFIRST = WS_YCAT + (size_t)T * D * 2;
constexpr size_t WS_RR = WS_VFIRST + RWARR, WS_RLW = WS_RR + RWARR, WS_RK = WS_RLW + RWARR, WS_RV = WS_RK + RWARR;
constexpr size_t WS_RNA = WS_RV + RWARR, WS_RBB = WS_RNA + RWARR, WS_RG = WS_RBB + RWARR, WS_RY = WS_RG + RWARR;
constexpr size_t WS_RSB = WS_RY + RWARR;
constexpr size_t WS_MKV = WS_RSB + (size_t)T * 8 * 4;
constexpr size_t WS_MCP = WS_MKV + (size_t)NITEM * 4096 * 4;
constexpr size_t WS_MNL = WS_MCP + (size_t)NITEM * 4096 * 4;
constexpr size_t WS_MNP = WS_MNL + (size_t)NITEM * 64 * 4;
constexpr size_t WS_MSC = WS_MNP + (size_t)NITEM * 64 * 4;
constexpr size_t WS_MLG = WS_MSC + (size_t)NITEM * 4 * 4;
constexpr size_t WS_MLI = WS_MLG + (size_t)T * 8 * 4;
constexpr size_t WS_XG = ((WS_MLI + (size_t)T * 8 * 4 + MiB - 1) / MiB) * MiB;
constexpr size_t WS_ACT = WS_XG + (size_t)NSLOT * D * 2;
constexpr size_t WS_OSL = WS_ACT + (size_t)NSLOT * FF * 2;
constexpr size_t WS_TKE = WS_OSL + (size_t)NSLOT * D * 2;
constexpr size_t WS_TKG = WS_TKE + (size_t)T * 4 * 4;
constexpr size_t WS_SLOT = WS_TKG + (size_t)T * 4 * 4;
constexpr size_t WS_GSL = WS_SLOT + (size_t)T * 4 * 4;
constexpr size_t CH_STRIDE = 49408;
constexpr size_t WS_RCH = ((WS_GSL + (size_t)NSLOT * 4 + MiB - 1) / MiB) * MiB;
constexpr size_t CO_STRIDE = 32768;
constexpr size_t WS_RCO = WS_RCH + (size_t)NITEM * CH_STRIDE;
constexpr size_t WS_RS0 = WS_RCO + (size_t)NITEM * CO_STRIDE;
constexpr size_t WS_RUT = WS_RS0 + (size_t)NITEM * 8192;
constexpr size_t WS_LORA = WS_RUT + (size_t)NITEM * 8192;
constexpr size_t WS_END = WS_LORA + 2 * 221184;
constexpr int CW_BAR = 4096;
constexpr int CW_CNT = 8192;
constexpr int CW_CUR = 8192 + 64;
constexpr int CW_NB = 8192 + 128;
constexpr int CW_BLKE = 8192 + 256;

constexpr int RING_OFF = 0, RING_BYTES = 131072;
constexpr int LDSCTL_OFF = RING_BYTES, PTR_OFF = LDSCTL_OFF + 512, MISC_OFF = LDSCTL_OFF + 1024;
constexpr int LDS_BYTES = 147456;

#define GAS __attribute__((address_space(1)))
#define LAS __attribute__((address_space(3)))
typedef unsigned short bf16;
typedef unsigned v4u __attribute__((ext_vector_type(4)));
typedef unsigned v2u __attribute__((ext_vector_type(2)));
typedef float f32x4 __attribute__((ext_vector_type(4)));
typedef GAS unsigned gu32;
#define RLX_AGENT __ATOMIC_RELAXED, __HIP_MEMORY_SCOPE_AGENT
#define LDS_WAIT() asm volatile("s_waitcnt lgkmcnt(0)" ::: "memory")
#define VM_WAIT() asm volatile("s_waitcnt vmcnt(0)" ::: "memory")
__device__ __forceinline__ unsigned f2bf(float f) { unsigned u = __builtin_bit_cast(unsigned, f); return (u + 0x7fffu + ((u >> 16) & 1u)) >> 16; }
__device__ __forceinline__ unsigned pk2(float lo, float hi) { return f2bf(lo) | (f2bf(hi) << 16); }
__device__ __forceinline__ float bf2f(unsigned b) { return __builtin_bit_cast(float, b << 16); }
__device__ __forceinline__ float wave_sum(float v) {
#pragma unroll
    for (int o = 1; o < 64; o <<= 1) v += __shfl_xor(v, o);
    return v;
}
__device__ __forceinline__ float wave_max(float v) {
#pragma unroll
    for (int o = 1; o < 64; o <<= 1) v = fmaxf(v, __shfl_xor(v, o));
    return v;
}
__device__ __forceinline__ float sigmoidf_(float x) { return 1.0f / (1.0f + __expf(-x)); }
__device__ __forceinline__ float softplusf_(float x) { return fmaxf(x, 0.f) + log1pf(__expf(-fabsf(x))); }
__device__ __forceinline__ float logsigmoidf_(float x) { return fminf(x, 0.f) - log1pf(__expf(-fabsf(x))); }

#define XB_TMO      128
#define XB_XCNT(j)  (256  + 64 * (j))
#define XB_XSUB(j)  (1280 + 64 * (j))
#define XB_XGEN(j)  (2304 + 64 * (j))
#define XB_TOP      3328
#define XB_TOPGEN   3392
#define XCD_BAR_WORDS 3456
#define XB_SPIN_CAP (1u << 18)

__device__ __forceinline__ unsigned xb_ld(unsigned* p)              { return __hip_atomic_load(p, __ATOMIC_RELAXED, __HIP_MEMORY_SCOPE_AGENT); }
__device__ __forceinline__ unsigned xb_add(unsigned* p, unsigned v) { return __hip_atomic_fetch_add(p, v, __ATOMIC_RELAXED, __HIP_MEMORY_SCOPE_AGENT); }
__device__ __forceinline__ unsigned xb_xcc_id() { return (unsigned)__builtin_amdgcn_s_getreg((3 << 11) | 20) & 0xFu; }
#define XB_SPIN(cond, bar) do { unsigned _sp = 0; while (cond) { __builtin_amdgcn_s_sleep(1); \
    if ((++_sp & 255u) == 0u) { if (xb_ld(&(bar)[XB_TMO])) break; if (_sp > XB_SPIN_CAP) { atomicAdd(&(bar)[XB_TMO], 1u); break; } } } } while (0)

struct XcdBarrier {
    unsigned* bar; unsigned x;
    volatile LAS unsigned* st;
};

__device__ __forceinline__ XcdBarrier xcd_barrier_post(unsigned* bar, volatile LAS unsigned* st) {
    XcdBarrier b; b.bar = bar; b.x = xb_xcc_id(); b.st = st;
    if (threadIdx.x == 0) (void)xb_add(&bar[XB_XCNT(b.x)], 1u);
    return b;
}
__device__ __forceinline__ void xcd_barrier_complete(unsigned* bar, unsigned x, unsigned& nloc, unsigned& nx) {
    const unsigned G = gridDim.x * gridDim.y * gridDim.z;
    unsigned sum, cnt, mine, sp = 0u;
    for (;;) {
        sum = 0u; cnt = 0u; mine = 0u;
#pragma unroll
        for (unsigned j = 0; j < 16; ++j) { const unsigned c = xb_ld(&bar[XB_XCNT(j)]); sum += c; cnt += (c > 0u) ? 1u : 0u; mine = (j == x) ? c : mine; }
        if (sum == G) break;
        __builtin_amdgcn_s_sleep(1);
        if ((++sp & 255u) == 0u) { if (xb_ld(&bar[XB_TMO])) break; if (sp > XB_SPIN_CAP) { atomicAdd(&bar[XB_TMO], 1u); break; } }
    }
    nloc = mine > 0u ? mine : 1u; nx = cnt > 0u ? cnt : 1u;
}

__device__ __forceinline__ void xcd_barrier(const XcdBarrier& b) {
    asm volatile("s_waitcnt vmcnt(0)" ::: "memory");
    __syncthreads();
    if (threadIdx.x == 0) {
        unsigned* bar = b.bar;
        __builtin_amdgcn_s_waitcnt(0);
        unsigned nloc = b.st[0], nx = b.st[1];
        if (nloc == 0u) { xcd_barrier_complete(bar, b.x, nloc, nx); b.st[0] = nloc; b.st[1] = nx; }
        const unsigned old = xb_add(&bar[XB_XSUB(b.x)], 1u);
        const unsigned gen = old / nloc;
        if (old + 1u == (gen + 1u) * nloc) {
            __builtin_amdgcn_fence(__ATOMIC_RELEASE, "agent");
            asm volatile("s_waitcnt vmcnt(0)" ::: "memory");
            const unsigned og = xb_add(&bar[XB_TOP], 1u);
            const unsigned tg = og / nx;
            if (og + 1u == (tg + 1u) * nx) xb_add(&bar[XB_TOPGEN], 1u);
            else XB_SPIN(xb_ld(&bar[XB_TOPGEN]) == tg, bar);
            __builtin_amdgcn_fence(__ATOMIC_ACQUIRE, "agent");
            xb_add(&bar[XB_XGEN(b.x)], 1u);
            asm volatile("s_waitcnt vmcnt(0)" ::: "memory");
        } else {
            XB_SPIN(xb_ld(&bar[XB_XGEN(b.x)]) == gen, bar);
            __builtin_amdgcn_fence(__ATOMIC_ACQUIRE, "agent");
            asm volatile("s_waitcnt vmcnt(0)" ::: "memory");
        }
    }
    __syncthreads();
}


struct Frame {
    LAS unsigned char* lds;
    volatile LAS unsigned* MISC;
    gu32* ctl;
    GAS unsigned char* ws;
    GAS float* out;
    int tid, lane, wave;
    int vcu, G;
};
enum { I_X = 0, I_WIN, I_POOLW, I_POOLS, I_MU, I_W0, I_W2, I_A0, I_A2, I_G2, I_KKS, I_KA, I_RK, I_LNXG, I_LNXB, I_V0, I_V1, I_V2,
       I_CONVW, I_CONVB, I_BI, I_BF, I_NORMG, I_WOUT, I_LN1G, I_LN1B, I_RTW, I_RTB, I_WGU, I_BGU, I_WDN, I_BDN, I_LN2G, I_LN2B };

#define WSP(T_, off) ((GAS T_*)(F.ws + (off)))
__device__ __forceinline__ const GAS float* inp_(LAS unsigned char* lds, int i) {
    const unsigned long long v = *(const LAS unsigned long long*)(lds + PTR_OFF + 8 * i);
    const unsigned lo = __builtin_amdgcn_readfirstlane((unsigned)v), hi = __builtin_amdgcn_readfirstlane((unsigned)(v >> 32));
    return (const GAS float*)(((unsigned long long)hi << 32) | lo);
}
#define INP(i) inp_(F.lds, (i))
__device__ __forceinline__ Frame launder(const Frame& G) {
    Frame F = G;
    asm volatile("" : "+v"(F.tid), "+v"(F.lane));
    asm volatile("" : "+s"(F.ws), "+s"(F.ctl), "+s"(F.out), "+s"(F.wave), "+s"(F.vcu), "+s"(F.G));
    return F;
}
__device__ __forceinline__ int launder_s(int x) { asm volatile("" : "+s"(x)); return x; }

template <int NN>
struct MoeOrder {
    int nb, c; const gu32* blke;
    __device__ __forceinline__ bool next(int i, pg8::Unit& u) const {
        constexpr int BPX = 32 / NN;
        const int x = c & 7, j = c >> 3;
        const int blk = i * (8 * BPX) + x * BPX + j / NN;
        if (blk >= nb) return false;
        u.pm = blk; u.pn = j % NN; u.e = (int)__builtin_amdgcn_readfirstlane(__hip_atomic_load(blke + blk, RLX_AGENT));
        return true;
    }
    __device__ __forceinline__ void a_ready(const pg8::Unit&) const {}
    __device__ __forceinline__ void done(const pg8::Unit&) const {}
};

__device__ __forceinline__ void transpose_item(const GAS float* src, int ld, bool valid, int k0, GAS bf16* dst  , LAS float* scr, int lane) {
    const GAS float* s0 = src + (size_t)(k0 + (lane >> 5)) * ld;
#pragma unroll 8
    for (int i = 0; i < 32; ++i) { const int kk = 2 * i + (lane >> 5); scr[kk * 33 + (lane & 31)] = valid ? s0[(size_t)(2 * i) * ld] : 0.f; }
    LDS_WAIT(); asm volatile("" ::: "memory");
    const int c = lane & 7;
#pragma unroll
    for (int j = 0; j < 4; ++j) { const int n = (lane >> 3) + 8 * j; const LAS float* s = scr + (8 * c) * 33 + n;
        v4u o; o.x = pk2(s[0 * 33], s[1 * 33]); o.y = pk2(s[2 * 33], s[3 * 33]); o.z = pk2(s[4 * 33], s[5 * 33]); o.w = pk2(s[6 * 33], s[7 * 33]);
        *(GAS v4u*)(dst + (size_t)n * D + k0 + 8 * c) = o; }
    LDS_WAIT(); asm volatile("" ::: "memory");
}
__device__ __forceinline__ void phase_convert(Frame& F) {
    LAS float* scr = (LAS float*)(F.lds + RING_OFF + F.wave * 16384);
    const int gw = F.vcu * NWAVES + F.wave, NGW = F.G * NWAVES; const int lane = F.lane;
    { const GAS float* x = INP(I_X); GAS bf16* h16 = WSP(bf16, WS_H16);
      for (int m = gw; m < T; m += NGW) { const GAS f32x4* xr = (const GAS f32x4*)(x + (size_t)m * D) + lane; GAS v2u* o = (GAS v2u*)(h16 + (size_t)m * D) + lane;
#pragma unroll
          for (int j = 0; j < 4; ++j) { const f32x4 v = xr[64 * j]; v2u w; w.x = pk2(v.x, v.y); w.y = pk2(v.z, v.w); o[64 * j] = w; } } }
    constexpr int KB = D / 64;
    constexpr int I_IN = 2 * (PC / 32) * KB;
    constexpr int I_OUT = 2 * (D / 32) * KB;
    constexpr int I_GU = 64 * (2048 / 32) * KB;
    constexpr int I_DN = 64 * (D / 32) * KB;
    constexpr int NITEMS = I_IN + I_OUT + I_GU + I_DN;
    for (int it = gw; it < NITEMS; it += NGW) {
        int r = it;
        if (r < I_IN) { const int l = r / ((PC / 32) * KB); r -= l * ((PC / 32) * KB); const int nb = r / KB, kb = r % KB; const int n = nb * 32 + (lane & 31);
            const GAS float* src; int ld; bool valid;
            if (n < DIN) { src = INP(I_WIN) + (size_t)l * D * DIN + n; ld = DIN; valid = true; }
            else if (l == 1 && n < DIN + 32) { src = INP(I_V1) + (n - DIN); ld = 32; valid = true; }
            else { src = INP(I_WIN); ld = 0; valid = false; }
            transpose_item(src, ld, valid, kb * 64, WSP(bf16, WS_WIN + l * WIN_L) + (size_t)(nb * 32) * D, scr, lane); continue; }
        r -= I_IN;
        if (r < I_OUT) { const int l = r / ((D / 32) * KB); r -= l * ((D / 32) * KB); const int nb = r / KB, kb = r % KB;
            transpose_item(INP(I_WOUT) + (size_t)l * D * D + nb * 32 + (lane & 31), D, true, kb * 64, WSP(bf16, WS_WOUT + l * WOUT_L) + (size_t)(nb * 32) * D, scr, lane); continue; }
        r -= I_OUT;
        if (r < I_GU) { const int le = r / (64 * KB); r -= le * (64 * KB); const int nb = r / KB, kb = r % KB; const int n0 = nb * 32;
            const int nn = n0 & 1023; const int drow = 256 * (nn >> 7) + (nn & 127) + ((n0 >= 1024) ? 128 : 0);
            transpose_item(INP(I_WGU) + (size_t)le * D * 2048 + n0 + (lane & 31), 2048, true, kb * 64, WSP(bf16, WS_WGU + le * WGU_E) + (size_t)drow * D, scr, lane); continue; }
        r -= I_GU;
        { const int le = r / (32 * KB); r -= le * (32 * KB); const int nb = r / KB, kb = r % KB;
            transpose_item(INP(I_WDN) + (size_t)le * D * D + nb * 32 + (lane & 31), D, true, kb * 64, WSP(bf16, WS_WDN + le * WDN_E) + (size_t)(nb * 32) * D, scr, lane); }
    }
}

__device__ __forceinline__ void pool_items(Frame& F, int l) {
    const GAS float* p = WSP(float, WS_P); GAS bf16* ycat = WSP(bf16, WS_YCAT);
    LAS float* dt = (LAS float*)(F.lds + RING_OFF + F.wave * 8192);
    const int gw = F.vcu * NWAVES + F.wave, NGW = F.G * NWAVES, lane = F.lane;
    for (int it = gw; it < (T / 32) * 4; it += NGW) {
        const int g = it & 3, tile = it >> 2, tok0 = tile * 32, t0 = tok0 & (SEQ - 1);
        const int win = 2 << g; const int col = 64 * g + lane;
        const GAS float* pc = p + (size_t)tok0 * PC + col;
        float ub[47];
#pragma unroll
        for (int j = 0; j < 47; ++j) { const int rel = j - 15; const int relc = (t0 + rel >= 0) ? rel : 0; const float x = pc[(ptrdiff_t)relc * PC]; ub[j] = (t0 + rel >= 0) ? x : 0.f; }
        float s = 0.f;
#pragma unroll
        for (int j = 1; j < 16; ++j) if (j < win) s += ub[15 - j];
#pragma unroll
        for (int t = 0; t < 32; ++t) {
            const float u = ub[15 + t]; s += u;
            const int cnt = min(t0 + t + 1, win);
            dt[t * 64 + lane] = s / (float)cnt - u;
            const float d2 = ub[15 + t - 1], d4 = ub[15 + t - 3], d8 = ub[15 + t - 7], d16 = ub[15 + t - 15];
            s -= (g == 0) ? d2 : (g == 1) ? d4 : (g == 2) ? d8 : d16;
        }
        LDS_WAIT(); asm volatile("" ::: "memory");
        float w[64];
        const GAS float* pw = INP(I_POOLW) + ((size_t)(l * 4 + g) * 64) * 64 + lane;
#pragma unroll
        for (int i = 0; i < 64; ++i) w[i] = pw[i * 64];
        const float sc = INP(I_POOLS)[l * 256 + col];
        for (int t = 0; t < 32; ++t) {
            float a0 = 0.f, a1 = 0.f, a2 = 0.f, a3 = 0.f;
#pragma unroll
            for (int i = 0; i < 64; i += 4) { const f32x4 d = *(const LAS f32x4*)(dt + t * 64 + i); a0 += d.x * w[i]; a1 += d.y * w[i + 1]; a2 += d.z * w[i + 2]; a3 += d.w * w[i + 3]; }
            ycat[(size_t)(tok0 + t) * D + col] = (bf16)f2bf(((a0 + a1) + (a2 + a3)) * sc);
        }
        LDS_WAIT(); asm volatile("" ::: "memory");
    }
}

constexpr int XS_PITCH = 1440;
__device__ __forceinline__ void rwkv_prep(Frame& F, int l) {
    const GAS float* p = WSP(float, WS_P);
    LAS float* xs = (LAS float*)(F.lds + RING_OFF);
    const GAS float* mu = INP(I_MU) + l * RWC;
    GAS float* vfirst = WSP(float, WS_VFIRST);
    GAS float* oR = WSP(float, WS_RR), *oLW = WSP(float, WS_RLW), *oK = WSP(float, WS_RK), *oV = WSP(float, WS_RV), *oNA = WSP(float, WS_RNA), *oBB = WSP(float, WS_RBB), *oG = WSP(float, WS_RG), *oSB = WSP(float, WS_RSB);
    for (int grp = F.vcu; grp < T / 8; grp += F.G) {
        const int tok0 = grp * 8;
#pragma unroll 2
        for (int idx = F.tid; idx < 8 * RWC; idx += NWAVES * 64) {
            const int tk = idx / RWC, j = idx - tk * RWC; const int tok = tok0 + tk;
            const bool first = (tok & (SEQ - 1)) == 0;
            const float cur = p[(size_t)tok * PC + P_RW + j];
            const float pv = p[(size_t)(first ? tok : tok - 1) * PC + P_RW + j];
            const float prev = first ? 0.f : pv;
            float x = cur + mu[j] * (prev - cur);
            if (j >= 1152 && j < 1216) x = tanhf(x);
            else if (j >= 1280) x = sigmoidf_(x);
            xs[tk * XS_PITCH + j] = x;
        }
        if (l == 1) for (int idx = F.tid; idx < 8 * 32; idx += NWAVES * 64) { const int tk = idx >> 5, j = idx & 31; xs[tk * XS_PITCH + RWC + j] = p[(size_t)(tok0 + tk) * PC + P_V1 + j]; }
        __syncthreads();
        if (F.wave < 6) {
            const int h = F.wave, ch = 64 * h + F.lane;
            float dw[8], da[8], dg[8], dv[8];
#pragma unroll
            for (int t = 0; t < 8; ++t) { dw[t] = 0.f; da[t] = 0.f; dg[t] = 0.f; dv[t] = 0.f; }
            const GAS float* w2 = INP(I_W2) + (size_t)l * 64 * RW + ch; const GAS float* a2 = INP(I_A2) + (size_t)l * 64 * RW + ch; const GAS float* g2 = INP(I_G2) + (size_t)l * 128 * RW + ch;
#pragma unroll 1
            for (int j = 0; j < 64; j += 4) {
                float wv[4], av[4];
#pragma unroll
                for (int q = 0; q < 4; ++q) { wv[q] = w2[(size_t)(j + q) * RW]; av[q] = a2[(size_t)(j + q) * RW]; }
#pragma unroll
                for (int t = 0; t < 8; ++t) { const f32x4 xw = *(const LAS f32x4*)(xs + t * XS_PITCH + 1152 + j); const f32x4 xa = *(const LAS f32x4*)(xs + t * XS_PITCH + 1216 + j);
                    dw[t] += xw.x * wv[0] + xw.y * wv[1] + xw.z * wv[2] + xw.w * wv[3]; da[t] += xa.x * av[0] + xa.y * av[1] + xa.z * av[2] + xa.w * av[3]; }
            }
#pragma unroll 1
            for (int j = 0; j < 128; j += 4) {
                float gv[4];
#pragma unroll
                for (int q = 0; q < 4; ++q) gv[q] = g2[(size_t)(j + q) * RW];
#pragma unroll
                for (int t = 0; t < 8; ++t) { const f32x4 xg = *(const LAS f32x4*)(xs + t * XS_PITCH + 1280 + j); dg[t] += xg.x * gv[0] + xg.y * gv[1] + xg.z * gv[2] + xg.w * gv[3]; }
            }
            if (l == 1) { const GAS float* v2 = INP(I_V2) + ch;
#pragma unroll 1
                for (int j = 0; j < 32; j += 4) {
                    float vv[4];
#pragma unroll
                    for (int q = 0; q < 4; ++q) vv[q] = v2[(size_t)(j + q) * RW];
#pragma unroll
                    for (int t = 0; t < 8; ++t) { const f32x4 xv = *(const LAS f32x4*)(xs + t * XS_PITCH + RWC + j); dv[t] += xv.x * vv[0] + xv.y * vv[1] + xv.z * vv[2] + xv.w * vv[3]; }
                } }
            LAS float* accl = (LAS float*)(F.lds + RING_OFF + 49152) + h * 2048;
#pragma unroll
            for (int t = 0; t < 8; ++t) { accl[(0 * 8 + t) * 64 + F.lane] = dw[t]; accl[(1 * 8 + t) * 64 + F.lane] = da[t]; accl[(2 * 8 + t) * 64 + F.lane] = dg[t]; accl[(3 * 8 + t) * 64 + F.lane] = dv[t]; }
            LDS_WAIT(); asm volatile("" ::: "memory");
            const float w0 = INP(I_W0)[l * RW + ch], a0 = INP(I_A0)[l * RW + ch], kks = INP(I_KKS)[l * RW + ch], ka = INP(I_KA)[l * RW + ch], rk = INP(I_RK)[l * RW + ch];
            const float v0 = (l == 1) ? INP(I_V0)[ch] : 0.f;
#pragma unroll 1
            for (int t = 0; t < 8; ++t) {
                const int tok = tok0 + t; const size_t o = (size_t)tok * RW + ch;
                const float dwt = accl[(0 * 8 + t) * 64 + F.lane], dat = accl[(1 * 8 + t) * 64 + F.lane], dgt = accl[(2 * 8 + t) * 64 + F.lane], dvt = accl[(3 * 8 + t) * 64 + F.lane];
                const float r = xs[t * XS_PITCH + ch], k = xs[t * XS_PITCH + 384 + ch]; float v = xs[t * XS_PITCH + 768 + ch];
                const float wlog = -softplusf_(-(w0 + dwt)) - 0.5f; const float lw = -__expf(wlog);
                const float ai = sigmoidf_(a0 + dat);
                if (l == 0) vfirst[o] = v; else { const float vg = sigmoidf_(v0 + dvt); v = v + (vfirst[o] - v) * vg; }
                const float kkv = k * kks; const float nrm = sqrtf(wave_sum(kkv * kkv)); const float kk = kkv / fmaxf(nrm, 1e-12f);
                const float kp = k * (1.0f + (ai - 1.0f) * ka);
                const float sb = wave_sum(r * kp * rk);
                oR[o] = r; oLW[o] = lw; oK[o] = kp; oV[o] = v; oNA[o] = -kk; oBB[o] = kk * ai; oG[o] = dgt;
                if (F.lane == 0) oSB[tok * 8 + h] = sb;
            }
        }
        __syncthreads();
    }
}

__device__ __forceinline__ void mlstm_qk_tile(Frame& F, int l, int b, int c, int h, int which, LAS float* tile) {
    const GAS float* p = WSP(float, WS_P);
    const GAS float* cw = INP(I_CONVW) + (size_t)l * 4 * 768 + which * 384 + 64 * h; const GAS float* cb = INP(I_CONVB) + l * 768 + which * 384 + 64 * h;
    const int pcol = P_ML + which * 384 + 64 * h;
#pragma unroll 4
    for (int idx = F.tid; idx < 4096; idx += NWAVES * 64) {
        const int s = idx >> 6, d = idx & 63; const int tl = 64 * c + s; const size_t tok = (size_t)b * SEQ + tl;
        float acc = cb[d];
#pragma unroll
        for (int i = 0; i < 4; ++i) { const int tt = tl - 3 + i; const float x = p[(tt >= 0 ? tok - 3 + i : tok) * PC + pcol + d]; acc += (tt >= 0 ? cw[i * 768 + d] : 0.f) * x; }
        float y = acc * sigmoidf_(acc); if (which == 0) y *= 0.125f;
        tile[s * 65 + d] = y;
    }
}
__device__ __forceinline__ void mlstm_summ(Frame& F, int l) {
    const GAS float* p = WSP(float, WS_P);
    LAS float* kt = (LAS float*)(F.lds + RING_OFF);
    LAS float* vt = kt + 64 * 65;
    LAS float* we = vt + 64 * 64;
    GAS float* kvloc = WSP(float, WS_MKV); GAS float* nloc = WSP(float, WS_MNL); GAS float* msc = WSP(float, WS_MSC); GAS float* mlg = WSP(float, WS_MLG); GAS float* mli = WSP(float, WS_MLI);
    for (int item = F.vcu; item < NITEM; item += F.G) {
        const int h = item % 6, bc = item / 6, c = bc % NCH, b = bc / NCH;
        const size_t tokb = (size_t)b * SEQ + 64 * c;
        if (F.wave == 0) {
            const size_t tok = tokb + F.lane;
            const float ig = p[tok * PC + P_ML + 1536 + h] + INP(I_BI)[l * 6 + h];
            const float lf = logsigmoidf_(p[tok * PC + P_ML + 1542 + h] + INP(I_BF)[l * 6 + h]);
            float g = lf;
#pragma unroll
            for (int o = 1; o < 64; o <<= 1) { const float t = __shfl_up(g, o); if (F.lane >= o) g += t; }
            const float glast = __shfl(g, 63);
            const float e = glast - g + ig; const float mloc = wave_max(e);
            we[F.lane] = __expf(e - mloc);
            mlg[tok * 8 + h] = g; mli[tok * 8 + h] = ig;
            if (F.lane == 0) { msc[item * 4 + 0] = mloc; msc[item * 4 + 1] = glast; }
        }
        mlstm_qk_tile(F, l, b, c, h, 1, kt);
        for (int idx = F.tid; idx < 4096; idx += NWAVES * 64) { const int s = idx >> 6, d = idx & 63; vt[idx] = p[(tokb + s) * PC + P_ML + 768 + 64 * h + d]; }
        __syncthreads();
        { const int kd = F.tid >> 3, v0 = (F.tid & 7) * 8;
          float acc[8]; float an = 0.f;
#pragma unroll
          for (int j = 0; j < 8; ++j) acc[j] = 0.f;
          for (int s = 0; s < 64; ++s) { const float kw = we[s] * kt[s * 65 + kd]; an += kw; const f32x4 va = *(const LAS f32x4*)(vt + s * 64 + v0), vb = *(const LAS f32x4*)(vt + s * 64 + v0 + 4);
              acc[0] += kw * va.x; acc[1] += kw * va.y; acc[2] += kw * va.z; acc[3] += kw * va.w; acc[4] += kw * vb.x; acc[5] += kw * vb.y; acc[6] += kw * vb.z; acc[7] += kw * vb.w; }
          GAS float* o = kvloc + (size_t)item * 4096 + kd * 64 + v0;
          *(GAS f32x4*)o = (f32x4){acc[0], acc[1], acc[2], acc[3]}; *(GAS f32x4*)(o + 4) = (f32x4){acc[4], acc[5], acc[6], acc[7]};
          if ((F.tid & 7) == 0) nloc[item * 64 + kd] = an; }
        __syncthreads();
    }
}

__device__ __forceinline__ void rwkv_scan_seq(Frame& F) {
    if (F.vcu >= 12) return;
    const int b = F.vcu / 6, h = F.vcu % 6;
    LAS float* L = (LAS float*)(F.lds + RING_OFF);
    LAS float* ybuf = L + 6 * 4096;
    const GAS float* src[6] = {WSP(float, WS_RR), WSP(float, WS_RLW), WSP(float, WS_RK), WSP(float, WS_RV), WSP(float, WS_RNA), WSP(float, WS_RBB)};
    GAS float* yraw = WSP(float, WS_RY);
    const int vrow = (F.tid >> 2) & 63, q = F.tid & 3;
    float S[16];
#pragma unroll
    for (int i = 0; i < 16; ++i) S[i] = 0.f;
    for (int blk = 0; blk < SEQ / 64; ++blk) {
        const size_t tokb = (size_t)b * SEQ + blk * 64;
#pragma unroll
        for (int a = 0; a < 6; ++a)
            for (int idx = F.tid; idx < 4096; idx += NWAVES * 64) { const int s = idx >> 6, d = idx & 63; float x = src[a][(tokb + s) * RW + 64 * h + d]; if (a == 1) x = __expf(x); L[a * 4096 + idx] = x; }
        __syncthreads();
        if (F.tid < 256) {
            for (int t = 0; t < 64; ++t) {
                const LAS float* base = L + t * 64 + 16 * q;
                float sa = 0.f;
#pragma unroll
                for (int i = 0; i < 16; ++i) sa += S[i] * base[4 * 4096 + i];
                sa += __shfl_xor(sa, 1); sa += __shfl_xor(sa, 2);
                const float vv = L[3 * 4096 + t * 64 + vrow];
                float y = 0.f;
#pragma unroll
                for (int i = 0; i < 16; ++i) { S[i] = S[i] * base[1 * 4096 + i] + sa * base[5 * 4096 + i] + vv * base[2 * 4096 + i]; y += S[i] * base[i]; }
                y += __shfl_xor(y, 1); y += __shfl_xor(y, 2);
                if (q == 0) ybuf[t * 64 + vrow] = y;
            }
        }
        __syncthreads();
        for (int idx = F.tid; idx < 4096; idx += NWAVES * 64) { const int s = idx >> 6, d = idx & 63; yraw[(tokb + s) * RW + 64 * h + d] = ybuf[idx]; }
        __syncthreads();
    }
}
__device__ __forceinline__ void mlstm_scan(Frame& F) {
    if (F.vcu < 12) return;
    const int gt = (F.vcu - 12) * (NWAVES * 64) + F.tid;
    const GAS float* msc = WSP(float, WS_MSC);
    if (gt < 12 * 4096 + 12 * 64) {
        const bool isn = gt >= 12 * 4096;
        const int g2 = isn ? gt - 12 * 4096 : gt;
        const int bh = isn ? (g2 >> 6) : (g2 >> 12), el = isn ? (g2 & 63) : (g2 & 4095), b = bh / 6, h = bh % 6;
        const int es = isn ? 64 : 4096;
        const GAS float* src = isn ? WSP(float, WS_MNL) : WSP(float, WS_MKV); GAS float* dst = isn ? WSP(float, WS_MNP) : WSP(float, WS_MCP); GAS float* mscw = WSP(float, WS_MSC);
        float C = 0.f, m = 0.f;
        for (int c0 = 0; c0 < NCH; c0 += 8) {
            float x[8], ml[8], gl[8];
#pragma unroll
            for (int i = 0; i < 8; ++i) { const int item = (b * NCH + c0 + i) * 6 + h; ml[i] = msc[item * 4 + 0]; gl[i] = msc[item * 4 + 1]; x[i] = src[(size_t)item * es + el]; }
#pragma unroll
            for (int i = 0; i < 8; ++i) { const int item = (b * NCH + c0 + i) * 6 + h;
                dst[(size_t)item * es + el] = C;
                if (!isn && el == 0) mscw[item * 4 + 2] = m;
                const float mn = fmaxf(gl[i] + m, ml[i]); const float ao = __expf(gl[i] + m - mn), an = __expf(ml[i] - mn);
                C = ao * C + an * x[i]; m = mn; }
        }
    }
}

__device__ __forceinline__ void rwkv_finish(Frame& F, int l) {
    const GAS float* yraw = WSP(float, WS_RY); const GAS float* v = WSP(float, WS_RV); const GAS float* g = WSP(float, WS_RG); const GAS float* sb = WSP(float, WS_RSB);
    GAS bf16* ycat = WSP(bf16, WS_YCAT);
    const int gw = F.vcu * NWAVES + F.wave, NGW = F.G * NWAVES, lane = F.lane;
    for (int tok = gw; tok < T; tok += NGW) {
#pragma unroll
        for (int h = 0; h < 6; ++h) {
            const size_t o = (size_t)tok * RW + 64 * h + lane;
            const float y = yraw[o]; const float mean = wave_sum(y) * (1.f / 64.f); const float d = y - mean; const float var = wave_sum(d * d) * (1.f / 64.f);
            float r = d * (1.0f / sqrtf(var + GN_EPS)) * INP(I_LNXG)[l * RW + 64 * h + lane] + INP(I_LNXB)[l * RW + 64 * h + lane];
            r += sb[tok * 8 + h] * v[o];
            r *= g[o];
            ycat[(size_t)tok * D + 256 + 64 * h + lane] = (bf16)f2bf(r);
        }
    }
}
__device__ __forceinline__ void mlstm_out(Frame& F, int l) {
    const GAS float* p = WSP(float, WS_P);
    LAS float* qt = (LAS float*)(F.lds + RING_OFF);
    LAS float* kt = qt + 64 * 65;
    LAS float* At = kt + 64 * 65;
    LAS float* vt = At + 64 * 65;
    LAS float* cpt = vt + 4096;
    LAS float* sm = cpt + 4096;
    const GAS float* cp = WSP(float, WS_MCP); const GAS float* np = WSP(float, WS_MNP); const GAS float* msc = WSP(float, WS_MSC); const GAS float* mlg = WSP(float, WS_MLG); const GAS float* mli = WSP(float, WS_MLI);
    GAS bf16* ycat = WSP(bf16, WS_YCAT);
    for (int item = F.vcu; item < NITEM; item += F.G) {
        const int h = item % 6, bc = item / 6, c = bc % NCH, b = bc / NCH;
        const size_t tokb = (size_t)b * SEQ + 64 * c;
        mlstm_qk_tile(F, l, b, c, h, 0, qt);
        mlstm_qk_tile(F, l, b, c, h, 1, kt);
        for (int idx = F.tid; idx < 4096; idx += NWAVES * 64) { const int s = idx >> 6, d = idx & 63; vt[idx] = p[(tokb + s) * PC + P_ML + 768 + 64 * h + d]; cpt[idx] = cp[(size_t)item * 4096 + idx]; }
        if (F.tid < 64) { sm[F.tid] = mlg[(tokb + F.tid) * 8 + h]; sm[64 + F.tid] = mli[(tokb + F.tid) * 8 + h]; sm[128 + F.tid] = np[item * 64 + F.tid]; }
        const float mprev = msc[item * 4 + 2];
        __syncthreads();
        const int j = F.tid >> 3, sub = F.tid & 7;
        { const int s0 = sub * 8;
          float acc[8];
#pragma unroll
          for (int i = 0; i < 8; ++i) acc[i] = 0.f;
          for (int d = 0; d < 64; ++d) { const float qv = qt[j * 65 + d];
#pragma unroll
              for (int i = 0; i < 8; ++i) acc[i] += qv * kt[(s0 + i) * 65 + d]; }
          const float gj = sm[j];
          float dl[8]; float mx = -INFINITY;
#pragma unroll
          for (int i = 0; i < 8; ++i) { const int s = s0 + i; dl[i] = (s <= j) ? (gj - sm[s] + sm[64 + s]) : -INFINITY; mx = fmaxf(mx, dl[i]); }
          mx = fmaxf(mx, __shfl_xor(mx, 1)); mx = fmaxf(mx, __shfl_xor(mx, 2)); mx = fmaxf(mx, __shfl_xor(mx, 4));
          const float il = gj + mprev; const float mj = fmaxf(mx, il);
          float dsum = 0.f;
#pragma unroll
          for (int i = 0; i < 8; ++i) { const int s = s0 + i; const float w = (s <= j) ? __expf(dl[i] - mj) * acc[i] : 0.f; At[j * 65 + s] = w; dsum += w; }
          dsum += __shfl_xor(dsum, 1); dsum += __shfl_xor(dsum, 2); dsum += __shfl_xor(dsum, 4);
          if (sub == 0) { float qn = 0.f; for (int d = 0; d < 64; ++d) qn += qt[j * 65 + d] * sm[128 + d];
              const float wi = __expf(il - mj); const float den = dsum + wi * qn;
              sm[192 + j] = wi; sm[256 + j] = 1.0f / fmaxf(fabsf(den), __expf(-mj)); } }
        __syncthreads();
        { const int v0 = sub * 8;
          float acc[8];
#pragma unroll
          for (int i = 0; i < 8; ++i) acc[i] = 0.f;
          for (int s = 0; s <= j; ++s) { const float a = At[j * 65 + s]; const f32x4 va = *(const LAS f32x4*)(vt + s * 64 + v0), vb = *(const LAS f32x4*)(vt + s * 64 + v0 + 4);
              acc[0] += a * va.x; acc[1] += a * va.y; acc[2] += a * va.z; acc[3] += a * va.w; acc[4] += a * vb.x; acc[5] += a * vb.y; acc[6] += a * vb.z; acc[7] += a * vb.w; }
          const float wi = sm[192 + j];
          for (int d = 0; d < 64; ++d) { const float a = qt[j * 65 + d] * wi; const f32x4 va = *(const LAS f32x4*)(cpt + d * 64 + v0), vb = *(const LAS f32x4*)(cpt + d * 64 + v0 + 4);
              acc[0] += a * va.x; acc[1] += a * va.y; acc[2] += a * va.z; acc[3] += a * va.w; acc[4] += a * vb.x; acc[5] += a * vb.y; acc[6] += a * vb.z; acc[7] += a * vb.w; }
          const float di = sm[256 + j];
          float sum = 0.f;
#pragma unroll
          for (int i = 0; i < 8; ++i) { acc[i] *= di; sum += acc[i]; }
          sum += __shfl_xor(sum, 1); sum += __shfl_xor(sum, 2); sum += __shfl_xor(sum, 4);
          const float mean = sum * (1.f / 64.f); float vs = 0.f;
#pragma unroll
          for (int i = 0; i < 8; ++i) { acc[i] -= mean; vs += acc[i] * acc[i]; }
          vs += __shfl_xor(vs, 1); vs += __shfl_xor(vs, 2); vs += __shfl_xor(vs, 4);
          const float rstd = 1.0f / sqrtf(vs * (1.f / 64.f) + LN_EPS);
          const size_t tok = tokb + j;
          const GAS float* og = p + tok * PC + P_ML + 1152 + 64 * h + v0; const GAS float* ng = INP(I_NORMG) + l * 384 + 64 * h + v0;
          float o[8];
#pragma unroll
          for (int i = 0; i < 8; ++i) o[i] = sigmoidf_(og[i]) * (acc[i] * rstd * ng[i]);
          v4u w; w.x = pk2(o[0], o[1]); w.y = pk2(o[2], o[3]); w.z = pk2(o[4], o[5]); w.w = pk2(o[6], o[7]);
          *(GAS v4u*)(ycat + tok * D + 640 + 64 * h + v0) = w; }
        __syncthreads();
    }
}

__device__ __forceinline__ void ln_rows(Frame& F, const GAS float* hin, const GAS float* add, const GAS float* gam, const GAS float* bet, GAS float* out32, GAS bf16* h16) {
    const int gw = F.vcu * NWAVES + F.wave, NGW = F.G * NWAVES, lane = F.lane;
    for (int m = gw; m < T; m += NGW) {
        const GAS f32x4* hr = (const GAS f32x4*)(hin + (size_t)m * D) + lane; const GAS f32x4* ar = (const GAS f32x4*)(add + (size_t)m * D) + lane;
        f32x4 v[4]; float s = 0.f;
#pragma unroll
        for (int j = 0; j < 4; ++j) { v[j] = hr[64 * j] * DN_ALPHA + ar[64 * j]; s += (v[j].x + v[j].y) + (v[j].z + v[j].w); }
        const float mean = wave_sum(s) * (1.f / D); float s2 = 0.f;
#pragma unroll
        for (int j = 0; j < 4; ++j) { v[j] = v[j] - mean; s2 += (v[j].x * v[j].x + v[j].y * v[j].y) + (v[j].z * v[j].z + v[j].w * v[j].w); }
        const float rstd = 1.f / sqrtf(wave_sum(s2) * (1.f / D) + LN_EPS);
        GAS f32x4* o4 = (GAS f32x4*)(out32 + (size_t)m * D) + lane; GAS v2u* o2 = (GAS v2u*)(h16 + (size_t)m * D) + lane;
#pragma unroll
        for (int j = 0; j < 4; ++j) { const f32x4 gg = *((const GAS f32x4*)gam + 64 * j + lane), bb = *((const GAS f32x4*)bet + 64 * j + lane);
            const f32x4 r = v[j] * rstd * gg + bb; o4[64 * j] = r; v2u w; w.x = pk2(r.x, r.y); w.y = pk2(r.z, r.w); o2[64 * j] = w; }
    }
}
__device__ __forceinline__ void router_phase(Frame& F, int l, const GAS float* h1) {
    LAS float* xs = (LAS float*)(F.lds + RING_OFF + F.wave * 16384);
    LAS unsigned* hist = (LAS unsigned*)(F.lds + LDSCTL_OFF);
    const GAS float* rw = INP(I_RTW) + (size_t)l * D * NE; const GAS float* rb = INP(I_RTB) + l * NE;
    GAS int* tke = WSP(int, WS_TKE); GAS float* tkg = WSP(float, WS_TKG);
    const int gw = F.vcu * NWAVES + F.wave, NGW = F.G * NWAVES, lane = F.lane;
    const int e = lane & 31, half = lane >> 5;
    for (int grp = gw; grp < T / 4; grp += NGW) {
        const int row0 = grp * 4;
#pragma unroll
        for (int r = 0; r < 4; ++r) { const GAS f32x4* xr = (const GAS f32x4*)(h1 + (size_t)(row0 + r) * D) + lane;
#pragma unroll
            for (int j = 0; j < 4; ++j) *(LAS f32x4*)(xs + r * 1024 + 4 * (64 * j + lane)) = xr[64 * j]; }
        LDS_WAIT(); asm volatile("" ::: "memory");
        float acc[4] = {0.f, 0.f, 0.f, 0.f};
        const GAS float* wp = rw + (size_t)(512 * half) * NE + e;
        for (int k = 0; k < 512; k += 4) {
            const float w0 = wp[(size_t)(k + 0) * NE], w1 = wp[(size_t)(k + 1) * NE], w2 = wp[(size_t)(k + 2) * NE], w3 = wp[(size_t)(k + 3) * NE];
#pragma unroll
            for (int r = 0; r < 4; ++r) { const f32x4 x = *(const LAS f32x4*)(xs + r * 1024 + 512 * half + k); acc[r] += (x.x * w0 + x.y * w1) + (x.z * w2 + x.w * w3); }
        }
        const float bias = rb[e];
#pragma unroll
        for (int r = 0; r < 4; ++r) {
            float lg = acc[r] + __shfl_xor(acc[r], 32) + bias;
            float v = (lane < 32) ? lg : -INFINITY;
            float tv[4]; int ti[4];
#pragma unroll
            for (int i = 0; i < 4; ++i) { const float m = wave_max(v); const unsigned long long bal = __ballot(v == m); const int idx = __ffsll((long long)bal) - 1; tv[i] = m; ti[i] = idx; if (lane == idx) v = -INFINITY; }
            const float e1 = __expf(tv[1] - tv[0]), e2 = __expf(tv[2] - tv[0]), e3 = __expf(tv[3] - tv[0]); const float inv = 1.0f / (1.0f + e1 + e2 + e3);
            if (lane < 4) { const int ee = (lane == 0) ? ti[0] : (lane == 1) ? ti[1] : (lane == 2) ? ti[2] : ti[3]; const float gg = ((lane == 0) ? 1.0f : (lane == 1) ? e1 : (lane == 2) ? e2 : e3) * inv;
                tke[(row0 + r) * 4 + lane] = ee; tkg[(row0 + r) * 4 + lane] = gg; __hip_atomic_fetch_add(&hist[ee], 1u, __ATOMIC_RELAXED, __HIP_MEMORY_SCOPE_WORKGROUP); }
        }
        LDS_WAIT(); asm volatile("" ::: "memory");
    }
    __syncthreads();
    if (F.tid < NE) { const unsigned c = hist[F.tid]; if (c) __hip_atomic_fetch_add(F.ctl + CW_CNT + l * NE + F.tid, c, RLX_AGENT); }
    __syncthreads();
    if (F.tid < NE) hist[F.tid] = 0u;
    __syncthreads();
}
__device__ __forceinline__ void assign_phase(Frame& F, int l) {
    LAS unsigned* pst = (LAS unsigned*)(F.lds + RING_OFF);
    if (F.tid == 0) {
        unsigned run = 0;
        for (int e = 0; e < NE; ++e) { const unsigned c = __hip_atomic_load(F.ctl + CW_CNT + l * NE + e, RLX_AGENT); pst[e] = run; const unsigned nbk = (c + 255u) >> 8;
            if (blockIdx.x == 0) for (unsigned k = 0; k < nbk; ++k) __hip_atomic_store(F.ctl + CW_BLKE + l * 320 + (run >> 8) + k, (unsigned)e, RLX_AGENT);
            run += nbk << 8; }
        if (blockIdx.x == 0) __hip_atomic_store(F.ctl + CW_NB + l, run >> 8, RLX_AGENT);
    }
    __syncthreads();
    const GAS int* tke = WSP(int, WS_TKE); const GAS float* tkg = WSP(float, WS_TKG); GAS int* slot_of = WSP(int, WS_SLOT); GAS float* gsl = WSP(float, WS_GSL);
    const GAS bf16* h16 = WSP(bf16, WS_H16); GAS bf16* xg = WSP(bf16, WS_XG);
    const int gw = F.vcu * NWAVES + F.wave, NGW = F.G * NWAVES, lane = F.lane;
    for (int tok = gw; tok < T; tok += NGW) {
        int slot = 0;
        if (lane < 4) { const int e = tke[tok * 4 + lane]; const unsigned pos = __hip_atomic_fetch_add(F.ctl + CW_CUR + l * NE + e, 1u, RLX_AGENT); slot = (int)(pst[e] + pos);
            slot_of[tok * 4 + lane] = slot; gsl[slot] = tkg[tok * 4 + lane]; }
        const GAS v4u* src = (const GAS v4u*)(h16 + (size_t)tok * D) + lane; const v4u a = src[0], b = src[64];
#pragma unroll
        for (int i = 0; i < 4; ++i) { const int s = __shfl(slot, i); GAS v4u* dst = (GAS v4u*)(xg + (size_t)s * D) + lane; dst[0] = a; dst[64] = b; }
    }
}
__device__ __forceinline__ void combine_phase(Frame& F, const GAS float* h1, const GAS float* gam, const GAS float* bet, GAS float* out32, GAS bf16* h16) {
    const GAS int* slot_of = WSP(int, WS_SLOT); const GAS bf16* osl = WSP(bf16, WS_OSL);
    const int gw = F.vcu * NWAVES + F.wave, NGW = F.G * NWAVES, lane = F.lane;
    for (int m = gw; m < T; m += NGW) {
        const GAS f32x4* hr = (const GAS f32x4*)(h1 + (size_t)m * D) + lane;
        f32x4 v[4];
#pragma unroll
        for (int j = 0; j < 4; ++j) v[j] = hr[64 * j] * DN_ALPHA;
        const int sl = (lane < 4) ? slot_of[m * 4 + lane] : 0;
#pragma unroll
        for (int i = 0; i < 4; ++i) { const int s = __shfl(sl, i); const GAS v2u* orow = (const GAS v2u*)(osl + (size_t)s * D) + lane;
#pragma unroll
            for (int j = 0; j < 4; ++j) { const v2u w = orow[64 * j]; v[j].x += bf2f(w.x & 0xffffu); v[j].y += bf2f(w.x >> 16); v[j].z += bf2f(w.y & 0xffffu); v[j].w += bf2f(w.y >> 16); } }
        float s = 0.f;
#pragma unroll
        for (int j = 0; j < 4; ++j) s += (v[j].x + v[j].y) + (v[j].z + v[j].w);
        const float mean = wave_sum(s) * (1.f / D); float s2 = 0.f;
#pragma unroll
        for (int j = 0; j < 4; ++j) { v[j] = v[j] - mean; s2 += (v[j].x * v[j].x + v[j].y * v[j].y) + (v[j].z * v[j].z + v[j].w * v[j].w); }
        const float rstd = 1.f / sqrtf(wave_sum(s2) * (1.f / D) + LN_EPS);
        GAS f32x4* o4 = (GAS f32x4*)(out32 + (size_t)m * D) + lane; GAS v2u* o2 = (GAS v2u*)(h16 + (size_t)m * D) + lane;
#pragma unroll
        for (int j = 0; j < 4; ++j) { const f32x4 gg = *((const GAS f32x4*)gam + 64 * j + lane), bb = *((const GAS f32x4*)bet + 64 * j + lane);
            const f32x4 r = v[j] * rstd * gg + bb; o4[64 * j] = r; v2u w; w.x = pk2(r.x, r.y); w.y = pk2(r.z, r.w); o2[64 * j] = w; }
    }
}

constexpr int TP = 68;
typedef short bf16x8_t __attribute__((ext_vector_type(8)));
typedef float f32x2_t __attribute__((ext_vector_type(2))); typedef __bf16 bf16x2_t __attribute__((ext_vector_type(2)));
__device__ __forceinline__ unsigned cvtpk(float lo, float hi) { f32x2_t v = {lo, hi}; bf16x2_t b = __builtin_convertvector(v, bf16x2_t); return __builtin_bit_cast(unsigned, b); }
__device__ __forceinline__ int perm_idx(int pos) { const int s = pos >> 5, q = (pos >> 3) & 3, j = pos & 7; return 32 * s + 16 * (j >> 2) + 4 * q + (j & 3); }

__device__ __forceinline__ void mm_nt(const LAS float* P, const LAS float* Q, int t, int sub, float (&out)[8]) {
#pragma unroll
    for (int j = 0; j < 8; ++j) out[j] = 0.f;
#pragma unroll 4
    for (int k = 0; k < 64; k += 4) {
        const f32x4 a = *(const LAS f32x4*)(P + t * TP + k);
#pragma unroll
        for (int j = 0; j < 8; ++j) { const f32x4 q = *(const LAS f32x4*)(Q + (sub + 8 * j) * TP + k); out[j] += (a.x * q.x + a.y * q.y) + (a.z * q.z + a.w * q.w); }
    }
}
__device__ __forceinline__ void mm_nn(const LAS float* X, const LAS float* Vt, int t, int sub, float (&out)[8]) {
#pragma unroll
    for (int j = 0; j < 8; ++j) out[j] = 0.f;
#pragma unroll 2
    for (int i = 0; i < 64; i += 4) {
        const f32x4 a = *(const LAS f32x4*)(X + t * TP + i);
#pragma unroll
        for (int e = 0; e < 4; ++e) { const float av = a[e]; const f32x4 v0 = *(const LAS f32x4*)(Vt + (i + e) * TP + 8 * sub), v1 = *(const LAS f32x4*)(Vt + (i + e) * TP + 8 * sub + 4);
            out[0] += av * v0.x; out[1] += av * v0.y; out[2] += av * v0.z; out[3] += av * v0.w; out[4] += av * v1.x; out[5] += av * v1.y; out[6] += av * v1.z; out[7] += av * v1.w; }
    }
}
__device__ __forceinline__ void rwkv_chunk_prep(Frame& F) {
    LAS float* tA = (LAS float*)(F.lds + RING_OFF);
    LAS float* tR = tA + 64 * TP; LAS float* tB = tR + 64 * TP; LAS float* tK = tB + 64 * TP; LAS float* tV = tK + 64 * TP; LAS float* tT = tV + 64 * TP; LAS float* tX = tT + 64 * TP;
    const GAS float* gR = WSP(float, WS_RR), *gLW = WSP(float, WS_RLW), *gK = WSP(float, WS_RK), *gV = WSP(float, WS_RV), *gNA = WSP(float, WS_RNA), *gBB = WSP(float, WS_RBB);
    const int t = F.tid >> 3, sub = F.tid & 7;
    for (int item = F.vcu; item < NITEM; item += F.G) {
        const int h = item % 6, bc = item / 6, c = bc % NCH, b = bc / NCH; const size_t tokb = (size_t)b * SEQ + 64 * c;
        const int ci = (b * 6 + h) * NCH + c;
        GAS unsigned char* chd = F.ws + WS_RCH + (size_t)ci * CH_STRIDE; GAS unsigned char* cod = F.ws + WS_RCO + (size_t)ci * CO_STRIDE;
        for (int idx = F.tid; idx < 4096; idx += NWAVES * 64) { const int s = idx >> 6, d = idx & 63; tX[s * TP + d] = gLW[(tokb + s) * RW + 64 * h + d]; }
        __syncthreads();
        if (F.tid < 64) { float run = 0.f; for (int s = 0; s < 64; ++s) { run += tX[s * TP + F.tid]; tX[s * TP + F.tid] = run; } ((GAS float*)(chd + 49152))[F.tid] = __expf(run); }
        __syncthreads();
        for (int idx = F.tid; idx < 4096; idx += NWAVES * 64) { const int s = idx >> 6, d = idx & 63; const size_t o = (tokb + s) * RW + 64 * h + d;
            const float cw = tX[s * TP + d]; const float lw = gLW[o]; const float ecw = __expf(cw), ecx = __expf(cw - lw), ein = __expf(-cw);
            tA[s * TP + d] = gNA[o] * ecx; tR[s * TP + d] = gR[o] * ecw; tB[s * TP + d] = gBB[o] * ein; tK[s * TP + d] = gK[o] * ein; tV[s * TP + d] = gV[o]; }
        __syncthreads();
        float m[8];
        mm_nt(tA, tK, t, sub, m);
#pragma unroll
        for (int j = 0; j < 8; ++j) { const int i = sub + 8 * j; tX[t * TP + i] = (i < t) ? m[j] : 0.f; }
        __syncthreads();
        mm_nn(tX, tV, t, sub, m);
        *(LAS f32x4*)(tT + t * TP + 8 * sub) = (f32x4){m[0], m[1], m[2], m[3]}; *(LAS f32x4*)(tT + t * TP + 8 * sub + 4) = (f32x4){m[4], m[5], m[6], m[7]};
        __syncthreads();
        mm_nt(tR, tK, t, sub, m);
#pragma unroll
        for (int j = 0; j < 8; ++j) { const int i = sub + 8 * j; tX[t * TP + i] = (i <= t) ? m[j] : 0.f; }
        __syncthreads();
        mm_nn(tX, tV, t, sub, m);
        { GAS float* y0 = (GAS float*)(cod + 16384) + t * 64 + 8 * sub; *(GAS f32x4*)y0 = (f32x4){m[0], m[1], m[2], m[3]}; *(GAS f32x4*)(y0 + 4) = (f32x4){m[4], m[5], m[6], m[7]}; }
        __syncthreads();
        mm_nt(tR, tB, t, sub, m);
#pragma unroll
        for (int j = 0; j < 8; ++j) { const int i = sub + 8 * j; tX[t * TP + i] = (i <= t) ? m[j] : 0.f; }
        __syncthreads();
        { const f32x4 a = *(const LAS f32x4*)(tX + t * TP + 8 * sub), bq = *(const LAS f32x4*)(tX + t * TP + 8 * sub + 4);
          v4u w; w.x = pk2(a.x, a.y); w.y = pk2(a.z, a.w); w.z = pk2(bq.x, bq.y); w.w = pk2(bq.z, bq.w); *(GAS v4u*)(cod + 8192 + (t * 64 + 8 * sub) * 2) = w; }
        __syncthreads();
        mm_nt(tA, tB, t, sub, m);
#pragma unroll
        for (int j = 0; j < 8; ++j) { const int i = sub + 8 * j; tX[i * TP + t] = (i < t) ? m[j] : 0.f; }
        __syncthreads();
        if (F.wave < 2) {
            LAS float* tile = (F.wave == 0) ? tA : tT; const int cidx = F.lane;
            const LAS float* tXv = tX + (F.lane & 0); asm volatile("" : "+v"(tXv));
            float acc[64];
#pragma unroll
            for (int i = 0; i < 64; ++i) acc[i] = tile[i * TP + cidx];
#pragma unroll
            for (int i = 0; i < 63; ++i) {
                const float xi = acc[i];
#pragma unroll
                for (int t4 = ((i + 1) & ~3); t4 < 64; t4 += 4) { const f32x4 mm = *(const LAS f32x4*)(tXv + i * TP + t4);
                    if (t4 + 0 > i) acc[t4 + 0] += mm.x * xi; if (t4 + 1 > i) acc[t4 + 1] += mm.y * xi; if (t4 + 2 > i) acc[t4 + 2] += mm.z * xi; if (t4 + 3 > i) acc[t4 + 3] += mm.w * xi; }
            }
#pragma unroll
            for (int i = 0; i < 64; ++i) tile[i * TP + cidx] = acc[i];
        }
        __syncthreads();
        { const int s_ = sub >> 2, q_ = sub & 3; const int i0 = 32 * s_ + 4 * q_, i1 = i0 + 16;
          { const f32x4 a = *(const LAS f32x4*)(tA + t * TP + i0), bq = *(const LAS f32x4*)(tA + t * TP + i1);
            v4u w; w.x = pk2(a.x, a.y); w.y = pk2(a.z, a.w); w.z = pk2(bq.x, bq.y); w.w = pk2(bq.z, bq.w); *(GAS v4u*)(chd + (t * 64 + 8 * sub) * 2) = w; }
          { float e[8];
#pragma unroll
            for (int j = 0; j < 8; ++j) e[j] = tB[((j < 4 ? i0 : i1) + (j & 3)) * TP + t];
            v4u w; w.x = pk2(e[0], e[1]); w.y = pk2(e[2], e[3]); w.z = pk2(e[4], e[5]); w.w = pk2(e[6], e[7]); *(GAS v4u*)(chd + 8192 + (t * 64 + 8 * sub) * 2) = w;
#pragma unroll
            for (int j = 0; j < 8; ++j) e[j] = tK[((j < 4 ? i0 : i1) + (j & 3)) * TP + t];
            w.x = pk2(e[0], e[1]); w.y = pk2(e[2], e[3]); w.z = pk2(e[4], e[5]); w.w = pk2(e[6], e[7]); *(GAS v4u*)(chd + 16384 + (t * 64 + 8 * sub) * 2) = w;
#pragma unroll
            for (int j = 0; j < 8; ++j) e[j] = tV[((j < 4 ? i0 : i1) + (j & 3)) * TP + t];
            w.x = pk2(e[0], e[1]); w.y = pk2(e[2], e[3]); w.z = pk2(e[4], e[5]); w.w = pk2(e[6], e[7]); *(GAS v4u*)(chd + 24576 + (t * 64 + 8 * sub) * 2) = w;
#pragma unroll
            for (int j = 0; j < 8; ++j) e[j] = tT[(8 * sub + j) * TP + t];
            GAS float* u0 = (GAS float*)(chd + 32768) + t * 64 + 8 * sub; *(GAS f32x4*)u0 = (f32x4){e[0], e[1], e[2], e[3]}; *(GAS f32x4*)(u0 + 4) = (f32x4){e[4], e[5], e[6], e[7]}; }
          { const f32x4 a = *(const LAS f32x4*)(tR + t * TP + 8 * sub), bq = *(const LAS f32x4*)(tR + t * TP + 8 * sub + 4);
            v4u w; w.x = pk2(a.x, a.y); w.y = pk2(a.z, a.w); w.z = pk2(bq.x, bq.y); w.w = pk2(bq.z, bq.w); *(GAS v4u*)(cod + (t * 64 + 8 * sub) * 2) = w; } }
        __syncthreads();
    }
}

constexpr int CH_STAGE = 49152;
constexpr int CH_PIECES = (int)(CH_STRIDE / 16);
#define CH_BAR() do { asm volatile("s_waitcnt lgkmcnt(0)" ::: "memory"); __builtin_amdgcn_s_barrier(); asm volatile("" ::: "memory"); } while (0)
__device__ __forceinline__ void rwkv_chain(Frame& F) {
    if (F.vcu >= 12) return;
    const int bh = F.vcu;
    const GAS unsigned char* src = F.ws + WS_RCH + (size_t)bh * NCH * CH_STRIDE;
    GAS unsigned char* s0g = F.ws + WS_RS0 + (size_t)bh * NCH * 8192; GAS unsigned char* utg = F.ws + WS_RUT + (size_t)bh * NCH * 8192;
    LAS unsigned char* st0 = F.lds + RING_OFF; LAS unsigned char* st1 = st0 + CH_STAGE;
    const int lane = F.lane, q = lane >> 4, r16 = lane & 15;
    if (F.wave >= 4) {
        const int lt = F.tid - 256;
        v4u RA[12], RB[12];
#define CH_LOAD(R, c) do { const GAS v4u* g_ = (const GAS v4u*)(src + (size_t)(c) * CH_STRIDE); _Pragma("unroll") for (int p = 0; p < 12; ++p) R[p] = g_[p * 256 + lt]; } while (0)
#define CH_WRITE(R, st) do { _Pragma("unroll") for (int p = 0; p < 12; ++p) *(LAS v4u*)((st) + (p * 256 + lt) * 16) = R[p]; } while (0)
        CH_LOAD(RA, 0); CH_LOAD(RB, 1);
        CH_WRITE(RA, st0); CH_LOAD(RA, 2);
        CH_BAR();
        for (int c = 0; c < NCH; c += 2) {
            CH_WRITE(RB, st1); if (c + 3 < NCH) CH_LOAD(RB, c + 3);
            CH_BAR();
            if (c + 2 < NCH) { CH_WRITE(RA, st0); if (c + 4 < NCH) CH_LOAD(RA, c + 4); }
            CH_BAR();
        }
#undef CH_LOAD
#undef CH_WRITE
    } else {
        const int w = F.wave; const int vrow = 16 * w + r16;
        f32x4 sacc[4]; bf16x8_t sb[2];
#pragma unroll
        for (int i = 0; i < 4; ++i) sacc[i] = (f32x4){0.f, 0.f, 0.f, 0.f};
        sb[0] = (bf16x8_t){0, 0, 0, 0, 0, 0, 0, 0}; sb[1] = sb[0];
        f32x4 gln[4];
#pragma unroll
        for (int kt = 0; kt < 4; ++kt) gln[kt] = *(const GAS f32x4*)(src + 49152 + (16 * kt + 4 * q) * 4);
        CH_BAR();
        for (int c = 0; c < NCH; ++c) {
            const LAS unsigned char* st = (c & 1) ? st1 : st0;
            f32x4 glc[4];
#pragma unroll
            for (int kt = 0; kt < 4; ++kt) glc[kt] = gln[kt];
            { const int cn = (c + 1 < NCH) ? c + 1 : c;
#pragma unroll
              for (int kt = 0; kt < 4; ++kt) gln[kt] = *(const GAS f32x4*)(src + (size_t)cn * CH_STRIDE + 49152 + (16 * kt + 4 * q) * 4); }
            { GAS v2u* o = (GAS v2u*)(s0g + (size_t)c * 8192 + (vrow * 64 + 4 * q) * 2);
              const v4u w0 = __builtin_bit_cast(v4u, sb[0]), w1 = __builtin_bit_cast(v4u, sb[1]);
              o[0] = (v2u){w0.x, w0.y}; o[4] = (v2u){w0.z, w0.w}; o[8] = (v2u){w1.x, w1.y}; o[12] = (v2u){w1.z, w1.w}; }
            f32x4 u[4];
#pragma unroll
            for (int tt = 0; tt < 4; ++tt) {
                u[tt] = *(const LAS f32x4*)(st + 32768 + (vrow * 64 + 16 * tt + 4 * q) * 4);
#pragma unroll
                for (int s = 0; s < 2; ++s) { const bf16x8_t a = *(const LAS bf16x8_t*)(st + ((16 * tt + r16) * 64 + 32 * s + 8 * q) * 2); u[tt] = __builtin_amdgcn_mfma_f32_16x16x32_bf16(a, sb[s], u[tt], 0, 0, 0); }
            }
            bf16x8_t ub[2];
            { v4u w0, w1; w0.x = cvtpk(u[0][0], u[0][1]); w0.y = cvtpk(u[0][2], u[0][3]); w0.z = cvtpk(u[1][0], u[1][1]); w0.w = cvtpk(u[1][2], u[1][3]);
              w1.x = cvtpk(u[2][0], u[2][1]); w1.y = cvtpk(u[2][2], u[2][3]); w1.z = cvtpk(u[3][0], u[3][1]); w1.w = cvtpk(u[3][2], u[3][3]);
              ub[0] = __builtin_bit_cast(bf16x8_t, w0); ub[1] = __builtin_bit_cast(bf16x8_t, w1);
              GAS v2u* o = (GAS v2u*)(utg + (size_t)c * 8192 + (vrow * 64 + 4 * q) * 2);
              o[0] = (v2u){w0.x, w0.y}; o[4] = (v2u){w0.z, w0.w}; o[8] = (v2u){w1.x, w1.y}; o[12] = (v2u){w1.z, w1.w}; }
            bf16x8_t vb[2];
#pragma unroll
            for (int s = 0; s < 2; ++s) vb[s] = *(const LAS bf16x8_t*)(st + 24576 + (vrow * 64 + 32 * s + 8 * q) * 2);
#pragma unroll
            for (int kt = 0; kt < 4; ++kt) {
#pragma unroll
                for (int s = 0; s < 2; ++s) { const bf16x8_t a = *(const LAS bf16x8_t*)(st + 16384 + ((16 * kt + r16) * 64 + 32 * s + 8 * q) * 2); sacc[kt] = __builtin_amdgcn_mfma_f32_16x16x32_bf16(a, vb[s], sacc[kt], 0, 0, 0); }
#pragma unroll
                for (int s = 0; s < 2; ++s) { const bf16x8_t a = *(const LAS bf16x8_t*)(st + 8192 + ((16 * kt + r16) * 64 + 32 * s + 8 * q) * 2); sacc[kt] = __builtin_amdgcn_mfma_f32_16x16x32_bf16(a, ub[s], sacc[kt], 0, 0, 0); }
                sacc[kt] = sacc[kt] * glc[kt];
            }
            { v4u w0, w1; w0.x = cvtpk(sacc[0][0], sacc[0][1]); w0.y = cvtpk(sacc[0][2], sacc[0][3]); w0.z = cvtpk(sacc[1][0], sacc[1][1]); w0.w = cvtpk(sacc[1][2], sacc[1][3]);
              w1.x = cvtpk(sacc[2][0], sacc[2][1]); w1.y = cvtpk(sacc[2][2], sacc[2][3]); w1.z = cvtpk(sacc[3][0], sacc[3][1]); w1.w = cvtpk(sacc[3][2], sacc[3][3]);
              sb[0] = __builtin_bit_cast(bf16x8_t, w0); sb[1] = __builtin_bit_cast(bf16x8_t, w1); }
            CH_BAR();
        }
    }
}

__device__ __forceinline__ void rwkv_chunk_out(Frame& F, int l) {
    LAS float* tRq = (LAS float*)(F.lds + RING_OFF);
    LAS float* tS = tRq + 64 * TP; LAS float* tM = tS + 64 * TP; LAS float* tU = tM + 64 * TP;
    const GAS float* gv = WSP(float, WS_RV); const GAS float* gg = WSP(float, WS_RG); const GAS float* sbp = WSP(float, WS_RSB);
    GAS bf16* ycat = WSP(bf16, WS_YCAT);
    const int t = F.tid >> 3, sub = F.tid & 7;
    for (int item = F.vcu; item < NITEM; item += F.G) {
        const int h = item % 6, bc = item / 6, c = bc % NCH, b = bc / NCH; const size_t tokb = (size_t)b * SEQ + 64 * c;
        const int ci = (b * 6 + h) * NCH + c;
        const GAS unsigned char* cod = F.ws + WS_RCO + (size_t)ci * CO_STRIDE;
        const GAS bf16* srcs[4] = {(const GAS bf16*)cod, (const GAS bf16*)(F.ws + WS_RS0 + (size_t)ci * 8192), (const GAS bf16*)(cod + 8192), (const GAS bf16*)(F.ws + WS_RUT + (size_t)ci * 8192)};
#pragma unroll
        for (int a = 0; a < 4; ++a) {
            LAS float* dstt = tRq + a * 64 * TP;
            const v4u wv = *(const GAS v4u*)(srcs[a] + t * 64 + 8 * sub);
            *(LAS f32x4*)(dstt + t * TP + 8 * sub) = (f32x4){bf2f(wv.x & 0xffffu), bf2f(wv.x >> 16), bf2f(wv.y & 0xffffu), bf2f(wv.y >> 16)};
            *(LAS f32x4*)(dstt + t * TP + 8 * sub + 4) = (f32x4){bf2f(wv.z & 0xffffu), bf2f(wv.z >> 16), bf2f(wv.w & 0xffffu), bf2f(wv.w >> 16)};
        }
        __syncthreads();
        float y1[8], y2[8];
        mm_nt(tRq, tS, t, sub, y1);
        mm_nt(tM, tU, t, sub, y2);
        const GAS float* y0 = (const GAS float*)(cod + 16384) + t * 64;
        float sum = 0.f;
#pragma unroll
        for (int j = 0; j < 8; ++j) { y1[j] += y2[j] + y0[sub + 8 * j]; sum += y1[j]; }
        sum += __shfl_xor(sum, 1); sum += __shfl_xor(sum, 2); sum += __shfl_xor(sum, 4);
        const float mean = sum * (1.f / 64.f); float vs = 0.f;
#pragma unroll
        for (int j = 0; j < 8; ++j) { y1[j] -= mean; vs += y1[j] * y1[j]; }
        vs += __shfl_xor(vs, 1); vs += __shfl_xor(vs, 2); vs += __shfl_xor(vs, 4);
        const float rstd = 1.0f / sqrtf(vs * (1.f / 64.f) + GN_EPS);
        const size_t tok = tokb + t; const float sbv = sbp[tok * 8 + h];
        const GAS float* lg = INP(I_LNXG) + l * RW + 64 * h; const GAS float* lb = INP(I_LNXB) + l * RW + 64 * h;
#pragma unroll
        for (int j = 0; j < 8; ++j) { const int v = sub + 8 * j; const size_t o = tok * RW + 64 * h + v;
            float r = y1[j] * rstd * lg[v] + lb[v]; r += sbv * gv[o]; r *= gg[o];
            ycat[tok * D + 256 + 64 * h + v] = (bf16)f2bf(r); }
        __syncthreads();
    }
}

constexpr int BP = 72;
typedef LAS unsigned short lbf;
__device__ __forceinline__ f32x4 mma_nt64(const lbf* P, int p0, const lbf* Q, int q0, int r16, int q, f32x4 acc) {
#pragma unroll
    for (int s = 0; s < 2; ++s) { const bf16x8_t a = *(const LAS bf16x8_t*)(P + (p0 + r16) * BP + 32 * s + 8 * q); const bf16x8_t b = *(const LAS bf16x8_t*)(Q + (q0 + r16) * BP + 32 * s + 8 * q);
        acc = __builtin_amdgcn_mfma_f32_16x16x32_bf16(a, b, acc, 0, 0, 0); }
    return acc;
}
constexpr size_t LORA_L = 221184;

__device__ __forceinline__ void rwkv_item_prep(Frame& F, int l) {
    LAS unsigned char* L = F.lds + RING_OFF;
    LAS float* fR = (LAS float*)(L + 0); LAS float* fK = (LAS float*)(L + 17408); LAS float* fV = (LAS float*)(L + 34816); LAS float* fL = (LAS float*)(L + 52224);
    LAS float* fA = (LAS float*)(L + 69632); LAS float* fT = (LAS float*)(L + 87040); LAS float* fX = (LAS float*)(L + 104448);
    lbf* Xw = (lbf*)(L + 69632); lbf* Xa = (lbf*)(L + 78848); lbf* Xg = (lbf*)(L + 88064); lbf* Xv = (lbf*)(L + 105472); LAS float* tot = (LAS float*)(L + 110592); LAS float* red = (LAS float*)(L + 111616);
    lbf* bA = (lbf*)(L + 0); lbf* bR = (lbf*)(L + 9216); lbf* bB = (lbf*)(L + 18432); lbf* bK = (lbf*)(L + 27648); lbf* bVT = (lbf*)(L + 36864); lbf* bMak = (lbf*)(L + 46080); lbf* bMrk = (lbf*)(L + 55296); lbf* bMrb = (lbf*)(L + 121856);
    const GAS float* p = WSP(float, WS_P); const GAS float* mu = INP(I_MU) + l * RWC;
    GAS float* vfirst = WSP(float, WS_VFIRST); GAS float* oV = WSP(float, WS_RV); GAS float* oG = WSP(float, WS_RG); GAS float* oSB = WSP(float, WS_RSB);
    const GAS unsigned char* lw_ = F.ws + WS_LORA + (size_t)l * LORA_L;
    const int lane = F.lane, r16 = lane & 15, q = lane >> 4, w = F.wave;
    for (int item = F.vcu; item < NITEM; item += F.G) {
        const int h = item % 6, bc = item / 6, c = bc % NCH, b = bc / NCH; const size_t tokb = (size_t)b * SEQ + 64 * c;
        const int ci = (b * 6 + h) * NCH + c;
        GAS unsigned char* chd = F.ws + WS_RCH + (size_t)ci * CH_STRIDE; GAS unsigned char* cod = F.ws + WS_RCO + (size_t)ci * CO_STRIDE;
        const bool first = (c == 0);
#pragma unroll 4
        for (int idx = F.tid; idx < 3 * 4096; idx += NWAVES * 64) { const int which = idx >> 12, s = (idx >> 6) & 63, d = idx & 63; const int j = which * 384 + 64 * h + d;
            const GAS float* pc = p + (tokb + s) * PC + P_RW + j; const float cur = pc[0]; const float pv = pc[(first && s == 0) ? 0 : -PC]; const float prev = (first && s == 0) ? 0.f : pv;
            ((LAS float*)(L + which * 17408))[s * TP + d] = cur + mu[j] * (prev - cur); }
#pragma unroll 4
        for (int idx = F.tid; idx < 2 * 4096; idx += NWAVES * 64) { const int which = idx >> 12, s = (idx >> 6) & 63, d = idx & 63; const int j = 1152 + which * 64 + d;
            const GAS float* pc = p + (tokb + s) * PC + P_RW + j; const float cur = pc[0]; const float pv = pc[(first && s == 0) ? 0 : -PC]; const float prev = (first && s == 0) ? 0.f : pv;
            float x = cur + mu[j] * (prev - cur); if (which == 0) x = tanhf(x);
            (which == 0 ? Xw : Xa)[s * BP + d] = (unsigned short)f2bf(x); }
#pragma unroll 4
        for (int idx = F.tid; idx < 8192; idx += NWAVES * 64) { const int s = idx >> 7, d = idx & 127; const int j = 1280 + d;
            const GAS float* pc = p + (tokb + s) * PC + P_RW + j; const float cur = pc[0]; const float pv = pc[(first && s == 0) ? 0 : -PC]; const float prev = (first && s == 0) ? 0.f : pv;
            Xg[s * 136 + d] = (unsigned short)f2bf(sigmoidf_(cur + mu[j] * (prev - cur))); }
        if (l == 1) for (int idx = F.tid; idx < 2048; idx += NWAVES * 64) { const int s = idx >> 5, d = idx & 31; Xv[s * 40 + d] = (unsigned short)f2bf(p[(tokb + s) * PC + P_V1 + d]); }
        __syncthreads();
        float er[8], ena[8], ebb[8], ekp[8], ev[8], elw[8];
        const int mtw = w >> 1, hw = w & 1;
        {
            f32x4 dw[2], da[2], dg[2], dv[2];
#pragma unroll
            for (int n2 = 0; n2 < 2; ++n2) {
                const int chg = 64 * h + 16 * (2 * hw + n2) + r16;
                dw[n2] = (f32x4){0.f, 0.f, 0.f, 0.f}; da[n2] = dw[n2]; dg[n2] = dw[n2]; dv[n2] = dw[n2];
#pragma unroll
                for (int s = 0; s < 2; ++s) { const bf16x8_t a = *(const LAS bf16x8_t*)(Xw + (16 * mtw + r16) * BP + 32 * s + 8 * q); const bf16x8_t bb_ = *(const GAS bf16x8_t*)(lw_ + ((size_t)chg * 64 + 32 * s + 8 * q) * 2);
                    dw[n2] = __builtin_amdgcn_mfma_f32_16x16x32_bf16(a, bb_, dw[n2], 0, 0, 0); }
#pragma unroll
                for (int s = 0; s < 2; ++s) { const bf16x8_t a = *(const LAS bf16x8_t*)(Xa + (16 * mtw + r16) * BP + 32 * s + 8 * q); const bf16x8_t bb_ = *(const GAS bf16x8_t*)(lw_ + 49152 + ((size_t)chg * 64 + 32 * s + 8 * q) * 2);
                    da[n2] = __builtin_amdgcn_mfma_f32_16x16x32_bf16(a, bb_, da[n2], 0, 0, 0); }
#pragma unroll
                for (int s = 0; s < 4; ++s) { const bf16x8_t a = *(const LAS bf16x8_t*)(Xg + (16 * mtw + r16) * 136 + 32 * s + 8 * q); const bf16x8_t bb_ = *(const GAS bf16x8_t*)(lw_ + 98304 + ((size_t)chg * 128 + 32 * s + 8 * q) * 2);
                    dg[n2] = __builtin_amdgcn_mfma_f32_16x16x32_bf16(a, bb_, dg[n2], 0, 0, 0); }
                if (l == 1) { const bf16x8_t a = *(const LAS bf16x8_t*)(Xv + (16 * mtw + r16) * 40 + 8 * q); const bf16x8_t bb_ = *(const GAS bf16x8_t*)(lw_ + 196608 + ((size_t)chg * 32 + 8 * q) * 2);
                    dv[n2] = __builtin_amdgcn_mfma_f32_16x16x32_bf16(a, bb_, dv[n2], 0, 0, 0); }
            }
            float kk2[4] = {0.f, 0.f, 0.f, 0.f}, sbs[4] = {0.f, 0.f, 0.f, 0.f};
#pragma unroll
            for (int n2 = 0; n2 < 2; ++n2) {
                const int chl = 16 * (2 * hw + n2) + r16, chg = l * RW + 64 * h + chl;
                const float w0 = INP(I_W0)[chg], a0 = INP(I_A0)[chg], kks = INP(I_KKS)[chg], ka = INP(I_KA)[chg], rk = INP(I_RK)[chg];
                const float v0 = (l == 1) ? INP(I_V0)[64 * h + chl] : 0.f;
#pragma unroll
                for (int rg = 0; rg < 4; ++rg) {
                    const int e = 4 * n2 + rg; const int tk = 16 * mtw + 4 * q + rg; const size_t o = (tokb + tk) * RW + 64 * h + chl;
                    const float r = fR[tk * TP + chl], k = fK[tk * TP + chl]; float v = fV[tk * TP + chl];
                    const float wlog = -softplusf_(-(w0 + dw[n2][rg])) - 0.5f; elw[e] = -__expf(wlog);
                    const float ai = sigmoidf_(a0 + da[n2][rg]);
                    if (l == 0) vfirst[o] = v; else { const float vg = sigmoidf_(v0 + dv[n2][rg]); v = v + (vfirst[o] - v) * vg; }
                    const float kkv = k * kks; kk2[rg] += kkv * kkv; ena[e] = kkv;
                    const float kp = k * (1.0f + (ai - 1.0f) * ka); sbs[rg] += r * kp * rk;
                    er[e] = r; ekp[e] = kp; ev[e] = v; ebb[e] = ai;
                    oV[o] = v; oG[o] = dg[n2][rg];
                    fL[tk * TP + chl] = elw[e];
                }
            }
#pragma unroll
            for (int rg = 0; rg < 4; ++rg) {
#pragma unroll
                for (int o_ = 1; o_ < 16; o_ <<= 1) { kk2[rg] += __shfl_xor(kk2[rg], o_); sbs[rg] += __shfl_xor(sbs[rg], o_); }
                if (r16 == 0) { red[(hw * 64 + 16 * mtw + 4 * q + rg) * 2 + 0] = kk2[rg]; red[(hw * 64 + 16 * mtw + 4 * q + rg) * 2 + 1] = sbs[rg]; }
            }
        }
        __syncthreads();
#pragma unroll
        for (int rg = 0; rg < 4; ++rg) { const int tk = 16 * mtw + 4 * q + rg;
            const float k2 = red[tk * 2] + red[(64 + tk) * 2]; const float inv = 1.0f / fmaxf(sqrtf(k2), 1e-12f);
#pragma unroll
            for (int n2 = 0; n2 < 2; ++n2) { const int e = 4 * n2 + rg; const float kk = ena[e] * inv; ena[e] = -kk; ebb[e] = kk * ebb[e]; }
            if (hw == 0 && r16 == 0) oSB[(tokb + tk) * 8 + h] = red[tk * 2 + 1] + red[(64 + tk) * 2 + 1]; }
        if (F.tid < 256) { const int ch = F.tid & 63, sg = F.tid >> 6; float run = 0.f;
#pragma unroll
            for (int s = 0; s < 16; ++s) { run += fL[(16 * sg + s) * TP + ch]; fL[(16 * sg + s) * TP + ch] = run; }
            tot[sg * 64 + ch] = run; }
        __syncthreads();
        if (F.tid < 256) { const int ch = F.tid & 63, sg = F.tid >> 6; float off = 0.f;
            for (int s2 = 0; s2 < sg; ++s2) off += tot[s2 * 64 + ch];
            if (sg > 0) {
#pragma unroll
                for (int s = 0; s < 16; ++s) fL[(16 * sg + s) * TP + ch] += off; } }
        __syncthreads();
        {
#pragma unroll
            for (int n2 = 0; n2 < 2; ++n2) { const int chl = 16 * (2 * hw + n2) + r16;
                float vv[4];
#pragma unroll
                for (int rg = 0; rg < 4; ++rg) { const int e = 4 * n2 + rg; const int tk = 16 * mtw + 4 * q + rg;
                    const float cw = fL[tk * TP + chl]; const float ecw = __expf(cw), ecx = __expf(cw - elw[e]), ein = __expf(-cw);
                    const float at = ena[e] * ecx;
                    fA[tk * TP + chl] = at; bA[tk * BP + chl] = (unsigned short)f2bf(at); bR[tk * BP + chl] = (unsigned short)f2bf(er[e] * ecw);
                    bB[tk * BP + chl] = (unsigned short)f2bf(ebb[e] * ein); bK[tk * BP + chl] = (unsigned short)f2bf(ekp[e] * ein); vv[rg] = ev[e];
                    if (tk == 63) ((GAS float*)(chd + 49152))[chl] = ecw; }
                *(LAS v2u*)(bVT + chl * BP + 16 * mtw + 4 * q) = (v2u){pk2(vv[0], vv[1]), pk2(vv[2], vv[3])};
            }
        }
        __syncthreads();
        { const int kind = w >> 1;
#pragma unroll 1
          for (int tix = 0; tix < 8; ++tix) { const int tile = (w & 1) * 8 + tix; const int mt = tile >> 2, nt = tile & 3;
            f32x4 acc = (f32x4){0.f, 0.f, 0.f, 0.f};
            if (kind == 3) {
                acc = mma_nt64(bA, 16 * mt, bB, 16 * nt, r16, q, acc);
                const int i = 16 * nt + r16; f32x4 o;
#pragma unroll
                for (int rg = 0; rg < 4; ++rg) o[rg] = (i < 16 * mt + 4 * q + rg) ? acc[rg] : 0.f;
                *(LAS f32x4*)(fX + i * TP + 16 * mt + 4 * q) = o;
            } else {
                const lbf* Pm = (kind == 2) ? bB : bK; const lbf* Qm = (kind == 0) ? bA : bR; lbf* dst = (kind == 0) ? bMak : (kind == 1) ? bMrk : bMrb;
                acc = mma_nt64(Pm, 16 * nt, Qm, 16 * mt, r16, q, acc);
                const int t = 16 * mt + r16; float o[4];
#pragma unroll
                for (int rg = 0; rg < 4; ++rg) { const int i = 16 * nt + 4 * q + rg; o[rg] = ((kind == 0) ? (i < t) : (i <= t)) ? acc[rg] : 0.f; }
                *(LAS v2u*)(dst + t * BP + 16 * nt + 4 * q) = (v2u){pk2(o[0], o[1]), pk2(o[2], o[3])};
            } } }
        __syncthreads();
        { const int mt = w & 3;
#pragma unroll 1
          for (int nt = 0; nt < 4; ++nt) {
            f32x4 acc = (f32x4){0.f, 0.f, 0.f, 0.f};
            if (w < 4) { acc = mma_nt64(bMak, 16 * mt, bVT, 16 * nt, r16, q, acc);
#pragma unroll
                for (int rg = 0; rg < 4; ++rg) fT[(16 * mt + 4 * q + rg) * TP + 16 * nt + r16] = acc[rg]; }
            else { acc = mma_nt64(bVT, 16 * nt, bMrk, 16 * mt, r16, q, acc);
                *(GAS f32x4*)((GAS float*)(cod + 16384) + (16 * mt + r16) * 64 + 16 * nt + 4 * q) = acc; } } }
        __syncthreads();
        if (w < 2) {
            LAS float* tile = (w == 0) ? fA : fT; const int cidx = lane;
            const LAS float* tXv = fX + (lane & 0); asm volatile("" : "+v"(tXv));
            float acc[64];
#pragma unroll
            for (int i = 0; i < 64; ++i) acc[i] = tile[i * TP + cidx];
#pragma unroll
            for (int i = 0; i < 63; ++i) {
                const float xi = acc[i];
#pragma unroll
                for (int t4 = ((i + 1) & ~3); t4 < 64; t4 += 4) { const f32x4 mm = *(const LAS f32x4*)(tXv + i * TP + t4);
                    if (t4 + 0 > i) acc[t4 + 0] += mm.x * xi; if (t4 + 1 > i) acc[t4 + 1] += mm.y * xi; if (t4 + 2 > i) acc[t4 + 2] += mm.z * xi; if (t4 + 3 > i) acc[t4 + 3] += mm.w * xi; }
            }
#pragma unroll
            for (int i = 0; i < 64; ++i) tile[i * TP + cidx] = acc[i];
        } else {
            for (int pz = F.tid - 128; pz < 512; pz += 384) { const int row = pz >> 3, sub = pz & 7; const int s_ = sub >> 2, q_ = sub & 3; const int i0 = 32 * s_ + 4 * q_, i1 = i0 + 16;
                *(GAS v4u*)(cod + pz * 16) = *(const LAS v4u*)(bR + row * BP + 8 * sub);
                *(GAS v4u*)(cod + 8192 + pz * 16) = *(const LAS v4u*)(bMrb + row * BP + 8 * sub);
                { const v2u a = *(const LAS v2u*)(bVT + row * BP + i0), b2 = *(const LAS v2u*)(bVT + row * BP + i1); *(GAS v4u*)(chd + 24576 + pz * 16) = (v4u){a.x, a.y, b2.x, b2.y}; }
                unsigned e[8];
#pragma unroll
                for (int j = 0; j < 8; ++j) e[j] = bB[((j < 4 ? i0 : i1) + (j & 3)) * BP + row];
                *(GAS v4u*)(chd + 8192 + pz * 16) = (v4u){e[0] | (e[1] << 16), e[2] | (e[3] << 16), e[4] | (e[5] << 16), e[6] | (e[7] << 16)};
#pragma unroll
                for (int j = 0; j < 8; ++j) e[j] = bK[((j < 4 ? i0 : i1) + (j & 3)) * BP + row];
                *(GAS v4u*)(chd + 16384 + pz * 16) = (v4u){e[0] | (e[1] << 16), e[2] | (e[3] << 16), e[4] | (e[5] << 16), e[6] | (e[7] << 16)}; }
        }
        __syncthreads();
        { const int row = F.tid >> 3, sub = F.tid & 7; const int s_ = sub >> 2, q_ = sub & 3; const int i0 = 32 * s_ + 4 * q_, i1 = i0 + 16;
          const f32x4 a = *(const LAS f32x4*)(fA + row * TP + i0), bq = *(const LAS f32x4*)(fA + row * TP + i1);
          *(GAS v4u*)(chd + F.tid * 16) = (v4u){pk2(a.x, a.y), pk2(a.z, a.w), pk2(bq.x, bq.y), pk2(bq.z, bq.w)};
#pragma unroll
          for (int hh = 0; hh < 2; ++hh) { const int pz = F.tid + 512 * hh; const int v = pz >> 4, t4 = (pz & 15) * 4;
              *(GAS f32x4*)(chd + 32768 + pz * 16) = (f32x4){fT[(t4 + 0) * TP + v], fT[(t4 + 1) * TP + v], fT[(t4 + 2) * TP + v], fT[(t4 + 3) * TP + v]}; } }
        __syncthreads();
    }
}
__device__ __forceinline__ void lora_convert(Frame& F) {
    const int gt = F.vcu * (NWAVES * 64) + F.tid, NT_ = F.G * NWAVES * 64;
    for (int l = 0; l < DEPTH; ++l) {
        bf16* base = (bf16*)(F.ws + WS_LORA + (size_t)l * LORA_L);
        const GAS float* w2 = INP(I_W2) + (size_t)l * 64 * RW; const GAS float* a2 = INP(I_A2) + (size_t)l * 64 * RW; const GAS float* g2 = INP(I_G2) + (size_t)l * 128 * RW; const GAS float* v2 = INP(I_V2);
        for (int i = gt; i < RW * 64; i += NT_) { const int ch = i >> 6, j = i & 63; base[i] = (bf16)f2bf(w2[(size_t)j * RW + ch]); base[24576 + i] = (bf16)f2bf(a2[(size_t)j * RW + ch]); }
        for (int i = gt; i < RW * 128; i += NT_) { const int ch = i >> 7, j = i & 127; base[49152 + i] = (bf16)f2bf(g2[(size_t)j * RW + ch]); }
        if (l == 1) for (int i = gt; i < RW * 32; i += NT_) { const int ch = i >> 5, j = i & 31; base[98304 + i] = (bf16)f2bf(v2[(size_t)j * RW + ch]); }
    }
}

#ifndef MK_N_LAUNCHES
#define MK_N_LAUNCHES 1
#endif
constexpr int PH_PER_LAYER = 11, N_PHASES = 1 + DEPTH * PH_PER_LAYER;
struct Args { const float* in[34]; float* out; unsigned char* ws; int ph_lo, ph_hi; };
__global__ void __launch_bounds__(NWAVES * 64, 2) mk_fwd(Args args) {
    extern __shared__ __attribute__((aligned(16))) unsigned char lds[];
    Frame F0;
    F0.lds = (LAS unsigned char*)lds;
    F0.MISC = (volatile LAS unsigned*)(F0.lds + MISC_OFF);
    F0.tid = threadIdx.x; F0.lane = F0.tid & 63; F0.wave = __builtin_amdgcn_readfirstlane(F0.tid >> 6);
    F0.G = gridDim.x; { const int bx = blockIdx.x; F0.vcu = (F0.G % 8 == 0) ? (bx % 8) * (F0.G / 8) + bx / 8 : bx; }
    F0.ws = (GAS unsigned char*)args.ws; F0.ctl = (gu32*)(args.ws + WS_CTL); F0.out = (GAS float*)args.out;
    for (int u = F0.tid; u < (LDS_BYTES - LDSCTL_OFF) / 4; u += NWAVES * 64) ((LAS unsigned*)(F0.lds + LDSCTL_OFF))[u] = 0u;
    __syncthreads();
    if (F0.tid < 34) *(LAS unsigned long long*)(F0.lds + PTR_OFF + 8 * F0.tid) = (unsigned long long)args.in[F0.tid];
    __syncthreads();
    XcdBarrier bar; bar.bar = (unsigned*)(F0.ctl + CW_BAR); bar.x = 0; bar.st = nullptr;
    const int lo = args.ph_lo, hi = args.ph_hi;
    if (hi - lo > 1) bar = xcd_barrier_post((unsigned*)(F0.ctl + CW_BAR), F0.MISC + 8);

#ifndef PROBE_KP
#define PROBE_KP (-1)
#define PROBE_REPS 1
#endif
#ifndef PROBE_SUB
#define PROBE_SUB (-1)
#endif
#define SUBRUN(i) (rep == 0 || PROBE_SUB < 0 || PROBE_SUB == (i))
    for (int ph_ = lo; ph_ < hi; ++ph_) {
    const int ph = launder_s(ph_);
    const int nrep = ((ph == 0 && PROBE_KP == 100) || (ph > 0 && (ph - 1) % PH_PER_LAYER == PROBE_KP)) ? PROBE_REPS : 1;
    for (int rep = 0; rep < nrep; ++rep) {
    if (rep > 0) xcd_barrier(bar);
    if (ph == 0) { Frame F = launder(F0);
#ifndef SKIP_CONV
            phase_convert(F);
            { Frame Fb = launder(F0); lora_convert(Fb); }
#endif
             }

    else {
        const int l = launder_s((ph - 1) / PH_PER_LAYER); const int kp = launder_s((ph - 1) % PH_PER_LAYER);
        if (kp == 0) { Frame F = launder(F0);
            pg8::Gemm g{(const pg8::bf16_t*)WSP(pg8::bf16_t, WS_H16), (const pg8::bf16_t*)WSP(pg8::bf16_t, WS_WIN + l * WIN_L), T, PC, D, 0};
            pg8::StaticOrder S; S.init(T, PC, F.G, (int)blockIdx.x);
            pg8::EpiF32 E{WSP(float, WS_P), PC};

#ifndef SKIP_G1
            pg8::gemm_phase<pg8::EpiF32, pg8::StaticOrder, true, true>(F.lds + RING_OFF, g, S, E);
#endif

        }
        else if (kp == 1) { Frame F = launder(F0);
#ifndef SKIP_PREP
            if (SUBRUN(0)) { Frame Fa = launder(F0); pool_items(Fa, launder_s(l)); } __syncthreads(); if (SUBRUN(1)) { Frame Fb = launder(F0); rwkv_item_prep(Fb, launder_s(l)); } if (SUBRUN(2)) { Frame Fc = launder(F0); mlstm_summ(Fc, launder_s(l)); }
#endif
             }
        else if (kp == 2) { Frame F = launder(F0);
#ifndef SKIP_SCAN
            if (SUBRUN(0)) { Frame Fa = launder(F0); mlstm_scan(Fa); } if (SUBRUN(1)) { Frame Fb = launder(F0); rwkv_chain(Fb); }
#endif
             }
        else if (kp == 3) { Frame F = launder(F0);
#ifndef SKIP_FIN
            if (SUBRUN(0)) { Frame Fa = launder(F0); rwkv_chunk_out(Fa, launder_s(l)); } if (SUBRUN(1)) { Frame Fb = launder(F0); mlstm_out(Fb, launder_s(l)); }
#endif
             }
        else if (kp == 4) { Frame F = launder(F0);
            pg8::Gemm g{(const pg8::bf16_t*)WSP(pg8::bf16_t, WS_YCAT), (const pg8::bf16_t*)WSP(pg8::bf16_t, WS_WOUT + l * WOUT_L), T, D, D, 0};
            pg8::StaticOrder S; S.init(T, D, F.G, (int)blockIdx.x);
            pg8::EpiF32 E{WSP(float, WS_MIX), D};

#ifndef SKIP_G2
            pg8::gemm_phase<pg8::EpiF32, pg8::StaticOrder, false, true>(F.lds + RING_OFF, g, S, E);
#endif

        }
        else if (kp == 5) { Frame F = launder(F0);
#ifndef SKIP_LN
            ln_rows(F, (l == 0) ? INP(I_X) : WSP(float, WS_HB), WSP(float, WS_MIX), INP(I_LN1G) + l * D, INP(I_LN1B) + l * D, WSP(float, WS_HA), WSP(bf16, WS_H16));
#endif
             }
        else if (kp == 6) { Frame F = launder(F0);
#ifndef SKIP_RT
            router_phase(F, l, WSP(float, WS_HA));
#endif
             }
        else if (kp == 7) { Frame F = launder(F0);
#ifndef SKIP_AS
            assign_phase(F, l);
#endif
             }
        else if (kp == 8) { Frame F = launder(F0);
            pg8::Gemm g{(const pg8::bf16_t*)WSP(pg8::bf16_t, WS_XG), (const pg8::bf16_t*)WSP(pg8::bf16_t, WS_WGU + (size_t)l * 32 * WGU_E), NSLOT, 2048, D, WGU_E};
            MoeOrder<8> S; S.nb = (int)__builtin_amdgcn_readfirstlane(__hip_atomic_load(F.ctl + CW_NB + l, RLX_AGENT)); S.c = (int)blockIdx.x; S.blke = F.ctl + CW_BLKE + l * 320;
            pg8::EpiSwiGLU E{WSP(pg8::bf16_t, WS_ACT), INP(I_BGU) + (size_t)l * NE * 2048};

#ifndef SKIP_GU
            pg8::gemm_phase<pg8::EpiSwiGLU, MoeOrder<8>, true, true>(F.lds + RING_OFF, g, S, E);
#endif

        }
        else if (kp == 9) { Frame F = launder(F0);
            pg8::Gemm g{(const pg8::bf16_t*)WSP(pg8::bf16_t, WS_ACT), (const pg8::bf16_t*)WSP(pg8::bf16_t, WS_WDN + (size_t)l * 32 * WDN_E), NSLOT, D, FF, WDN_E};
            MoeOrder<4> S; S.nb = (int)__builtin_amdgcn_readfirstlane(__hip_atomic_load(F.ctl + CW_NB + l, RLX_AGENT)); S.c = (int)blockIdx.x; S.blke = F.ctl + CW_BLKE + l * 320;
            pg8::EpiDown E{WSP(pg8::bf16_t, WS_OSL), INP(I_BDN) + (size_t)l * NE * D, WSP(float, WS_GSL)};

#ifndef SKIP_DN
            pg8::gemm_phase<pg8::EpiDown, MoeOrder<4>, true, true>(F.lds + RING_OFF, g, S, E);
#endif

        }
        else if (kp == 10) { Frame F = launder(F0);
#ifndef SKIP_CB
            combine_phase(F, WSP(float, WS_HA), INP(I_LN2G) + l * D, INP(I_LN2B) + l * D, (l == DEPTH - 1) ? F.out : WSP(float, WS_HB), WSP(bf16, WS_H16));
#endif
             }
    }
    }
    if (ph_ + 1 < hi) xcd_barrier(bar);
    }
}

extern "C" void kernel_launch(void* const* d_in, const int* in_sizes, int n_in, void* d_out, int out_size, void* d_ws, size_t ws_size, hipStream_t stream) {
    static int grid = 0;
    if (grid == 0) {
        if (n_in != 34 || in_sizes[0] != T * D || out_size != T * D || ws_size < WS_END) { fprintf(stderr, "kernel_launch: unexpected shapes / workspace (n_in %d, in0 %d, out %d, ws %zu, need %zu)\n", n_in, n_in > 0 ? in_sizes[0] : -1, out_size, ws_size, (size_t)WS_END); grid = -1; return; }
        int dev = 0, cus = 0, per_cu = 0;
        if (hipGetDevice(&dev) != hipSuccess || hipDeviceGetAttribute(&cus, hipDeviceAttributeMultiprocessorCount, dev) != hipSuccess) { grid = -1; return; }
        if (hipFuncSetAttribute((const void*)mk_fwd, hipFuncAttributeMaxDynamicSharedMemorySize, LDS_BYTES) != hipSuccess) { fprintf(stderr, "kernel_launch: hipFuncSetAttribute failed\n"); grid = -1; return; }
        if (hipOccupancyMaxActiveBlocksPerMultiprocessor(&per_cu, (const void*)mk_fwd, NWAVES * 64, LDS_BYTES) != hipSuccess || per_cu < 1) { fprintf(stderr, "kernel_launch: occupancy query says %d blocks per CU\n", per_cu); }
        (void)hipGetLastError();
        grid = cus;
        if (grid % 8 != 0 || grid > 256) grid = (grid > 256) ? 256 : (grid / 8) * 8;
    }
    if (grid <= 0) return;
    (void)hipMemsetAsync((char*)d_ws + WS_CTL, 0, CTL_ZERO_BYTES, stream);
    Args a{};
    for (int i = 0; i < 34; ++i) a.in[i] = (const float*)d_in[i];
    a.out = (float*)d_out; a.ws = (unsigned char*)d_ws;
#if MK_N_LAUNCHES == 1
    a.ph_lo = 0; a.ph_hi = N_PHASES;
    hipLaunchKernelGGL(mk_fwd, dim3(grid), dim3(NWAVES * 64), LDS_BYTES, stream, a);
#else
    for (int ph = 0; ph < N_PHASES; ++ph) { a.ph_lo = ph; a.ph_hi = ph + 1; hipLaunchKernelGGL(mk_fwd, dim3(grid), dim3(NWAVES * 64), LDS_BYTES, stream, a); }
#endif
}
```

```cpp
#include <hip/hip_runtime.h>
#include <cstdio>
#include <cstdint>
namespace pg8 {
#define PG8_LAS __attribute__((address_space(3)))
typedef unsigned short bf16_t;
typedef short bf16x8 __attribute__((ext_vector_type(8)));
typedef float f32x4 __attribute__((ext_vector_type(4)));
typedef unsigned u32x4 __attribute__((ext_vector_type(4)));
constexpr int BM = 256, BK = 64, HALF = 128, HTB = HALF * BK * 2  , STAGE_BYTES = 8 * HTB, NXCD = 8, WGM = 8;

__host__ __device__ __forceinline__ int lds_byte(int r, int c) { const int st = (r >> 4) * 2 + (c >> 5), rr = r & 15, cc = c & 31, ob = rr * 64 + cc * 2; return st * 1024 + (ob ^ (((ob >> 9) & 1) << 5)); }
__host__ __device__ __forceinline__ void stage_rc(int b, int& R, int& C) { const int st = b / 1024, sb = b % 1024, swz = sb ^ (((sb >> 9) & 1) << 5); R = (st >> 1) * 16 + swz / 64; C = (st & 1) * 32 + (swz % 64) / 2; }
__host__ __device__ __forceinline__ int perm32(int rho) { const int n = rho >> 4, i = rho & 15; return 8 * (i >> 2) + 4 * n + (i & 3); }

struct Unit { int pm, pn, e; };
struct Gemm { const bf16_t* A; const bf16_t* Bt; int M, N, K; size_t bstride; };

struct StaticOrder {
    int nM, nN, nwg, G, c;
    __host__ __device__ void init(int M, int N, int G_, int c_) { nM = M / BM; nN = N / BM; nwg = nM * nN; G = G_; c = c_; }
    __host__ __device__ bool next(int i, Unit& u) const {
        const long L = (long)i * G + c; if (L >= nwg) return false;
        int wgid = (int)L; { const int q = nwg / NXCD, r = nwg % NXCD, xcd = wgid % NXCD, off = wgid / NXCD; wgid = (xcd < r ? xcd * (q + 1) : r * (q + 1) + (xcd - r) * q) + off; }
        const int nig = WGM * nN, gid = wgid / nig, fm = gid * WGM, gsz = (nM - fm) < WGM ? (nM - fm) : WGM;
        u.pm = fm + ((wgid % nig) % gsz); u.pn = (wgid % nig) / gsz; u.e = 0; return true;
    }
    __device__ __forceinline__ void a_ready(const Unit&) const {}
    __device__ __forceinline__ void done(const Unit&) const {}
};

#define GAS_ __attribute__((address_space(1)))
__device__ __forceinline__ unsigned cvt_pk_bf16(float lo, float hi) { unsigned r; asm volatile("v_cvt_pk_bf16_f32 %0, %1, %2" : "=v"(r) : "v"(lo), "v"(hi)); return r; }

struct EpiF32 {
    static constexpr bool PERM = false, AFTER_DRAIN = false;
    GAS_ float* C; int ldc;
    __device__ __forceinline__ void operator()(const f32x4 (&acc)[2][2][4][2], const Unit& u, int wr, int wc, int fr, int fq) const {
        const int row0 = u.pm * BM + wr * 64 + fr, col0 = u.pn * BM + wc * 32 + 4 * fq;
#pragma unroll
        for (int ai = 0; ai < 2; ++ai)
#pragma unroll
            for (int m = 0; m < 4; ++m) { GAS_ float* rowp = C + (size_t)(row0 + ai * HALF + m * 16) * ldc + col0;
#pragma unroll
                for (int bj = 0; bj < 2; ++bj)
#pragma unroll
                    for (int n = 0; n < 2; ++n) *(GAS_ f32x4*)(rowp + bj * HALF + n * 16) = acc[ai][bj][m][n]; }
    }
};
struct EpiSwiGLU {
    static constexpr bool PERM = true, AFTER_DRAIN = false;
    GAS_ bf16_t* O; const GAS_ float* bias;
    __device__ __forceinline__ void operator()(const f32x4 (&acc)[2][2][4][2], const Unit& u, int wr, int wc, int fr, int fq) const {
        const int row0 = u.pm * BM + wr * 64 + fr; const int c0 = u.pn * HALF + wc * 32 + 8 * fq;
        const GAS_ float* bg = bias + (size_t)u.e * 2048 + c0; const GAS_ float* bl = bg + 1024;
        f32x4 bgv[2], blv[2];
#pragma unroll
        for (int n = 0; n < 2; ++n) { bgv[n] = *(const GAS_ f32x4*)(bg + 4 * n); blv[n] = *(const GAS_ f32x4*)(bl + 4 * n); }
#pragma unroll
        for (int ai = 0; ai < 2; ++ai)
#pragma unroll
            for (int m = 0; m < 4; ++m) {
                float o[8];
#pragma unroll
                for (int n = 0; n < 2; ++n) {
                    const f32x4 gv = acc[ai][0][m][n] + bgv[n], lv = acc[ai][1][m][n] + blv[n];
#pragma unroll
                    for (int j = 0; j < 4; ++j) {
                        const float gl = fminf(gv[j], 7.0f); const float li = fminf(fmaxf(lv[j], -7.0f), 7.0f);
                        const float sg = __builtin_amdgcn_rcpf(1.0f + __builtin_amdgcn_exp2f(-1.702f * 1.4426950408889634f * gl));
                        o[4 * n + j] = gl * sg * (li + 1.0f);
                    }
                }
                u32x4 w; w.x = cvt_pk_bf16(o[0], o[1]); w.y = cvt_pk_bf16(o[2], o[3]); w.z = cvt_pk_bf16(o[4], o[5]); w.w = cvt_pk_bf16(o[6], o[7]);
                *(GAS_ u32x4*)(O + (size_t)(row0 + ai * HALF + m * 16) * 1024 + c0) = w;
            }
    }
};
struct EpiDown {
    static constexpr bool PERM = true, AFTER_DRAIN = false;
    GAS_ bf16_t* O; const GAS_ float* bias; const GAS_ float* gate;
    __device__ __forceinline__ void operator()(const f32x4 (&acc)[2][2][4][2], const Unit& u, int wr, int wc, int fr, int fq) const {
        const int row0 = u.pm * BM + wr * 64 + fr; const int c0 = u.pn * BM + wc * 32 + 8 * fq;
        const GAS_ float* bb = bias + (size_t)u.e * 1024 + c0;
        f32x4 bv[2][2];
#pragma unroll
        for (int bj = 0; bj < 2; ++bj)
#pragma unroll
            for (int n = 0; n < 2; ++n) bv[bj][n] = *(const GAS_ f32x4*)(bb + bj * HALF + 4 * n);
#pragma unroll
        for (int ai = 0; ai < 2; ++ai)
#pragma unroll
            for (int m = 0; m < 4; ++m) { const int row = row0 + ai * HALF + m * 16; const float gt = gate[row];
#pragma unroll
                for (int bj = 0; bj < 2; ++bj) { const f32x4 v0 = (acc[ai][bj][m][0] + bv[bj][0]) * gt, v1 = (acc[ai][bj][m][1] + bv[bj][1]) * gt;
                    u32x4 w; w.x = cvt_pk_bf16(v0[0], v0[1]); w.y = cvt_pk_bf16(v0[2], v0[3]); w.z = cvt_pk_bf16(v1[0], v1[1]); w.w = cvt_pk_bf16(v1[2], v1[3]);
                    *(GAS_ u32x4*)(O + (size_t)row * 1024 + c0 + bj * HALF) = w; } }
    }
};

template <class Epi, class Sched, bool ALIGN_EPI = false, bool SP2 = false>
__device__ __forceinline__ void gemm_phase(PG8_LAS unsigned char* lds, const Gemm g, const Sched& S, const Epi& E) {
    int tid_ = threadIdx.x; asm volatile("" : "+v"(tid_));
    const int tid = tid_, wid = __builtin_amdgcn_readfirstlane(tid >> 6), lane = tid & 63, wr = wid >> 2, wc = wid & 3, fr = lane & 15, fq = lane >> 4;
    int K_ = g.K; asm volatile("" : "+s"(K_)); const int K = K_, nt = K / BK;
    unsigned voffA[2], voffB[2];
#pragma unroll
    for (int i = 0; i < 2; ++i) { int R, C; stage_rc(tid * 16 + i * 8192, R, C); const int Rb = Epi::PERM ? ((R & ~31) + perm32(R & 31)) : R;
        voffA[i] = (unsigned)(R * K + C) * 2u; voffB[i] = (unsigned)(Rb * K + C) * 2u; }
    const size_t kstep = (size_t)(BK * 2);
    const size_t hstep = (size_t)HALF * K * 2;
    const size_t tstep = 2 * hstep;
    const unsigned ldsw = (unsigned)wid * 1024u;
    const int aoff = lds_byte(wr * 64 + fr, fq * 8), boff = lds_byte(wc * 32 + fr, fq * 8);
#define PG8_SA(b, h) (((b) * 2 + (h)) * HTB)
#define PG8_SB(b, h) ((4 + (b) * 2 + (h)) * HTB)
#define PG8_STAGE(bufoff, gbase, voff) do { _Pragma("unroll") for (int _i = 0; _i < 2; ++_i) \
        __builtin_amdgcn_global_load_lds((const unsigned*)((const char*)(gbase) + (voff)[_i]), (PG8_LAS unsigned*)(lds + (bufoff) + ldsw + _i * 8192), 16, 0, 0); } while (0)
#define PG8_LDA(dst, b, h) do { _Pragma("unroll") for (int m = 0; m < 4; ++m) _Pragma("unroll") for (int k = 0; k < 2; ++k) dst[m][k] = *(const PG8_LAS bf16x8*)(lds + PG8_SA(b, h) + aoff + m * 2048 + k * 1024); } while (0)
#define PG8_LDB(dst, b, h) do { _Pragma("unroll") for (int n = 0; n < 2; ++n) _Pragma("unroll") for (int k = 0; k < 2; ++k) dst[n][k] = *(const PG8_LAS bf16x8*)(lds + PG8_SB(b, h) + boff + n * 2048 + k * 1024); } while (0)
#define PG8_MMA(ai, bj, At, Bt) do { __builtin_amdgcn_s_setprio(1); _Pragma("unroll") for (int m = 0; m < 4; ++m) _Pragma("unroll") for (int n = 0; n < 2; ++n) _Pragma("unroll") for (int k = 0; k < 2; ++k) \
        acc[ai][bj][m][n] = __builtin_amdgcn_mfma_f32_16x16x32_bf16(Bt[n][k], At[m][k], acc[ai][bj][m][n], 0, 0, 0); __builtin_amdgcn_s_setprio(0); } while (0)
#define PG8_WAIT_V(n) asm volatile("s_waitcnt vmcnt(" #n ")" ::: "memory")
#define PG8_WAIT_L(n) asm volatile("s_waitcnt lgkmcnt(" #n ")" ::: "memory")
#define PG8_BAR __builtin_amdgcn_s_barrier()
#define PG8_SCHED __builtin_amdgcn_sched_barrier(0)
    Unit cur, nxt; int ui = 0;
    if (!S.next(0, cur)) return;
    f32x4 acc[2][2][4][2];
#pragma unroll
    for (int a = 0; a < 2; ++a)
#pragma unroll
        for (int b = 0; b < 2; ++b)
#pragma unroll
            for (int m = 0; m < 4; ++m)
#pragma unroll
                for (int n = 0; n < 2; ++n) acc[a][b][m][n] = (f32x4){0.f, 0.f, 0.f, 0.f};
    bf16x8 At[4][2], B0[2][2], B1[2][2];
    const char* cA = (const char*)g.A + (size_t)cur.pm * tstep; const char* cB = (const char*)g.Bt + (size_t)cur.e * g.bstride + (size_t)cur.pn * tstep;
    S.a_ready(cur);
    if constexpr (SP2) {
        PG8_STAGE(PG8_SB(0, 0), cB, voffB); PG8_STAGE(PG8_SB(0, 1), cB + hstep, voffB); PG8_STAGE(PG8_SA(0, 0), cA, voffA); PG8_STAGE(PG8_SA(0, 1), cA + hstep, voffA);
        if (wr == 1) PG8_BAR;
        PG8_WAIT_V(2); PG8_BAR;
        PG8_STAGE(PG8_SB(1, 0), cB + kstep, voffB); PG8_STAGE(PG8_SA(1, 0), cA + kstep, voffA); PG8_STAGE(PG8_SB(1, 1), cB + hstep + kstep, voffB);
        PG8_WAIT_V(6); PG8_BAR;
    } else {
        PG8_STAGE(PG8_SB(0, 0), cB, voffB); PG8_STAGE(PG8_SA(0, 0), cA, voffA); PG8_STAGE(PG8_SB(0, 1), cB + hstep, voffB); PG8_STAGE(PG8_SA(0, 1), cA + hstep, voffA);
        if (wr == 1) PG8_BAR;
        PG8_WAIT_V(4); PG8_BAR;
        PG8_STAGE(PG8_SB(1, 0), cB + kstep, voffB); PG8_STAGE(PG8_SA(1, 0), cA + kstep, voffA); PG8_STAGE(PG8_SB(1, 1), cB + hstep + kstep, voffB);
        PG8_WAIT_V(6); PG8_BAR;
    }
    for (;;) {
        const bool has_next = S.next(ui + 1, nxt);
        const char* nA = has_next ? (const char*)g.A + (size_t)nxt.pm * tstep : cA; const char* nB = has_next ? (const char*)g.Bt + (size_t)nxt.e * g.bstride + (size_t)nxt.pn * tstep : cB;
        for (int t = 0; t < nt; t += 2) {
            const bool last = (t == nt - 2);
            const char* a1 = cA + (size_t)(t + 1) * kstep;
            const char* a2 = last ? nA : cA + (size_t)(t + 2) * kstep; const char* b2 = last ? nB : cB + (size_t)(t + 2) * kstep;
            const char* a3 = a2 + kstep; const char* b3 = b2 + kstep;
            if (last && has_next) S.a_ready(nxt);
            if constexpr (SP2) {
            PG8_LDB(B0, 0, 0); PG8_LDB(B1, 0, 1); PG8_SCHED; PG8_LDA(At, 0, 0); PG8_STAGE(PG8_SA(1, 1), a1 + hstep, voffA);
            PG8_WAIT_V(8); PG8_WAIT_L(0); PG8_BAR; PG8_MMA(0, 0, At, B0); PG8_MMA(0, 1, At, B1); PG8_BAR; PG8_SCHED;
            PG8_LDA(At, 0, 1); PG8_STAGE(PG8_SB(0, 0), b2, voffB); PG8_STAGE(PG8_SB(0, 1), b2 + hstep, voffB); PG8_STAGE(PG8_SA(0, 0), a2, voffA);
            PG8_WAIT_V(8); PG8_WAIT_L(0); PG8_BAR; PG8_MMA(1, 0, At, B0); PG8_MMA(1, 1, At, B1); PG8_BAR; PG8_SCHED;
            PG8_LDB(B0, 1, 0); PG8_LDB(B1, 1, 1); PG8_SCHED; PG8_LDA(At, 1, 0); PG8_STAGE(PG8_SA(0, 1), a2 + hstep, voffA);
            PG8_WAIT_V(8); PG8_WAIT_L(0); PG8_BAR; PG8_MMA(0, 0, At, B0); PG8_MMA(0, 1, At, B1); PG8_BAR; PG8_SCHED;
            PG8_LDA(At, 1, 1); PG8_STAGE(PG8_SB(1, 0), b3, voffB); PG8_STAGE(PG8_SB(1, 1), b3 + hstep, voffB); PG8_STAGE(PG8_SA(1, 0), a3, voffA);
            PG8_WAIT_V(8); PG8_WAIT_L(0); PG8_BAR; PG8_MMA(1, 0, At, B0); PG8_MMA(1, 1, At, B1); PG8_BAR; PG8_SCHED;
            } else {
            PG8_LDB(B0, 0, 0); PG8_SCHED; PG8_LDA(At, 0, 0); PG8_STAGE(PG8_SA(1, 1), a1 + hstep, voffA);
            PG8_WAIT_L(8); PG8_BAR; PG8_WAIT_L(0); PG8_MMA(0, 0, At, B0); PG8_BAR; PG8_SCHED;
            PG8_LDB(B1, 0, 1); PG8_STAGE(PG8_SB(0, 0), b2, voffB);
            PG8_BAR; PG8_WAIT_L(0); PG8_MMA(0, 1, At, B1); PG8_BAR;
            PG8_LDA(At, 0, 1); PG8_STAGE(PG8_SA(0, 0), a2, voffA);
            PG8_BAR; PG8_WAIT_L(0); PG8_MMA(1, 0, At, B0); PG8_BAR; PG8_SCHED;
            PG8_STAGE(PG8_SB(0, 1), b2 + hstep, voffB);
            PG8_WAIT_V(6); PG8_BAR; PG8_MMA(1, 1, At, B1); PG8_BAR;
            PG8_LDB(B0, 1, 0); PG8_SCHED; PG8_LDA(At, 1, 0); PG8_STAGE(PG8_SA(0, 1), a2 + hstep, voffA);
            PG8_WAIT_L(8); PG8_BAR; PG8_WAIT_L(0); PG8_MMA(0, 0, At, B0); PG8_BAR; PG8_SCHED;
            PG8_LDB(B1, 1, 1); PG8_STAGE(PG8_SB(1, 0), b3, voffB);
            PG8_BAR; PG8_WAIT_L(0); PG8_MMA(0, 1, At, B1); PG8_BAR;
            PG8_LDA(At, 1, 1); PG8_STAGE(PG8_SA(1, 0), a3, voffA);
            PG8_BAR; PG8_WAIT_L(0); PG8_MMA(1, 0, At, B0); PG8_BAR; PG8_SCHED;
            PG8_STAGE(PG8_SB(1, 1), b3 + hstep, voffB);
            PG8_WAIT_V(6); PG8_BAR; PG8_MMA(1, 1, At, B1); PG8_BAR;
            }
        }
        if constexpr (ALIGN_EPI) { if (wr == 0) PG8_BAR; }
        if constexpr (!Epi::AFTER_DRAIN) { E(acc, cur, wr, wc, fr, fq); S.done(cur); }
        if (!has_next) break;
#pragma unroll
        for (int a = 0; a < 2; ++a)
#pragma unroll
            for (int b = 0; b < 2; ++b)
#pragma unroll
                for (int m = 0; m < 4; ++m)
#pragma unroll
                    for (int n = 0; n < 2; ++n) acc[a][b][m][n] = (f32x4){0.f, 0.f, 0.f, 0.f};
        cur = nxt; cA = nA; cB = nB; ++ui;
        if constexpr (ALIGN_EPI) { if (wr == 1) PG8_BAR; }
    }
    PG8_WAIT_V(0);
    if constexpr (!ALIGN_EPI) { if (wr == 0) PG8_BAR; }
    PG8_BAR;
    if constexpr (Epi::AFTER_DRAIN) { E.fused(acc, cur, wr, wc, fr, fq, lds, wid, lane); S.done(cur); }
#undef PG8_SA
#undef PG8_SB
#undef PG8_STAGE
#undef PG8_LDA
#undef PG8_LDB
#undef PG8_MMA
#undef PG8_WAIT_V
#undef PG8_WAIT_L
#undef PG8_BAR
#undef PG8_SCHED
}
}
constexpr int NWAVES = 8;
constexpr int BATCH = 2, SEQ = 8192, D = 1024, T = BATCH * SEQ, DEPTH = 2;
constexpr int PC = 3328;
constexpr int DIN = 3212;
constexpr int P_RW = 256, P_ML = 1664, P_V1 = 3212;
constexpr int RW = 384, RWC = 1408;
constexpr int NE = 32, TOPK = 4, FF = 1024;
constexpr int MAXBLK = T * TOPK / 256 + NE;
constexpr int NSLOT = MAXBLK * 256;
constexpr float LN_EPS = 1e-5f, GN_EPS = 64e-5f;
constexpr float DN_ALPHA = 1.41421356237f;
constexpr int NCH = SEQ / 64;
constexpr int NITEM = BATCH * NCH * 6;

constexpr size_t MiB = 1u << 20;
constexpr size_t WS_CTL = 0, CTL_ZERO_BYTES = 1 * MiB;
constexpr size_t WS_WIN = 1 * MiB;
constexpr size_t WIN_L = (size_t)PC * D * 2;
constexpr size_t WS_WOUT = WS_WIN + 2 * WIN_L;
constexpr size_t WOUT_L = (size_t)D * D * 2;
constexpr size_t WS_WGU = WS_WOUT + 2 * WOUT_L;
constexpr size_t WGU_E = (size_t)2048 * D * 2;
constexpr size_t WS_WDN = WS_WGU + 64 * WGU_E;
constexpr size_t WDN_E = (size_t)D * D * 2;
constexpr size_t WS_H16 = WS_WDN + 64 * WDN_E;
constexpr size_t WS_HA = WS_H16 + (size_t)T * D * 2;
constexpr size_t WS_HB = WS_HA + (size_t)T * D * 4;
constexpr size_t WS_P = WS_HB + (size_t)T * D * 4;
constexpr size_t WS_MIX = WS_P + (size_t)T * PC * 4;
constexpr size_t WS_YCAT = WS_MIX + (size_t)T * D * 4;
constexpr size_t RWARR = (size_t)T * RW * 4;
constexpr size_t WS_VFIRST = WS_YCAT + (size_t)T * D * 2;
constexpr size_t WS_RR = WS_VFIRST + RWARR, WS_RLW = WS_RR + RWARR, WS_RK = WS_RLW + RWARR, WS_RV = WS_RK + RWARR;
constexpr size_t WS_RNA = WS_RV + RWARR, WS_RBB = WS_RNA + RWARR, WS_RG = WS_RBB + RWARR, WS_RY = WS_RG + RWARR;
constexpr size_t WS_RSB = WS_RY + RWARR;
constexpr size_t WS_MKV = WS_RSB + (size_t)T * 8 * 4;
constexpr size_t WS_MCP = WS_MKV + (size_t)NITEM * 4096 * 4;
constexpr size_t WS_MNL = WS_MCP + (size_t)NITEM * 4096 * 4;
constexpr size_t WS_MNP = WS_MNL + (size_t)NITEM * 64 * 4;
constexpr size_t WS_MSC = WS_MNP + (size_t)NITEM * 64 * 4;
constexpr size_t WS_MLG = WS_MSC + (size_t)NITEM * 4 * 4;
constexpr size_t WS_MLI = WS_MLG + (size_t)T * 8 * 4;
constexpr size_t WS_XG = ((WS_MLI + (size_t)T * 8 * 4 + MiB - 1) / MiB) * MiB;
constexpr size_t WS_ACT = WS_XG + (size_t)NSLOT * D * 2;
constexpr size_t WS_OSL = WS_ACT + (size_t)NSLOT * FF * 2;
constexpr size_t WS_TKE = WS_OSL + (size_t)NSLOT * D * 2;
constexpr size_t WS_TKG = WS_TKE + (size_t)T * 4 * 4;
constexpr size_t WS_SLOT = WS_TKG + (size_t)T * 4 * 4;
constexpr size_t WS_GSL = WS_SLOT + (size_t)T * 4 * 4;
constexpr size_t CH_STRIDE = 49408;
constexpr size_t WS_RCH = ((WS_GSL + (size_t)NSLOT * 4 + MiB - 1) / MiB) * MiB;
constexpr size_t CO_STRIDE = 32768;
constexpr size_t WS_RCO = WS_RCH + (size_t)NITEM * CH_STRIDE;
constexpr size_t WS_RS0 = WS_RCO + (size_t)NITEM * CO_STRIDE;
constexpr size_t WS_RUT = WS_RS0 + (size_t)NITEM * 8192;
constexpr size_t WS_LORA = WS_RUT + (size_t)NITEM * 8192;
constexpr size_t WS_END = WS_LORA + 2 * 221184;
constexpr int CW_BAR = 4096;
constexpr int CW_CNT = 8192;
constexpr int CW_CUR = 8192 + 64;
constexpr int CW_NB = 8192 + 128;
constexpr int CW_BLKE = 8192 + 256;

constexpr int RING_OFF = 0, RING_BYTES = 131072;
constexpr int LDSCTL_OFF = RING_BYTES, PTR_OFF = LDSCTL_OFF + 512, MISC_OFF = LDSCTL_OFF + 1024;
constexpr int LDS_BYTES = 147456;

#define GAS __attribute__((address_space(1)))
#define LAS __attribute__((address_space(3)))
typedef unsigned short bf16;
typedef unsigned v4u __attribute__((ext_vector_type(4)));
typedef unsigned v2u __attribute__((ext_vector_type(2)));
typedef float f32x4 __attribute__((ext_vector_type(4)));
typedef GAS unsigned gu32;
#define RLX_AGENT __ATOMIC_RELAXED, __HIP_MEMORY_SCOPE_AGENT
#define LDS_WAIT() asm volatile("s_waitcnt lgkmcnt(0)" ::: "memory")
#define VM_WAIT() asm volatile("s_waitcnt vmcnt(0)" ::: "memory")
__device__ __forceinline__ unsigned f2bf(float f) { unsigned u = __builtin_bit_cast(unsigned, f); return (u + 0x7fffu + ((u >> 16) & 1u)) >> 16; }
__device__ __forceinline__ unsigned pk2(float lo, float hi) { return f2bf(lo) | (f2bf(hi) << 16); }
__device__ __forceinline__ float bf2f(unsigned b) { return __builtin_bit_cast(float, b << 16); }
__device__ __forceinline__ float wave_sum(float v) {
#pragma unroll
    for (int o = 1; o < 64; o <<= 1) v += __shfl_xor(v, o);
    return v;
}
__device__ __forceinline__ float wave_max(float v) {
#pragma unroll
    for (int o = 1; o < 64; o <<= 1) v = fmaxf(v, __shfl_xor(v, o));
    return v;
}
__device__ __forceinline__ float fexp(float x) { return __builtin_amdgcn_exp2f(x * 1.4426950408889634f); }
__device__ __forceinline__ float frcp(float x) { return __builtin_amdgcn_rcpf(x); }
__device__ __forceinline__ float flog(float x) { return __builtin_amdgcn_logf(x) * 0.6931471805599453f; }
__device__ __forceinline__ float frsq(float x) { return __builtin_amdgcn_rsqf(x); }
__device__ __forceinline__ float sigmoidf_(float x) { return frcp(1.0f + fexp(-x)); }
__device__ __forceinline__ float tanhf_(float x) { return 1.0f - 2.0f * frcp(1.0f + fexp(2.0f * x)); }
__device__ __forceinline__ float softplusf_(float x) { return fmaxf(x, 0.f) + flog(1.0f + fexp(-fabsf(x))); }
__device__ __forceinline__ float logsigmoidf_(float x) { return fminf(x, 0.f) - flog(1.0f + fexp(-fabsf(x))); }

#define XB_TMO      128
#define XB_XCNT(j)  (256  + 64 * (j))
#define XB_XSUB(j)  (1280 + 64 * (j))
#define XB_XGEN(j)  (2304 + 64 * (j))
#define XB_TOP      3328
#define XB_TOPGEN   3392
#define XCD_BAR_WORDS 3456
#define XB_SPIN_CAP (1u << 18)

__device__ __forceinline__ unsigned xb_ld(unsigned* p)              { return __hip_atomic_load(p, __ATOMIC_RELAXED, __HIP_MEMORY_SCOPE_AGENT); }
__device__ __forceinline__ unsigned xb_add(unsigned* p, unsigned v) { return __hip_atomic_fetch_add(p, v, __ATOMIC_RELAXED, __HIP_MEMORY_SCOPE_AGENT); }
__device__ __forceinline__ unsigned xb_xcc_id() { return (unsigned)__builtin_amdgcn_s_getreg((3 << 11) | 20) & 0xFu; }
#define XB_SPIN(cond, bar) do { unsigned _sp = 0; while (cond) { __builtin_amdgcn_s_sleep(1); \
    if ((++_sp & 255u) == 0u) { if (xb_ld(&(bar)[XB_TMO])) break; if (_sp > XB_SPIN_CAP) { atomicAdd(&(bar)[XB_TMO], 1u); break; } } } } while (0)

struct XcdBarrier {
    unsigned* bar; unsigned x;
    volatile LAS unsigned* st;
};

__device__ __forceinline__ XcdBarrier xcd_barrier_post(unsigned* bar, volatile LAS unsigned* st) {
    XcdBarrier b; b.bar = bar; b.x = xb_xcc_id(); b.st = st;
    if (threadIdx.x == 0) (void)xb_add(&bar[XB_XCNT(b.x)], 1u);
    return b;
}
__device__ __forceinline__ void xcd_barrier_complete(unsigned* bar, unsigned x, unsigned& nloc, unsigned& nx) {
    const unsigned G = gridDim.x * gridDim.y * gridDim.z;
    unsigned sum, cnt, mine, sp = 0u;
    for (;;) {
        sum = 0u; cnt = 0u; mine = 0u;
#pragma unroll
        for (unsigned j = 0; j < 16; ++j) { const unsigned c = xb_ld(&bar[XB_XCNT(j)]); sum += c; cnt += (c > 0u) ? 1u : 0u; mine = (j == x) ? c : mine; }
        if (sum == G) break;
        __builtin_amdgcn_s_sleep(1);
        if ((++sp & 255u) == 0u) { if (xb_ld(&bar[XB_TMO])) break; if (sp > XB_SPIN_CAP) { atomicAdd(&bar[XB_TMO], 1u); break; } }
    }
    nloc = mine > 0u ? mine : 1u; nx = cnt > 0u ? cnt : 1u;
}

__device__ __forceinline__ void xcd_barrier(const XcdBarrier& b) {
    asm volatile("s_waitcnt vmcnt(0)" ::: "memory");
    __syncthreads();
    if (threadIdx.x == 0) {
        unsigned* bar = b.bar;
        __builtin_amdgcn_s_waitcnt(0);
        unsigned nloc = b.st[0], nx = b.st[1];
        if (nloc == 0u) { xcd_barrier_complete(bar, b.x, nloc, nx); b.st[0] = nloc; b.st[1] = nx; }
        const unsigned old = xb_add(&bar[XB_XSUB(b.x)], 1u);
        const unsigned gen = old / nloc;
        if (old + 1u == (gen + 1u) * nloc) {
            __builtin_amdgcn_fence(__ATOMIC_RELEASE, "agent");
            asm volatile("s_waitcnt vmcnt(0)" ::: "memory");
            const unsigned og = xb_add(&bar[XB_TOP], 1u);
            const unsigned tg = og / nx;
            if (og + 1u == (tg + 1u) * nx) xb_add(&bar[XB_TOPGEN], 1u);
            else XB_SPIN(xb_ld(&bar[XB_TOPGEN]) == tg, bar);
            __builtin_amdgcn_fence(__ATOMIC_ACQUIRE, "agent");
            xb_add(&bar[XB_XGEN(b.x)], 1u);
            asm volatile("s_waitcnt vmcnt(0)" ::: "memory");
        } else {
            XB_SPIN(xb_ld(&bar[XB_XGEN(b.x)]) == gen, bar);
            __builtin_amdgcn_fence(__ATOMIC_ACQUIRE, "agent");
            asm volatile("s_waitcnt vmcnt(0)" ::: "memory");
        }
    }
    __syncthreads();
}


struct Frame {
    LAS unsigned char* lds;
    volatile LAS unsigned* MISC;
    gu32* ctl;
    GAS unsigned char* ws;
    GAS float* out;
    int tid, lane, wave;
    int vcu, G;
};
enum { I_X = 0, I_WIN, I_POOLW, I_POOLS, I_MU, I_W0, I_W2, I_A0, I_A2, I_G2, I_KKS, I_KA, I_RK, I_LNXG, I_LNXB, I_V0, I_V1, I_V2,
       I_CONVW, I_CONVB, I_BI, I_BF, I_NORMG, I_WOUT, I_LN1G, I_LN1B, I_RTW, I_RTB, I_WGU, I_BGU, I_WDN, I_BDN, I_LN2G, I_LN2B };

#define WSP(T_, off) ((GAS T_*)(F.ws + (off)))
__device__ __forceinline__ const GAS float* inp_(LAS unsigned char* lds, int i) {
    const unsigned long long v = *(const LAS unsigned long long*)(lds + PTR_OFF + 8 * i);
    const unsigned lo = __builtin_amdgcn_readfirstlane((unsigned)v), hi = __builtin_amdgcn_readfirstlane((unsigned)(v >> 32));
    return (const GAS float*)(((unsigned long long)hi << 32) | lo);
}
#define INP(i) inp_(F.lds, (i))
__device__ __forceinline__ Frame launder(const Frame& G) {
    Frame F = G;
    F.tid = threadIdx.x; asm volatile("" : "+v"(F.tid)); F.lane = F.tid & 63;
    F.wave = __builtin_amdgcn_readfirstlane(F.tid >> 6);
    F.G = gridDim.x; { const int bx = blockIdx.x; F.vcu = (F.G % 8 == 0) ? (bx % 8) * (F.G / 8) + bx / 8 : bx; }
    asm volatile("" : "+s"(F.ws), "+s"(F.out), "+s"(F.vcu), "+s"(F.G));
    F.ctl = (gu32*)(F.ws + WS_CTL);
    return F;
}
__device__ __forceinline__ int launder_s(int x) { asm volatile("" : "+s"(x)); return x; }

template <int NN>
struct MoeOrder {
    int nb, c; const gu32* blke;
    __device__ __forceinline__ bool next(int i, pg8::Unit& u) const {
        constexpr int BPX = 32 / NN;
        const int x = c & 7, j = c >> 3;
        const int blk = i * (8 * BPX) + x * BPX + j / NN;
        if (blk >= nb) return false;
        u.pm = blk; u.pn = j % NN; u.e = (int)__builtin_amdgcn_readfirstlane(__hip_atomic_load(blke + blk, RLX_AGENT));
        return true;
    }
    __device__ __forceinline__ void a_ready(const pg8::Unit&) const {}
    __device__ __forceinline__ void done(const pg8::Unit&) const {}
};

__device__ __forceinline__ void transpose_item(const GAS float* src, int ld, bool valid, int k0, GAS bf16* dst  , LAS float* scr, int lane) {
    const GAS float* s0 = src + (size_t)(k0 + (lane >> 5)) * ld;
#pragma unroll 8
    for (int i = 0; i < 32; ++i) { const int kk = 2 * i + (lane >> 5); scr[kk * 33 + (lane & 31)] = valid ? s0[(size_t)(2 * i) * ld] : 0.f; }
    LDS_WAIT(); asm volatile("" ::: "memory");
    const int c = lane & 7;
#pragma unroll
    for (int j = 0; j < 4; ++j) { const int n = (lane >> 3) + 8 * j; const LAS float* s = scr + (8 * c) * 33 + n;
        v4u o; o.x = pk2(s[0 * 33], s[1 * 33]); o.y = pk2(s[2 * 33], s[3 * 33]); o.z = pk2(s[4 * 33], s[5 * 33]); o.w = pk2(s[6 * 33], s[7 * 33]);
        *(GAS v4u*)(dst + (size_t)n * D + k0 + 8 * c) = o; }
    LDS_WAIT(); asm volatile("" ::: "memory");
}
__device__ __forceinline__ void phase_convert(Frame& F) {
    LAS float* scr = (LAS float*)(F.lds + RING_OFF + F.wave * 16384);
    const int gw = F.vcu * NWAVES + F.wave, NGW = F.G * NWAVES; const int lane = F.lane;
    { const GAS float* x = INP(I_X); GAS bf16* h16 = WSP(bf16, WS_H16);
      for (int m = gw; m < T; m += NGW) { const GAS f32x4* xr = (const GAS f32x4*)(x + (size_t)m * D) + lane; GAS v2u* o = (GAS v2u*)(h16 + (size_t)m * D) + lane;
#pragma unroll
          for (int j = 0; j < 4; ++j) { const f32x4 v = xr[64 * j]; v2u w; w.x = pk2(v.x, v.y); w.y = pk2(v.z, v.w); o[64 * j] = w; } } }
    constexpr int KB = D / 64;
    constexpr int I_IN = 2 * (PC / 32) * KB;
    constexpr int I_OUT = 2 * (D / 32) * KB;
    constexpr int I_GU = 64 * (2048 / 32) * KB;
    constexpr int I_DN = 64 * (D / 32) * KB;
    constexpr int NITEMS = I_IN + I_OUT + I_GU + I_DN;
    for (int it = gw; it < NITEMS; it += NGW) {
        int r = it;
        if (r < I_IN) { const int l = r / ((PC / 32) * KB); r -= l * ((PC / 32) * KB); const int nb = r / KB, kb = r % KB; const int n = nb * 32 + (lane & 31);
            const GAS float* src; int ld; bool valid;
            if (n < DIN) { src = INP(I_WIN) + (size_t)l * D * DIN + n; ld = DIN; valid = true; }
            else if (l == 1 && n < DIN + 32) { src = INP(I_V1) + (n - DIN); ld = 32; valid = true; }
            else { src = INP(I_WIN); ld = 0; valid = false; }
            transpose_item(src, ld, valid, kb * 64, WSP(bf16, WS_WIN + l * WIN_L) + (size_t)(nb * 32) * D, scr, lane); continue; }
        r -= I_IN;
        if (r < I_OUT) { const int l = r / ((D / 32) * KB); r -= l * ((D / 32) * KB); const int nb = r / KB, kb = r % KB;
            transpose_item(INP(I_WOUT) + (size_t)l * D * D + nb * 32 + (lane & 31), D, true, kb * 64, WSP(bf16, WS_WOUT + l * WOUT_L) + (size_t)(nb * 32) * D, scr, lane); continue; }
        r -= I_OUT;
        if (r < I_GU) { const int le = r / (64 * KB); r -= le * (64 * KB); const int nb = r / KB, kb = r % KB; const int n0 = nb * 32;
            const int nn = n0 & 1023; const int drow = 256 * (nn >> 7) + (nn & 127) + ((n0 >= 1024) ? 128 : 0);
            transpose_item(INP(I_WGU) + (size_t)le * D * 2048 + n0 + (lane & 31), 2048, true, kb * 64, WSP(bf16, WS_WGU + le * WGU_E) + (size_t)drow * D, scr, lane); continue; }
        r -= I_GU;
        { const int le = r / (32 * KB); r -= le * (32 * KB); const int nb = r / KB, kb = r % KB;
            transpose_item(INP(I_WDN) + (size_t)le * D * D + nb * 32 + (lane & 31), D, true, kb * 64, WSP(bf16, WS_WDN + le * WDN_E) + (size_t)(nb * 32) * D, scr, lane); }
    }
}

__device__ __forceinline__ void pool_items(Frame& F, int l) {
    const GAS float* p = WSP(float, WS_P); GAS bf16* ycat = WSP(bf16, WS_YCAT);
    LAS float* dt = (LAS float*)(F.lds + RING_OFF + F.wave * 8192);
    const int gw = F.vcu * NWAVES + F.wave, NGW = F.G * NWAVES, lane = F.lane;
    for (int it = gw; it < (T / 32) * 4; it += NGW) {
        const int g = it & 3, tile = it >> 2, tok0 = tile * 32, t0 = tok0 & (SEQ - 1);
        const int win = 2 << g; const int col = 64 * g + lane;
        const GAS float* pc = p + (size_t)tok0 * PC + col;
        float ub[47];
#pragma unroll
        for (int j = 0; j < 47; ++j) { const int rel = j - 15; const int relc = (t0 + rel >= 0) ? rel : 0; const float x = pc[(ptrdiff_t)relc * PC]; ub[j] = (t0 + rel >= 0) ? x : 0.f; }
        float s = 0.f;
#pragma unroll
        for (int j = 1; j < 16; ++j) if (j < win) s += ub[15 - j];
#pragma unroll
        for (int t = 0; t < 32; ++t) {
            const float u = ub[15 + t]; s += u;
            const int cnt = min(t0 + t + 1, win);
            dt[t * 64 + lane] = s * frcp((float)cnt) - u;
            const float d2 = ub[15 + t - 1], d4 = ub[15 + t - 3], d8 = ub[15 + t - 7], d16 = ub[15 + t - 15];
            s -= (g == 0) ? d2 : (g == 1) ? d4 : (g == 2) ? d8 : d16;
        }
        LDS_WAIT(); asm volatile("" ::: "memory");
        float w[64];
        const GAS float* pw = INP(I_POOLW) + ((size_t)(l * 4 + g) * 64) * 64 + lane;
#pragma unroll
        for (int i = 0; i < 64; ++i) w[i] = pw[i * 64];
        const float sc = INP(I_POOLS)[l * 256 + col];
        for (int t = 0; t < 32; ++t) {
            float a0 = 0.f, a1 = 0.f, a2 = 0.f, a3 = 0.f;
#pragma unroll
            for (int i = 0; i < 64; i += 4) { const f32x4 d = *(const LAS f32x4*)(dt + t * 64 + i); a0 += d.x * w[i]; a1 += d.y * w[i + 1]; a2 += d.z * w[i + 2]; a3 += d.w * w[i + 3]; }
            ycat[(size_t)(tok0 + t) * D + col] = (bf16)f2bf(((a0 + a1) + (a2 + a3)) * sc);
        }
        LDS_WAIT(); asm volatile("" ::: "memory");
    }
}

constexpr int XS_PITCH = 1440;
__device__ __forceinline__ void rwkv_prep(Frame& F, int l) {
    const GAS float* p = WSP(float, WS_P);
    LAS float* xs = (LAS float*)(F.lds + RING_OFF);
    const GAS float* mu = INP(I_MU) + l * RWC;
    GAS float* vfirst = WSP(float, WS_VFIRST);
    GAS float* oR = WSP(float, WS_RR), *oLW = WSP(float, WS_RLW), *oK = WSP(float, WS_RK), *oV = WSP(float, WS_RV), *oNA = WSP(float, WS_RNA), *oBB = WSP(float, WS_RBB), *oG = WSP(float, WS_RG), *oSB = WSP(float, WS_RSB);
    for (int grp = F.vcu; grp < T / 8; grp += F.G) {
        const int tok0 = grp * 8;
#pragma unroll 2
        for (int idx = F.tid; idx < 8 * RWC; idx += NWAVES * 64) {
            const int tk = idx / RWC, j = idx - tk * RWC; const int tok = tok0 + tk;
            const bool first = (tok & (SEQ - 1)) == 0;
            const float cur = p[(size_t)tok * PC + P_RW + j];
            const float pv = p[(size_t)(first ? tok : tok - 1) * PC + P_RW + j];
            const float prev = first ? 0.f : pv;
            float x = cur + mu[j] * (prev - cur);
            if (j >= 1152 && j < 1216) x = tanhf_(x);
            else if (j >= 1280) x = sigmoidf_(x);
            xs[tk * XS_PITCH + j] = x;
        }
        if (l == 1) for (int idx = F.tid; idx < 8 * 32; idx += NWAVES * 64) { const int tk = idx >> 5, j = idx & 31; xs[tk * XS_PITCH + RWC + j] = p[(size_t)(tok0 + tk) * PC + P_V1 + j]; }
        __syncthreads();
        if (F.wave < 6) {
            const int h = F.wave, ch = 64 * h + F.lane;
            float dw[8], da[8], dg[8], dv[8];
#pragma unroll
            for (int t = 0; t < 8; ++t) { dw[t] = 0.f; da[t] = 0.f; dg[t] = 0.f; dv[t] = 0.f; }
            const GAS float* w2 = INP(I_W2) + (size_t)l * 64 * RW + ch; const GAS float* a2 = INP(I_A2) + (size_t)l * 64 * RW + ch; const GAS float* g2 = INP(I_G2) + (size_t)l * 128 * RW + ch;
#pragma unroll 1
            for (int j = 0; j < 64; j += 4) {
                float wv[4], av[4];
#pragma unroll
                for (int q = 0; q < 4; ++q) { wv[q] = w2[(size_t)(j + q) * RW]; av[q] = a2[(size_t)(j + q) * RW]; }
#pragma unroll
                for (int t = 0; t < 8; ++t) { const f32x4 xw = *(const LAS f32x4*)(xs + t * XS_PITCH + 1152 + j); const f32x4 xa = *(const LAS f32x4*)(xs + t * XS_PITCH + 1216 + j);
                    dw[t] += xw.x * wv[0] + xw.y * wv[1] + xw.z * wv[2] + xw.w * wv[3]; da[t] += xa.x * av[0] + xa.y * av[1] + xa.z * av[2] + xa.w * av[3]; }
            }
#pragma unroll 1
            for (int j = 0; j < 128; j += 4) {
                float gv[4];
#pragma unroll
                for (int q = 0; q < 4; ++q) gv[q] = g2[(size_t)(j + q) * RW];
#pragma unroll
                for (int t = 0; t < 8; ++t) { const f32x4 xg = *(const LAS f32x4*)(xs + t * XS_PITCH + 1280 + j); dg[t] += xg.x * gv[0] + xg.y * gv[1] + xg.z * gv[2] + xg.w * gv[3]; }
            }
            if (l == 1) { const GAS float* v2 = INP(I_V2) + ch;
#pragma unroll 1
                for (int j = 0; j < 32; j += 4) {
                    float vv[4];
#pragma unroll
                    for (int q = 0; q < 4; ++q) vv[q] = v2[(size_t)(j + q) * RW];
#pragma unroll
                    for (int t = 0; t < 8; ++t) { const f32x4 xv = *(const LAS f32x4*)(xs + t * XS_PITCH + RWC + j); dv[t] += xv.x * vv[0] + xv.y * vv[1] + xv.z * vv[2] + xv.w * vv[3]; }
                } }
            LAS float* accl = (LAS float*)(F.lds + RING_OFF + 49152) + h * 2048;
#pragma unroll
            for (int t = 0; t < 8; ++t) { accl[(0 * 8 + t) * 64 + F.lane] = dw[t]; accl[(1 * 8 + t) * 64 + F.lane] = da[t]; accl[(2 * 8 + t) * 64 + F.lane] = dg[t]; accl[(3 * 8 + t) * 64 + F.lane] = dv[t]; }
            LDS_WAIT(); asm volatile("" ::: "memory");
            const float w0 = INP(I_W0)[l * RW + ch], a0 = INP(I_A0)[l * RW + ch], kks = INP(I_KKS)[l * RW + ch], ka = INP(I_KA)[l * RW + ch], rk = INP(I_RK)[l * RW + ch];
            const float v0 = (l == 1) ? INP(I_V0)[ch] : 0.f;
#pragma unroll 1
            for (int t = 0; t < 8; ++t) {
                const int tok = tok0 + t; const size_t o = (size_t)tok * RW + ch;
                const float dwt = accl[(0 * 8 + t) * 64 + F.lane], dat = accl[(1 * 8 + t) * 64 + F.lane], dgt = accl[(2 * 8 + t) * 64 + F.lane], dvt = accl[(3 * 8 + t) * 64 + F.lane];
                const float r = xs[t * XS_PITCH + ch], k = xs[t * XS_PITCH + 384 + ch]; float v = xs[t * XS_PITCH + 768 + ch];
                const float wlog = -softplusf_(-(w0 + dwt)) - 0.5f; const float lw = -fexp(wlog);
                const float ai = sigmoidf_(a0 + dat);
                if (l == 0) vfirst[o] = v; else { const float vg = sigmoidf_(v0 + dvt); v = v + (vfirst[o] - v) * vg; }
                const float kkv = k * kks; const float nrm = sqrtf(wave_sum(kkv * kkv)); const float kk = kkv / fmaxf(nrm, 1e-12f);
                const float kp = k * (1.0f + (ai - 1.0f) * ka);
                const float sb = wave_sum(r * kp * rk);
                oR[o] = r; oLW[o] = lw; oK[o] = kp; oV[o] = v; oNA[o] = -kk; oBB[o] = kk * ai; oG[o] = dgt;
                if (F.lane == 0) oSB[tok * 8 + h] = sb;
            }
        }
        __syncthreads();
    }
}

__device__ __forceinline__ void mlstm_qk_tile(Frame& F, int l, int b, int c, int h, int which, LAS float* tile) {
    const GAS float* p = WSP(float, WS_P);
    const GAS float* cw = INP(I_CONVW) + (size_t)l * 4 * 768 + which * 384 + 64 * h; const GAS float* cb = INP(I_CONVB) + l * 768 + which * 384 + 64 * h;
    const int pcol = P_ML + which * 384 + 64 * h;
#pragma unroll 4
    for (int idx = F.tid; idx < 4096; idx += NWAVES * 64) {
        const int s = idx >> 6, d = idx & 63; const int tl = 64 * c + s; const size_t tok = (size_t)b * SEQ + tl;
        float acc = cb[d];
#pragma unroll
        for (int i = 0; i < 4; ++i) { const int tt = tl - 3 + i; const float x = p[(tt >= 0 ? tok - 3 + i : tok) * PC + pcol + d]; acc += (tt >= 0 ? cw[i * 768 + d] : 0.f) * x; }
        float y = acc * sigmoidf_(acc); if (which == 0) y *= 0.125f;
        tile[s * 65 + d] = y;
    }
}
__device__ __forceinline__ void mlstm_summ(Frame& F, int l) {
    const GAS float* p = WSP(float, WS_P);
    LAS float* kt = (LAS float*)(F.lds + RING_OFF);
    LAS float* vt = kt + 64 * 65;
    LAS float* we = vt + 64 * 64;
    GAS float* kvloc = WSP(float, WS_MKV); GAS float* nloc = WSP(float, WS_MNL); GAS float* msc = WSP(float, WS_MSC); GAS float* mlg = WSP(float, WS_MLG); GAS float* mli = WSP(float, WS_MLI);
    for (int item = F.vcu; item < NITEM; item += F.G) {
        const int h = item % 6, bc = item / 6, c = bc % NCH, b = bc / NCH;
        const size_t tokb = (size_t)b * SEQ + 64 * c;
        if (F.wave == 0) {
            const size_t tok = tokb + F.lane;
            const float ig = p[tok * PC + P_ML + 1536 + h] + INP(I_BI)[l * 6 + h];
            const float lf = logsigmoidf_(p[tok * PC + P_ML + 1542 + h] + INP(I_BF)[l * 6 + h]);
            float g = lf;
#pragma unroll
            for (int o = 1; o < 64; o <<= 1) { const float t = __shfl_up(g, o); if (F.lane >= o) g += t; }
            const float glast = __shfl(g, 63);
            const float e = glast - g + ig; const float mloc = wave_max(e);
            we[F.lane] = fexp(e - mloc);
            mlg[tok * 8 + h] = g; mli[tok * 8 + h] = ig;
            if (F.lane == 0) { msc[item * 4 + 0] = mloc; msc[item * 4 + 1] = glast; }
        }
        mlstm_qk_tile(F, l, b, c, h, 1, kt);
        for (int idx = F.tid; idx < 4096; idx += NWAVES * 64) { const int s = idx >> 6, d = idx & 63; vt[idx] = p[(tokb + s) * PC + P_ML + 768 + 64 * h + d]; }
        __syncthreads();
        { const int kd = F.tid >> 3, v0 = (F.tid & 7) * 8;
          float acc[8]; float an = 0.f;
#pragma unroll
          for (int j = 0; j < 8; ++j) acc[j] = 0.f;
          for (int s = 0; s < 64; ++s) { const float kw = we[s] * kt[s * 65 + kd]; an += kw; const f32x4 va = *(const LAS f32x4*)(vt + s * 64 + v0), vb = *(const LAS f32x4*)(vt + s * 64 + v0 + 4);
              acc[0] += kw * va.x; acc[1] += kw * va.y; acc[2] += kw * va.z; acc[3] += kw * va.w; acc[4] += kw * vb.x; acc[5] += kw * vb.y; acc[6] += kw * vb.z; acc[7] += kw * vb.w; }
          GAS float* o = kvloc + (size_t)item * 4096 + kd * 64 + v0;
          *(GAS f32x4*)o = (f32x4){acc[0], acc[1], acc[2], acc[3]}; *(GAS f32x4*)(o + 4) = (f32x4){acc[4], acc[5], acc[6], acc[7]};
          if ((F.tid & 7) == 0) nloc[item * 64 + kd] = an; }
        __syncthreads();
    }
}

__device__ __forceinline__ void rwkv_scan_seq(Frame& F) {
    if (F.vcu >= 12) return;
    const int b = F.vcu / 6, h = F.vcu % 6;
    LAS float* L = (LAS float*)(F.lds + RING_OFF);
    LAS float* ybuf = L + 6 * 4096;
    const GAS float* src[6] = {WSP(float, WS_RR), WSP(float, WS_RLW), WSP(float, WS_RK), WSP(float, WS_RV), WSP(float, WS_RNA), WSP(float, WS_RBB)};
    GAS float* yraw = WSP(float, WS_RY);
    const int vrow = (F.tid >> 2) & 63, q = F.tid & 3;
    float S[16];
#pragma unroll
    for (int i = 0; i < 16; ++i) S[i] = 0.f;
    for (int blk = 0; blk < SEQ / 64; ++blk) {
        const size_t tokb = (size_t)b * SEQ + blk * 64;
#pragma unroll
        for (int a = 0; a < 6; ++a)
            for (int idx = F.tid; idx < 4096; idx += NWAVES * 64) { const int s = idx >> 6, d = idx & 63; float x = src[a][(tokb + s) * RW + 64 * h + d]; if (a == 1) x = fexp(x); L[a * 4096 + idx] = x; }
        __syncthreads();
        if (F.tid < 256) {
            for (int t = 0; t < 64; ++t) {
                const LAS float* base = L + t * 64 + 16 * q;
                float sa = 0.f;
#pragma unroll
                for (int i = 0; i < 16; ++i) sa += S[i] * base[4 * 4096 + i];
                sa += __shfl_xor(sa, 1); sa += __shfl_xor(sa, 2);
                const float vv = L[3 * 4096 + t * 64 + vrow];
                float y = 0.f;
#pragma unroll
                for (int i = 0; i < 16; ++i) { S[i] = S[i] * base[1 * 4096 + i] + sa * base[5 * 4096 + i] + vv * base[2 * 4096 + i]; y += S[i] * base[i]; }
                y += __shfl_xor(y, 1); y += __shfl_xor(y, 2);
                if (q == 0) ybuf[t * 64 + vrow] = y;
            }
        }
        __syncthreads();
        for (int idx = F.tid; idx < 4096; idx += NWAVES * 64) { const int s = idx >> 6, d = idx & 63; yraw[(tokb + s) * RW + 64 * h + d] = ybuf[idx]; }
        __syncthreads();
    }
}
__device__ __forceinline__ void mlstm_scan(Frame& F) {
    if (blockIdx.x < 48) return;
    const int gt = ((int)blockIdx.x - 48) * (NWAVES * 64) + F.tid;
    const GAS float* msc = WSP(float, WS_MSC);
    if (gt < 12 * 4096 + 12 * 64) {
        const bool isn = gt >= 12 * 4096;
        const int g2 = isn ? gt - 12 * 4096 : gt;
        const int bh = isn ? (g2 >> 6) : (g2 >> 12), el = isn ? (g2 & 63) : (g2 & 4095), b = bh / 6, h = bh % 6;
        const int es = isn ? 64 : 4096;
        const GAS float* src = isn ? WSP(float, WS_MNL) : WSP(float, WS_MKV); GAS float* dst = isn ? WSP(float, WS_MNP) : WSP(float, WS_MCP); GAS float* mscw = WSP(float, WS_MSC);
        float C = 0.f, m = 0.f;
        for (int c0 = 0; c0 < NCH; c0 += 8) {
            float x[8], ml[8], gl[8];
#pragma unroll
            for (int i = 0; i < 8; ++i) { const int item = (b * NCH + c0 + i) * 6 + h; ml[i] = msc[item * 4 + 0]; gl[i] = msc[item * 4 + 1]; x[i] = src[(size_t)item * es + el]; }
#pragma unroll
            for (int i = 0; i < 8; ++i) { const int item = (b * NCH + c0 + i) * 6 + h;
                dst[(size_t)item * es + el] = C;
                if (!isn && el == 0) mscw[item * 4 + 2] = m;
                const float mn = fmaxf(gl[i] + m, ml[i]); const float ao = fexp(gl[i] + m - mn), an = fexp(ml[i] - mn);
                C = ao * C + an * x[i]; m = mn; }
        }
    }
}

__device__ __forceinline__ void rwkv_finish(Frame& F, int l) {
    const GAS float* yraw = WSP(float, WS_RY); const GAS float* v = WSP(float, WS_RV); const GAS float* g = WSP(float, WS_RG); const GAS float* sb = WSP(float, WS_RSB);
    GAS bf16* ycat = WSP(bf16, WS_YCAT);
    const int gw = F.vcu * NWAVES + F.wave, NGW = F.G * NWAVES, lane = F.lane;
    for (int tok = gw; tok < T; tok += NGW) {
#pragma unroll
        for (int h = 0; h < 6; ++h) {
            const size_t o = (size_t)tok * RW + 64 * h + lane;
            const float y = yraw[o]; const float mean = wave_sum(y) * (1.f / 64.f); const float d = y - mean; const float var = wave_sum(d * d) * (1.f / 64.f);
            float r = d * (frsq(var + GN_EPS)) * INP(I_LNXG)[l * RW + 64 * h + lane] + INP(I_LNXB)[l * RW + 64 * h + lane];
            r += sb[tok * 8 + h] * v[o];
            r *= g[o];
            ycat[(size_t)tok * D + 256 + 64 * h + lane] = (bf16)f2bf(r);
        }
    }
}
__device__ __forceinline__ void mlstm_out(Frame& F, int l) {
    const GAS float* p = WSP(float, WS_P);
    LAS float* qt = (LAS float*)(F.lds + RING_OFF);
    LAS float* kt = qt + 64 * 65;
    LAS float* At = kt + 64 * 65;
    LAS float* vt = At + 64 * 65;
    LAS float* cpt = vt + 4096;
    LAS float* sm = cpt + 4096;
    const GAS float* cp = WSP(float, WS_MCP); const GAS float* np = WSP(float, WS_MNP); const GAS float* msc = WSP(float, WS_MSC); const GAS float* mlg = WSP(float, WS_MLG); const GAS float* mli = WSP(float, WS_MLI);
    GAS bf16* ycat = WSP(bf16, WS_YCAT);
    for (int item = F.vcu; item < NITEM; item += F.G) {
        const int h = item % 6, bc = item / 6, c = bc % NCH, b = bc / NCH;
        const size_t tokb = (size_t)b * SEQ + 64 * c;
        mlstm_qk_tile(F, l, b, c, h, 0, qt);
        mlstm_qk_tile(F, l, b, c, h, 1, kt);
        for (int idx = F.tid; idx < 4096; idx += NWAVES * 64) { const int s = idx >> 6, d = idx & 63; vt[idx] = p[(tokb + s) * PC + P_ML + 768 + 64 * h + d]; cpt[idx] = cp[(size_t)item * 4096 + idx]; }
        if (F.tid < 64) { sm[F.tid] = mlg[(tokb + F.tid) * 8 + h]; sm[64 + F.tid] = mli[(tokb + F.tid) * 8 + h]; sm[128 + F.tid] = np[item * 64 + F.tid]; }
        const float mprev = msc[item * 4 + 2];
        __syncthreads();
        const int j = F.tid >> 3, sub = F.tid & 7;
        { const int s0 = sub * 8;
          float acc[8];
#pragma unroll
          for (int i = 0; i < 8; ++i) acc[i] = 0.f;
          for (int d = 0; d < 64; ++d) { const float qv = qt[j * 65 + d];
#pragma unroll
              for (int i = 0; i < 8; ++i) acc[i] += qv * kt[(s0 + i) * 65 + d]; }
          const float gj = sm[j];
          float dl[8]; float mx = -INFINITY;
#pragma unroll
          for (int i = 0; i < 8; ++i) { const int s = s0 + i; dl[i] = (s <= j) ? (gj - sm[s] + sm[64 + s]) : -INFINITY; mx = fmaxf(mx, dl[i]); }
          mx = fmaxf(mx, __shfl_xor(mx, 1)); mx = fmaxf(mx, __shfl_xor(mx, 2)); mx = fmaxf(mx, __shfl_xor(mx, 4));
          const float il = gj + mprev; const float mj = fmaxf(mx, il);
          float dsum = 0.f;
#pragma unroll
          for (int i = 0; i < 8; ++i) { const int s = s0 + i; const float w = (s <= j) ? fexp(dl[i] - mj) * acc[i] : 0.f; At[j * 65 + s] = w; dsum += w; }
          dsum += __shfl_xor(dsum, 1); dsum += __shfl_xor(dsum, 2); dsum += __shfl_xor(dsum, 4);
          if (sub == 0) { float qn = 0.f; for (int d = 0; d < 64; ++d) qn += qt[j * 65 + d] * sm[128 + d];
              const float wi = fexp(il - mj); const float den = dsum + wi * qn;
              sm[192 + j] = wi; sm[256 + j] = frcp(fmaxf(fabsf(den), fexp(-mj))); } }
        __syncthreads();
        { const int v0 = sub * 8;
          float acc[8];
#pragma unroll
          for (int i = 0; i < 8; ++i) acc[i] = 0.f;
          for (int s = 0; s <= j; ++s) { const float a = At[j * 65 + s]; const f32x4 va = *(const LAS f32x4*)(vt + s * 64 + v0), vb = *(const LAS f32x4*)(vt + s * 64 + v0 + 4);
              acc[0] += a * va.x; acc[1] += a * va.y; acc[2] += a * va.z; acc[3] += a * va.w; acc[4] += a * vb.x; acc[5] += a * vb.y; acc[6] += a * vb.z; acc[7] += a * vb.w; }
          const float wi = sm[192 + j];
          for (int d = 0; d < 64; ++d) { const float a = qt[j * 65 + d] * wi; const f32x4 va = *(const LAS f32x4*)(cpt + d * 64 + v0), vb = *(const LAS f32x4*)(cpt + d * 64 + v0 + 4);
              acc[0] += a * va.x; acc[1] += a * va.y; acc[2] += a * va.z; acc[3] += a * va.w; acc[4] += a * vb.x; acc[5] += a * vb.y; acc[6] += a * vb.z; acc[7] += a * vb.w; }
          const float di = sm[256 + j];
          float sum = 0.f;
#pragma unroll
          for (int i = 0; i < 8; ++i) { acc[i] *= di; sum += acc[i]; }
          sum += __shfl_xor(sum, 1); sum += __shfl_xor(sum, 2); sum += __shfl_xor(sum, 4);
          const float mean = sum * (1.f / 64.f); float vs = 0.f;
#pragma unroll
          for (int i = 0; i < 8; ++i) { acc[i] -= mean; vs += acc[i] * acc[i]; }
          vs += __shfl_xor(vs, 1); vs += __shfl_xor(vs, 2); vs += __shfl_xor(vs, 4);
          const float rstd = frsq(vs * (1.f / 64.f) + LN_EPS);
          const size_t tok = tokb + j;
          const GAS float* og = p + tok * PC + P_ML + 1152 + 64 * h + v0; const GAS float* ng = INP(I_NORMG) + l * 384 + 64 * h + v0;
          float o[8];
#pragma unroll
          for (int i = 0; i < 8; ++i) o[i] = sigmoidf_(og[i]) * (acc[i] * rstd * ng[i]);
          v4u w; w.x = pk2(o[0], o[1]); w.y = pk2(o[2], o[3]); w.z = pk2(o[4], o[5]); w.w = pk2(o[6], o[7]);
          *(GAS v4u*)(ycat + tok * D + 640 + 64 * h + v0) = w; }
        __syncthreads();
    }
}

__device__ __forceinline__ void ln_rows(Frame& F, const GAS float* hin, const GAS float* add, const GAS float* gam, const GAS float* bet, GAS float* out32, GAS bf16* h16) {
    const int gw = F.vcu * NWAVES + F.wave, NGW = F.G * NWAVES, lane = F.lane;
    for (int m = gw; m < T; m += NGW) {
        const GAS f32x4* hr = (const GAS f32x4*)(hin + (size_t)m * D) + lane; const GAS f32x4* ar = (const GAS f32x4*)(add + (size_t)m * D) + lane;
        f32x4 v[4]; float s = 0.f;
#pragma unroll
        for (int j = 0; j < 4; ++j) { v[j] = hr[64 * j] * DN_ALPHA + ar[64 * j]; s += (v[j].x + v[j].y) + (v[j].z + v[j].w); }
        const float mean = wave_sum(s) * (1.f / D); float s2 = 0.f;
#pragma unroll
        for (int j = 0; j < 4; ++j) { v[j] = v[j] - mean; s2 += (v[j].x * v[j].x + v[j].y * v[j].y) + (v[j].z * v[j].z + v[j].w * v[j].w); }
        const float rstd = frsq(wave_sum(s2) * (1.f / D) + LN_EPS);
        GAS f32x4* o4 = (GAS f32x4*)(out32 + (size_t)m * D) + lane; GAS v2u* o2 = (GAS v2u*)(h16 + (size_t)m * D) + lane;
#pragma unroll
        for (int j = 0; j < 4; ++j) { const f32x4 gg = *((const GAS f32x4*)gam + 64 * j + lane), bb = *((const GAS f32x4*)bet + 64 * j + lane);
            const f32x4 r = v[j] * rstd * gg + bb; o4[64 * j] = r; v2u w; w.x = pk2(r.x, r.y); w.y = pk2(r.z, r.w); o2[64 * j] = w; }
    }
}
__device__ __forceinline__ void router_phase(Frame& F, int l, const GAS float* h1) {
    LAS float* xs = (LAS float*)(F.lds + RING_OFF + F.wave * 16384);
    LAS unsigned* hist = (LAS unsigned*)(F.lds + LDSCTL_OFF);
    const GAS float* rw = INP(I_RTW) + (size_t)l * D * NE; const GAS float* rb = INP(I_RTB) + l * NE;
    GAS int* tke = WSP(int, WS_TKE); GAS float* tkg = WSP(float, WS_TKG);
    const int gw = F.vcu * NWAVES + F.wave, NGW = F.G * NWAVES, lane = F.lane;
    const int e = lane & 31, half = lane >> 5;
    for (int grp = gw; grp < T / 4; grp += NGW) {
        const int row0 = grp * 4;
#pragma unroll
        for (int r = 0; r < 4; ++r) { const GAS f32x4* xr = (const GAS f32x4*)(h1 + (size_t)(row0 + r) * D) + lane;
#pragma unroll
            for (int j = 0; j < 4; ++j) *(LAS f32x4*)(xs + r * 1024 + 4 * (64 * j + lane)) = xr[64 * j]; }
        LDS_WAIT(); asm volatile("" ::: "memory");
        float acc[4] = {0.f, 0.f, 0.f, 0.f};
        const GAS float* wp = rw + (size_t)(512 * half) * NE + e;
        for (int k = 0; k < 512; k += 4) {
            const float w0 = wp[(size_t)(k + 0) * NE], w1 = wp[(size_t)(k + 1) * NE], w2 = wp[(size_t)(k + 2) * NE], w3 = wp[(size_t)(k + 3) * NE];
#pragma unroll
            for (int r = 0; r < 4; ++r) { const f32x4 x = *(const LAS f32x4*)(xs + r * 1024 + 512 * half + k); acc[r] += (x.x * w0 + x.y * w1) + (x.z * w2 + x.w * w3); }
        }
        const float bias = rb[e];
#pragma unroll
        for (int r = 0; r < 4; ++r) {
            float lg = acc[r] + __shfl_xor(acc[r], 32) + bias;
            float v = (lane < 32) ? lg : -INFINITY;
            float tv[4]; int ti[4];
#pragma unroll
            for (int i = 0; i < 4; ++i) { const float m = wave_max(v); const unsigned long long bal = __ballot(v == m); const int idx = __ffsll((long long)bal) - 1; tv[i] = m; ti[i] = idx; if (lane == idx) v = -INFINITY; }
            const float e1 = fexp(tv[1] - tv[0]), e2 = fexp(tv[2] - tv[0]), e3 = fexp(tv[3] - tv[0]); const float inv = frcp(1.0f + e1 + e2 + e3);
            if (lane < 4) { const int ee = (lane == 0) ? ti[0] : (lane == 1) ? ti[1] : (lane == 2) ? ti[2] : ti[3]; const float gg = ((lane == 0) ? 1.0f : (lane == 1) ? e1 : (lane == 2) ? e2 : e3) * inv;
                tke[(row0 + r) * 4 + lane] = ee; tkg[(row0 + r) * 4 + lane] = gg; __hip_atomic_fetch_add(&hist[ee], 1u, __ATOMIC_RELAXED, __HIP_MEMORY_SCOPE_WORKGROUP); }
        }
        LDS_WAIT(); asm volatile("" ::: "memory");
    }
    __syncthreads();
    if (F.tid < NE) { const unsigned c = hist[F.tid]; if (c) __hip_atomic_fetch_add(F.ctl + CW_CNT + l * NE + F.tid, c, RLX_AGENT); }
    __syncthreads();
    if (F.tid < NE) hist[F.tid] = 0u;
    __syncthreads();
}
__device__ __forceinline__ void assign_phase(Frame& F, int l) {
    LAS unsigned* pst = (LAS unsigned*)(F.lds + RING_OFF);
    if (F.tid == 0) {
        unsigned run = 0;
        for (int e = 0; e < NE; ++e) { const unsigned c = __hip_atomic_load(F.ctl + CW_CNT + l * NE + e, RLX_AGENT); pst[e] = run; const unsigned nbk = (c + 255u) >> 8;
            if (blockIdx.x == 0) for (unsigned k = 0; k < nbk; ++k) __hip_atomic_store(F.ctl + CW_BLKE + l * 320 + (run >> 8) + k, (unsigned)e, RLX_AGENT);
            run += nbk << 8; }
        if (blockIdx.x == 0) __hip_atomic_store(F.ctl + CW_NB + l, run >> 8, RLX_AGENT);
    }
    __syncthreads();
    const GAS int* tke = WSP(int, WS_TKE); const GAS float* tkg = WSP(float, WS_TKG); GAS int* slot_of = WSP(int, WS_SLOT); GAS float* gsl = WSP(float, WS_GSL);
    const GAS bf16* h16 = WSP(bf16, WS_H16); GAS bf16* xg = WSP(bf16, WS_XG);
    const int gw = F.vcu * NWAVES + F.wave, NGW = F.G * NWAVES, lane = F.lane;
    for (int tok = gw; tok < T; tok += NGW) {
        int slot = 0;
        if (lane < 4) { const int e = tke[tok * 4 + lane]; const unsigned pos = __hip_atomic_fetch_add(F.ctl + CW_CUR + l * NE + e, 1u, RLX_AGENT); slot = (int)(pst[e] + pos);
            slot_of[tok * 4 + lane] = slot; gsl[slot] = tkg[tok * 4 + lane]; }
        const GAS v4u* src = (const GAS v4u*)(h16 + (size_t)tok * D) + lane; const v4u a = src[0], b = src[64];
#pragma unroll
        for (int i = 0; i < 4; ++i) { const int s = __shfl(slot, i); GAS v4u* dst = (GAS v4u*)(xg + (size_t)s * D) + lane; dst[0] = a; dst[64] = b; }
    }
}
__device__ __forceinline__ void combine_phase(Frame& F, const GAS float* h1, const GAS float* gam, const GAS float* bet, GAS float* out32, GAS bf16* h16) {
    const GAS int* slot_of = WSP(int, WS_SLOT); const GAS bf16* osl = WSP(bf16, WS_OSL);
    const int gw = F.vcu * NWAVES + F.wave, NGW = F.G * NWAVES, lane = F.lane;
    for (int m = gw; m < T; m += NGW) {
        const GAS f32x4* hr = (const GAS f32x4*)(h1 + (size_t)m * D) + lane;
        f32x4 v[4];
#pragma unroll
        for (int j = 0; j < 4; ++j) v[j] = hr[64 * j] * DN_ALPHA;
        const int sl = (lane < 4) ? slot_of[m * 4 + lane] : 0;
#pragma unroll
        for (int i = 0; i < 4; ++i) { const int s = __shfl(sl, i); const GAS v2u* orow = (const GAS v2u*)(osl + (size_t)s * D) + lane;
#pragma unroll
            for (int j = 0; j < 4; ++j) { const v2u w = orow[64 * j]; v[j].x += bf2f(w.x & 0xffffu); v[j].y += bf2f(w.x >> 16); v[j].z += bf2f(w.y & 0xffffu); v[j].w += bf2f(w.y >> 16); } }
        float s = 0.f;
#pragma unroll
        for (int j = 0; j < 4; ++j) s += (v[j].x + v[j].y) + (v[j].z + v[j].w);
        const float mean = wave_sum(s) * (1.f / D); float s2 = 0.f;
#pragma unroll
        for (int j = 0; j < 4; ++j) { v[j] = v[j] - mean; s2 += (v[j].x * v[j].x + v[j].y * v[j].y) + (v[j].z * v[j].z + v[j].w * v[j].w); }
        const float rstd = frsq(wave_sum(s2) * (1.f / D) + LN_EPS);
        GAS f32x4* o4 = (GAS f32x4*)(out32 + (size_t)m * D) + lane; GAS v2u* o2 = (GAS v2u*)(h16 + (size_t)m * D) + lane;
#pragma unroll
        for (int j = 0; j < 4; ++j) { const f32x4 gg = *((const GAS f32x4*)gam + 64 * j + lane), bb = *((const GAS f32x4*)bet + 64 * j + lane);
            const f32x4 r = v[j] * rstd * gg + bb; o4[64 * j] = r; v2u w; w.x = pk2(r.x, r.y); w.y = pk2(r.z, r.w); o2[64 * j] = w; }
    }
}

constexpr int TP = 68;
typedef short bf16x8_t __attribute__((ext_vector_type(8)));
typedef float f32x2_t __attribute__((ext_vector_type(2))); typedef __bf16 bf16x2_t __attribute__((ext_vector_type(2)));
__device__ __forceinline__ unsigned cvtpk(float lo, float hi) { f32x2_t v = {lo, hi}; bf16x2_t b = __builtin_convertvector(v, bf16x2_t); return __builtin_bit_cast(unsigned, b); }
__device__ __forceinline__ int perm_idx(int pos) { const int s = pos >> 5, q = (pos >> 3) & 3, j = pos & 7; return 32 * s + 16 * (j >> 2) + 4 * q + (j & 3); }

__device__ __forceinline__ void mm_nt(const LAS float* P, const LAS float* Q, int t, int sub, float (&out)[8]) {
#pragma unroll
    for (int j = 0; j < 8; ++j) out[j] = 0.f;
#pragma unroll 4
    for (int k = 0; k < 64; k += 4) {
        const f32x4 a = *(const LAS f32x4*)(P + t * TP + k);
#pragma unroll
        for (int j = 0; j < 8; ++j) { const f32x4 q = *(const LAS f32x4*)(Q + (sub + 8 * j) * TP + k); out[j] += (a.x * q.x + a.y * q.y) + (a.z * q.z + a.w * q.w); }
    }
}
__device__ __forceinline__ void mm_nn(const LAS float* X, const LAS float* Vt, int t, int sub, float (&out)[8]) {
#pragma unroll
    for (int j = 0; j < 8; ++j) out[j] = 0.f;
#pragma unroll 2
    for (int i = 0; i < 64; i += 4) {
        const f32x4 a = *(const LAS f32x4*)(X + t * TP + i);
#pragma unroll
        for (int e = 0; e < 4; ++e) { const float av = a[e]; const f32x4 v0 = *(const LAS f32x4*)(Vt + (i + e) * TP + 8 * sub), v1 = *(const LAS f32x4*)(Vt + (i + e) * TP + 8 * sub + 4);
            out[0] += av * v0.x; out[1] += av * v0.y; out[2] += av * v0.z; out[3] += av * v0.w; out[4] += av * v1.x; out[5] += av * v1.y; out[6] += av * v1.z; out[7] += av * v1.w; }
    }
}
__device__ __forceinline__ void rwkv_chunk_prep(Frame& F) {
    LAS float* tA = (LAS float*)(F.lds + RING_OFF);
    LAS float* tR = tA + 64 * TP; LAS float* tB = tR + 64 * TP; LAS float* tK = tB + 64 * TP; LAS float* tV = tK + 64 * TP; LAS float* tT = tV + 64 * TP; LAS float* tX = tT + 64 * TP;
    const GAS float* gR = WSP(float, WS_RR), *gLW = WSP(float, WS_RLW), *gK = WSP(float, WS_RK), *gV = WSP(float, WS_RV), *gNA = WSP(float, WS_RNA), *gBB = WSP(float, WS_RBB);
    const int t = F.tid >> 3, sub = F.tid & 7;
    for (int item = F.vcu; item < NITEM; item += F.G) {
        const int h = item % 6, bc = item / 6, c = bc % NCH, b = bc / NCH; const size_t tokb = (size_t)b * SEQ + 64 * c;
        const int ci = (b * 6 + h) * NCH + c;
        GAS unsigned char* chd = F.ws + WS_RCH + (size_t)ci * CH_STRIDE; GAS unsigned char* cod = F.ws + WS_RCO + (size_t)ci * CO_STRIDE;
        for (int idx = F.tid; idx < 4096; idx += NWAVES * 64) { const int s = idx >> 6, d = idx & 63; tX[s * TP + d] = gLW[(tokb + s) * RW + 64 * h + d]; }
        __syncthreads();
        if (F.tid < 64) { float run = 0.f; for (int s = 0; s < 64; ++s) { run += tX[s * TP + F.tid]; tX[s * TP + F.tid] = run; } ((GAS float*)(chd + 49152))[F.tid] = fexp(run); }
        __syncthreads();
        for (int idx = F.tid; idx < 4096; idx += NWAVES * 64) { const int s = idx >> 6, d = idx & 63; const size_t o = (tokb + s) * RW + 64 * h + d;
            const float cw = tX[s * TP + d]; const float lw = gLW[o]; const float ecw = fexp(cw), ecx = fexp(cw - lw), ein = fexp(-cw);
            tA[s * TP + d] = gNA[o] * ecx; tR[s * TP + d] = gR[o] * ecw; tB[s * TP + d] = gBB[o] * ein; tK[s * TP + d] = gK[o] * ein; tV[s * TP + d] = gV[o]; }
        __syncthreads();
        float m[8];
        mm_nt(tA, tK, t, sub, m);
#pragma unroll
        for (int j = 0; j < 8; ++j) { const int i = sub + 8 * j; tX[t * TP + i] = (i < t) ? m[j] : 0.f; }
        __syncthreads();
        mm_nn(tX, tV, t, sub, m);
        *(LAS f32x4*)(tT + t * TP + 8 * sub) = (f32x4){m[0], m[1], m[2], m[3]}; *(LAS f32x4*)(tT + t * TP + 8 * sub + 4) = (f32x4){m[4], m[5], m[6], m[7]};
        __syncthreads();
        mm_nt(tR, tK, t, sub, m);
#pragma unroll
        for (int j = 0; j < 8; ++j) { const int i = sub + 8 * j; tX[t * TP + i] = (i <= t) ? m[j] : 0.f; }
        __syncthreads();
        mm_nn(tX, tV, t, sub, m);
        { GAS float* y0 = (GAS float*)(cod + 16384) + t * 64 + 8 * sub; *(GAS f32x4*)y0 = (f32x4){m[0], m[1], m[2], m[3]}; *(GAS f32x4*)(y0 + 4) = (f32x4){m[4], m[5], m[6], m[7]}; }
        __syncthreads();
        mm_nt(tR, tB, t, sub, m);
#pragma unroll
        for (int j = 0; j < 8; ++j) { const int i = sub + 8 * j; tX[t * TP + i] = (i <= t) ? m[j] : 0.f; }
        __syncthreads();
        { const f32x4 a = *(const LAS f32x4*)(tX + t * TP + 8 * sub), bq = *(const LAS f32x4*)(tX + t * TP + 8 * sub + 4);
          v4u w; w.x = pk2(a.x, a.y); w.y = pk2(a.z, a.w); w.z = pk2(bq.x, bq.y); w.w = pk2(bq.z, bq.w); *(GAS v4u*)(cod + 8192 + (t * 64 + 8 * sub) * 2) = w; }
        __syncthreads();
        mm_nt(tA, tB, t, sub, m);
#pragma unroll
        for (int j = 0; j < 8; ++j) { const int i = sub + 8 * j; tX[i * TP + t] = (i < t) ? m[j] : 0.f; }
        __syncthreads();
        if (F.wave < 2) {
            LAS float* tile = (F.wave == 0) ? tA : tT; const int cidx = F.lane;
            const LAS float* tXv = tX + (F.lane & 0); asm volatile("" : "+v"(tXv));
            float acc[64];
#pragma unroll
            for (int i = 0; i < 64; ++i) acc[i] = tile[i * TP + cidx];
#pragma unroll
            for (int i = 0; i < 63; ++i) {
                const float xi = acc[i];
#pragma unroll
                for (int t4 = ((i + 1) & ~3); t4 < 64; t4 += 4) { const f32x4 mm = *(const LAS f32x4*)(tXv + i * TP + t4);
                    if (t4 + 0 > i) acc[t4 + 0] += mm.x * xi; if (t4 + 1 > i) acc[t4 + 1] += mm.y * xi; if (t4 + 2 > i) acc[t4 + 2] += mm.z * xi; if (t4 + 3 > i) acc[t4 + 3] += mm.w * xi; }
            }
#pragma unroll
            for (int i = 0; i < 64; ++i) tile[i * TP + cidx] = acc[i];
        }
        __syncthreads();
        { const int s_ = sub >> 2, q_ = sub & 3; const int i0 = 32 * s_ + 4 * q_, i1 = i0 + 16;
          { const f32x4 a = *(const LAS f32x4*)(tA + t * TP + i0), bq = *(const LAS f32x4*)(tA + t * TP + i1);
            v4u w; w.x = pk2(a.x, a.y); w.y = pk2(a.z, a.w); w.z = pk2(bq.x, bq.y); w.w = pk2(bq.z, bq.w); *(GAS v4u*)(chd + (t * 64 + 8 * sub) * 2) = w; }
          { float e[8];
#pragma unroll
            for (int j = 0; j < 8; ++j) e[j] = tB[((j < 4 ? i0 : i1) + (j & 3)) * TP + t];
            v4u w; w.x = pk2(e[0], e[1]); w.y = pk2(e[2], e[3]); w.z = pk2(e[4], e[5]); w.w = pk2(e[6], e[7]); *(GAS v4u*)(chd + 8192 + (t * 64 + 8 * sub) * 2) = w;
#pragma unroll
            for (int j = 0; j < 8; ++j) e[j] = tK[((j < 4 ? i0 : i1) + (j & 3)) * TP + t];
            w.x = pk2(e[0], e[1]); w.y = pk2(e[2], e[3]); w.z = pk2(e[4], e[5]); w.w = pk2(e[6], e[7]); *(GAS v4u*)(chd + 16384 + (t * 64 + 8 * sub) * 2) = w;
#pragma unroll
            for (int j = 0; j < 8; ++j) e[j] = tV[((j < 4 ? i0 : i1) + (j & 3)) * TP + t];
            w.x = pk2(e[0], e[1]); w.y = pk2(e[2], e[3]); w.z = pk2(e[4], e[5]); w.w = pk2(e[6], e[7]); *(GAS v4u*)(chd + 24576 + (t * 64 + 8 * sub) * 2) = w;
#pragma unroll
            for (int j = 0; j < 8; ++j) e[j] = tT[(8 * sub + j) * TP + t];
            GAS float* u0 = (GAS float*)(chd + 32768) + t * 64 + 8 * sub; *(GAS f32x4*)u0 = (f32x4){e[0], e[1], e[2], e[3]}; *(GAS f32x4*)(u0 + 4) = (f32x4){e[4], e[5], e[6], e[7]}; }
          { const f32x4 a = *(const LAS f32x4*)(tR + t * TP + 8 * sub), bq = *(const LAS f32x4*)(tR + t * TP + 8 * sub + 4);
            v4u w; w.x = pk2(a.x, a.y); w.y = pk2(a.z, a.w); w.z = pk2(bq.x, bq.y); w.w = pk2(bq.z, bq.w); *(GAS v4u*)(cod + (t * 64 + 8 * sub) * 2) = w; } }
        __syncthreads();
    }
}

constexpr int CH_STAGE = 49152;
constexpr int CH_PIECES = (int)(CH_STRIDE / 16);
#define CH_BAR() do { asm volatile("s_waitcnt lgkmcnt(0)" ::: "memory"); __builtin_amdgcn_s_barrier(); asm volatile("" ::: "memory"); } while (0)
__device__ __forceinline__ void rwkv_chain(Frame& F) {
    if (F.vcu >= 12) return;
    const int bh = F.vcu;
    const GAS unsigned char* src = F.ws + WS_RCH + (size_t)bh * NCH * CH_STRIDE;
    GAS unsigned char* s0g = F.ws + WS_RS0 + (size_t)bh * NCH * 8192; GAS unsigned char* utg = F.ws + WS_RUT + (size_t)bh * NCH * 8192;
    LAS unsigned char* st0 = F.lds + RING_OFF; LAS unsigned char* st1 = st0 + CH_STAGE;
    const int lane = F.lane, q = lane >> 4, r16 = lane & 15;
    if (F.wave >= 4) {
        const int lt = F.tid - 256;
        v4u RA[12], RB[12];
#define CH_LOAD(R, c) do { const GAS v4u* g_ = (const GAS v4u*)(src + (size_t)(c) * CH_STRIDE); _Pragma("unroll") for (int p = 0; p < 12; ++p) R[p] = g_[p * 256 + lt]; } while (0)
#define CH_WRITE(R, st) do { _Pragma("unroll") for (int p = 0; p < 12; ++p) *(LAS v4u*)((st) + (p * 256 + lt) * 16) = R[p]; } while (0)
        CH_LOAD(RA, 0); CH_LOAD(RB, 1);
        CH_WRITE(RA, st0); CH_LOAD(RA, 2);
        CH_BAR();
        for (int c = 0; c < NCH; c += 2) {
            CH_WRITE(RB, st1); if (c + 3 < NCH) CH_LOAD(RB, c + 3);
            CH_BAR();
            if (c + 2 < NCH) { CH_WRITE(RA, st0); if (c + 4 < NCH) CH_LOAD(RA, c + 4); }
            CH_BAR();
        }
#undef CH_LOAD
#undef CH_WRITE
    } else {
        const int w = F.wave; const int vrow = 16 * w + r16;
        f32x4 sacc[4]; bf16x8_t sb[2];
#pragma unroll
        for (int i = 0; i < 4; ++i) sacc[i] = (f32x4){0.f, 0.f, 0.f, 0.f};
        sb[0] = (bf16x8_t){0, 0, 0, 0, 0, 0, 0, 0}; sb[1] = sb[0];
        f32x4 gln[4];
#pragma unroll
        for (int kt = 0; kt < 4; ++kt) gln[kt] = *(const GAS f32x4*)(src + 49152 + (16 * kt + 4 * q) * 4);
        CH_BAR();
        for (int c = 0; c < NCH; ++c) {
            const LAS unsigned char* st = (c & 1) ? st1 : st0;
            f32x4 glc[4];
#pragma unroll
            for (int kt = 0; kt < 4; ++kt) glc[kt] = gln[kt];
            { const int cn = (c + 1 < NCH) ? c + 1 : c;
#pragma unroll
              for (int kt = 0; kt < 4; ++kt) gln[kt] = *(const GAS f32x4*)(src + (size_t)cn * CH_STRIDE + 49152 + (16 * kt + 4 * q) * 4); }
            { GAS v2u* o = (GAS v2u*)(s0g + (size_t)c * 8192 + (vrow * 64 + 4 * q) * 2);
              const v4u w0 = __builtin_bit_cast(v4u, sb[0]), w1 = __builtin_bit_cast(v4u, sb[1]);
              o[0] = (v2u){w0.x, w0.y}; o[4] = (v2u){w0.z, w0.w}; o[8] = (v2u){w1.x, w1.y}; o[12] = (v2u){w1.z, w1.w}; }
            f32x4 u[4];
#pragma unroll
            for (int tt = 0; tt < 4; ++tt) {
                u[tt] = *(const LAS f32x4*)(st + 32768 + (vrow * 64 + 16 * tt + 4 * q) * 4);
#pragma unroll
                for (int s = 0; s < 2; ++s) { const bf16x8_t a = *(const LAS bf16x8_t*)(st + ((16 * tt + r16) * 64 + 32 * s + 8 * q) * 2); u[tt] = __builtin_amdgcn_mfma_f32_16x16x32_bf16(a, sb[s], u[tt], 0, 0, 0); }
            }
            bf16x8_t ub[2];
            { v4u w0, w1; w0.x = cvtpk(u[0][0], u[0][1]); w0.y = cvtpk(u[0][2], u[0][3]); w0.z = cvtpk(u[1][0], u[1][1]); w0.w = cvtpk(u[1][2], u[1][3]);
              w1.x = cvtpk(u[2][0], u[2][1]); w1.y = cvtpk(u[2][2], u[2][3]); w1.z = cvtpk(u[3][0], u[3][1]); w1.w = cvtpk(u[3][2], u[3][3]);
              ub[0] = __builtin_bit_cast(bf16x8_t, w0); ub[1] = __builtin_bit_cast(bf16x8_t, w1);
              GAS v2u* o = (GAS v2u*)(utg + (size_t)c * 8192 + (vrow * 64 + 4 * q) * 2);
              o[0] = (v2u){w0.x, w0.y}; o[4] = (v2u){w0.z, w0.w}; o[8] = (v2u){w1.x, w1.y}; o[12] = (v2u){w1.z, w1.w}; }
            bf16x8_t vb[2];
#pragma unroll
            for (int s = 0; s < 2; ++s) vb[s] = *(const LAS bf16x8_t*)(st + 24576 + (vrow * 64 + 32 * s + 8 * q) * 2);
#pragma unroll
            for (int kt = 0; kt < 4; ++kt) {
#pragma unroll
                for (int s = 0; s < 2; ++s) { const bf16x8_t a = *(const LAS bf16x8_t*)(st + 16384 + ((16 * kt + r16) * 64 + 32 * s + 8 * q) * 2); sacc[kt] = __builtin_amdgcn_mfma_f32_16x16x32_bf16(a, vb[s], sacc[kt], 0, 0, 0); }
#pragma unroll
                for (int s = 0; s < 2; ++s) { const bf16x8_t a = *(const LAS bf16x8_t*)(st + 8192 + ((16 * kt + r16) * 64 + 32 * s + 8 * q) * 2); sacc[kt] = __builtin_amdgcn_mfma_f32_16x16x32_bf16(a, ub[s], sacc[kt], 0, 0, 0); }
                sacc[kt] = sacc[kt] * glc[kt];
            }
            { v4u w0, w1; w0.x = cvtpk(sacc[0][0], sacc[0][1]); w0.y = cvtpk(sacc[0][2], sacc[0][3]); w0.z = cvtpk(sacc[1][0], sacc[1][1]); w0.w = cvtpk(sacc[1][2], sacc[1][3]);
              w1.x = cvtpk(sacc[2][0], sacc[2][1]); w1.y = cvtpk(sacc[2][2], sacc[2][3]); w1.z = cvtpk(sacc[3][0], sacc[3][1]); w1.w = cvtpk(sacc[3][2], sacc[3][3]);
              sb[0] = __builtin_bit_cast(bf16x8_t, w0); sb[1] = __builtin_bit_cast(bf16x8_t, w1); }
            CH_BAR();
        }
    }
}

__device__ __forceinline__ void rwkv_chunk_out(Frame& F, int l) {
    LAS float* tRq = (LAS float*)(F.lds + RING_OFF);
    LAS float* tS = tRq + 64 * TP; LAS float* tM = tS + 64 * TP; LAS float* tU = tM + 64 * TP;
    const GAS float* gv = WSP(float, WS_RV); const GAS float* gg = WSP(float, WS_RG); const GAS float* sbp = WSP(float, WS_RSB);
    GAS bf16* ycat = WSP(bf16, WS_YCAT);
    const int t = F.tid >> 3, sub = F.tid & 7;
    for (int item = F.vcu; item < NITEM; item += F.G) {
        const int h = item % 6, bc = item / 6, c = bc % NCH, b = bc / NCH; const size_t tokb = (size_t)b * SEQ + 64 * c;
        const int ci = (b * 6 + h) * NCH + c;
        const GAS unsigned char* cod = F.ws + WS_RCO + (size_t)ci * CO_STRIDE;
        const GAS bf16* srcs[4] = {(const GAS bf16*)cod, (const GAS bf16*)(F.ws + WS_RS0 + (size_t)ci * 8192), (const GAS bf16*)(cod + 8192), (const GAS bf16*)(F.ws + WS_RUT + (size_t)ci * 8192)};
#pragma unroll
        for (int a = 0; a < 4; ++a) {
            LAS float* dstt = tRq + a * 64 * TP;
            const v4u wv = *(const GAS v4u*)(srcs[a] + t * 64 + 8 * sub);
            *(LAS f32x4*)(dstt + t * TP + 8 * sub) = (f32x4){bf2f(wv.x & 0xffffu), bf2f(wv.x >> 16), bf2f(wv.y & 0xffffu), bf2f(wv.y >> 16)};
            *(LAS f32x4*)(dstt + t * TP + 8 * sub + 4) = (f32x4){bf2f(wv.z & 0xffffu), bf2f(wv.z >> 16), bf2f(wv.w & 0xffffu), bf2f(wv.w >> 16)};
        }
        __syncthreads();
        float y1[8], y2[8];
        mm_nt(tRq, tS, t, sub, y1);
        mm_nt(tM, tU, t, sub, y2);
        const GAS float* y0 = (const GAS float*)(cod + 16384) + t * 64;
        float sum = 0.f;
#pragma unroll
        for (int j = 0; j < 8; ++j) { y1[j] += y2[j] + y0[sub + 8 * j]; sum += y1[j]; }
        sum += __shfl_xor(sum, 1); sum += __shfl_xor(sum, 2); sum += __shfl_xor(sum, 4);
        const float mean = sum * (1.f / 64.f); float vs = 0.f;
#pragma unroll
        for (int j = 0; j < 8; ++j) { y1[j] -= mean; vs += y1[j] * y1[j]; }
        vs += __shfl_xor(vs, 1); vs += __shfl_xor(vs, 2); vs += __shfl_xor(vs, 4);
        const float rstd = frsq(vs * (1.f / 64.f) + GN_EPS);
        const size_t tok = tokb + t; const float sbv = sbp[tok * 8 + h];
        const GAS float* lg = INP(I_LNXG) + l * RW + 64 * h; const GAS float* lb = INP(I_LNXB) + l * RW + 64 * h;
#pragma unroll
        for (int j = 0; j < 8; ++j) { const int v = sub + 8 * j; const size_t o = tok * RW + 64 * h + v;
            float r = y1[j] * rstd * lg[v] + lb[v]; r += sbv * gv[o]; r *= gg[o];
            ycat[tok * D + 256 + 64 * h + v] = (bf16)f2bf(r); }
        __syncthreads();
    }
}

constexpr int BP = 72;
typedef LAS unsigned short lbf;
__device__ __forceinline__ f32x4 mma_nt64(const lbf* P, int p0, const lbf* Q, int q0, int r16, int q, f32x4 acc) {
#pragma unroll
    for (int s = 0; s < 2; ++s) { const bf16x8_t a = *(const LAS bf16x8_t*)(P + (p0 + r16) * BP + 32 * s + 8 * q); const bf16x8_t b = *(const LAS bf16x8_t*)(Q + (q0 + r16) * BP + 32 * s + 8 * q);
        acc = __builtin_amdgcn_mfma_f32_16x16x32_bf16(a, b, acc, 0, 0, 0); }
    return acc;
}
constexpr size_t LORA_L = 221184;

__device__ __forceinline__ void rwkv_item_prep(Frame& F, int l, int stop) {
    LAS unsigned char* L = F.lds + RING_OFF;
    LAS float* fR = (LAS float*)(L + 0); LAS float* fK = (LAS float*)(L + 17408); LAS float* fV = (LAS float*)(L + 34816); LAS float* fL = (LAS float*)(L + 52224);
    LAS float* fA = (LAS float*)(L + 69632); LAS float* fT = (LAS float*)(L + 87040); LAS float* fX = (LAS float*)(L + 104448);
    lbf* Xw = (lbf*)(L + 69632); lbf* Xa = (lbf*)(L + 78848); lbf* Xg = (lbf*)(L + 88064); lbf* Xv = (lbf*)(L + 105472); LAS float* tbb = (LAS float*)(L + 64512); LAS float* tot = (LAS float*)(L + 110592); LAS float* red = (LAS float*)(L + 111616);
    lbf* bA = (lbf*)(L + 0); lbf* bR = (lbf*)(L + 9216); lbf* bB = (lbf*)(L + 18432); lbf* bK = (lbf*)(L + 27648); lbf* bVT = (lbf*)(L + 36864); lbf* bMak = (lbf*)(L + 46080); lbf* bMrk = (lbf*)(L + 55296); lbf* bMrb = (lbf*)(L + 121856);
    const GAS float* p = WSP(float, WS_P); const GAS float* mu = INP(I_MU) + l * RWC;
    GAS float* vfirst = WSP(float, WS_VFIRST); GAS float* oV = WSP(float, WS_RV); GAS float* oG = WSP(float, WS_RG); GAS float* oSB = WSP(float, WS_RSB);
    const GAS unsigned char* lw_ = F.ws + WS_LORA + (size_t)l * LORA_L;
    const int lane = F.lane, r16 = lane & 15, q = lane >> 4, w = F.wave;
    for (int item = F.vcu; item < NITEM; item += F.G) {
        const int h = item % 6, bc = item / 6, c = bc % NCH, b = bc / NCH; const size_t tokb = (size_t)b * SEQ + 64 * c;
        const int ci = (b * 6 + h) * NCH + c;
        GAS unsigned char* chd = F.ws + WS_RCH + (size_t)ci * CH_STRIDE; GAS unsigned char* cod = F.ws + WS_RCO + (size_t)ci * CO_STRIDE;
        const bool first = (c == 0);
#define SHIFT4(colj, s_) \
            const GAS float* pc = p + (tokb + (s_)) * PC + P_RW + (colj); const f32x4 cur = *(const GAS f32x4*)pc; const bool fz = first && (s_) == 0; \
            const f32x4 pv = *(const GAS f32x4*)(pc + (fz ? 0 : -PC)); const f32x4 prev = fz ? (f32x4){0.f, 0.f, 0.f, 0.f} : pv; const f32x4 m4 = *(const GAS f32x4*)(mu + (colj)); \
            const f32x4 x = cur + m4 * (prev - cur);
#pragma unroll 1
        for (int idx = F.tid; idx < 3 * 1024; idx += NWAVES * 64) { const int which = idx >> 10, s = (idx >> 4) & 63, d4 = (idx & 15) * 4; const int j = which * 384 + 64 * h + d4;
            SHIFT4(j, s)
            *(LAS f32x4*)((LAS float*)(L + which * 17408) + s * TP + d4) = x; }
#pragma unroll 1
        for (int idx = F.tid; idx < 2 * 1024; idx += NWAVES * 64) { const int which = idx >> 10, s = (idx >> 4) & 63, d4 = (idx & 15) * 4; const int j = 1152 + which * 64 + d4;
            SHIFT4(j, s)
            f32x4 y = x; if (which == 0) { y.x = tanhf_(x.x); y.y = tanhf_(x.y); y.z = tanhf_(x.z); y.w = tanhf_(x.w); }
            *(LAS v2u*)((which == 0 ? Xw : Xa) + s * BP + d4) = (v2u){pk2(y.x, y.y), pk2(y.z, y.w)}; }
#pragma unroll 1
        for (int idx = F.tid; idx < 2048; idx += NWAVES * 64) { const int s = idx >> 5, d4 = (idx & 31) * 4; const int j = 1280 + d4;
            SHIFT4(j, s)
            *(LAS v2u*)(Xg + s * 136 + d4) = (v2u){pk2(sigmoidf_(x.x), sigmoidf_(x.y)), pk2(sigmoidf_(x.z), sigmoidf_(x.w))}; }
#undef SHIFT4
        if (l == 1) { const int idx = F.tid; const int s = idx >> 3, d4 = (idx & 7) * 4; const f32x4 x = *(const GAS f32x4*)(p + (tokb + s) * PC + P_V1 + d4);
            *(LAS v2u*)(Xv + s * 40 + d4) = (v2u){pk2(x.x, x.y), pk2(x.z, x.w)}; }
        __syncthreads();
        if (stop <= 1) continue;
        float er[8], ena[8], ebb[8], ekp[8], ev[8], elw[8];
        const int mtw = w >> 1, hw = w & 1;
        {
            f32x4 dw[2], da[2], dg[2], dv[2];
#pragma unroll
            for (int n2 = 0; n2 < 2; ++n2) {
                const int chg = 64 * h + 16 * (2 * hw + n2) + r16;
                dw[n2] = (f32x4){0.f, 0.f, 0.f, 0.f}; da[n2] = dw[n2]; dg[n2] = dw[n2]; dv[n2] = dw[n2];
#pragma unroll
                for (int s = 0; s < 2; ++s) { const bf16x8_t a = *(const LAS bf16x8_t*)(Xw + (16 * mtw + r16) * BP + 32 * s + 8 * q); const bf16x8_t bb_ = *(const GAS bf16x8_t*)(lw_ + ((size_t)chg * 64 + 32 * s + 8 * q) * 2);
                    dw[n2] = __builtin_amdgcn_mfma_f32_16x16x32_bf16(a, bb_, dw[n2], 0, 0, 0); }
#pragma unroll
                for (int s = 0; s < 2; ++s) { const bf16x8_t a = *(const LAS bf16x8_t*)(Xa + (16 * mtw + r16) * BP + 32 * s + 8 * q); const bf16x8_t bb_ = *(const GAS bf16x8_t*)(lw_ + 49152 + ((size_t)chg * 64 + 32 * s + 8 * q) * 2);
                    da[n2] = __builtin_amdgcn_mfma_f32_16x16x32_bf16(a, bb_, da[n2], 0, 0, 0); }
#pragma unroll
                for (int s = 0; s < 4; ++s) { const bf16x8_t a = *(const LAS bf16x8_t*)(Xg + (16 * mtw + r16) * 136 + 32 * s + 8 * q); const bf16x8_t bb_ = *(const GAS bf16x8_t*)(lw_ + 98304 + ((size_t)chg * 128 + 32 * s + 8 * q) * 2);
                    dg[n2] = __builtin_amdgcn_mfma_f32_16x16x32_bf16(a, bb_, dg[n2], 0, 0, 0); }
                if (l == 1) { const bf16x8_t a = *(const LAS bf16x8_t*)(Xv + (16 * mtw + r16) * 40 + 8 * q); const bf16x8_t bb_ = *(const GAS bf16x8_t*)(lw_ + 196608 + ((size_t)chg * 32 + 8 * q) * 2);
                    dv[n2] = __builtin_amdgcn_mfma_f32_16x16x32_bf16(a, bb_, dv[n2], 0, 0, 0); }
            }
            float kk2[4] = {0.f, 0.f, 0.f, 0.f}, sbs[4] = {0.f, 0.f, 0.f, 0.f};
#pragma unroll
            for (int n2 = 0; n2 < 2; ++n2) {
                const int chl = 16 * (2 * hw + n2) + r16, chg = l * RW + 64 * h + chl;
                const float w0 = INP(I_W0)[chg], a0 = INP(I_A0)[chg], kks = INP(I_KKS)[chg], ka = INP(I_KA)[chg], rk = INP(I_RK)[chg];
                const float v0 = (l == 1) ? INP(I_V0)[64 * h + chl] : 0.f;
#pragma unroll
                for (int rg = 0; rg < 4; ++rg) {
                    const int e = 4 * n2 + rg; const int tk = 16 * mtw + 4 * q + rg; const size_t o = (tokb + tk) * RW + 64 * h + chl;
                    const float r = fR[tk * TP + chl], k = fK[tk * TP + chl]; float v = fV[tk * TP + chl];
                    const float wlog = -softplusf_(-(w0 + dw[n2][rg])) - 0.5f; elw[e] = -fexp(wlog);
                    const float ai = sigmoidf_(a0 + da[n2][rg]);
                    if (l == 0) vfirst[o] = v; else { const float vg = sigmoidf_(v0 + dv[n2][rg]); v = v + (vfirst[o] - v) * vg; }
                    const float kkv = k * kks; kk2[rg] += kkv * kkv; ena[e] = kkv;
                    const float kp = k * (1.0f + (ai - 1.0f) * ka); sbs[rg] += r * kp * rk;
                    er[e] = r; ekp[e] = kp; ev[e] = v; ebb[e] = ai;
                    oV[o] = v; oG[o] = dg[n2][rg];
                    fL[tk * TP + chl] = elw[e];
                }
            }
#pragma unroll
            for (int rg = 0; rg < 4; ++rg) {
#pragma unroll
                for (int o_ = 1; o_ < 16; o_ <<= 1) { kk2[rg] += __shfl_xor(kk2[rg], o_); sbs[rg] += __shfl_xor(sbs[rg], o_); }
                if (r16 == 0) { red[(hw * 64 + 16 * mtw + 4 * q + rg) * 2 + 0] = kk2[rg]; red[(hw * 64 + 16 * mtw + 4 * q + rg) * 2 + 1] = sbs[rg]; }
            }
        }
        __syncthreads();
#pragma unroll
        for (int rg = 0; rg < 4; ++rg) { const int tk = 16 * mtw + 4 * q + rg;
            const float k2 = red[tk * 2] + red[(64 + tk) * 2]; const float inv = frsq(fmaxf(k2, 1e-24f));
#pragma unroll
            for (int n2 = 0; n2 < 2; ++n2) { const int e = 4 * n2 + rg; const float kk = ena[e] * inv; ena[e] = -kk; ebb[e] = kk * ebb[e]; }
            if (hw == 0 && r16 == 0) oSB[(tokb + tk) * 8 + h] = red[tk * 2 + 1] + red[(64 + tk) * 2 + 1]; }
        if (stop <= 2) continue;
        if (F.tid < 256) { const int ch = F.tid & 63, sg = F.tid >> 6; float run = 0.f;
#pragma unroll
            for (int s = 0; s < 16; ++s) { run += fL[(16 * sg + s) * TP + ch]; fL[(16 * sg + s) * TP + ch] = run; }
            tot[sg * 64 + ch] = run; }
        __syncthreads();
        if (F.tid < 256) { const int ch = F.tid & 63, sg = F.tid >> 6; float off = 0.f;
            for (int s2 = 0; s2 < sg; ++s2) off += tot[s2 * 64 + ch];
            if (sg > 0) {
#pragma unroll
                for (int s = 0; s < 16; ++s) fL[(16 * sg + s) * TP + ch] += off; } }
        __syncthreads();
        if (stop <= 3) continue;
        {
#pragma unroll
            for (int n2 = 0; n2 < 2; ++n2) { const int chl = 16 * (2 * hw + n2) + r16;
                float vv[4];
#pragma unroll
                for (int rg = 0; rg < 4; ++rg) { const int e = 4 * n2 + rg; const int tk = 16 * mtw + 4 * q + rg;
                    const float cw = fL[tk * TP + chl]; const float ecw = fexp(cw), ecx = fexp(cw - elw[e]), ein = fexp(-cw);
                    const float at = ena[e] * ecx;
                    fA[tk * TP + chl] = at; bA[tk * BP + chl] = (unsigned short)f2bf(at); bR[tk * BP + chl] = (unsigned short)f2bf(er[e] * ecw);
                    bB[tk * BP + chl] = (unsigned short)f2bf(ebb[e] * ein); bK[tk * BP + chl] = (unsigned short)f2bf(ekp[e] * ein); vv[rg] = ev[e];
                    if (tk == 63) ((GAS float*)(chd + 49152))[chl] = ecw; }
                *(LAS v2u*)(bVT + chl * BP + 16 * mtw + 4 * q) = (v2u){pk2(vv[0], vv[1]), pk2(vv[2], vv[3])};
            }
        }
        __syncthreads();
        if (stop <= 4) continue;
        { const int kind = w >> 1;
#pragma unroll 1
          for (int tix = 0; tix < 8; ++tix) { const int tile = (w & 1) * 8 + tix; const int mt = tile >> 2, nt = tile & 3;
            f32x4 acc = (f32x4){0.f, 0.f, 0.f, 0.f};
            if (kind == 3) {
                acc = mma_nt64(bA, 16 * mt, bB, 16 * nt, r16, q, acc);
                const int i = 16 * nt + r16;
#pragma unroll
                for (int rg = 0; rg < 4; ++rg) { const int t = 16 * mt + 4 * q + rg; fX[t * TP + i] = (i < t) ? acc[rg] : 0.f; }
            } else {
                const lbf* Pm = (kind == 2) ? bB : bK; const lbf* Qm = (kind == 0) ? bA : bR; lbf* dst = (kind == 0) ? bMak : (kind == 1) ? bMrk : bMrb;
                acc = mma_nt64(Pm, 16 * nt, Qm, 16 * mt, r16, q, acc);
                const int t = 16 * mt + r16; float o[4];
#pragma unroll
                for (int rg = 0; rg < 4; ++rg) { const int i = 16 * nt + 4 * q + rg; o[rg] = ((kind == 0) ? (i < t) : (i <= t)) ? acc[rg] : 0.f; }
                *(LAS v2u*)(dst + t * BP + 16 * nt + 4 * q) = (v2u){pk2(o[0], o[1]), pk2(o[2], o[3])};
            } } }
        __syncthreads();
        if (stop <= 5) continue;
        { const int mt = w & 3;
#pragma unroll 1
          for (int nt = 0; nt < 4; ++nt) {
            f32x4 acc = (f32x4){0.f, 0.f, 0.f, 0.f};
            if (w < 4) { acc = mma_nt64(bMak, 16 * mt, bVT, 16 * nt, r16, q, acc);
#pragma unroll
                for (int rg = 0; rg < 4; ++rg) fT[(16 * mt + 4 * q + rg) * TP + 16 * nt + r16] = acc[rg]; }
            else { acc = mma_nt64(bVT, 16 * nt, bMrk, 16 * mt, r16, q, acc);
                *(GAS f32x4*)((GAS float*)(cod + 16384) + (16 * mt + r16) * 64 + 16 * nt + 4 * q) = acc; } } }
        __syncthreads();
        if (stop <= 6) continue;
        if (w == 0) {
            const int blk = lane >> 4, col = lane & 15; const LAS float* Nb = fX + (16 * blk) * TP + 16 * blk;
            float tv[16];
#pragma unroll
            for (int r = 0; r < 16; ++r) tv[r] = (r == col) ? 1.f : 0.f;
#pragma unroll
            for (int i = 0; i < 15; ++i) {
#pragma unroll
                for (int r = i + 1; r < 16; ++r) tv[r] += Nb[r * TP + i] * tv[i]; }
#pragma unroll
            for (int r = 0; r < 16; ++r) tbb[(blk * 16 + r) * 16 + col] = tv[r];
        } else {
            for (int pz = F.tid - 64; pz < 512; pz += 448) { const int row = pz >> 3, sub = pz & 7; const int s_ = sub >> 2, q_ = sub & 3; const int i0 = 32 * s_ + 4 * q_, i1 = i0 + 16;
                *(GAS v4u*)(cod + pz * 16) = *(const LAS v4u*)(bR + row * BP + 8 * sub);
                *(GAS v4u*)(cod + 8192 + pz * 16) = *(const LAS v4u*)(bMrb + row * BP + 8 * sub);
                { const v2u a = *(const LAS v2u*)(bVT + row * BP + i0), b2 = *(const LAS v2u*)(bVT + row * BP + i1); *(GAS v4u*)(chd + 24576 + pz * 16) = (v4u){a.x, a.y, b2.x, b2.y}; }
                unsigned e[8];
#pragma unroll
                for (int j = 0; j < 8; ++j) e[j] = bB[((j < 4 ? i0 : i1) + (j & 3)) * BP + row];
                *(GAS v4u*)(chd + 8192 + pz * 16) = (v4u){e[0] | (e[1] << 16), e[2] | (e[3] << 16), e[4] | (e[5] << 16), e[6] | (e[7] << 16)};
#pragma unroll
                for (int j = 0; j < 8; ++j) e[j] = bK[((j < 4 ? i0 : i1) + (j & 3)) * BP + row];
                *(GAS v4u*)(chd + 16384 + pz * 16) = (v4u){e[0] | (e[1] << 16), e[2] | (e[3] << 16), e[4] | (e[5] << 16), e[6] | (e[7] << 16)}; }
        }
        __syncthreads();
        { LAS float* tile = (w < 4) ? fA : fT; const int c0 = 16 * (w & 3) + r16;
          f32x4 X[4];
#pragma unroll
          for (int bb = 0; bb < 4; ++bb) {
              f32x4 acc;
#pragma unroll
              for (int rg = 0; rg < 4; ++rg) acc[rg] = tile[(16 * bb + 4 * q + rg) * TP + c0];
#pragma unroll
              for (int b2 = 0; b2 < 4; ++b2) if (b2 < bb) { const f32x4 af = *(const LAS f32x4*)(fX + (16 * bb + r16) * TP + 16 * b2 + 4 * q);
#pragma unroll
                  for (int s = 0; s < 4; ++s) acc = __builtin_amdgcn_mfma_f32_16x16x4f32(af[s], X[b2][s], acc, 0, 0, 0); }
              const f32x4 tf = *(const LAS f32x4*)(tbb + (bb * 16 + r16) * 16 + 4 * q);
              f32x4 xb = (f32x4){0.f, 0.f, 0.f, 0.f};
#pragma unroll
              for (int s = 0; s < 4; ++s) xb = __builtin_amdgcn_mfma_f32_16x16x4f32(tf[s], acc[s], xb, 0, 0, 0);
              X[bb] = xb;
#pragma unroll
              for (int rg = 0; rg < 4; ++rg) tile[(16 * bb + 4 * q + rg) * TP + c0] = xb[rg];
          } }
        __syncthreads();
        if (stop <= 7) continue;
        { const int row = F.tid >> 3, sub = F.tid & 7; const int s_ = sub >> 2, q_ = sub & 3; const int i0 = 32 * s_ + 4 * q_, i1 = i0 + 16;
          const f32x4 a = *(const LAS f32x4*)(fA + row * TP + i0), bq = *(const LAS f32x4*)(fA + row * TP + i1);
          *(GAS v4u*)(chd + F.tid * 16) = (v4u){pk2(a.x, a.y), pk2(a.z, a.w), pk2(bq.x, bq.y), pk2(bq.z, bq.w)};
#pragma unroll
          for (int hh = 0; hh < 2; ++hh) { const int pz = F.tid + 512 * hh; const int v = pz >> 4, t4 = (pz & 15) * 4;
              *(GAS f32x4*)(chd + 32768 + pz * 16) = (f32x4){fT[(t4 + 0) * TP + v], fT[(t4 + 1) * TP + v], fT[(t4 + 2) * TP + v], fT[(t4 + 3) * TP + v]}; } }
        __syncthreads();
    }
}
__device__ __forceinline__ void lora_convert(Frame& F) {
    const int gt = F.vcu * (NWAVES * 64) + F.tid, NT_ = F.G * NWAVES * 64;
    for (int l = 0; l < DEPTH; ++l) {
        bf16* base = (bf16*)(F.ws + WS_LORA + (size_t)l * LORA_L);
        const GAS float* w2 = INP(I_W2) + (size_t)l * 64 * RW; const GAS float* a2 = INP(I_A2) + (size_t)l * 64 * RW; const GAS float* g2 = INP(I_G2) + (size_t)l * 128 * RW; const GAS float* v2 = INP(I_V2);
        for (int i = gt; i < RW * 64; i += NT_) { const int ch = i >> 6, j = i & 63; base[i] = (bf16)f2bf(w2[(size_t)j * RW + ch]); base[24576 + i] = (bf16)f2bf(a2[(size_t)j * RW + ch]); }
        for (int i = gt; i < RW * 128; i += NT_) { const int ch = i >> 7, j = i & 127; base[49152 + i] = (bf16)f2bf(g2[(size_t)j * RW + ch]); }
        if (l == 1) for (int i = gt; i < RW * 32; i += NT_) { const int ch = i >> 5, j = i & 31; base[98304 + i] = (bf16)f2bf(v2[(size_t)j * RW + ch]); }
    }
}

__device__ __forceinline__ void rwkv_chunk_out_mfma(Frame& F, int l) {
    const GAS float* gv = WSP(float, WS_RV); const GAS float* gg = WSP(float, WS_RG); const GAS float* sbp = WSP(float, WS_RSB);
    GAS bf16* ycat = WSP(bf16, WS_YCAT);
    const int gw = F.vcu * NWAVES + F.wave, NGW = F.G * NWAVES, lane = F.lane, r16 = lane & 15, q = lane >> 4;
    for (int wi = gw; wi < NITEM * 4; wi += NGW) {
        const int item = wi >> 2, mt = wi & 3;
        const int h = item % 6, bc = item / 6, c = bc % NCH, b = bc / NCH; const size_t tokb = (size_t)b * SEQ + 64 * c;
        const int ci = (b * 6 + h) * NCH + c;
        const GAS unsigned char* cod = F.ws + WS_RCO + (size_t)ci * CO_STRIDE;
        const GAS unsigned char* s0 = F.ws + WS_RS0 + (size_t)ci * 8192; const GAS unsigned char* ut = F.ws + WS_RUT + (size_t)ci * 8192;
        const int t = 16 * mt + r16; const size_t tok = tokb + t;
        bf16x8_t rq[2], mb[2];
#pragma unroll
        for (int s = 0; s < 2; ++s) { rq[s] = *(const GAS bf16x8_t*)(cod + (t * 64 + 32 * s + 8 * q) * 2); mb[s] = *(const GAS bf16x8_t*)(cod + 8192 + (t * 64 + 32 * s + 8 * q) * 2); }
        f32x4 y[4];
#pragma unroll
        for (int nt = 0; nt < 4; ++nt) {
            y[nt] = *(const GAS f32x4*)(cod + 16384 + (t * 64 + 16 * nt + 4 * q) * 4);
#pragma unroll
            for (int s = 0; s < 2; ++s) { const bf16x8_t a = *(const GAS bf16x8_t*)(s0 + ((16 * nt + r16) * 64 + 32 * s + 8 * q) * 2); y[nt] = __builtin_amdgcn_mfma_f32_16x16x32_bf16(a, rq[s], y[nt], 0, 0, 0); }
#pragma unroll
            for (int s = 0; s < 2; ++s) { const bf16x8_t a = *(const GAS bf16x8_t*)(ut + ((16 * nt + r16) * 64 + 32 * s + 8 * q) * 2); y[nt] = __builtin_amdgcn_mfma_f32_16x16x32_bf16(a, mb[s], y[nt], 0, 0, 0); }
        }
        float sum = 0.f;
#pragma unroll
        for (int nt = 0; nt < 4; ++nt) sum += (y[nt][0] + y[nt][1]) + (y[nt][2] + y[nt][3]);
        sum += __shfl_xor(sum, 16); sum += __shfl_xor(sum, 32);
        const float mean = sum * (1.f / 64.f); float vs = 0.f;
#pragma unroll
        for (int nt = 0; nt < 4; ++nt) { y[nt] = y[nt] - mean; vs += (y[nt][0] * y[nt][0] + y[nt][1] * y[nt][1]) + (y[nt][2] * y[nt][2] + y[nt][3] * y[nt][3]); }
        vs += __shfl_xor(vs, 16); vs += __shfl_xor(vs, 32);
        const float rstd = frsq(vs * (1.f / 64.f) + GN_EPS);
        const float sbv = sbp[tok * 8 + h];
#pragma unroll
        for (int nt = 0; nt < 4; ++nt) { const int v0 = 16 * nt + 4 * q;
            const f32x4 lg = *(const GAS f32x4*)(INP(I_LNXG) + l * RW + 64 * h + v0), lb = *(const GAS f32x4*)(INP(I_LNXB) + l * RW + 64 * h + v0);
            const f32x4 vv = *(const GAS f32x4*)(gv + tok * RW + 64 * h + v0), g4 = *(const GAS f32x4*)(gg + tok * RW + 64 * h + v0);
            const f32x4 r = (y[nt] * rstd * lg + lb + vv * sbv) * g4;
            *(GAS v2u*)(ycat + tok * D + 256 + 64 * h + v0) = (v2u){pk2(r[0], r[1]), pk2(r[2], r[3])}; }
    }
}

constexpr int C2_STAGE = 30720;
__device__ __forceinline__ void rwkv_chain2(Frame& F) {
    const int id = blockIdx.x;
    if (id >= 48) return;
    const int bh = id % 12, vb = id / 12;
    const GAS unsigned char* src = F.ws + WS_RCH + (size_t)bh * NCH * CH_STRIDE;
    GAS unsigned char* s0g = F.ws + WS_RS0 + (size_t)bh * NCH * 8192; GAS unsigned char* utg = F.ws + WS_RUT + (size_t)bh * NCH * 8192;
    LAS unsigned char* ring = F.lds + RING_OFF;
    const int lane = F.lane, q = lane >> 4, r16 = lane & 15;
#define C2_BAR() do { asm volatile("s_waitcnt lgkmcnt(0)" ::: "memory"); __builtin_amdgcn_s_barrier(); asm volatile("" ::: "memory"); } while (0)
    if (F.wave >= 4) {
        const int lt = F.tid - 256;
        const int o6 = (lt < 128) ? (24576 + vb * 2048 + lt * 16) : (32768 + vb * 4096 + (lt - 128) * 16);
        const int d6 = (lt < 128) ? (24576 + lt * 16) : (26624 + (lt - 128) * 16);
        const int l7 = lt & 127; const int o7 = 32768 + vb * 4096 + 2048 + l7 * 16; const int d7 = 26624 + 2048 + l7 * 16;
        v4u RA[8], RB[8];
#define C2_LOAD(R, c) do { const GAS unsigned char* g_ = src + (size_t)(c) * CH_STRIDE; _Pragma("unroll") for (int p = 0; p < 6; ++p) R[p] = *(const GAS v4u*)(g_ + (p * 256 + lt) * 16); \
            R[6] = *(const GAS v4u*)(g_ + o6); R[7] = *(const GAS v4u*)(g_ + o7); } while (0)
#define C2_WRITE(R, c) do { LAS unsigned char* st_ = ring + ((c) & 3) * C2_STAGE; _Pragma("unroll") for (int p = 0; p < 6; ++p) *(LAS v4u*)(st_ + (p * 256 + lt) * 16) = R[p]; \
            *(LAS v4u*)(st_ + d6) = R[6]; *(LAS v4u*)(st_ + d7) = R[7]; } while (0)
        C2_LOAD(RA, 0); C2_LOAD(RB, 1); C2_WRITE(RA, 0); C2_LOAD(RA, 2); C2_WRITE(RB, 1); C2_LOAD(RB, 3); C2_WRITE(RA, 2); C2_LOAD(RA, 4);
        C2_BAR();
        for (int c = 0; c < NCH; c += 2) {
            if (c + 3 < NCH) { C2_WRITE(RB, c + 3); if (c + 5 < NCH) C2_LOAD(RB, c + 5); }
            C2_BAR();
            if (c + 4 < NCH) { C2_WRITE(RA, c + 4); if (c + 6 < NCH) C2_LOAD(RA, c + 6); }
            C2_BAR();
        }
#undef C2_LOAD
#undef C2_WRITE
    } else if (F.wave == 0) {
        const int vrow = 16 * vb + r16;
        f32x4 sacc[4]; bf16x8_t sb[2];
#pragma unroll
        for (int i = 0; i < 4; ++i) sacc[i] = (f32x4){0.f, 0.f, 0.f, 0.f};
        sb[0] = (bf16x8_t){0, 0, 0, 0, 0, 0, 0, 0}; sb[1] = sb[0];
        f32x4 gln[4];
#pragma unroll
        for (int kt = 0; kt < 4; ++kt) gln[kt] = *(const GAS f32x4*)(src + 49152 + (16 * kt + 4 * q) * 4);
        C2_BAR();
        for (int c = 0; c < NCH; ++c) {
            const LAS unsigned char* st = ring + (c & 3) * C2_STAGE;
            f32x4 glc[4];
#pragma unroll
            for (int kt = 0; kt < 4; ++kt) glc[kt] = gln[kt];
            { const int cn = (c + 1 < NCH) ? c + 1 : c;
#pragma unroll
              for (int kt = 0; kt < 4; ++kt) gln[kt] = *(const GAS f32x4*)(src + (size_t)cn * CH_STRIDE + 49152 + (16 * kt + 4 * q) * 4); }
            { GAS v2u* o = (GAS v2u*)(s0g + (size_t)c * 8192 + (vrow * 64 + 4 * q) * 2);
              const v4u w0 = __builtin_bit_cast(v4u, sb[0]), w1 = __builtin_bit_cast(v4u, sb[1]);
              o[0] = (v2u){w0.x, w0.y}; o[4] = (v2u){w0.z, w0.w}; o[8] = (v2u){w1.x, w1.y}; o[12] = (v2u){w1.z, w1.w}; }
            f32x4 u[4];
#pragma unroll
            for (int tt = 0; tt < 4; ++tt) {
                u[tt] = *(const LAS f32x4*)(st + 26624 + (r16 * 64 + 16 * tt + 4 * q) * 4);
#pragma unroll
                for (int s = 0; s < 2; ++s) { const bf16x8_t a = *(const LAS bf16x8_t*)(st + ((16 * tt + r16) * 64 + 32 * s + 8 * q) * 2); u[tt] = __builtin_amdgcn_mfma_f32_16x16x32_bf16(a, sb[s], u[tt], 0, 0, 0); }
            }
            bf16x8_t ub[2];
            { v4u w0, w1; w0.x = cvtpk(u[0][0], u[0][1]); w0.y = cvtpk(u[0][2], u[0][3]); w0.z = cvtpk(u[1][0], u[1][1]); w0.w = cvtpk(u[1][2], u[1][3]);
              w1.x = cvtpk(u[2][0], u[2][1]); w1.y = cvtpk(u[2][2], u[2][3]); w1.z = cvtpk(u[3][0], u[3][1]); w1.w = cvtpk(u[3][2], u[3][3]);
              ub[0] = __builtin_bit_cast(bf16x8_t, w0); ub[1] = __builtin_bit_cast(bf16x8_t, w1);
              GAS v2u* o = (GAS v2u*)(utg + (size_t)c * 8192 + (vrow * 64 + 4 * q) * 2);
              o[0] = (v2u){w0.x, w0.y}; o[4] = (v2u){w0.z, w0.w}; o[8] = (v2u){w1.x, w1.y}; o[12] = (v2u){w1.z, w1.w}; }
            bf16x8_t vbf[2];
#pragma unroll
            for (int s = 0; s < 2; ++s) vbf[s] = *(const LAS bf16x8_t*)(st + 24576 + (r16 * 64 + 32 * s + 8 * q) * 2);
#pragma unroll
            for (int kt = 0; kt < 4; ++kt) {
#pragma unroll
                for (int s = 0; s < 2; ++s) { const bf16x8_t a = *(const LAS bf16x8_t*)(st + 16384 + ((16 * kt + r16) * 64 + 32 * s + 8 * q) * 2); sacc[kt] = __builtin_amdgcn_mfma_f32_16x16x32_bf16(a, vbf[s], sacc[kt], 0, 0, 0); }
#pragma unroll
                for (int s = 0; s < 2; ++s) { const bf16x8_t a = *(const LAS bf16x8_t*)(st + 8192 + ((16 * kt + r16) * 64 + 32 * s + 8 * q) * 2); sacc[kt] = __builtin_amdgcn_mfma_f32_16x16x32_bf16(a, ub[s], sacc[kt], 0, 0, 0); }
                sacc[kt] = sacc[kt] * glc[kt];
            }
            { v4u w0, w1; w0.x = cvtpk(sacc[0][0], sacc[0][1]); w0.y = cvtpk(sacc[0][2], sacc[0][3]); w0.z = cvtpk(sacc[1][0], sacc[1][1]); w0.w = cvtpk(sacc[1][2], sacc[1][3]);
              w1.x = cvtpk(sacc[2][0], sacc[2][1]); w1.y = cvtpk(sacc[2][2], sacc[2][3]); w1.z = cvtpk(sacc[3][0], sacc[3][1]); w1.w = cvtpk(sacc[3][2], sacc[3][3]);
              sb[0] = __builtin_bit_cast(bf16x8_t, w0); sb[1] = __builtin_bit_cast(bf16x8_t, w1); }
            C2_BAR();
        }
    } else {
        C2_BAR();
        for (int c = 0; c < NCH; ++c) C2_BAR();
    }
#undef C2_BAR
}

#ifndef MK_N_LAUNCHES
#define MK_N_LAUNCHES 1
#endif
constexpr int PH_PER_LAYER = 11, N_PHASES = 1 + DEPTH * PH_PER_LAYER;
struct Args { const float* in[34]; float* out; unsigned char* ws; int ph_lo, ph_hi; };
__global__ void __launch_bounds__(NWAVES * 64, 2) mk_fwd(Args args) {
    extern __shared__ __attribute__((aligned(16))) unsigned char lds[];
    Frame F0;
    F0.lds = (LAS unsigned char*)lds;
    F0.MISC = (volatile LAS unsigned*)(F0.lds + MISC_OFF);
    F0.tid = threadIdx.x; F0.lane = F0.tid & 63; F0.wave = __builtin_amdgcn_readfirstlane(F0.tid >> 6);
    F0.G = gridDim.x; { const int bx = blockIdx.x; F0.vcu = (F0.G % 8 == 0) ? (bx % 8) * (F0.G / 8) + bx / 8 : bx; }
    F0.ws = (GAS unsigned char*)args.ws; F0.ctl = (gu32*)(args.ws + WS_CTL); F0.out = (GAS float*)args.out;
    for (int u = F0.tid; u < (LDS_BYTES - LDSCTL_OFF) / 4; u += NWAVES * 64) ((LAS unsigned*)(F0.lds + LDSCTL_OFF))[u] = 0u;
    __syncthreads();
    if (F0.tid < 34) *(LAS unsigned long long*)(F0.lds + PTR_OFF + 8 * F0.tid) = (unsigned long long)args.in[F0.tid];
    __syncthreads();
    XcdBarrier bar; bar.bar = (unsigned*)(F0.ctl + CW_BAR); bar.x = 0; bar.st = nullptr;
    const int lo = args.ph_lo, hi = args.ph_hi;
    if (hi - lo > 1) bar = xcd_barrier_post((unsigned*)(F0.ctl + CW_BAR), F0.MISC + 8);

#ifndef PROBE_KP
#define PROBE_KP (-1)
#define PROBE_REPS 1
#endif
#ifndef PROBE_STOP
#define PROBE_STOP 99
#endif
#ifndef PROBE_SUB
#define PROBE_SUB (-1)
#endif
#define SUBRUN(i) (rep == 0 || PROBE_SUB < 0 || PROBE_SUB == (i))
    for (int ph_ = lo; ph_ < hi; ++ph_) {
    const int ph = launder_s(ph_);
#if PROBE_REPS > 1
    const int nrep = ((ph == 0 && PROBE_KP == 100) || (ph > 0 && (ph - 1) % PH_PER_LAYER == PROBE_KP)) ? PROBE_REPS : 1;
    for (int rep = 0; rep < nrep; ++rep) {
    if (rep > 0) xcd_barrier(bar);
#else
    { constexpr int rep = 0;
#endif
    if (ph == 0) { Frame F = launder(F0);
#ifndef SKIP_CONV
            phase_convert(F);
            { Frame Fb = launder(F0); lora_convert(Fb); }
#endif
             }

    else {
        const int l = launder_s((ph - 1) / PH_PER_LAYER); const int kp = launder_s((ph - 1) % PH_PER_LAYER);
        if (kp == 0) { Frame F = launder(F0);
            pg8::Gemm g{(const pg8::bf16_t*)WSP(pg8::bf16_t, WS_H16), (const pg8::bf16_t*)WSP(pg8::bf16_t, WS_WIN + l * WIN_L), T, PC, D, 0};
            pg8::StaticOrder S; S.init(T, PC, F.G, (int)blockIdx.x);
            pg8::EpiF32 E{WSP(float, WS_P), PC};

#ifndef SKIP_G1
            pg8::gemm_phase<pg8::EpiF32, pg8::StaticOrder, true, true>(F.lds + RING_OFF, g, S, E);
#endif

        }
        else if (kp == 1) { Frame F = launder(F0);
#ifndef SKIP_PREP
            if (SUBRUN(0)) { Frame Fa = launder(F0); pool_items(Fa, launder_s(l)); } __syncthreads(); if (SUBRUN(1)) { Frame Fb = launder(F0); rwkv_item_prep(Fb, launder_s(l), (rep > 0) ? PROBE_STOP : 99); } if (SUBRUN(2)) { Frame Fc = launder(F0); mlstm_summ(Fc, launder_s(l)); }
#endif
             }
        else if (kp == 2) { Frame F = launder(F0);
#ifndef SKIP_SCAN
            if (SUBRUN(0)) { Frame Fa = launder(F0); mlstm_scan(Fa); } if (SUBRUN(1)) { Frame Fb = launder(F0); rwkv_chain2(Fb); }
#endif
             }
        else if (kp == 3) { Frame F = launder(F0);
#ifndef SKIP_FIN
            if (SUBRUN(0)) { Frame Fa = launder(F0); rwkv_chunk_out_mfma(Fa, launder_s(l)); } if (SUBRUN(1)) { Frame Fb = launder(F0); mlstm_out(Fb, launder_s(l)); }
#endif
             }
        else if (kp == 4) { Frame F = launder(F0);
            pg8::Gemm g{(const pg8::bf16_t*)WSP(pg8::bf16_t, WS_YCAT), (const pg8::bf16_t*)WSP(pg8::bf16_t, WS_WOUT + l * WOUT_L), T, D, D, 0};
            pg8::StaticOrder S; S.init(T, D, F.G, (int)blockIdx.x);
            pg8::EpiF32 E{WSP(float, WS_MIX), D};

#ifndef SKIP_G2
            pg8::gemm_phase<pg8::EpiF32, pg8::StaticOrder, false, true>(F.lds + RING_OFF, g, S, E);
#endif

        }
        else if (kp == 5) { Frame F = launder(F0);
#ifndef SKIP_LN
            ln_rows(F, (l == 0) ? INP(I_X) : WSP(float, WS_HB), WSP(float, WS_MIX), INP(I_LN1G) + l * D, INP(I_LN1B) + l * D, WSP(float, WS_HA), WSP(bf16, WS_H16));
#endif
             }
        else if (kp == 6) { Frame F = launder(F0);
#ifndef SKIP_RT
            router_phase(F, l, WSP(float, WS_HA));
#endif
             }
        else if (kp == 7) { Frame F = launder(F0);
#ifndef SKIP_AS
            assign_phase(F, l);
#endif
             }
        else if (kp == 8) { Frame F = launder(F0);
            pg8::Gemm g{(const pg8::bf16_t*)WSP(pg8::bf16_t, WS_XG), (const pg8::bf16_t*)WSP(pg8::bf16_t, WS_WGU + (size_t)l * 32 * WGU_E), NSLOT, 2048, D, WGU_E};
            MoeOrder<8> S; S.nb = (int)__builtin_amdgcn_readfirstlane(__hip_atomic_load(F.ctl + CW_NB + l, RLX_AGENT)); S.c = (int)blockIdx.x; S.blke = F.ctl + CW_BLKE + l * 320;
            pg8::EpiSwiGLU E{WSP(pg8::bf16_t, WS_ACT), INP(I_BGU) + (size_t)l * NE * 2048};

#ifndef SKIP_GU
            pg8::gemm_phase<pg8::EpiSwiGLU, MoeOrder<8>, true, true>(F.lds + RING_OFF, g, S, E);
#endif

        }
        else if (kp == 9) { Frame F = launder(F0);
            pg8::Gemm g{(const pg8::bf16_t*)WSP(pg8::bf16_t, WS_ACT), (const pg8::bf16_t*)WSP(pg8::bf16_t, WS_WDN + (size_t)l * 32 * WDN_E), NSLOT, D, FF, WDN_E};
            MoeOrder<4> S; S.nb = (int)__builtin_amdgcn_readfirstlane(__hip_atomic_load(F.ctl + CW_NB + l, RLX_AGENT)); S.c = (int)blockIdx.x; S.blke = F.ctl + CW_BLKE + l * 320;
            pg8::EpiDown E{WSP(pg8::bf16_t, WS_OSL), INP(I_BDN) + (size_t)l * NE * D, WSP(float, WS_GSL)};

#ifndef SKIP_DN
            pg8::gemm_phase<pg8::EpiDown, MoeOrder<4>, true, true>(F.lds + RING_OFF, g, S, E);
#endif

        }
        else if (kp == 10) { Frame F = launder(F0);
#ifndef SKIP_CB
            combine_phase(F, WSP(float, WS_HA), INP(I_LN2G) + l * D, INP(I_LN2B) + l * D, (l == DEPTH - 1) ? F.out : WSP(float, WS_HB), WSP(bf16, WS_H16));
#endif
             }
    }
    }
    if (ph_ + 1 < hi) xcd_barrier(bar);
    }
}

extern "C" void kernel_launch(void* const* d_in, const int* in_sizes, int n_in, void* d_out, int out_size, void* d_ws, size_t ws_size, hipStream_t stream) {
    static int grid = 0;
    if (grid == 0) {
        if (n_in != 34 || in_sizes[0] != T * D || out_size != T * D || ws_size < WS_END) { fprintf(stderr, "kernel_launch: unexpected shapes / workspace (n_in %d, in0 %d, out %d, ws %zu, need %zu)\n", n_in, n_in > 0 ? in_sizes[0] : -1, out_size, ws_size, (size_t)WS_END); grid = -1; return; }
        int dev = 0, cus = 0, per_cu = 0;
        if (hipGetDevice(&dev) != hipSuccess || hipDeviceGetAttribute(&cus, hipDeviceAttributeMultiprocessorCount, dev) != hipSuccess) { grid = -1; return; }
        if (hipFuncSetAttribute((const void*)mk_fwd, hipFuncAttributeMaxDynamicSharedMemorySize, LDS_BYTES) != hipSuccess) { fprintf(stderr, "kernel_launch: hipFuncSetAttribute failed\n"); grid = -1; return; }
        if (hipOccupancyMaxActiveBlocksPerMultiprocessor(&per_cu, (const void*)mk_fwd, NWAVES * 64, LDS_BYTES) != hipSuccess || per_cu < 1) { fprintf(stderr, "kernel_launch: occupancy query says %d blocks per CU\n", per_cu); }
        (void)hipGetLastError();
        grid = cus;
        if (grid % 8 != 0 || grid > 256) grid = (grid > 256) ? 256 : (grid / 8) * 8;
    }
    if (grid <= 0) return;
    (void)hipMemsetAsync((char*)d_ws + WS_CTL, 0, CTL_ZERO_BYTES, stream);
    Args a{};
    for (int i = 0; i < 34; ++i) a.in[i] = (const float*)d_in[i];
    a.out = (float*)d_out; a.ws = (unsigned char*)d_ws;
#if MK_N_LAUNCHES == 1
    a.ph_lo = 0; a.ph_hi = N_PHASES;
    hipLaunchKernelGGL(mk_fwd, dim3(grid), dim3(NWAVES * 64), LDS_BYTES, stream, a);
#else
    for (int ph = 0; ph < N_PHASES; ++ph) { a.ph_lo = ph; a.ph_hi = ph + 1; hipLaunchKernelGGL(mk_fwd, dim3(grid), dim3(NWAVES * 64), LDS_BYTES, stream, a); }
#endif
}
```

```cpp
#include <hip/hip_runtime.h>
#include <cstdio>
#include <cstdint>
namespace pg8 {
#define PG8_LAS __attribute__((address_space(3)))
typedef unsigned short bf16_t;
typedef short bf16x8 __attribute__((ext_vector_type(8)));
typedef float f32x4 __attribute__((ext_vector_type(4)));
typedef unsigned u32x4 __attribute__((ext_vector_type(4)));
constexpr int BM = 256, BK = 64, HALF = 128, HTB = HALF * BK * 2  , STAGE_BYTES = 8 * HTB, NXCD = 8, WGM = 8;

__host__ __device__ __forceinline__ int lds_byte(int r, int c) { const int st = (r >> 4) * 2 + (c >> 5), rr = r & 15, cc = c & 31, ob = rr * 64 + cc * 2; return st * 1024 + (ob ^ (((ob >> 9) & 1) << 5)); }
__host__ __device__ __forceinline__ void stage_rc(int b, int& R, int& C) { const int st = b / 1024, sb = b % 1024, swz = sb ^ (((sb >> 9) & 1) << 5); R = (st >> 1) * 16 + swz / 64; C = (st & 1) * 32 + (swz % 64) / 2; }
__host__ __device__ __forceinline__ int perm32(int rho) { const int n = rho >> 4, i = rho & 15; return 8 * (i >> 2) + 4 * n + (i & 3); }

struct Unit { int pm, pn, e; };
struct Gemm { const bf16_t* A; const bf16_t* Bt; int M, N, K; size_t bstride; };

struct StaticOrder {
    int nM, nN, nwg, G, c;
    __host__ __device__ void init(int M, int N, int G_, int c_) { nM = M / BM; nN = N / BM; nwg = nM * nN; G = G_; c = c_; }
    __host__ __device__ bool next(int i, Unit& u) const {
        const long L = (long)i * G + c; if (L >= nwg) return false;
        int wgid = (int)L; { const int q = nwg / NXCD, r = nwg % NXCD, xcd = wgid % NXCD, off = wgid / NXCD; wgid = (xcd < r ? xcd * (q + 1) : r * (q + 1) + (xcd - r) * q) + off; }
        const int nig = WGM * nN, gid = wgid / nig, fm = gid * WGM, gsz = (nM - fm) < WGM ? (nM - fm) : WGM;
        u.pm = fm + ((wgid % nig) % gsz); u.pn = (wgid % nig) / gsz; u.e = 0; return true;
    }
    __device__ __forceinline__ void a_ready(const Unit&) const {}
    __device__ __forceinline__ void done(const Unit&) const {}
};

#define GAS_ __attribute__((address_space(1)))
__device__ __forceinline__ unsigned cvt_pk_bf16(float lo, float hi) { unsigned r; asm volatile("v_cvt_pk_bf16_f32 %0, %1, %2" : "=v"(r) : "v"(lo), "v"(hi)); return r; }

struct EpiF32 {
    static constexpr bool PERM = false, AFTER_DRAIN = false;
    GAS_ float* C; int ldc;
    __device__ __forceinline__ void operator()(const f32x4 (&acc)[2][2][4][2], const Unit& u, int wr, int wc, int fr, int fq) const {
        const int row0 = u.pm * BM + wr * 64 + fr, col0 = u.pn * BM + wc * 32 + 4 * fq;
#pragma unroll
        for (int ai = 0; ai < 2; ++ai)
#pragma unroll
            for (int m = 0; m < 4; ++m) { GAS_ float* rowp = C + (size_t)(row0 + ai * HALF + m * 16) * ldc + col0;
#pragma unroll
                for (int bj = 0; bj < 2; ++bj)
#pragma unroll
                    for (int n = 0; n < 2; ++n) *(GAS_ f32x4*)(rowp + bj * HALF + n * 16) = acc[ai][bj][m][n]; }
    }
};
struct EpiSwiGLU {
    static constexpr bool PERM = true, AFTER_DRAIN = false;
    GAS_ bf16_t* O; const GAS_ float* bias;
    __device__ __forceinline__ void operator()(const f32x4 (&acc)[2][2][4][2], const Unit& u, int wr, int wc, int fr, int fq) const {
        const int row0 = u.pm * BM + wr * 64 + fr; const int c0 = u.pn * HALF + wc * 32 + 8 * fq;
        const GAS_ float* bg = bias + (size_t)u.e * 2048 + c0; const GAS_ float* bl = bg + 1024;
        f32x4 bgv[2], blv[2];
#pragma unroll
        for (int n = 0; n < 2; ++n) { bgv[n] = *(const GAS_ f32x4*)(bg + 4 * n); blv[n] = *(const GAS_ f32x4*)(bl + 4 * n); }
#pragma unroll
        for (int ai = 0; ai < 2; ++ai)
#pragma unroll
            for (int m = 0; m < 4; ++m) {
                float o[8];
#pragma unroll
                for (int n = 0; n < 2; ++n) {
                    const f32x4 gv = acc[ai][0][m][n] + bgv[n], lv = acc[ai][1][m][n] + blv[n];
#pragma unroll
                    for (int j = 0; j < 4; ++j) {
                        const float gl = fminf(gv[j], 7.0f); const float li = fminf(fmaxf(lv[j], -7.0f), 7.0f);
                        const float sg = __builtin_amdgcn_rcpf(1.0f + __builtin_amdgcn_exp2f(-1.702f * 1.4426950408889634f * gl));
                        o[4 * n + j] = gl * sg * (li + 1.0f);
                    }
                }
                u32x4 w; w.x = cvt_pk_bf16(o[0], o[1]); w.y = cvt_pk_bf16(o[2], o[3]); w.z = cvt_pk_bf16(o[4], o[5]); w.w = cvt_pk_bf16(o[6], o[7]);
                *(GAS_ u32x4*)(O + (size_t)(row0 + ai * HALF + m * 16) * 1024 + c0) = w;
            }
    }
};
struct EpiDown {
    static constexpr bool PERM = true, AFTER_DRAIN = false;
    GAS_ bf16_t* O; const GAS_ float* bias; const GAS_ float* gate;
    __device__ __forceinline__ void operator()(const f32x4 (&acc)[2][2][4][2], const Unit& u, int wr, int wc, int fr, int fq) const {
        const int row0 = u.pm * BM + wr * 64 + fr; const int c0 = u.pn * BM + wc * 32 + 8 * fq;
        const GAS_ float* bb = bias + (size_t)u.e * 1024 + c0;
        f32x4 bv[2][2];
#pragma unroll
        for (int bj = 0; bj < 2; ++bj)
#pragma unroll
            for (int n = 0; n < 2; ++n) bv[bj][n] = *(const GAS_ f32x4*)(bb + bj * HALF + 4 * n);
#pragma unroll
        for (int ai = 0; ai < 2; ++ai)
#pragma unroll
            for (int m = 0; m < 4; ++m) { const int row = row0 + ai * HALF + m * 16; const float gt = gate[row];
#pragma unroll
                for (int bj = 0; bj < 2; ++bj) { const f32x4 v0 = (acc[ai][bj][m][0] + bv[bj][0]) * gt, v1 = (acc[ai][bj][m][1] + bv[bj][1]) * gt;
                    u32x4 w; w.x = cvt_pk_bf16(v0[0], v0[1]); w.y = cvt_pk_bf16(v0[2], v0[3]); w.z = cvt_pk_bf16(v1[0], v1[1]); w.w = cvt_pk_bf16(v1[2], v1[3]);
                    *(GAS_ u32x4*)(O + (size_t)row * 1024 + c0 + bj * HALF) = w; } }
    }
};

template <class Epi, class Sched, bool ALIGN_EPI = false, bool SP2 = false>
__device__ __forceinline__ void gemm_phase(PG8_LAS unsigned char* lds, const Gemm g, const Sched& S, const Epi& E) {
    int tid_ = threadIdx.x; asm volatile("" : "+v"(tid_));
    const int tid = tid_, wid = __builtin_amdgcn_readfirstlane(tid >> 6), lane = tid & 63, wr = wid >> 2, wc = wid & 3, fr = lane & 15, fq = lane >> 4;
    int K_ = g.K; asm volatile("" : "+s"(K_)); const int K = K_, nt = K / BK;
    unsigned voffA[2], voffB[2];
#pragma unroll
    for (int i = 0; i < 2; ++i) { int R, C; stage_rc(tid * 16 + i * 8192, R, C); const int Rb = Epi::PERM ? ((R & ~31) + perm32(R & 31)) : R;
        voffA[i] = (unsigned)(R * K + C) * 2u; voffB[i] = (unsigned)(Rb * K + C) * 2u; }
    const size_t kstep = (size_t)(BK * 2);
    const size_t hstep = (size_t)HALF * K * 2;
    const size_t tstep = 2 * hstep;
    const unsigned ldsw = (unsigned)wid * 1024u;
    const int aoff = lds_byte(wr * 64 + fr, fq * 8), boff = lds_byte(wc * 32 + fr, fq * 8);
#define PG8_SA(b, h) (((b) * 2 + (h)) * HTB)
#define PG8_SB(b, h) ((4 + (b) * 2 + (h)) * HTB)
#define PG8_STAGE(bufoff, gbase, voff) do { _Pragma("unroll") for (int _i = 0; _i < 2; ++_i) \
        __builtin_amdgcn_global_load_lds((const unsigned*)((const char*)(gbase) + (voff)[_i]), (PG8_LAS unsigned*)(lds + (bufoff) + ldsw + _i * 8192), 16, 0, 0); } while (0)
#define PG8_LDA(dst, b, h) do { _Pragma("unroll") for (int m = 0; m < 4; ++m) _Pragma("unroll") for (int k = 0; k < 2; ++k) dst[m][k] = *(const PG8_LAS bf16x8*)(lds + PG8_SA(b, h) + aoff + m * 2048 + k * 1024); } while (0)
#define PG8_LDB(dst, b, h) do { _Pragma("unroll") for (int n = 0; n < 2; ++n) _Pragma("unroll") for (int k = 0; k < 2; ++k) dst[n][k] = *(const PG8_LAS bf16x8*)(lds + PG8_SB(b, h) + boff + n * 2048 + k * 1024); } while (0)
#define PG8_MMA(ai, bj, At, Bt) do { __builtin_amdgcn_s_setprio(1); _Pragma("unroll") for (int m = 0; m < 4; ++m) _Pragma("unroll") for (int n = 0; n < 2; ++n) _Pragma("unroll") for (int k = 0; k < 2; ++k) \
        acc[ai][bj][m][n] = __builtin_amdgcn_mfma_f32_16x16x32_bf16(Bt[n][k], At[m][k], acc[ai][bj][m][n], 0, 0, 0); __builtin_amdgcn_s_setprio(0); } while (0)
#define PG8_WAIT_V(n) asm volatile("s_waitcnt vmcnt(" #n ")" ::: "memory")
#define PG8_WAIT_L(n) asm volatile("s_waitcnt lgkmcnt(" #n ")" ::: "memory")
#define PG8_BAR __builtin_amdgcn_s_barrier()
#define PG8_SCHED __builtin_amdgcn_sched_barrier(0)
    Unit cur, nxt; int ui = 0;
    if (!S.next(0, cur)) return;
    f32x4 acc[2][2][4][2];
#pragma unroll
    for (int a = 0; a < 2; ++a)
#pragma unroll
        for (int b = 0; b < 2; ++b)
#pragma unroll
            for (int m = 0; m < 4; ++m)
#pragma unroll
                for (int n = 0; n < 2; ++n) acc[a][b][m][n] = (f32x4){0.f, 0.f, 0.f, 0.f};
    bf16x8 At[4][2], B0[2][2], B1[2][2];
    const char* cA = (const char*)g.A + (size_t)cur.pm * tstep; const char* cB = (const char*)g.Bt + (size_t)cur.e * g.bstride + (size_t)cur.pn * tstep;
    S.a_ready(cur);
    if constexpr (SP2) {
        PG8_STAGE(PG8_SB(0, 0), cB, voffB); PG8_STAGE(PG8_SB(0, 1), cB + hstep, voffB); PG8_STAGE(PG8_SA(0, 0), cA, voffA); PG8_STAGE(PG8_SA(0, 1), cA + hstep, voffA);
        if (wr == 1) PG8_BAR;
        PG8_WAIT_V(2); PG8_BAR;
        PG8_STAGE(PG8_SB(1, 0), cB + kstep, voffB); PG8_STAGE(PG8_SA(1, 0), cA + kstep, voffA); PG8_STAGE(PG8_SB(1, 1), cB + hstep + kstep, voffB);
        PG8_WAIT_V(6); PG8_BAR;
    } else {
        PG8_STAGE(PG8_SB(0, 0), cB, voffB); PG8_STAGE(PG8_SA(0, 0), cA, voffA); PG8_STAGE(PG8_SB(0, 1), cB + hstep, voffB); PG8_STAGE(PG8_SA(0, 1), cA + hstep, voffA);
        if (wr == 1) PG8_BAR;
        PG8_WAIT_V(4); PG8_BAR;
        PG8_STAGE(PG8_SB(1, 0), cB + kstep, voffB); PG8_STAGE(PG8_SA(1, 0), cA + kstep, voffA); PG8_STAGE(PG8_SB(1, 1), cB + hstep + kstep, voffB);
        PG8_WAIT_V(6); PG8_BAR;
    }
    for (;;) {
        const bool has_next = S.next(ui + 1, nxt);
        const char* nA = has_next ? (const char*)g.A + (size_t)nxt.pm * tstep : cA; const char* nB = has_next ? (const char*)g.Bt + (size_t)nxt.e * g.bstride + (size_t)nxt.pn * tstep : cB;
        for (int t = 0; t < nt; t += 2) {
            const bool last = (t == nt - 2);
            const char* a1 = cA + (size_t)(t + 1) * kstep;
            const char* a2 = last ? nA : cA + (size_t)(t + 2) * kstep; const char* b2 = last ? nB : cB + (size_t)(t + 2) * kstep;
            const char* a3 = a2 + kstep; const char* b3 = b2 + kstep;
            if (last && has_next) S.a_ready(nxt);
            if constexpr (SP2) {
            PG8_LDB(B0, 0, 0); PG8_LDB(B1, 0, 1); PG8_SCHED; PG8_LDA(At, 0, 0); PG8_STAGE(PG8_SA(1, 1), a1 + hstep, voffA);
            PG8_WAIT_V(8); PG8_WAIT_L(0); PG8_BAR; PG8_MMA(0, 0, At, B0); PG8_MMA(0, 1, At, B1); PG8_BAR; PG8_SCHED;
            PG8_LDA(At, 0, 1); PG8_STAGE(PG8_SB(0, 0), b2, voffB); PG8_STAGE(PG8_SB(0, 1), b2 + hstep, voffB); PG8_STAGE(PG8_SA(0, 0), a2, voffA);
            PG8_WAIT_V(8); PG8_WAIT_L(0); PG8_BAR; PG8_MMA(1, 0, At, B0); PG8_MMA(1, 1, At, B1); PG8_BAR; PG8_SCHED;
            PG8_LDB(B0, 1, 0); PG8_LDB(B1, 1, 1); PG8_SCHED; PG8_LDA(At, 1, 0); PG8_STAGE(PG8_SA(0, 1), a2 + hstep, voffA);
            PG8_WAIT_V(8); PG8_WAIT_L(0); PG8_BAR; PG8_MMA(0, 0, At, B0); PG8_MMA(0, 1, At, B1); PG8_BAR; PG8_SCHED;
            PG8_LDA(At, 1, 1); PG8_STAGE(PG8_SB(1, 0), b3, voffB); PG8_STAGE(PG8_SB(1, 1), b3 + hstep, voffB); PG8_STAGE(PG8_SA(1, 0), a3, voffA);
            PG8_WAIT_V(8); PG8_WAIT_L(0); PG8_BAR; PG8_MMA(1, 0, At, B0); PG8_MMA(1, 1, At, B1); PG8_BAR; PG8_SCHED;
            } else {
            PG8_LDB(B0, 0, 0); PG8_SCHED; PG8_LDA(At, 0, 0); PG8_STAGE(PG8_SA(1, 1), a1 + hstep, voffA);
            PG8_WAIT_L(8); PG8_BAR; PG8_WAIT_L(0); PG8_MMA(0, 0, At, B0); PG8_BAR; PG8_SCHED;
            PG8_LDB(B1, 0, 1); PG8_STAGE(PG8_SB(0, 0), b2, voffB);
            PG8_BAR; PG8_WAIT_L(0); PG8_MMA(0, 1, At, B1); PG8_BAR;
            PG8_LDA(At, 0, 1); PG8_STAGE(PG8_SA(0, 0), a2, voffA);
            PG8_BAR; PG8_WAIT_L(0); PG8_MMA(1, 0, At, B0); PG8_BAR; PG8_SCHED;
            PG8_STAGE(PG8_SB(0, 1), b2 + hstep, voffB);
            PG8_WAIT_V(6); PG8_BAR; PG8_MMA(1, 1, At, B1); PG8_BAR;
            PG8_LDB(B0, 1, 0); PG8_SCHED; PG8_LDA(At, 1, 0); PG8_STAGE(PG8_SA(0, 1), a2 + hstep, voffA);
            PG8_WAIT_L(8); PG8_BAR; PG8_WAIT_L(0); PG8_MMA(0, 0, At, B0); PG8_BAR; PG8_SCHED;
            PG8_LDB(B1, 1, 1); PG8_STAGE(PG8_SB(1, 0), b3, voffB);
            PG8_BAR; PG8_WAIT_L(0); PG8_MMA(0, 1, At, B1); PG8_BAR;
            PG8_LDA(At, 1, 1); PG8_STAGE(PG8_SA(1, 0), a3, voffA);
            PG8_BAR; PG8_WAIT_L(0); PG8_MMA(1, 0, At, B0); PG8_BAR; PG8_SCHED;
            PG8_STAGE(PG8_SB(1, 1), b3 + hstep, voffB);
            PG8_WAIT_V(6); PG8_BAR; PG8_MMA(1, 1, At, B1); PG8_BAR;
            }
        }
        if constexpr (ALIGN_EPI) { if (wr == 0) PG8_BAR; }
        if constexpr (!Epi::AFTER_DRAIN) { E(acc, cur, wr, wc, fr, fq); S.done(cur); }
        if (!has_next) break;
#pragma unroll
        for (int a = 0; a < 2; ++a)
#pragma unroll
            for (int b = 0; b < 2; ++b)
#pragma unroll
                for (int m = 0; m < 4; ++m)
#pragma unroll
                    for (int n = 0; n < 2; ++n) acc[a][b][m][n] = (f32x4){0.f, 0.f, 0.f, 0.f};
        cur = nxt; cA = nA; cB = nB; ++ui;
        if constexpr (ALIGN_EPI) { if (wr == 1) PG8_BAR; }
    }
    PG8_WAIT_V(0);
    if constexpr (!ALIGN_EPI) { if (wr == 0) PG8_BAR; }
    PG8_BAR;
    if constexpr (Epi::AFTER_DRAIN) { E.fused(acc, cur, wr, wc, fr, fq, lds, wid, lane); S.done(cur); }
#undef PG8_SA
#undef PG8_SB
#undef PG8_STAGE
#undef PG8_LDA
#undef PG8_LDB
#undef PG8_MMA
#undef PG8_WAIT_V
#undef PG8_WAIT_L
#undef PG8_BAR
#undef PG8_SCHED
}
}
constexpr int NWAVES = 8;
constexpr int BATCH = 2, SEQ = 8192, D = 1024, T = BATCH * SEQ, DEPTH = 2;
constexpr int PC = 3328;
constexpr int DIN = 3212;
constexpr int P_RW = 256, P_ML = 1664, P_V1 = 3212;
constexpr int RW = 384, RWC = 1408;
constexpr int NE = 32, TOPK = 4, FF = 1024;
constexpr int MAXBLK = T * TOPK / 256 + NE;
constexpr int NSLOT = MAXBLK * 256;
constexpr float LN_EPS = 1e-5f, GN_EPS = 64e-5f;
constexpr float DN_ALPHA = 1.41421356237f;
constexpr int NCH = SEQ / 64;
constexpr int NITEM = BATCH * NCH * 6;

constexpr size_t MiB = 1u << 20;
constexpr size_t WS_CTL = 0, CTL_ZERO_BYTES = 1 * MiB;
constexpr size_t WS_WIN = 1 * MiB;
constexpr size_t WIN_L = (size_t)PC * D * 2;
constexpr size_t WS_WOUT = WS_WIN + 2 * WIN_L;
constexpr size_t WOUT_L = (size_t)D * D * 2;
constexpr size_t WS_WGU = WS_WOUT + 2 * WOUT_L;
constexpr size_t WGU_E = (size_t)2048 * D * 2;
constexpr size_t WS_WDN = WS_WGU + 64 * WGU_E;
constexpr size_t WDN_E = (size_t)D * D * 2;
constexpr size_t WS_H16 = WS_WDN + 64 * WDN_E;
constexpr size_t WS_HA = WS_H16 + (size_t)T * D * 2;
constexpr size_t WS_HB = WS_HA + (size_t)T * D * 4;
constexpr size_t WS_P = WS_HB + (size_t)T * D * 4;
constexpr size_t WS_MIX = WS_P + (size_t)T * PC * 4;
constexpr size_t WS_YCAT = WS_MIX + (size_t)T * D * 4;
constexpr size_t RWARR = (size_t)T * RW * 4;
constexpr size_t WS_VFIRST = WS_YCAT + (size_t)T * D * 2;
constexpr size_t WS_RR = WS_VFIRST + RWARR, WS_RLW = WS_RR + RWARR, WS_RK = WS_RLW + RWARR, WS_RV = WS_RK + RWARR;
constexpr size_t WS_RNA = WS_RV + RWARR, WS_RBB = WS_RNA + RWARR, WS_RG = WS_RBB + RWARR, WS_RY = WS_RG + RWARR;
constexpr size_t WS_RSB = WS_RY + RWARR;
constexpr size_t WS_MKV = WS_RSB + (size_t)T * 8 * 4;
constexpr size_t WS_MCP = WS_MKV + (size_t)NITEM * 4096 * 4;
constexpr size_t WS_MNL = WS_MCP + (size_t)NITEM * 4096 * 4;
constexpr size_t WS_MNP = WS_MNL + (size_t)NITEM * 64 * 4;
constexpr size_t WS_MSC = WS_MNP + (size_t)NITEM * 64 * 4;
constexpr size_t WS_MLG = WS_MSC + (size_t)NITEM * 4 * 4;
constexpr size_t WS_MLI = WS_MLG + (size_t)T * 8 * 4;
constexpr size_t WS_XG = ((WS_MLI + (size_t)T * 8 * 4 + MiB - 1) / MiB) * MiB;
constexpr size_t WS_ACT = WS_XG + (size_t)NSLOT * D * 2;
constexpr size_t WS_OSL = WS_ACT + (size_t)NSLOT * FF * 2;
constexpr size_t WS_TKE = WS_OSL + (size_t)NSLOT * D * 2;
constexpr size_t WS_TKG = WS_TKE + (size_t)T * 4 * 4;
constexpr size_t WS_SLOT = WS_TKG + (size_t)T * 4 * 4;
constexpr size_t WS_GSL = WS_SLOT + (size_t)T * 4 * 4;
constexpr size_t CH_STRIDE = 49408;
constexpr size_t WS_RCH = ((WS_GSL + (size_t)NSLOT * 4 + MiB - 1) / MiB) * MiB;
constexpr size_t CO_STRIDE = 32768;
constexpr size_t WS_RCO = WS_RCH + (size_t)NITEM * CH_STRIDE;
constexpr size_t WS_RS0 = WS_RCO + (size_t)NITEM * CO_STRIDE;
constexpr size_t WS_RUT = WS_RS0 + (size_t)NITEM * 8192;
constexpr size_t WS_LORA = WS_RUT + (size_t)NITEM * 8192;
constexpr size_t WS_MQC = ((WS_LORA + 2 * 221184 + 4095) / 4096) * 4096;
constexpr size_t WS_MKC = WS_MQC + (size_t)T * 384 * 2;
constexpr size_t WS_MVT = WS_MKC + (size_t)T * 384 * 2;
constexpr size_t WS_RTW = WS_MVT + (size_t)NITEM * 8192;
constexpr size_t WS_RNK = WS_RTW + 2 * 2 * 32 * 1024 * 2;
constexpr size_t WS_WGB = WS_RNK + (size_t)T * 4 * 4;
constexpr size_t WS_END = WS_WGB + 2 * 256 * 32 * 4;
constexpr int CW_BAR = 4096;
constexpr int CW_CNT = 8192;
constexpr int CW_CUR = 8192 + 64;
constexpr int CW_NB = 8192 + 128;
constexpr int CW_BLKE = 8192 + 256;

constexpr int RING_OFF = 0, RING_BYTES = 131072;
constexpr int LDSCTL_OFF = RING_BYTES, PTR_OFF = LDSCTL_OFF + 512, MISC_OFF = LDSCTL_OFF + 1024;
constexpr int LDS_BYTES = 147456;

#define GAS __attribute__((address_space(1)))
#define LAS __attribute__((address_space(3)))
typedef unsigned short bf16;
typedef unsigned v4u __attribute__((ext_vector_type(4)));
typedef unsigned v2u __attribute__((ext_vector_type(2)));
typedef float f32x4 __attribute__((ext_vector_type(4)));
typedef GAS unsigned gu32;
#define RLX_AGENT __ATOMIC_RELAXED, __HIP_MEMORY_SCOPE_AGENT
#define LDS_WAIT() asm volatile("s_waitcnt lgkmcnt(0)" ::: "memory")
#define VM_WAIT() asm volatile("s_waitcnt vmcnt(0)" ::: "memory")
__device__ __forceinline__ unsigned f2bf(float f) { unsigned u = __builtin_bit_cast(unsigned, f); return (u + 0x7fffu + ((u >> 16) & 1u)) >> 16; }
__device__ __forceinline__ unsigned pk2(float lo, float hi) { return f2bf(lo) | (f2bf(hi) << 16); }
__device__ __forceinline__ float bf2f(unsigned b) { return __builtin_bit_cast(float, b << 16); }
__device__ __forceinline__ float wave_sum(float v) {
#pragma unroll
    for (int o = 1; o < 64; o <<= 1) v += __shfl_xor(v, o);
    return v;
}
__device__ __forceinline__ float wave_max(float v) {
#pragma unroll
    for (int o = 1; o < 64; o <<= 1) v = fmaxf(v, __shfl_xor(v, o));
    return v;
}
__device__ __forceinline__ float fexp(float x) { return __builtin_amdgcn_exp2f(x * 1.4426950408889634f); }
__device__ __forceinline__ float frcp(float x) { return __builtin_amdgcn_rcpf(x); }
__device__ __forceinline__ float flog(float x) { return __builtin_amdgcn_logf(x) * 0.6931471805599453f; }
__device__ __forceinline__ float frsq(float x) { return __builtin_amdgcn_rsqf(x); }
__device__ __forceinline__ float sigmoidf_(float x) { return frcp(1.0f + fexp(-x)); }
__device__ __forceinline__ float tanhf_(float x) { return 1.0f - 2.0f * frcp(1.0f + fexp(2.0f * x)); }
__device__ __forceinline__ float softplusf_(float x) { return fmaxf(x, 0.f) + flog(1.0f + fexp(-fabsf(x))); }
__device__ __forceinline__ float logsigmoidf_(float x) { return fminf(x, 0.f) - flog(1.0f + fexp(-fabsf(x))); }

#define XB_TMO      128
#define XB_XCNT(j)  (256  + 64 * (j))
#define XB_XSUB(j)  (1280 + 64 * (j))
#define XB_XGEN(j)  (2304 + 64 * (j))
#define XB_TOP      3328
#define XB_TOPGEN   3392
#define XCD_BAR_WORDS 3456
#define XB_SPIN_CAP (1u << 18)

__device__ __forceinline__ unsigned xb_ld(unsigned* p)              { return __hip_atomic_load(p, __ATOMIC_RELAXED, __HIP_MEMORY_SCOPE_AGENT); }
__device__ __forceinline__ unsigned xb_add(unsigned* p, unsigned v) { return __hip_atomic_fetch_add(p, v, __ATOMIC_RELAXED, __HIP_MEMORY_SCOPE_AGENT); }
__device__ __forceinline__ unsigned xb_xcc_id() { return (unsigned)__builtin_amdgcn_s_getreg((3 << 11) | 20) & 0xFu; }
#define XB_SPIN(cond, bar) do { unsigned _sp = 0; while (cond) { __builtin_amdgcn_s_sleep(1); \
    if ((++_sp & 255u) == 0u) { if (xb_ld(&(bar)[XB_TMO])) break; if (_sp > XB_SPIN_CAP) { atomicAdd(&(bar)[XB_TMO], 1u); break; } } } } while (0)

struct XcdBarrier {
    unsigned* bar; unsigned x;
    volatile LAS unsigned* st;
};

__device__ __forceinline__ XcdBarrier xcd_barrier_post(unsigned* bar, volatile LAS unsigned* st) {
    XcdBarrier b; b.bar = bar; b.x = xb_xcc_id(); b.st = st;
    if (threadIdx.x == 0) (void)xb_add(&bar[XB_XCNT(b.x)], 1u);
    return b;
}
__device__ __forceinline__ void xcd_barrier_complete(unsigned* bar, unsigned x, unsigned& nloc, unsigned& nx) {
    const unsigned G = gridDim.x * gridDim.y * gridDim.z;
    unsigned sum, cnt, mine, sp = 0u;
    for (;;) {
        sum = 0u; cnt = 0u; mine = 0u;
#pragma unroll
        for (unsigned j = 0; j < 16; ++j) { const unsigned c = xb_ld(&bar[XB_XCNT(j)]); sum += c; cnt += (c > 0u) ? 1u : 0u; mine = (j == x) ? c : mine; }
        if (sum == G) break;
        __builtin_amdgcn_s_sleep(1);
        if ((++sp & 255u) == 0u) { if (xb_ld(&bar[XB_TMO])) break; if (sp > XB_SPIN_CAP) { atomicAdd(&bar[XB_TMO], 1u); break; } }
    }
    nloc = mine > 0u ? mine : 1u; nx = cnt > 0u ? cnt : 1u;
}

__device__ __forceinline__ void xcd_barrier(const XcdBarrier& b) {
    asm volatile("s_waitcnt vmcnt(0)" ::: "memory");
    __syncthreads();
    if (threadIdx.x == 0) {
        unsigned* bar = b.bar;
        __builtin_amdgcn_s_waitcnt(0);
        unsigned nloc = b.st[0], nx = b.st[1];
        if (nloc == 0u) { xcd_barrier_complete(bar, b.x, nloc, nx); b.st[0] = nloc; b.st[1] = nx; }
        const unsigned old = xb_add(&bar[XB_XSUB(b.x)], 1u);
        const unsigned gen = old / nloc;
        if (old + 1u == (gen + 1u) * nloc) {
            __builtin_amdgcn_fence(__ATOMIC_RELEASE, "agent");
            asm volatile("s_waitcnt vmcnt(0)" ::: "memory");
            const unsigned og = xb_add(&bar[XB_TOP], 1u);
            const unsigned tg = og / nx;
            if (og + 1u == (tg + 1u) * nx) xb_add(&bar[XB_TOPGEN], 1u);
            else XB_SPIN(xb_ld(&bar[XB_TOPGEN]) == tg, bar);
            __builtin_amdgcn_fence(__ATOMIC_ACQUIRE, "agent");
            xb_add(&bar[XB_XGEN(b.x)], 1u);
            asm volatile("s_waitcnt vmcnt(0)" ::: "memory");
        } else {
            XB_SPIN(xb_ld(&bar[XB_XGEN(b.x)]) == gen, bar);
            __builtin_amdgcn_fence(__ATOMIC_ACQUIRE, "agent");
            asm volatile("s_waitcnt vmcnt(0)" ::: "memory");
        }
    }
    __syncthreads();
}


struct Frame {
    LAS unsigned char* lds;
    volatile LAS unsigned* MISC;
    gu32* ctl;
    GAS unsigned char* ws;
    GAS float* out;
    int tid, lane, wave;
    int vcu, G;
};
enum { I_X = 0, I_WIN, I_POOLW, I_POOLS, I_MU, I_W0, I_W2, I_A0, I_A2, I_G2, I_KKS, I_KA, I_RK, I_LNXG, I_LNXB, I_V0, I_V1, I_V2,
       I_CONVW, I_CONVB, I_BI, I_BF, I_NORMG, I_WOUT, I_LN1G, I_LN1B, I_RTW, I_RTB, I_WGU, I_BGU, I_WDN, I_BDN, I_LN2G, I_LN2B };

#define WSP(T_, off) ((GAS T_*)(F.ws + (off)))
__device__ __forceinline__ const GAS float* inp_(LAS unsigned char* lds, int i) {
    const unsigned long long v = *(const LAS unsigned long long*)(lds + PTR_OFF + 8 * i);
    const unsigned lo = __builtin_amdgcn_readfirstlane((unsigned)v), hi = __builtin_amdgcn_readfirstlane((unsigned)(v >> 32));
    return (const GAS float*)(((unsigned long long)hi << 32) | lo);
}
#define INP(i) inp_(F.lds, (i))
__device__ __forceinline__ Frame launder(const Frame& G) {
    Frame F = G;
    F.tid = threadIdx.x; asm volatile("" : "+v"(F.tid)); F.lane = F.tid & 63;
    F.wave = __builtin_amdgcn_readfirstlane(F.tid >> 6);
    F.G = gridDim.x; { const int bx = blockIdx.x; F.vcu = (F.G % 8 == 0) ? (bx % 8) * (F.G / 8) + bx / 8 : bx; }
    asm volatile("" : "+s"(F.ws), "+s"(F.out), "+s"(F.vcu), "+s"(F.G));
    F.ctl = (gu32*)(F.ws + WS_CTL);
    return F;
}
__device__ __forceinline__ int launder_s(int x) { asm volatile("" : "+s"(x)); return x; }

template <int NN>
struct MoeOrder {
    int nb, c; const gu32* blke;
    __device__ __forceinline__ bool next(int i, pg8::Unit& u) const {
        constexpr int BPX = 32 / NN;
        const int x = c & 7, j = c >> 3;
        const int blk = i * (8 * BPX) + x * BPX + j / NN;
        if (blk >= nb) return false;
        u.pm = blk; u.pn = j % NN; u.e = (int)__builtin_amdgcn_readfirstlane(__hip_atomic_load(blke + blk, RLX_AGENT));
        return true;
    }
    __device__ __forceinline__ void a_ready(const pg8::Unit&) const {}
    __device__ __forceinline__ void done(const pg8::Unit&) const {}
};

__device__ __forceinline__ void transpose_item(const GAS float* src, int ld, bool valid, int k0, GAS bf16* dst  , LAS float* scr, int lane) {
    const GAS float* s0 = src + (size_t)(k0 + (lane >> 5)) * ld;
#pragma unroll 8
    for (int i = 0; i < 32; ++i) { const int kk = 2 * i + (lane >> 5); scr[kk * 33 + (lane & 31)] = valid ? s0[(size_t)(2 * i) * ld] : 0.f; }
    LDS_WAIT(); asm volatile("" ::: "memory");
    const int c = lane & 7;
#pragma unroll
    for (int j = 0; j < 4; ++j) { const int n = (lane >> 3) + 8 * j; const LAS float* s = scr + (8 * c) * 33 + n;
        v4u o; o.x = pk2(s[0 * 33], s[1 * 33]); o.y = pk2(s[2 * 33], s[3 * 33]); o.z = pk2(s[4 * 33], s[5 * 33]); o.w = pk2(s[6 * 33], s[7 * 33]);
        *(GAS v4u*)(dst + (size_t)n * D + k0 + 8 * c) = o; }
    LDS_WAIT(); asm volatile("" ::: "memory");
}
__device__ __forceinline__ void phase_convert(Frame& F) {
    LAS float* scr = (LAS float*)(F.lds + RING_OFF + F.wave * 16384);
    const int gw = F.vcu * NWAVES + F.wave, NGW = F.G * NWAVES; const int lane = F.lane;
    { const GAS float* x = INP(I_X); GAS bf16* h16 = WSP(bf16, WS_H16);
      for (int m = gw; m < T; m += NGW) { const GAS f32x4* xr = (const GAS f32x4*)(x + (size_t)m * D) + lane; GAS v2u* o = (GAS v2u*)(h16 + (size_t)m * D) + lane;
#pragma unroll
          for (int j = 0; j < 4; ++j) { const f32x4 v = xr[64 * j]; v2u w; w.x = pk2(v.x, v.y); w.y = pk2(v.z, v.w); o[64 * j] = w; } } }
    constexpr int KB = D / 64;
    constexpr int I_IN = 2 * (PC / 32) * KB;
    constexpr int I_OUT = 2 * (D / 32) * KB;
    constexpr int I_GU = 64 * (2048 / 32) * KB;
    constexpr int I_DN = 64 * (D / 32) * KB;
    constexpr int NITEMS = I_IN + I_OUT + I_GU + I_DN;
    for (int it = gw; it < NITEMS; it += NGW) {
        int r = it;
        if (r < I_IN) { const int l = r / ((PC / 32) * KB); r -= l * ((PC / 32) * KB); const int nb = r / KB, kb = r % KB; const int n = nb * 32 + (lane & 31);
            const GAS float* src; int ld; bool valid;
            if (n < DIN) { src = INP(I_WIN) + (size_t)l * D * DIN + n; ld = DIN; valid = true; }
            else if (l == 1 && n < DIN + 32) { src = INP(I_V1) + (n - DIN); ld = 32; valid = true; }
            else { src = INP(I_WIN); ld = 0; valid = false; }
            transpose_item(src, ld, valid, kb * 64, WSP(bf16, WS_WIN + l * WIN_L) + (size_t)(nb * 32) * D, scr, lane); continue; }
        r -= I_IN;
        if (r < I_OUT) { const int l = r / ((D / 32) * KB); r -= l * ((D / 32) * KB); const int nb = r / KB, kb = r % KB;
            transpose_item(INP(I_WOUT) + (size_t)l * D * D + nb * 32 + (lane & 31), D, true, kb * 64, WSP(bf16, WS_WOUT + l * WOUT_L) + (size_t)(nb * 32) * D, scr, lane); continue; }
        r -= I_OUT;
        if (r < I_GU) { const int le = r / (64 * KB); r -= le * (64 * KB); const int nb = r / KB, kb = r % KB; const int n0 = nb * 32;
            const int nn = n0 & 1023; const int drow = 256 * (nn >> 7) + (nn & 127) + ((n0 >= 1024) ? 128 : 0);
            transpose_item(INP(I_WGU) + (size_t)le * D * 2048 + n0 + (lane & 31), 2048, true, kb * 64, WSP(bf16, WS_WGU + le * WGU_E) + (size_t)drow * D, scr, lane); continue; }
        r -= I_GU;
        { const int le = r / (32 * KB); r -= le * (32 * KB); const int nb = r / KB, kb = r % KB;
            transpose_item(INP(I_WDN) + (size_t)le * D * D + nb * 32 + (lane & 31), D, true, kb * 64, WSP(bf16, WS_WDN + le * WDN_E) + (size_t)(nb * 32) * D, scr, lane); }
    }
}

__device__ __forceinline__ void pool_items(Frame& F, int l) {
    const GAS float* p = WSP(float, WS_P); GAS bf16* ycat = WSP(bf16, WS_YCAT);
    LAS float* dt = (LAS float*)(F.lds + RING_OFF + F.wave * 8192);
    const int gw = F.vcu * NWAVES + F.wave, NGW = F.G * NWAVES, lane = F.lane;
    for (int it = gw; it < (T / 32) * 4; it += NGW) {
        const int g = it & 3, tile = it >> 2, tok0 = tile * 32, t0 = tok0 & (SEQ - 1);
        const int win = 2 << g; const int col = 64 * g + lane;
        const GAS float* pc = p + (size_t)tok0 * PC + col;
        float ub[47];
#pragma unroll
        for (int j = 0; j < 47; ++j) { const int rel = j - 15; const int relc = (t0 + rel >= 0) ? rel : 0; const float x = pc[(ptrdiff_t)relc * PC]; ub[j] = (t0 + rel >= 0) ? x : 0.f; }
        float s = 0.f;
#pragma unroll
        for (int j = 1; j < 16; ++j) if (j < win) s += ub[15 - j];
#pragma unroll
        for (int t = 0; t < 32; ++t) {
            const float u = ub[15 + t]; s += u;
            const int cnt = min(t0 + t + 1, win);
            dt[t * 64 + lane] = s * frcp((float)cnt) - u;
            const float d2 = ub[15 + t - 1], d4 = ub[15 + t - 3], d8 = ub[15 + t - 7], d16 = ub[15 + t - 15];
            s -= (g == 0) ? d2 : (g == 1) ? d4 : (g == 2) ? d8 : d16;
        }
        LDS_WAIT(); asm volatile("" ::: "memory");
        float w[64];
        const GAS float* pw = INP(I_POOLW) + ((size_t)(l * 4 + g) * 64) * 64 + lane;
#pragma unroll
        for (int i = 0; i < 64; ++i) w[i] = pw[i * 64];
        const float sc = INP(I_POOLS)[l * 256 + col];
        for (int t = 0; t < 32; ++t) {
            float a0 = 0.f, a1 = 0.f, a2 = 0.f, a3 = 0.f;
#pragma unroll
            for (int i = 0; i < 64; i += 4) { const f32x4 d = *(const LAS f32x4*)(dt + t * 64 + i); a0 += d.x * w[i]; a1 += d.y * w[i + 1]; a2 += d.z * w[i + 2]; a3 += d.w * w[i + 3]; }
            ycat[(size_t)(tok0 + t) * D + col] = (bf16)f2bf(((a0 + a1) + (a2 + a3)) * sc);
        }
        LDS_WAIT(); asm volatile("" ::: "memory");
    }
}

constexpr int XS_PITCH = 1440;
__device__ __forceinline__ void rwkv_prep(Frame& F, int l) {
    const GAS float* p = WSP(float, WS_P);
    LAS float* xs = (LAS float*)(F.lds + RING_OFF);
    const GAS float* mu = INP(I_MU) + l * RWC;
    GAS float* vfirst = WSP(float, WS_VFIRST);
    GAS float* oR = WSP(float, WS_RR), *oLW = WSP(float, WS_RLW), *oK = WSP(float, WS_RK), *oV = WSP(float, WS_RV), *oNA = WSP(float, WS_RNA), *oBB = WSP(float, WS_RBB), *oG = WSP(float, WS_RG), *oSB = WSP(float, WS_RSB);
    for (int grp = F.vcu; grp < T / 8; grp += F.G) {
        const int tok0 = grp * 8;
#pragma unroll 2
        for (int idx = F.tid; idx < 8 * RWC; idx += NWAVES * 64) {
            const int tk = idx / RWC, j = idx - tk * RWC; const int tok = tok0 + tk;
            const bool first = (tok & (SEQ - 1)) == 0;
            const float cur = p[(size_t)tok * PC + P_RW + j];
            const float pv = p[(size_t)(first ? tok : tok - 1) * PC + P_RW + j];
            const float prev = first ? 0.f : pv;
            float x = cur + mu[j] * (prev - cur);
            if (j >= 1152 && j < 1216) x = tanhf_(x);
            else if (j >= 1280) x = sigmoidf_(x);
            xs[tk * XS_PITCH + j] = x;
        }
        if (l == 1) for (int idx = F.tid; idx < 8 * 32; idx += NWAVES * 64) { const int tk = idx >> 5, j = idx & 31; xs[tk * XS_PITCH + RWC + j] = p[(size_t)(tok0 + tk) * PC + P_V1 + j]; }
        __syncthreads();
        if (F.wave < 6) {
            const int h = F.wave, ch = 64 * h + F.lane;
            float dw[8], da[8], dg[8], dv[8];
#pragma unroll
            for (int t = 0; t < 8; ++t) { dw[t] = 0.f; da[t] = 0.f; dg[t] = 0.f; dv[t] = 0.f; }
            const GAS float* w2 = INP(I_W2) + (size_t)l * 64 * RW + ch; const GAS float* a2 = INP(I_A2) + (size_t)l * 64 * RW + ch; const GAS float* g2 = INP(I_G2) + (size_t)l * 128 * RW + ch;
#pragma unroll 1
            for (int j = 0; j < 64; j += 4) {
                float wv[4], av[4];
#pragma unroll
                for (int q = 0; q < 4; ++q) { wv[q] = w2[(size_t)(j + q) * RW]; av[q] = a2[(size_t)(j + q) * RW]; }
#pragma unroll
                for (int t = 0; t < 8; ++t) { const f32x4 xw = *(const LAS f32x4*)(xs + t * XS_PITCH + 1152 + j); const f32x4 xa = *(const LAS f32x4*)(xs + t * XS_PITCH + 1216 + j);
                    dw[t] += xw.x * wv[0] + xw.y * wv[1] + xw.z * wv[2] + xw.w * wv[3]; da[t] += xa.x * av[0] + xa.y * av[1] + xa.z * av[2] + xa.w * av[3]; }
            }
#pragma unroll 1
            for (int j = 0; j < 128; j += 4) {
                float gv[4];
#pragma unroll
                for (int q = 0; q < 4; ++q) gv[q] = g2[(size_t)(j + q) * RW];
#pragma unroll
                for (int t = 0; t < 8; ++t) { const f32x4 xg = *(const LAS f32x4*)(xs + t * XS_PITCH + 1280 + j); dg[t] += xg.x * gv[0] + xg.y * gv[1] + xg.z * gv[2] + xg.w * gv[3]; }
            }
            if (l == 1) { const GAS float* v2 = INP(I_V2) + ch;
#pragma unroll 1
                for (int j = 0; j < 32; j += 4) {
                    float vv[4];
#pragma unroll
                    for (int q = 0; q < 4; ++q) vv[q] = v2[(size_t)(j + q) * RW];
#pragma unroll
                    for (int t = 0; t < 8; ++t) { const f32x4 xv = *(const LAS f32x4*)(xs + t * XS_PITCH + RWC + j); dv[t] += xv.x * vv[0] + xv.y * vv[1] + xv.z * vv[2] + xv.w * vv[3]; }
                } }
            LAS float* accl = (LAS float*)(F.lds + RING_OFF + 49152) + h * 2048;
#pragma unroll
            for (int t = 0; t < 8; ++t) { accl[(0 * 8 + t) * 64 + F.lane] = dw[t]; accl[(1 * 8 + t) * 64 + F.lane] = da[t]; accl[(2 * 8 + t) * 64 + F.lane] = dg[t]; accl[(3 * 8 + t) * 64 + F.lane] = dv[t]; }
            LDS_WAIT(); asm volatile("" ::: "memory");
            const float w0 = INP(I_W0)[l * RW + ch], a0 = INP(I_A0)[l * RW + ch], kks = INP(I_KKS)[l * RW + ch], ka = INP(I_KA)[l * RW + ch], rk = INP(I_RK)[l * RW + ch];
            const float v0 = (l == 1) ? INP(I_V0)[ch] : 0.f;
#pragma unroll 1
            for (int t = 0; t < 8; ++t) {
                const int tok = tok0 + t; const size_t o = (size_t)tok * RW + ch;
                const float dwt = accl[(0 * 8 + t) * 64 + F.lane], dat = accl[(1 * 8 + t) * 64 + F.lane], dgt = accl[(2 * 8 + t) * 64 + F.lane], dvt = accl[(3 * 8 + t) * 64 + F.lane];
                const float r = xs[t * XS_PITCH + ch], k = xs[t * XS_PITCH + 384 + ch]; float v = xs[t * XS_PITCH + 768 + ch];
                const float wlog = -softplusf_(-(w0 + dwt)) - 0.5f; const float lw = -fexp(wlog);
                const float ai = sigmoidf_(a0 + dat);
                if (l == 0) vfirst[o] = v; else { const float vg = sigmoidf_(v0 + dvt); v = v + (vfirst[o] - v) * vg; }
                const float kkv = k * kks; const float nrm = sqrtf(wave_sum(kkv * kkv)); const float kk = kkv / fmaxf(nrm, 1e-12f);
                const float kp = k * (1.0f + (ai - 1.0f) * ka);
                const float sb = wave_sum(r * kp * rk);
                oR[o] = r; oLW[o] = lw; oK[o] = kp; oV[o] = v; oNA[o] = -kk; oBB[o] = kk * ai; oG[o] = dgt;
                if (F.lane == 0) oSB[tok * 8 + h] = sb;
            }
        }
        __syncthreads();
    }
}

__device__ __forceinline__ void mlstm_qk_tile(Frame& F, int l, int b, int c, int h, int which, LAS float* tile) {
    const GAS float* p = WSP(float, WS_P);
    const GAS float* cw = INP(I_CONVW) + (size_t)l * 4 * 768 + which * 384 + 64 * h; const GAS float* cb = INP(I_CONVB) + l * 768 + which * 384 + 64 * h;
    const int pcol = P_ML + which * 384 + 64 * h;
#pragma unroll 4
    for (int idx = F.tid; idx < 4096; idx += NWAVES * 64) {
        const int s = idx >> 6, d = idx & 63; const int tl = 64 * c + s; const size_t tok = (size_t)b * SEQ + tl;
        float acc = cb[d];
#pragma unroll
        for (int i = 0; i < 4; ++i) { const int tt = tl - 3 + i; const float x = p[(tt >= 0 ? tok - 3 + i : tok) * PC + pcol + d]; acc += (tt >= 0 ? cw[i * 768 + d] : 0.f) * x; }
        float y = acc * sigmoidf_(acc); if (which == 0) y *= 0.125f;
        tile[s * 65 + d] = y;
    }
}
__device__ __forceinline__ void mlstm_summ(Frame& F, int l) {
    const GAS float* p = WSP(float, WS_P);
    LAS float* kt = (LAS float*)(F.lds + RING_OFF);
    LAS float* vt = kt + 64 * 65;
    LAS float* we = vt + 64 * 64;
    GAS float* kvloc = WSP(float, WS_MKV); GAS float* nloc = WSP(float, WS_MNL); GAS float* msc = WSP(float, WS_MSC); GAS float* mlg = WSP(float, WS_MLG); GAS float* mli = WSP(float, WS_MLI);
    for (int item = F.vcu; item < NITEM; item += F.G) {
        const int h = item % 6, bc = item / 6, c = bc % NCH, b = bc / NCH;
        const size_t tokb = (size_t)b * SEQ + 64 * c;
        if (F.wave == 0) {
            const size_t tok = tokb + F.lane;
            const float ig = p[tok * PC + P_ML + 1536 + h] + INP(I_BI)[l * 6 + h];
            const float lf = logsigmoidf_(p[tok * PC + P_ML + 1542 + h] + INP(I_BF)[l * 6 + h]);
            float g = lf;
#pragma unroll
            for (int o = 1; o < 64; o <<= 1) { const float t = __shfl_up(g, o); if (F.lane >= o) g += t; }
            const float glast = __shfl(g, 63);
            const float e = glast - g + ig; const float mloc = wave_max(e);
            we[F.lane] = fexp(e - mloc);
            mlg[tok * 8 + h] = g; mli[tok * 8 + h] = ig;
            if (F.lane == 0) { msc[item * 4 + 0] = mloc; msc[item * 4 + 1] = glast; }
        }
        mlstm_qk_tile(F, l, b, c, h, 1, kt);
        for (int idx = F.tid; idx < 4096; idx += NWAVES * 64) { const int s = idx >> 6, d = idx & 63; vt[idx] = p[(tokb + s) * PC + P_ML + 768 + 64 * h + d]; }
        __syncthreads();
        { const int kd = F.tid >> 3, v0 = (F.tid & 7) * 8;
          float acc[8]; float an = 0.f;
#pragma unroll
          for (int j = 0; j < 8; ++j) acc[j] = 0.f;
          for (int s = 0; s < 64; ++s) { const float kw = we[s] * kt[s * 65 + kd]; an += kw; const f32x4 va = *(const LAS f32x4*)(vt + s * 64 + v0), vb = *(const LAS f32x4*)(vt + s * 64 + v0 + 4);
              acc[0] += kw * va.x; acc[1] += kw * va.y; acc[2] += kw * va.z; acc[3] += kw * va.w; acc[4] += kw * vb.x; acc[5] += kw * vb.y; acc[6] += kw * vb.z; acc[7] += kw * vb.w; }
          GAS float* o = kvloc + (size_t)item * 4096 + kd * 64 + v0;
          *(GAS f32x4*)o = (f32x4){acc[0], acc[1], acc[2], acc[3]}; *(GAS f32x4*)(o + 4) = (f32x4){acc[4], acc[5], acc[6], acc[7]};
          if ((F.tid & 7) == 0) nloc[item * 64 + kd] = an; }
        __syncthreads();
    }
}

__device__ __forceinline__ void rwkv_scan_seq(Frame& F) {
    if (F.vcu >= 12) return;
    const int b = F.vcu / 6, h = F.vcu % 6;
    LAS float* L = (LAS float*)(F.lds + RING_OFF);
    LAS float* ybuf = L + 6 * 4096;
    const GAS float* src[6] = {WSP(float, WS_RR), WSP(float, WS_RLW), WSP(float, WS_RK), WSP(float, WS_RV), WSP(float, WS_RNA), WSP(float, WS_RBB)};
    GAS float* yraw = WSP(float, WS_RY);
    const int vrow = (F.tid >> 2) & 63, q = F.tid & 3;
    float S[16];
#pragma unroll
    for (int i = 0; i < 16; ++i) S[i] = 0.f;
    for (int blk = 0; blk < SEQ / 64; ++blk) {
        const size_t tokb = (size_t)b * SEQ + blk * 64;
#pragma unroll
        for (int a = 0; a < 6; ++a)
            for (int idx = F.tid; idx < 4096; idx += NWAVES * 64) { const int s = idx >> 6, d = idx & 63; float x = src[a][(tokb + s) * RW + 64 * h + d]; if (a == 1) x = fexp(x); L[a * 4096 + idx] = x; }
        __syncthreads();
        if (F.tid < 256) {
            for (int t = 0; t < 64; ++t) {
                const LAS float* base = L + t * 64 + 16 * q;
                float sa = 0.f;
#pragma unroll
                for (int i = 0; i < 16; ++i) sa += S[i] * base[4 * 4096 + i];
                sa += __shfl_xor(sa, 1); sa += __shfl_xor(sa, 2);
                const float vv = L[3 * 4096 + t * 64 + vrow];
                float y = 0.f;
#pragma unroll
                for (int i = 0; i < 16; ++i) { S[i] = S[i] * base[1 * 4096 + i] + sa * base[5 * 4096 + i] + vv * base[2 * 4096 + i]; y += S[i] * base[i]; }
                y += __shfl_xor(y, 1); y += __shfl_xor(y, 2);
                if (q == 0) ybuf[t * 64 + vrow] = y;
            }
        }
        __syncthreads();
        for (int idx = F.tid; idx < 4096; idx += NWAVES * 64) { const int s = idx >> 6, d = idx & 63; yraw[(tokb + s) * RW + 64 * h + d] = ybuf[idx]; }
        __syncthreads();
    }
}
__device__ __forceinline__ void mlstm_scan(Frame& F) {
    if (blockIdx.x < 48) return;
    const int gt = ((int)blockIdx.x - 48) * (NWAVES * 64) + F.tid;
    const GAS float* msc = WSP(float, WS_MSC);
    if (gt < 12 * 4096 + 12 * 64) {
        const bool isn = gt >= 12 * 4096;
        const int g2 = isn ? gt - 12 * 4096 : gt;
        const int bh = isn ? (g2 >> 6) : (g2 >> 12), el = isn ? (g2 & 63) : (g2 & 4095), b = bh / 6, h = bh % 6;
        const int es = isn ? 64 : 4096;
        const GAS float* src = isn ? WSP(float, WS_MNL) : WSP(float, WS_MKV); GAS float* dst = isn ? WSP(float, WS_MNP) : WSP(float, WS_MCP); GAS float* mscw = WSP(float, WS_MSC);
        float C = 0.f, m = 0.f;
        for (int c0 = 0; c0 < NCH; c0 += 8) {
            float x[8], ml[8], gl[8];
#pragma unroll
            for (int i = 0; i < 8; ++i) { const int item = (b * NCH + c0 + i) * 6 + h; ml[i] = msc[item * 4 + 0]; gl[i] = msc[item * 4 + 1]; x[i] = src[(size_t)item * es + el]; }
#pragma unroll
            for (int i = 0; i < 8; ++i) { const int item = (b * NCH + c0 + i) * 6 + h;
                dst[(size_t)item * es + el] = C;
                if (!isn && el == 0) mscw[item * 4 + 2] = m;
                const float mn = fmaxf(gl[i] + m, ml[i]); const float ao = fexp(gl[i] + m - mn), an = fexp(ml[i] - mn);
                C = ao * C + an * x[i]; m = mn; }
        }
    }
}

__device__ __forceinline__ void rwkv_finish(Frame& F, int l) {
    const GAS float* yraw = WSP(float, WS_RY); const GAS float* v = WSP(float, WS_RV); const GAS float* g = WSP(float, WS_RG); const GAS float* sb = WSP(float, WS_RSB);
    GAS bf16* ycat = WSP(bf16, WS_YCAT);
    const int gw = F.vcu * NWAVES + F.wave, NGW = F.G * NWAVES, lane = F.lane;
    for (int tok = gw; tok < T; tok += NGW) {
#pragma unroll
        for (int h = 0; h < 6; ++h) {
            const size_t o = (size_t)tok * RW + 64 * h + lane;
            const float y = yraw[o]; const float mean = wave_sum(y) * (1.f / 64.f); const float d = y - mean; const float var = wave_sum(d * d) * (1.f / 64.f);
            float r = d * (frsq(var + GN_EPS)) * INP(I_LNXG)[l * RW + 64 * h + lane] + INP(I_LNXB)[l * RW + 64 * h + lane];
            r += sb[tok * 8 + h] * v[o];
            r *= g[o];
            ycat[(size_t)tok * D + 256 + 64 * h + lane] = (bf16)f2bf(r);
        }
    }
}
__device__ __forceinline__ void mlstm_out(Frame& F, int l) {
    const GAS float* p = WSP(float, WS_P);
    LAS float* qt = (LAS float*)(F.lds + RING_OFF);
    LAS float* kt = qt + 64 * 65;
    LAS float* At = kt + 64 * 65;
    LAS float* vt = At + 64 * 65;
    LAS float* cpt = vt + 4096;
    LAS float* sm = cpt + 4096;
    const GAS float* cp = WSP(float, WS_MCP); const GAS float* np = WSP(float, WS_MNP); const GAS float* msc = WSP(float, WS_MSC); const GAS float* mlg = WSP(float, WS_MLG); const GAS float* mli = WSP(float, WS_MLI);
    GAS bf16* ycat = WSP(bf16, WS_YCAT);
    for (int item = F.vcu; item < NITEM; item += F.G) {
        const int h = item % 6, bc = item / 6, c = bc % NCH, b = bc / NCH;
        const size_t tokb = (size_t)b * SEQ + 64 * c;
        mlstm_qk_tile(F, l, b, c, h, 0, qt);
        mlstm_qk_tile(F, l, b, c, h, 1, kt);
        for (int idx = F.tid; idx < 4096; idx += NWAVES * 64) { const int s = idx >> 6, d = idx & 63; vt[idx] = p[(tokb + s) * PC + P_ML + 768 + 64 * h + d]; cpt[idx] = cp[(size_t)item * 4096 + idx]; }
        if (F.tid < 64) { sm[F.tid] = mlg[(tokb + F.tid) * 8 + h]; sm[64 + F.tid] = mli[(tokb + F.tid) * 8 + h]; sm[128 + F.tid] = np[item * 64 + F.tid]; }
        const float mprev = msc[item * 4 + 2];
        __syncthreads();
        const int j = F.tid >> 3, sub = F.tid & 7;
        { const int s0 = sub * 8;
          float acc[8];
#pragma unroll
          for (int i = 0; i < 8; ++i) acc[i] = 0.f;
          for (int d = 0; d < 64; ++d) { const float qv = qt[j * 65 + d];
#pragma unroll
              for (int i = 0; i < 8; ++i) acc[i] += qv * kt[(s0 + i) * 65 + d]; }
          const float gj = sm[j];
          float dl[8]; float mx = -INFINITY;
#pragma unroll
          for (int i = 0; i < 8; ++i) { const int s = s0 + i; dl[i] = (s <= j) ? (gj - sm[s] + sm[64 + s]) : -INFINITY; mx = fmaxf(mx, dl[i]); }
          mx = fmaxf(mx, __shfl_xor(mx, 1)); mx = fmaxf(mx, __shfl_xor(mx, 2)); mx = fmaxf(mx, __shfl_xor(mx, 4));
          const float il = gj + mprev; const float mj = fmaxf(mx, il);
          float dsum = 0.f;
#pragma unroll
          for (int i = 0; i < 8; ++i) { const int s = s0 + i; const float w = (s <= j) ? fexp(dl[i] - mj) * acc[i] : 0.f; At[j * 65 + s] = w; dsum += w; }
          dsum += __shfl_xor(dsum, 1); dsum += __shfl_xor(dsum, 2); dsum += __shfl_xor(dsum, 4);
          if (sub == 0) { float qn = 0.f; for (int d = 0; d < 64; ++d) qn += qt[j * 65 + d] * sm[128 + d];
              const float wi = fexp(il - mj); const float den = dsum + wi * qn;
              sm[192 + j] = wi; sm[256 + j] = frcp(fmaxf(fabsf(den), fexp(-mj))); } }
        __syncthreads();
        { const int v0 = sub * 8;
          float acc[8];
#pragma unroll
          for (int i = 0; i < 8; ++i) acc[i] = 0.f;
          for (int s = 0; s <= j; ++s) { const float a = At[j * 65 + s]; const f32x4 va = *(const LAS f32x4*)(vt + s * 64 + v0), vb = *(const LAS f32x4*)(vt + s * 64 + v0 + 4);
              acc[0] += a * va.x; acc[1] += a * va.y; acc[2] += a * va.z; acc[3] += a * va.w; acc[4] += a * vb.x; acc[5] += a * vb.y; acc[6] += a * vb.z; acc[7] += a * vb.w; }
          const float wi = sm[192 + j];
          for (int d = 0; d < 64; ++d) { const float a = qt[j * 65 + d] * wi; const f32x4 va = *(const LAS f32x4*)(cpt + d * 64 + v0), vb = *(const LAS f32x4*)(cpt + d * 64 + v0 + 4);
              acc[0] += a * va.x; acc[1] += a * va.y; acc[2] += a * va.z; acc[3] += a * va.w; acc[4] += a * vb.x; acc[5] += a * vb.y; acc[6] += a * vb.z; acc[7] += a * vb.w; }
          const float di = sm[256 + j];
          float sum = 0.f;
#pragma unroll
          for (int i = 0; i < 8; ++i) { acc[i] *= di; sum += acc[i]; }
          sum += __shfl_xor(sum, 1); sum += __shfl_xor(sum, 2); sum += __shfl_xor(sum, 4);
          const float mean = sum * (1.f / 64.f); float vs = 0.f;
#pragma unroll
          for (int i = 0; i < 8; ++i) { acc[i] -= mean; vs += acc[i] * acc[i]; }
          vs += __shfl_xor(vs, 1); vs += __shfl_xor(vs, 2); vs += __shfl_xor(vs, 4);
          const float rstd = frsq(vs * (1.f / 64.f) + LN_EPS);
          const size_t tok = tokb + j;
          const GAS float* og = p + tok * PC + P_ML + 1152 + 64 * h + v0; const GAS float* ng = INP(I_NORMG) + l * 384 + 64 * h + v0;
          float o[8];
#pragma unroll
          for (int i = 0; i < 8; ++i) o[i] = sigmoidf_(og[i]) * (acc[i] * rstd * ng[i]);
          v4u w; w.x = pk2(o[0], o[1]); w.y = pk2(o[2], o[3]); w.z = pk2(o[4], o[5]); w.w = pk2(o[6], o[7]);
          *(GAS v4u*)(ycat + tok * D + 640 + 64 * h + v0) = w; }
        __syncthreads();
    }
}

__device__ __forceinline__ void ln_rows(Frame& F, const GAS float* hin, const GAS float* add, const GAS float* gam, const GAS float* bet, GAS float* out32, GAS bf16* h16) {
    const int gw = F.vcu * NWAVES + F.wave, NGW = F.G * NWAVES, lane = F.lane;
    for (int m = gw; m < T; m += NGW) {
        const GAS f32x4* hr = (const GAS f32x4*)(hin + (size_t)m * D) + lane; const GAS f32x4* ar = (const GAS f32x4*)(add + (size_t)m * D) + lane;
        f32x4 v[4]; float s = 0.f;
#pragma unroll
        for (int j = 0; j < 4; ++j) { v[j] = hr[64 * j] * DN_ALPHA + ar[64 * j]; s += (v[j].x + v[j].y) + (v[j].z + v[j].w); }
        const float mean = wave_sum(s) * (1.f / D); float s2 = 0.f;
#pragma unroll
        for (int j = 0; j < 4; ++j) { v[j] = v[j] - mean; s2 += (v[j].x * v[j].x + v[j].y * v[j].y) + (v[j].z * v[j].z + v[j].w * v[j].w); }
        const float rstd = frsq(wave_sum(s2) * (1.f / D) + LN_EPS);
        GAS f32x4* o4 = (GAS f32x4*)(out32 + (size_t)m * D) + lane; GAS v2u* o2 = (GAS v2u*)(h16 + (size_t)m * D) + lane;
#pragma unroll
        for (int j = 0; j < 4; ++j) { const f32x4 gg = *((const GAS f32x4*)gam + 64 * j + lane), bb = *((const GAS f32x4*)bet + 64 * j + lane);
            const f32x4 r = v[j] * rstd * gg + bb; o4[64 * j] = r; v2u w; w.x = pk2(r.x, r.y); w.y = pk2(r.z, r.w); o2[64 * j] = w; }
    }
}
__device__ __forceinline__ void router_phase(Frame& F, int l, const GAS float* h1) {
    LAS float* xs = (LAS float*)(F.lds + RING_OFF + F.wave * 16384);
    LAS unsigned* hist = (LAS unsigned*)(F.lds + LDSCTL_OFF);
    const GAS float* rw = INP(I_RTW) + (size_t)l * D * NE; const GAS float* rb = INP(I_RTB) + l * NE;
    GAS int* tke = WSP(int, WS_TKE); GAS float* tkg = WSP(float, WS_TKG);
    const int gw = F.vcu * NWAVES + F.wave, NGW = F.G * NWAVES, lane = F.lane;
    const int e = lane & 31, half = lane >> 5;
    for (int grp = gw; grp < T / 4; grp += NGW) {
        const int row0 = grp * 4;
#pragma unroll
        for (int r = 0; r < 4; ++r) { const GAS f32x4* xr = (const GAS f32x4*)(h1 + (size_t)(row0 + r) * D) + lane;
#pragma unroll
            for (int j = 0; j < 4; ++j) *(LAS f32x4*)(xs + r * 1024 + 4 * (64 * j + lane)) = xr[64 * j]; }
        LDS_WAIT(); asm volatile("" ::: "memory");
        float acc[4] = {0.f, 0.f, 0.f, 0.f};
        const GAS float* wp = rw + (size_t)(512 * half) * NE + e;
        for (int k = 0; k < 512; k += 4) {
            const float w0 = wp[(size_t)(k + 0) * NE], w1 = wp[(size_t)(k + 1) * NE], w2 = wp[(size_t)(k + 2) * NE], w3 = wp[(size_t)(k + 3) * NE];
#pragma unroll
            for (int r = 0; r < 4; ++r) { const f32x4 x = *(const LAS f32x4*)(xs + r * 1024 + 512 * half + k); acc[r] += (x.x * w0 + x.y * w1) + (x.z * w2 + x.w * w3); }
        }
        const float bias = rb[e];
#pragma unroll
        for (int r = 0; r < 4; ++r) {
            float lg = acc[r] + __shfl_xor(acc[r], 32) + bias;
            float v = (lane < 32) ? lg : -INFINITY;
            float tv[4]; int ti[4];
#pragma unroll
            for (int i = 0; i < 4; ++i) { const float m = wave_max(v); const unsigned long long bal = __ballot(v == m); const int idx = __ffsll((long long)bal) - 1; tv[i] = m; ti[i] = idx; if (lane == idx) v = -INFINITY; }
            const float e1 = fexp(tv[1] - tv[0]), e2 = fexp(tv[2] - tv[0]), e3 = fexp(tv[3] - tv[0]); const float inv = frcp(1.0f + e1 + e2 + e3);
            if (lane < 4) { const int ee = (lane == 0) ? ti[0] : (lane == 1) ? ti[1] : (lane == 2) ? ti[2] : ti[3]; const float gg = ((lane == 0) ? 1.0f : (lane == 1) ? e1 : (lane == 2) ? e2 : e3) * inv;
                tke[(row0 + r) * 4 + lane] = ee; tkg[(row0 + r) * 4 + lane] = gg; __hip_atomic_fetch_add(&hist[ee], 1u, __ATOMIC_RELAXED, __HIP_MEMORY_SCOPE_WORKGROUP); }
        }
        LDS_WAIT(); asm volatile("" ::: "memory");
    }
    __syncthreads();
    if (F.tid < NE) { const unsigned c = hist[F.tid]; if (c) __hip_atomic_fetch_add(F.ctl + CW_CNT + l * NE + F.tid, c, RLX_AGENT); }
    __syncthreads();
    if (F.tid < NE) hist[F.tid] = 0u;
    __syncthreads();
}
__device__ __forceinline__ void assign_phase(Frame& F, int l) {
    LAS unsigned* pst = (LAS unsigned*)(F.lds + RING_OFF);
    if (F.tid == 0) {
        unsigned run = 0;
        for (int e = 0; e < NE; ++e) { const unsigned c = __hip_atomic_load(F.ctl + CW_CNT + l * NE + e, RLX_AGENT); pst[e] = run; const unsigned nbk = (c + 255u) >> 8;
            if (blockIdx.x == 0) for (unsigned k = 0; k < nbk; ++k) __hip_atomic_store(F.ctl + CW_BLKE + l * 320 + (run >> 8) + k, (unsigned)e, RLX_AGENT);
            run += nbk << 8; }
        if (blockIdx.x == 0) __hip_atomic_store(F.ctl + CW_NB + l, run >> 8, RLX_AGENT);
    }
    __syncthreads();
    const GAS int* tke = WSP(int, WS_TKE); const GAS float* tkg = WSP(float, WS_TKG); GAS int* slot_of = WSP(int, WS_SLOT); GAS float* gsl = WSP(float, WS_GSL);
    const GAS bf16* h16 = WSP(bf16, WS_H16); GAS bf16* xg = WSP(bf16, WS_XG);
    const int gw = F.vcu * NWAVES + F.wave, NGW = F.G * NWAVES, lane = F.lane;
    for (int tok = gw; tok < T; tok += NGW) {
        int slot = 0;
        if (lane < 4) { const int e = tke[tok * 4 + lane]; const unsigned pos = __hip_atomic_fetch_add(F.ctl + CW_CUR + l * NE + e, 1u, RLX_AGENT); slot = (int)(pst[e] + pos);
            slot_of[tok * 4 + lane] = slot; gsl[slot] = tkg[tok * 4 + lane]; }
        const GAS v4u* src = (const GAS v4u*)(h16 + (size_t)tok * D) + lane; const v4u a = src[0], b = src[64];
#pragma unroll
        for (int i = 0; i < 4; ++i) { const int s = __shfl(slot, i); GAS v4u* dst = (GAS v4u*)(xg + (size_t)s * D) + lane; dst[0] = a; dst[64] = b; }
    }
}
__device__ __forceinline__ void combine_phase(Frame& F, const GAS float* h1, const GAS float* gam, const GAS float* bet, GAS float* out32, GAS bf16* h16) {
    const GAS int* slot_of = WSP(int, WS_SLOT); const GAS bf16* osl = WSP(bf16, WS_OSL);
    const int gw = F.vcu * NWAVES + F.wave, NGW = F.G * NWAVES, lane = F.lane;
    for (int m = gw; m < T; m += NGW) {
        const GAS f32x4* hr = (const GAS f32x4*)(h1 + (size_t)m * D) + lane;
        f32x4 v[4];
#pragma unroll
        for (int j = 0; j < 4; ++j) v[j] = hr[64 * j] * DN_ALPHA;
        const int sl = (lane < 4) ? slot_of[m * 4 + lane] : 0;
#pragma unroll
        for (int i = 0; i < 4; ++i) { const int s = __shfl(sl, i); const GAS v2u* orow = (const GAS v2u*)(osl + (size_t)s * D) + lane;
#pragma unroll
            for (int j = 0; j < 4; ++j) { const v2u w = orow[64 * j]; v[j].x += bf2f(w.x & 0xffffu); v[j].y += bf2f(w.x >> 16); v[j].z += bf2f(w.y & 0xffffu); v[j].w += bf2f(w.y >> 16); } }
        float s = 0.f;
#pragma unroll
        for (int j = 0; j < 4; ++j) s += (v[j].x + v[j].y) + (v[j].z + v[j].w);
        const float mean = wave_sum(s) * (1.f / D); float s2 = 0.f;
#pragma unroll
        for (int j = 0; j < 4; ++j) { v[j] = v[j] - mean; s2 += (v[j].x * v[j].x + v[j].y * v[j].y) + (v[j].z * v[j].z + v[j].w * v[j].w); }
        const float rstd = frsq(wave_sum(s2) * (1.f / D) + LN_EPS);
        GAS f32x4* o4 = (GAS f32x4*)(out32 + (size_t)m * D) + lane; GAS v2u* o2 = (GAS v2u*)(h16 + (size_t)m * D) + lane;
#pragma unroll
        for (int j = 0; j < 4; ++j) { const f32x4 gg = *((const GAS f32x4*)gam + 64 * j + lane), bb = *((const GAS f32x4*)bet + 64 * j + lane);
            const f32x4 r = v[j] * rstd * gg + bb; o4[64 * j] = r; v2u w; w.x = pk2(r.x, r.y); w.y = pk2(r.z, r.w); o2[64 * j] = w; }
    }
}

constexpr int TP = 68;
typedef short bf16x8_t __attribute__((ext_vector_type(8)));
typedef float f32x2_t __attribute__((ext_vector_type(2))); typedef __bf16 bf16x2_t __attribute__((ext_vector_type(2)));
__device__ __forceinline__ unsigned cvtpk(float lo, float hi) { f32x2_t v = {lo, hi}; bf16x2_t b = __builtin_convertvector(v, bf16x2_t); return __builtin_bit_cast(unsigned, b); }
__device__ __forceinline__ int perm_idx(int pos) { const int s = pos >> 5, q = (pos >> 3) & 3, j = pos & 7; return 32 * s + 16 * (j >> 2) + 4 * q + (j & 3); }

__device__ __forceinline__ void mm_nt(const LAS float* P, const LAS float* Q, int t, int sub, float (&out)[8]) {
#pragma unroll
    for (int j = 0; j < 8; ++j) out[j] = 0.f;
#pragma unroll 4
    for (int k = 0; k < 64; k += 4) {
        const f32x4 a = *(const LAS f32x4*)(P + t * TP + k);
#pragma unroll
        for (int j = 0; j < 8; ++j) { const f32x4 q = *(const LAS f32x4*)(Q + (sub + 8 * j) * TP + k); out[j] += (a.x * q.x + a.y * q.y) + (a.z * q.z + a.w * q.w); }
    }
}
__device__ __forceinline__ void mm_nn(const LAS float* X, const LAS float* Vt, int t, int sub, float (&out)[8]) {
#pragma unroll
    for (int j = 0; j < 8; ++j) out[j] = 0.f;
#pragma unroll 2
    for (int i = 0; i < 64; i += 4) {
        const f32x4 a = *(const LAS f32x4*)(X + t * TP + i);
#pragma unroll
        for (int e = 0; e < 4; ++e) { const float av = a[e]; const f32x4 v0 = *(const LAS f32x4*)(Vt + (i + e) * TP + 8 * sub), v1 = *(const LAS f32x4*)(Vt + (i + e) * TP + 8 * sub + 4);
            out[0] += av * v0.x; out[1] += av * v0.y; out[2] += av * v0.z; out[3] += av * v0.w; out[4] += av * v1.x; out[5] += av * v1.y; out[6] += av * v1.z; out[7] += av * v1.w; }
    }
}
__device__ __forceinline__ void rwkv_chunk_prep(Frame& F) {
    LAS float* tA = (LAS float*)(F.lds + RING_OFF);
    LAS float* tR = tA + 64 * TP; LAS float* tB = tR + 64 * TP; LAS float* tK = tB + 64 * TP; LAS float* tV = tK + 64 * TP; LAS float* tT = tV + 64 * TP; LAS float* tX = tT + 64 * TP;
    const GAS float* gR = WSP(float, WS_RR), *gLW = WSP(float, WS_RLW), *gK = WSP(float, WS_RK), *gV = WSP(float, WS_RV), *gNA = WSP(float, WS_RNA), *gBB = WSP(float, WS_RBB);
    const int t = F.tid >> 3, sub = F.tid & 7;
    for (int item = F.vcu; item < NITEM; item += F.G) {
        const int h = item % 6, bc = item / 6, c = bc % NCH, b = bc / NCH; const size_t tokb = (size_t)b * SEQ + 64 * c;
        const int ci = (b * 6 + h) * NCH + c;
        GAS unsigned char* chd = F.ws + WS_RCH + (size_t)ci * CH_STRIDE; GAS unsigned char* cod = F.ws + WS_RCO + (size_t)ci * CO_STRIDE;
        for (int idx = F.tid; idx < 4096; idx += NWAVES * 64) { const int s = idx >> 6, d = idx & 63; tX[s * TP + d] = gLW[(tokb + s) * RW + 64 * h + d]; }
        __syncthreads();
        if (F.tid < 64) { float run = 0.f; for (int s = 0; s < 64; ++s) { run += tX[s * TP + F.tid]; tX[s * TP + F.tid] = run; } ((GAS float*)(chd + 49152))[F.tid] = fexp(run); }
        __syncthreads();
        for (int idx = F.tid; idx < 4096; idx += NWAVES * 64) { const int s = idx >> 6, d = idx & 63; const size_t o = (tokb + s) * RW + 64 * h + d;
            const float cw = tX[s * TP + d]; const float lw = gLW[o]; const float ecw = fexp(cw), ecx = fexp(cw - lw), ein = fexp(-cw);
            tA[s * TP + d] = gNA[o] * ecx; tR[s * TP + d] = gR[o] * ecw; tB[s * TP + d] = gBB[o] * ein; tK[s * TP + d] = gK[o] * ein; tV[s * TP + d] = gV[o]; }
        __syncthreads();
        float m[8];
        mm_nt(tA, tK, t, sub, m);
#pragma unroll
        for (int j = 0; j < 8; ++j) { const int i = sub + 8 * j; tX[t * TP + i] = (i < t) ? m[j] : 0.f; }
        __syncthreads();
        mm_nn(tX, tV, t, sub, m);
        *(LAS f32x4*)(tT + t * TP + 8 * sub) = (f32x4){m[0], m[1], m[2], m[3]}; *(LAS f32x4*)(tT + t * TP + 8 * sub + 4) = (f32x4){m[4], m[5], m[6], m[7]};
        __syncthreads();
        mm_nt(tR, tK, t, sub, m);
#pragma unroll
        for (int j = 0; j < 8; ++j) { const int i = sub + 8 * j; tX[t * TP + i] = (i <= t) ? m[j] : 0.f; }
        __syncthreads();
        mm_nn(tX, tV, t, sub, m);
        { GAS float* y0 = (GAS float*)(cod + 16384) + t * 64 + 8 * sub; *(GAS f32x4*)y0 = (f32x4){m[0], m[1], m[2], m[3]}; *(GAS f32x4*)(y0 + 4) = (f32x4){m[4], m[5], m[6], m[7]}; }
        __syncthreads();
        mm_nt(tR, tB, t, sub, m);
#pragma unroll
        for (int j = 0; j < 8; ++j) { const int i = sub + 8 * j; tX[t * TP + i] = (i <= t) ? m[j] : 0.f; }
        __syncthreads();
        { const f32x4 a = *(const LAS f32x4*)(tX + t * TP + 8 * sub), bq = *(const LAS f32x4*)(tX + t * TP + 8 * sub + 4);
          v4u w; w.x = pk2(a.x, a.y); w.y = pk2(a.z, a.w); w.z = pk2(bq.x, bq.y); w.w = pk2(bq.z, bq.w); *(GAS v4u*)(cod + 8192 + (t * 64 + 8 * sub) * 2) = w; }
        __syncthreads();
        mm_nt(tA, tB, t, sub, m);
#pragma unroll
        for (int j = 0; j < 8; ++j) { const int i = sub + 8 * j; tX[i * TP + t] = (i < t) ? m[j] : 0.f; }
        __syncthreads();
        if (F.wave < 2) {
            LAS float* tile = (F.wave == 0) ? tA : tT; const int cidx = F.lane;
            const LAS float* tXv = tX + (F.lane & 0); asm volatile("" : "+v"(tXv));
            float acc[64];
#pragma unroll
            for (int i = 0; i < 64; ++i) acc[i] = tile[i * TP + cidx];
#pragma unroll
            for (int i = 0; i < 63; ++i) {
                const float xi = acc[i];
#pragma unroll
                for (int t4 = ((i + 1) & ~3); t4 < 64; t4 += 4) { const f32x4 mm = *(const LAS f32x4*)(tXv + i * TP + t4);
                    if (t4 + 0 > i) acc[t4 + 0] += mm.x * xi; if (t4 + 1 > i) acc[t4 + 1] += mm.y * xi; if (t4 + 2 > i) acc[t4 + 2] += mm.z * xi; if (t4 + 3 > i) acc[t4 + 3] += mm.w * xi; }
            }
#pragma unroll
            for (int i = 0; i < 64; ++i) tile[i * TP + cidx] = acc[i];
        }
        __syncthreads();
        { const int s_ = sub >> 2, q_ = sub & 3; const int i0 = 32 * s_ + 4 * q_, i1 = i0 + 16;
          { const f32x4 a = *(const LAS f32x4*)(tA + t * TP + i0), bq = *(const LAS f32x4*)(tA + t * TP + i1);
            v4u w; w.x = pk2(a.x, a.y); w.y = pk2(a.z, a.w); w.z = pk2(bq.x, bq.y); w.w = pk2(bq.z, bq.w); *(GAS v4u*)(chd + (t * 64 + 8 * sub) * 2) = w; }
          { float e[8];
#pragma unroll
            for (int j = 0; j < 8; ++j) e[j] = tB[((j < 4 ? i0 : i1) + (j & 3)) * TP + t];
            v4u w; w.x = pk2(e[0], e[1]); w.y = pk2(e[2], e[3]); w.z = pk2(e[4], e[5]); w.w = pk2(e[6], e[7]); *(GAS v4u*)(chd + 8192 + (t * 64 + 8 * sub) * 2) = w;
#pragma unroll
            for (int j = 0; j < 8; ++j) e[j] = tK[((j < 4 ? i0 : i1) + (j & 3)) * TP + t];
            w.x = pk2(e[0], e[1]); w.y = pk2(e[2], e[3]); w.z = pk2(e[4], e[5]); w.w = pk2(e[6], e[7]); *(GAS v4u*)(chd + 16384 + (t * 64 + 8 * sub) * 2) = w;
#pragma unroll
            for (int j = 0; j < 8; ++j) e[j] = tV[((j < 4 ? i0 : i1) + (j & 3)) * TP + t];
            w.x = pk2(e[0], e[1]); w.y = pk2(e[2], e[3]); w.z = pk2(e[4], e[5]); w.w = pk2(e[6], e[7]); *(GAS v4u*)(chd + 24576 + (t * 64 + 8 * sub) * 2) = w;
#pragma unroll
            for (int j = 0; j < 8; ++j) e[j] = tT[(8 * sub + j) * TP + t];
            GAS float* u0 = (GAS float*)(chd + 32768) + t * 64 + 8 * sub; *(GAS f32x4*)u0 = (f32x4){e[0], e[1], e[2], e[3]}; *(GAS f32x4*)(u0 + 4) = (f32x4){e[4], e[5], e[6], e[7]}; }
          { const f32x4 a = *(const LAS f32x4*)(tR + t * TP + 8 * sub), bq = *(const LAS f32x4*)(tR + t * TP + 8 * sub + 4);
            v4u w; w.x = pk2(a.x, a.y); w.y = pk2(a.z, a.w); w.z = pk2(bq.x, bq.y); w.w = pk2(bq.z, bq.w); *(GAS v4u*)(cod + (t * 64 + 8 * sub) * 2) = w; } }
        __syncthreads();
    }
}

constexpr int CH_STAGE = 49152;
constexpr int CH_PIECES = (int)(CH_STRIDE / 16);
#define CH_BAR() do { asm volatile("s_waitcnt lgkmcnt(0)" ::: "memory"); __builtin_amdgcn_s_barrier(); asm volatile("" ::: "memory"); } while (0)
__device__ __forceinline__ void rwkv_chain(Frame& F) {
    if (F.vcu >= 12) return;
    const int bh = F.vcu;
    const GAS unsigned char* src = F.ws + WS_RCH + (size_t)bh * NCH * CH_STRIDE;
    GAS unsigned char* s0g = F.ws + WS_RS0 + (size_t)bh * NCH * 8192; GAS unsigned char* utg = F.ws + WS_RUT + (size_t)bh * NCH * 8192;
    LAS unsigned char* st0 = F.lds + RING_OFF; LAS unsigned char* st1 = st0 + CH_STAGE;
    const int lane = F.lane, q = lane >> 4, r16 = lane & 15;
    if (F.wave >= 4) {
        const int lt = F.tid - 256;
        v4u RA[12], RB[12];
#define CH_LOAD(R, c) do { const GAS v4u* g_ = (const GAS v4u*)(src + (size_t)(c) * CH_STRIDE); _Pragma("unroll") for (int p = 0; p < 12; ++p) R[p] = g_[p * 256 + lt]; } while (0)
#define CH_WRITE(R, st) do { _Pragma("unroll") for (int p = 0; p < 12; ++p) *(LAS v4u*)((st) + (p * 256 + lt) * 16) = R[p]; } while (0)
        CH_LOAD(RA, 0); CH_LOAD(RB, 1);
        CH_WRITE(RA, st0); CH_LOAD(RA, 2);
        CH_BAR();
        for (int c = 0; c < NCH; c += 2) {
            CH_WRITE(RB, st1); if (c + 3 < NCH) CH_LOAD(RB, c + 3);
            CH_BAR();
            if (c + 2 < NCH) { CH_WRITE(RA, st0); if (c + 4 < NCH) CH_LOAD(RA, c + 4); }
            CH_BAR();
        }
#undef CH_LOAD
#undef CH_WRITE
    } else {
        const int w = F.wave; const int vrow = 16 * w + r16;
        f32x4 sacc[4]; bf16x8_t sb[2];
#pragma unroll
        for (int i = 0; i < 4; ++i) sacc[i] = (f32x4){0.f, 0.f, 0.f, 0.f};
        sb[0] = (bf16x8_t){0, 0, 0, 0, 0, 0, 0, 0}; sb[1] = sb[0];
        f32x4 gln[4];
#pragma unroll
        for (int kt = 0; kt < 4; ++kt) gln[kt] = *(const GAS f32x4*)(src + 49152 + (16 * kt + 4 * q) * 4);
        CH_BAR();
        for (int c = 0; c < NCH; ++c) {
            const LAS unsigned char* st = (c & 1) ? st1 : st0;
            f32x4 glc[4];
#pragma unroll
            for (int kt = 0; kt < 4; ++kt) glc[kt] = gln[kt];
            { const int cn = (c + 1 < NCH) ? c + 1 : c;
#pragma unroll
              for (int kt = 0; kt < 4; ++kt) gln[kt] = *(const GAS f32x4*)(src + (size_t)cn * CH_STRIDE + 49152 + (16 * kt + 4 * q) * 4); }
            { GAS v2u* o = (GAS v2u*)(s0g + (size_t)c * 8192 + (vrow * 64 + 4 * q) * 2);
              const v4u w0 = __builtin_bit_cast(v4u, sb[0]), w1 = __builtin_bit_cast(v4u, sb[1]);
              o[0] = (v2u){w0.x, w0.y}; o[4] = (v2u){w0.z, w0.w}; o[8] = (v2u){w1.x, w1.y}; o[12] = (v2u){w1.z, w1.w}; }
            f32x4 u[4];
#pragma unroll
            for (int tt = 0; tt < 4; ++tt) {
                u[tt] = *(const LAS f32x4*)(st + 32768 + (vrow * 64 + 16 * tt + 4 * q) * 4);
#pragma unroll
                for (int s = 0; s < 2; ++s) { const bf16x8_t a = *(const LAS bf16x8_t*)(st + ((16 * tt + r16) * 64 + 32 * s + 8 * q) * 2); u[tt] = __builtin_amdgcn_mfma_f32_16x16x32_bf16(a, sb[s], u[tt], 0, 0, 0); }
            }
            bf16x8_t ub[2];
            { v4u w0, w1; w0.x = cvtpk(u[0][0], u[0][1]); w0.y = cvtpk(u[0][2], u[0][3]); w0.z = cvtpk(u[1][0], u[1][1]); w0.w = cvtpk(u[1][2], u[1][3]);
              w1.x = cvtpk(u[2][0], u[2][1]); w1.y = cvtpk(u[2][2], u[2][3]); w1.z = cvtpk(u[3][0], u[3][1]); w1.w = cvtpk(u[3][2], u[3][3]);
              ub[0] = __builtin_bit_cast(bf16x8_t, w0); ub[1] = __builtin_bit_cast(bf16x8_t, w1);
              GAS v2u* o = (GAS v2u*)(utg + (size_t)c * 8192 + (vrow * 64 + 4 * q) * 2);
              o[0] = (v2u){w0.x, w0.y}; o[4] = (v2u){w0.z, w0.w}; o[8] = (v2u){w1.x, w1.y}; o[12] = (v2u){w1.z, w1.w}; }
            bf16x8_t vb[2];
#pragma unroll
            for (int s = 0; s < 2; ++s) vb[s] = *(const LAS bf16x8_t*)(st + 24576 + (vrow * 64 + 32 * s + 8 * q) * 2);
#pragma unroll
            for (int kt = 0; kt < 4; ++kt) {
#pragma unroll
                for (int s = 0; s < 2; ++s) { const bf16x8_t a = *(const LAS bf16x8_t*)(st + 16384 + ((16 * kt + r16) * 64 + 32 * s + 8 * q) * 2); sacc[kt] = __builtin_amdgcn_mfma_f32_16x16x32_bf16(a, vb[s], sacc[kt], 0, 0, 0); }
#pragma unroll
                for (int s = 0; s < 2; ++s) { const bf16x8_t a = *(const LAS bf16x8_t*)(st + 8192 + ((16 * kt + r16) * 64 + 32 * s + 8 * q) * 2); sacc[kt] = __builtin_amdgcn_mfma_f32_16x16x32_bf16(a, ub[s], sacc[kt], 0, 0, 0); }
                sacc[kt] = sacc[kt] * glc[kt];
            }
            { v4u w0, w1; w0.x = cvtpk(sacc[0][0], sacc[0][1]); w0.y = cvtpk(sacc[0][2], sacc[0][3]); w0.z = cvtpk(sacc[1][0], sacc[1][1]); w0.w = cvtpk(sacc[1][2], sacc[1][3]);
              w1.x = cvtpk(sacc[2][0], sacc[2][1]); w1.y = cvtpk(sacc[2][2], sacc[2][3]); w1.z = cvtpk(sacc[3][0], sacc[3][1]); w1.w = cvtpk(sacc[3][2], sacc[3][3]);
              sb[0] = __builtin_bit_cast(bf16x8_t, w0); sb[1] = __builtin_bit_cast(bf16x8_t, w1); }
            CH_BAR();
        }
    }
}

__device__ __forceinline__ void rwkv_chunk_out(Frame& F, int l) {
    LAS float* tRq = (LAS float*)(F.lds + RING_OFF);
    LAS float* tS = tRq + 64 * TP; LAS float* tM = tS + 64 * TP; LAS float* tU = tM + 64 * TP;
    const GAS float* gv = WSP(float, WS_RV); const GAS float* gg = WSP(float, WS_RG); const GAS float* sbp = WSP(float, WS_RSB);
    GAS bf16* ycat = WSP(bf16, WS_YCAT);
    const int t = F.tid >> 3, sub = F.tid & 7;
    for (int item = F.vcu; item < NITEM; item += F.G) {
        const int h = item % 6, bc = item / 6, c = bc % NCH, b = bc / NCH; const size_t tokb = (size_t)b * SEQ + 64 * c;
        const int ci = (b * 6 + h) * NCH + c;
        const GAS unsigned char* cod = F.ws + WS_RCO + (size_t)ci * CO_STRIDE;
        const GAS bf16* srcs[4] = {(const GAS bf16*)cod, (const GAS bf16*)(F.ws + WS_RS0 + (size_t)ci * 8192), (const GAS bf16*)(cod + 8192), (const GAS bf16*)(F.ws + WS_RUT + (size_t)ci * 8192)};
#pragma unroll
        for (int a = 0; a < 4; ++a) {
            LAS float* dstt = tRq + a * 64 * TP;
            const v4u wv = *(const GAS v4u*)(srcs[a] + t * 64 + 8 * sub);
            *(LAS f32x4*)(dstt + t * TP + 8 * sub) = (f32x4){bf2f(wv.x & 0xffffu), bf2f(wv.x >> 16), bf2f(wv.y & 0xffffu), bf2f(wv.y >> 16)};
            *(LAS f32x4*)(dstt + t * TP + 8 * sub + 4) = (f32x4){bf2f(wv.z & 0xffffu), bf2f(wv.z >> 16), bf2f(wv.w & 0xffffu), bf2f(wv.w >> 16)};
        }
        __syncthreads();
        float y1[8], y2[8];
        mm_nt(tRq, tS, t, sub, y1);
        mm_nt(tM, tU, t, sub, y2);
        const GAS float* y0 = (const GAS float*)(cod + 16384) + t * 64;
        float sum = 0.f;
#pragma unroll
        for (int j = 0; j < 8; ++j) { y1[j] += y2[j] + y0[sub + 8 * j]; sum += y1[j]; }
        sum += __shfl_xor(sum, 1); sum += __shfl_xor(sum, 2); sum += __shfl_xor(sum, 4);
        const float mean = sum * (1.f / 64.f); float vs = 0.f;
#pragma unroll
        for (int j = 0; j < 8; ++j) { y1[j] -= mean; vs += y1[j] * y1[j]; }
        vs += __shfl_xor(vs, 1); vs += __shfl_xor(vs, 2); vs += __shfl_xor(vs, 4);
        const float rstd = frsq(vs * (1.f / 64.f) + GN_EPS);
        const size_t tok = tokb + t; const float sbv = sbp[tok * 8 + h];
        const GAS float* lg = INP(I_LNXG) + l * RW + 64 * h; const GAS float* lb = INP(I_LNXB) + l * RW + 64 * h;
#pragma unroll
        for (int j = 0; j < 8; ++j) { const int v = sub + 8 * j; const size_t o = tok * RW + 64 * h + v;
            float r = y1[j] * rstd * lg[v] + lb[v]; r += sbv * gv[o]; r *= gg[o];
            ycat[tok * D + 256 + 64 * h + v] = (bf16)f2bf(r); }
        __syncthreads();
    }
}

constexpr int BP = 72;
typedef LAS unsigned short lbf;
__device__ __forceinline__ f32x4 mma_nt64(const lbf* P, int p0, const lbf* Q, int q0, int r16, int q, f32x4 acc) {
#pragma unroll
    for (int s = 0; s < 2; ++s) { const bf16x8_t a = *(const LAS bf16x8_t*)(P + (p0 + r16) * BP + 32 * s + 8 * q); const bf16x8_t b = *(const LAS bf16x8_t*)(Q + (q0 + r16) * BP + 32 * s + 8 * q);
        acc = __builtin_amdgcn_mfma_f32_16x16x32_bf16(a, b, acc, 0, 0, 0); }
    return acc;
}
constexpr size_t LORA_L = 221184;

__device__ __forceinline__ void rwkv_item_prep(Frame& F, int l, int stop) {
    LAS unsigned char* L = F.lds + RING_OFF;
    LAS float* fR = (LAS float*)(L + 0); LAS float* fK = (LAS float*)(L + 17408); LAS float* fV = (LAS float*)(L + 34816); LAS float* fL = (LAS float*)(L + 52224);
    LAS float* fA = (LAS float*)(L + 69632); LAS float* fT = (LAS float*)(L + 87040); LAS float* fX = (LAS float*)(L + 104448);
    lbf* Xw = (lbf*)(L + 69632); lbf* Xa = (lbf*)(L + 78848); lbf* Xg = (lbf*)(L + 88064); lbf* Xv = (lbf*)(L + 105472); LAS float* tbb = (LAS float*)(L + 64512); LAS float* tot = (LAS float*)(L + 110592); LAS float* red = (LAS float*)(L + 111616);
    lbf* bA = (lbf*)(L + 0); lbf* bR = (lbf*)(L + 9216); lbf* bB = (lbf*)(L + 18432); lbf* bK = (lbf*)(L + 27648); lbf* bVT = (lbf*)(L + 36864); lbf* bMak = (lbf*)(L + 46080); lbf* bMrk = (lbf*)(L + 55296); lbf* bMrb = (lbf*)(L + 121856);
    const GAS float* p = WSP(float, WS_P); const GAS float* mu = INP(I_MU) + l * RWC;
    GAS float* vfirst = WSP(float, WS_VFIRST); GAS float* oV = WSP(float, WS_RV); GAS float* oG = WSP(float, WS_RG); GAS float* oSB = WSP(float, WS_RSB);
    const GAS unsigned char* lw_ = F.ws + WS_LORA + (size_t)l * LORA_L;
    const int lane = F.lane, r16 = lane & 15, q = lane >> 4, w = F.wave;
    for (int item = F.vcu; item < NITEM; item += F.G) {
        const int h = item % 6, bc = item / 6, c = bc % NCH, b = bc / NCH; const size_t tokb = (size_t)b * SEQ + 64 * c;
        const int ci = (b * 6 + h) * NCH + c;
        GAS unsigned char* chd = F.ws + WS_RCH + (size_t)ci * CH_STRIDE; GAS unsigned char* cod = F.ws + WS_RCO + (size_t)ci * CO_STRIDE;
        const bool first = (c == 0);
#define SHIFT4(colj, s_) \
            const GAS float* pc = p + (tokb + (s_)) * PC + P_RW + (colj); const f32x4 cur = *(const GAS f32x4*)pc; const bool fz = first && (s_) == 0; \
            const f32x4 pv = *(const GAS f32x4*)(pc + (fz ? 0 : -PC)); const f32x4 prev = fz ? (f32x4){0.f, 0.f, 0.f, 0.f} : pv; const f32x4 m4 = *(const GAS f32x4*)(mu + (colj)); \
            const f32x4 x = cur + m4 * (prev - cur);
#pragma unroll 1
        for (int idx = F.tid; idx < 3 * 1024; idx += NWAVES * 64) { const int which = idx >> 10, s = (idx >> 4) & 63, d4 = (idx & 15) * 4; const int j = which * 384 + 64 * h + d4;
            SHIFT4(j, s)
            *(LAS f32x4*)((LAS float*)(L + which * 17408) + s * TP + d4) = x; }
#pragma unroll 1
        for (int idx = F.tid; idx < 2 * 1024; idx += NWAVES * 64) { const int which = idx >> 10, s = (idx >> 4) & 63, d4 = (idx & 15) * 4; const int j = 1152 + which * 64 + d4;
            SHIFT4(j, s)
            f32x4 y = x; if (which == 0) { y.x = tanhf_(x.x); y.y = tanhf_(x.y); y.z = tanhf_(x.z); y.w = tanhf_(x.w); }
            *(LAS v2u*)((which == 0 ? Xw : Xa) + s * BP + d4) = (v2u){pk2(y.x, y.y), pk2(y.z, y.w)}; }
#pragma unroll 1
        for (int idx = F.tid; idx < 2048; idx += NWAVES * 64) { const int s = idx >> 5, d4 = (idx & 31) * 4; const int j = 1280 + d4;
            SHIFT4(j, s)
            *(LAS v2u*)(Xg + s * 136 + d4) = (v2u){pk2(sigmoidf_(x.x), sigmoidf_(x.y)), pk2(sigmoidf_(x.z), sigmoidf_(x.w))}; }
#undef SHIFT4
        if (l == 1) { const int idx = F.tid; const int s = idx >> 3, d4 = (idx & 7) * 4; const f32x4 x = *(const GAS f32x4*)(p + (tokb + s) * PC + P_V1 + d4);
            *(LAS v2u*)(Xv + s * 40 + d4) = (v2u){pk2(x.x, x.y), pk2(x.z, x.w)}; }
        __syncthreads();
        if (stop <= 1) continue;
        float er[8], ena[8], ebb[8], ekp[8], ev[8], elw[8];
        const int mtw = w >> 1, hw = w & 1;
        {
            f32x4 dw[2], da[2], dg[2], dv[2];
#pragma unroll
            for (int n2 = 0; n2 < 2; ++n2) {
                const int chg = 64 * h + 16 * (2 * hw + n2) + r16;
                dw[n2] = (f32x4){0.f, 0.f, 0.f, 0.f}; da[n2] = dw[n2]; dg[n2] = dw[n2]; dv[n2] = dw[n2];
#pragma unroll
                for (int s = 0; s < 2; ++s) { const bf16x8_t a = *(const LAS bf16x8_t*)(Xw + (16 * mtw + r16) * BP + 32 * s + 8 * q); const bf16x8_t bb_ = *(const GAS bf16x8_t*)(lw_ + ((size_t)chg * 64 + 32 * s + 8 * q) * 2);
                    dw[n2] = __builtin_amdgcn_mfma_f32_16x16x32_bf16(a, bb_, dw[n2], 0, 0, 0); }
#pragma unroll
                for (int s = 0; s < 2; ++s) { const bf16x8_t a = *(const LAS bf16x8_t*)(Xa + (16 * mtw + r16) * BP + 32 * s + 8 * q); const bf16x8_t bb_ = *(const GAS bf16x8_t*)(lw_ + 49152 + ((size_t)chg * 64 + 32 * s + 8 * q) * 2);
                    da[n2] = __builtin_amdgcn_mfma_f32_16x16x32_bf16(a, bb_, da[n2], 0, 0, 0); }
#pragma unroll
                for (int s = 0; s < 4; ++s) { const bf16x8_t a = *(const LAS bf16x8_t*)(Xg + (16 * mtw + r16) * 136 + 32 * s + 8 * q); const bf16x8_t bb_ = *(const GAS bf16x8_t*)(lw_ + 98304 + ((size_t)chg * 128 + 32 * s + 8 * q) * 2);
                    dg[n2] = __builtin_amdgcn_mfma_f32_16x16x32_bf16(a, bb_, dg[n2], 0, 0, 0); }
                if (l == 1) { const bf16x8_t a = *(const LAS bf16x8_t*)(Xv + (16 * mtw + r16) * 40 + 8 * q); const bf16x8_t bb_ = *(const GAS bf16x8_t*)(lw_ + 196608 + ((size_t)chg * 32 + 8 * q) * 2);
                    dv[n2] = __builtin_amdgcn_mfma_f32_16x16x32_bf16(a, bb_, dv[n2], 0, 0, 0); }
            }
            float kk2[4] = {0.f, 0.f, 0.f, 0.f}, sbs[4] = {0.f, 0.f, 0.f, 0.f};
#pragma unroll
            for (int n2 = 0; n2 < 2; ++n2) {
                const int chl = 16 * (2 * hw + n2) + r16, chg = l * RW + 64 * h + chl;
                const float w0 = INP(I_W0)[chg], a0 = INP(I_A0)[chg], kks = INP(I_KKS)[chg], ka = INP(I_KA)[chg], rk = INP(I_RK)[chg];
                const float v0 = (l == 1) ? INP(I_V0)[64 * h + chl] : 0.f;
#pragma unroll
                for (int rg = 0; rg < 4; ++rg) {
                    const int e = 4 * n2 + rg; const int tk = 16 * mtw + 4 * q + rg; const size_t o = (tokb + tk) * RW + 64 * h + chl;
                    const float r = fR[tk * TP + chl], k = fK[tk * TP + chl]; float v = fV[tk * TP + chl];
                    const float wlog = -softplusf_(-(w0 + dw[n2][rg])) - 0.5f; elw[e] = -fexp(wlog);
                    const float ai = sigmoidf_(a0 + da[n2][rg]);
                    if (l == 0) vfirst[o] = v; else { const float vg = sigmoidf_(v0 + dv[n2][rg]); v = v + (vfirst[o] - v) * vg; }
                    const float kkv = k * kks; kk2[rg] += kkv * kkv; ena[e] = kkv;
                    const float kp = k * (1.0f + (ai - 1.0f) * ka); sbs[rg] += r * kp * rk;
                    er[e] = r; ekp[e] = kp; ev[e] = v; ebb[e] = ai;
                    oV[o] = v; oG[o] = dg[n2][rg];
                    fL[tk * TP + chl] = elw[e];
                }
            }
#pragma unroll
            for (int rg = 0; rg < 4; ++rg) {
#pragma unroll
                for (int o_ = 1; o_ < 16; o_ <<= 1) { kk2[rg] += __shfl_xor(kk2[rg], o_); sbs[rg] += __shfl_xor(sbs[rg], o_); }
                if (r16 == 0) { red[(hw * 64 + 16 * mtw + 4 * q + rg) * 2 + 0] = kk2[rg]; red[(hw * 64 + 16 * mtw + 4 * q + rg) * 2 + 1] = sbs[rg]; }
            }
        }
        __syncthreads();
#pragma unroll
        for (int rg = 0; rg < 4; ++rg) { const int tk = 16 * mtw + 4 * q + rg;
            const float k2 = red[tk * 2] + red[(64 + tk) * 2]; const float inv = frsq(fmaxf(k2, 1e-24f));
#pragma unroll
            for (int n2 = 0; n2 < 2; ++n2) { const int e = 4 * n2 + rg; const float kk = ena[e] * inv; ena[e] = -kk; ebb[e] = kk * ebb[e]; }
            if (hw == 0 && r16 == 0) oSB[(tokb + tk) * 8 + h] = red[tk * 2 + 1] + red[(64 + tk) * 2 + 1]; }
        if (stop <= 2) continue;
        if (F.tid < 256) { const int ch = F.tid & 63, sg = F.tid >> 6; float run = 0.f;
#pragma unroll
            for (int s = 0; s < 16; ++s) { run += fL[(16 * sg + s) * TP + ch]; fL[(16 * sg + s) * TP + ch] = run; }
            tot[sg * 64 + ch] = run; }
        __syncthreads();
        if (F.tid < 256) { const int ch = F.tid & 63, sg = F.tid >> 6; float off = 0.f;
            for (int s2 = 0; s2 < sg; ++s2) off += tot[s2 * 64 + ch];
            if (sg > 0) {
#pragma unroll
                for (int s = 0; s < 16; ++s) fL[(16 * sg + s) * TP + ch] += off; } }
        __syncthreads();
        if (stop <= 3) continue;
        {
#pragma unroll
            for (int n2 = 0; n2 < 2; ++n2) { const int chl = 16 * (2 * hw + n2) + r16;
                float vv[4];
#pragma unroll
                for (int rg = 0; rg < 4; ++rg) { const int e = 4 * n2 + rg; const int tk = 16 * mtw + 4 * q + rg;
                    const float cw = fL[tk * TP + chl]; const float ecw = fexp(cw), ecx = fexp(cw - elw[e]), ein = fexp(-cw);
                    const float at = ena[e] * ecx;
                    fA[tk * TP + chl] = at; bA[tk * BP + chl] = (unsigned short)f2bf(at); bR[tk * BP + chl] = (unsigned short)f2bf(er[e] * ecw);
                    bB[tk * BP + chl] = (unsigned short)f2bf(ebb[e] * ein); bK[tk * BP + chl] = (unsigned short)f2bf(ekp[e] * ein); vv[rg] = ev[e];
                    if (tk == 63) ((GAS float*)(chd + 49152))[chl] = ecw; }
                *(LAS v2u*)(bVT + chl * BP + 16 * mtw + 4 * q) = (v2u){pk2(vv[0], vv[1]), pk2(vv[2], vv[3])};
            }
        }
        __syncthreads();
        if (stop <= 4) continue;
        { const int kind = w >> 1;
#pragma unroll 1
          for (int tix = 0; tix < 8; ++tix) { const int tile = (w & 1) * 8 + tix; const int mt = tile >> 2, nt = tile & 3;
            f32x4 acc = (f32x4){0.f, 0.f, 0.f, 0.f};
            if (kind == 3) {
                acc = mma_nt64(bA, 16 * mt, bB, 16 * nt, r16, q, acc);
                const int i = 16 * nt + r16;
#pragma unroll
                for (int rg = 0; rg < 4; ++rg) { const int t = 16 * mt + 4 * q + rg; fX[t * TP + i] = (i < t) ? acc[rg] : 0.f; }
            } else {
                const lbf* Pm = (kind == 2) ? bB : bK; const lbf* Qm = (kind == 0) ? bA : bR; lbf* dst = (kind == 0) ? bMak : (kind == 1) ? bMrk : bMrb;
                acc = mma_nt64(Pm, 16 * nt, Qm, 16 * mt, r16, q, acc);
                const int t = 16 * mt + r16; float o[4];
#pragma unroll
                for (int rg = 0; rg < 4; ++rg) { const int i = 16 * nt + 4 * q + rg; o[rg] = ((kind == 0) ? (i < t) : (i <= t)) ? acc[rg] : 0.f; }
                *(LAS v2u*)(dst + t * BP + 16 * nt + 4 * q) = (v2u){pk2(o[0], o[1]), pk2(o[2], o[3])};
            } } }
        __syncthreads();
        if (stop <= 5) continue;
        { const int mt = w & 3;
#pragma unroll 1
          for (int nt = 0; nt < 4; ++nt) {
            f32x4 acc = (f32x4){0.f, 0.f, 0.f, 0.f};
            if (w < 4) { acc = mma_nt64(bMak, 16 * mt, bVT, 16 * nt, r16, q, acc);
#pragma unroll
                for (int rg = 0; rg < 4; ++rg) fT[(16 * mt + 4 * q + rg) * TP + 16 * nt + r16] = acc[rg]; }
            else { acc = mma_nt64(bVT, 16 * nt, bMrk, 16 * mt, r16, q, acc);
                *(GAS f32x4*)((GAS float*)(cod + 16384) + (16 * mt + r16) * 64 + 16 * nt + 4 * q) = acc; } } }
        __syncthreads();
        if (stop <= 6) continue;
        if (w == 0) {
            const int blk = lane >> 4, col = lane & 15; const LAS float* Nb = fX + (16 * blk) * TP + 16 * blk;
            float tv[16];
#pragma unroll
            for (int r = 0; r < 16; ++r) tv[r] = (r == col) ? 1.f : 0.f;
#pragma unroll
            for (int i = 0; i < 15; ++i) {
#pragma unroll
                for (int r = i + 1; r < 16; ++r) tv[r] += Nb[r * TP + i] * tv[i]; }
#pragma unroll
            for (int r = 0; r < 16; ++r) tbb[(blk * 16 + r) * 16 + col] = tv[r];
        } else {
            for (int pz = F.tid - 64; pz < 512; pz += 448) { const int row = pz >> 3, sub = pz & 7; const int s_ = sub >> 2, q_ = sub & 3; const int i0 = 32 * s_ + 4 * q_, i1 = i0 + 16;
                *(GAS v4u*)(cod + pz * 16) = *(const LAS v4u*)(bR + row * BP + 8 * sub);
                *(GAS v4u*)(cod + 8192 + pz * 16) = *(const LAS v4u*)(bMrb + row * BP + 8 * sub);
                { const v2u a = *(const LAS v2u*)(bVT + row * BP + i0), b2 = *(const LAS v2u*)(bVT + row * BP + i1); *(GAS v4u*)(chd + 24576 + pz * 16) = (v4u){a.x, a.y, b2.x, b2.y}; }
                unsigned e[8];
#pragma unroll
                for (int j = 0; j < 8; ++j) e[j] = bB[((j < 4 ? i0 : i1) + (j & 3)) * BP + row];
                *(GAS v4u*)(chd + 8192 + pz * 16) = (v4u){e[0] | (e[1] << 16), e[2] | (e[3] << 16), e[4] | (e[5] << 16), e[6] | (e[7] << 16)};
#pragma unroll
                for (int j = 0; j < 8; ++j) e[j] = bK[((j < 4 ? i0 : i1) + (j & 3)) * BP + row];
                *(GAS v4u*)(chd + 16384 + pz * 16) = (v4u){e[0] | (e[1] << 16), e[2] | (e[3] << 16), e[4] | (e[5] << 16), e[6] | (e[7] << 16)}; }
        }
        __syncthreads();
        { LAS float* tile = (w < 4) ? fA : fT; const int c0 = 16 * (w & 3) + r16;
          f32x4 X[4];
#pragma unroll
          for (int bb = 0; bb < 4; ++bb) {
              f32x4 acc;
#pragma unroll
              for (int rg = 0; rg < 4; ++rg) acc[rg] = tile[(16 * bb + 4 * q + rg) * TP + c0];
#pragma unroll
              for (int b2 = 0; b2 < 4; ++b2) if (b2 < bb) { const f32x4 af = *(const LAS f32x4*)(fX + (16 * bb + r16) * TP + 16 * b2 + 4 * q);
#pragma unroll
                  for (int s = 0; s < 4; ++s) acc = __builtin_amdgcn_mfma_f32_16x16x4f32(af[s], X[b2][s], acc, 0, 0, 0); }
              const f32x4 tf = *(const LAS f32x4*)(tbb + (bb * 16 + r16) * 16 + 4 * q);
              f32x4 xb = (f32x4){0.f, 0.f, 0.f, 0.f};
#pragma unroll
              for (int s = 0; s < 4; ++s) xb = __builtin_amdgcn_mfma_f32_16x16x4f32(tf[s], acc[s], xb, 0, 0, 0);
              X[bb] = xb;
#pragma unroll
              for (int rg = 0; rg < 4; ++rg) tile[(16 * bb + 4 * q + rg) * TP + c0] = xb[rg];
          } }
        __syncthreads();
        if (stop <= 7) continue;
        { const int row = F.tid >> 3, sub = F.tid & 7; const int s_ = sub >> 2, q_ = sub & 3; const int i0 = 32 * s_ + 4 * q_, i1 = i0 + 16;
          const f32x4 a = *(const LAS f32x4*)(fA + row * TP + i0), bq = *(const LAS f32x4*)(fA + row * TP + i1);
          *(GAS v4u*)(chd + F.tid * 16) = (v4u){pk2(a.x, a.y), pk2(a.z, a.w), pk2(bq.x, bq.y), pk2(bq.z, bq.w)};
#pragma unroll
          for (int hh = 0; hh < 2; ++hh) { const int pz = F.tid + 512 * hh; const int v = pz >> 4, t4 = (pz & 15) * 4;
              *(GAS f32x4*)(chd + 32768 + pz * 16) = (f32x4){fT[(t4 + 0) * TP + v], fT[(t4 + 1) * TP + v], fT[(t4 + 2) * TP + v], fT[(t4 + 3) * TP + v]}; } }
        __syncthreads();
    }
}
__device__ __forceinline__ void lora_convert(Frame& F) {
    const int gt = F.vcu * (NWAVES * 64) + F.tid, NT_ = F.G * NWAVES * 64;
    for (int l = 0; l < DEPTH; ++l) {
        bf16* base = (bf16*)(F.ws + WS_LORA + (size_t)l * LORA_L);
        const GAS float* w2 = INP(I_W2) + (size_t)l * 64 * RW; const GAS float* a2 = INP(I_A2) + (size_t)l * 64 * RW; const GAS float* g2 = INP(I_G2) + (size_t)l * 128 * RW; const GAS float* v2 = INP(I_V2);
        for (int i = gt; i < RW * 64; i += NT_) { const int ch = i >> 6, j = i & 63; base[i] = (bf16)f2bf(w2[(size_t)j * RW + ch]); base[24576 + i] = (bf16)f2bf(a2[(size_t)j * RW + ch]); }
        for (int i = gt; i < RW * 128; i += NT_) { const int ch = i >> 7, j = i & 127; base[49152 + i] = (bf16)f2bf(g2[(size_t)j * RW + ch]); }
        if (l == 1) for (int i = gt; i < RW * 32; i += NT_) { const int ch = i >> 5, j = i & 31; base[98304 + i] = (bf16)f2bf(v2[(size_t)j * RW + ch]); }
    }
}

__device__ __forceinline__ void rwkv_chunk_out_mfma(Frame& F, int l) {
    const GAS float* gv = WSP(float, WS_RV); const GAS float* gg = WSP(float, WS_RG); const GAS float* sbp = WSP(float, WS_RSB);
    GAS bf16* ycat = WSP(bf16, WS_YCAT);
    const int gw = F.vcu * NWAVES + F.wave, NGW = F.G * NWAVES, lane = F.lane, r16 = lane & 15, q = lane >> 4;
    for (int wi = gw; wi < NITEM * 4; wi += NGW) {
        const int item = wi >> 2, mt = wi & 3;
        const int h = item % 6, bc = item / 6, c = bc % NCH, b = bc / NCH; const size_t tokb = (size_t)b * SEQ + 64 * c;
        const int ci = (b * 6 + h) * NCH + c;
        const GAS unsigned char* cod = F.ws + WS_RCO + (size_t)ci * CO_STRIDE;
        const GAS unsigned char* s0 = F.ws + WS_RS0 + (size_t)ci * 8192; const GAS unsigned char* ut = F.ws + WS_RUT + (size_t)ci * 8192;
        const int t = 16 * mt + r16; const size_t tok = tokb + t;
        bf16x8_t rq[2], mb[2];
#pragma unroll
        for (int s = 0; s < 2; ++s) { rq[s] = *(const GAS bf16x8_t*)(cod + (t * 64 + 32 * s + 8 * q) * 2); mb[s] = *(const GAS bf16x8_t*)(cod + 8192 + (t * 64 + 32 * s + 8 * q) * 2); }
        f32x4 y[4];
#pragma unroll
        for (int nt = 0; nt < 4; ++nt) {
            y[nt] = *(const GAS f32x4*)(cod + 16384 + (t * 64 + 16 * nt + 4 * q) * 4);
#pragma unroll
            for (int s = 0; s < 2; ++s) { const bf16x8_t a = *(const GAS bf16x8_t*)(s0 + ((16 * nt + r16) * 64 + 32 * s + 8 * q) * 2); y[nt] = __builtin_amdgcn_mfma_f32_16x16x32_bf16(a, rq[s], y[nt], 0, 0, 0); }
#pragma unroll
            for (int s = 0; s < 2; ++s) { const bf16x8_t a = *(const GAS bf16x8_t*)(ut + ((16 * nt + r16) * 64 + 32 * s + 8 * q) * 2); y[nt] = __builtin_amdgcn_mfma_f32_16x16x32_bf16(a, mb[s], y[nt], 0, 0, 0); }
        }
        float sum = 0.f;
#pragma unroll
        for (int nt = 0; nt < 4; ++nt) sum += (y[nt][0] + y[nt][1]) + (y[nt][2] + y[nt][3]);
        sum += __shfl_xor(sum, 16); sum += __shfl_xor(sum, 32);
        const float mean = sum * (1.f / 64.f); float vs = 0.f;
#pragma unroll
        for (int nt = 0; nt < 4; ++nt) { y[nt] = y[nt] - mean; vs += (y[nt][0] * y[nt][0] + y[nt][1] * y[nt][1]) + (y[nt][2] * y[nt][2] + y[nt][3] * y[nt][3]); }
        vs += __shfl_xor(vs, 16); vs += __shfl_xor(vs, 32);
        const float rstd = frsq(vs * (1.f / 64.f) + GN_EPS);
        const float sbv = sbp[tok * 8 + h];
#pragma unroll
        for (int nt = 0; nt < 4; ++nt) { const int v0 = 16 * nt + 4 * q;
            const f32x4 lg = *(const GAS f32x4*)(INP(I_LNXG) + l * RW + 64 * h + v0), lb = *(const GAS f32x4*)(INP(I_LNXB) + l * RW + 64 * h + v0);
            const f32x4 vv = *(const GAS f32x4*)(gv + tok * RW + 64 * h + v0), g4 = *(const GAS f32x4*)(gg + tok * RW + 64 * h + v0);
            const f32x4 r = (y[nt] * rstd * lg + lb + vv * sbv) * g4;
            *(GAS v2u*)(ycat + tok * D + 256 + 64 * h + v0) = (v2u){pk2(r[0], r[1]), pk2(r[2], r[3])}; }
    }
}

constexpr int C2_STAGE = 30720;
__device__ __forceinline__ void rwkv_chain2(Frame& F) {
    const int id = blockIdx.x;
    if (id >= 48) return;
    const int bh = id % 12, vb = id / 12;
    const GAS unsigned char* src = F.ws + WS_RCH + (size_t)bh * NCH * CH_STRIDE;
    GAS unsigned char* s0g = F.ws + WS_RS0 + (size_t)bh * NCH * 8192; GAS unsigned char* utg = F.ws + WS_RUT + (size_t)bh * NCH * 8192;
    LAS unsigned char* ring = F.lds + RING_OFF;
    const int lane = F.lane, q = lane >> 4, r16 = lane & 15;
#define C2_BAR() do { asm volatile("s_waitcnt lgkmcnt(0)" ::: "memory"); __builtin_amdgcn_s_barrier(); asm volatile("" ::: "memory"); } while (0)
    if (F.wave >= 4) {
        const int lt = F.tid - 256;
        const int o6 = (lt < 128) ? (24576 + vb * 2048 + lt * 16) : (32768 + vb * 4096 + (lt - 128) * 16);
        const int d6 = (lt < 128) ? (24576 + lt * 16) : (26624 + (lt - 128) * 16);
        const int l7 = lt & 127; const int o7 = 32768 + vb * 4096 + 2048 + l7 * 16; const int d7 = 26624 + 2048 + l7 * 16;
        v4u RA[8], RB[8];
#define C2_LOAD(R, c) do { const GAS unsigned char* g_ = src + (size_t)(c) * CH_STRIDE; _Pragma("unroll") for (int p = 0; p < 6; ++p) R[p] = *(const GAS v4u*)(g_ + (p * 256 + lt) * 16); \
            R[6] = *(const GAS v4u*)(g_ + o6); R[7] = *(const GAS v4u*)(g_ + o7); } while (0)
#define C2_WRITE(R, c) do { LAS unsigned char* st_ = ring + ((c) & 3) * C2_STAGE; _Pragma("unroll") for (int p = 0; p < 6; ++p) *(LAS v4u*)(st_ + (p * 256 + lt) * 16) = R[p]; \
            *(LAS v4u*)(st_ + d6) = R[6]; *(LAS v4u*)(st_ + d7) = R[7]; } while (0)
        C2_LOAD(RA, 0); C2_LOAD(RB, 1); C2_WRITE(RA, 0); C2_LOAD(RA, 2); C2_WRITE(RB, 1); C2_LOAD(RB, 3); C2_WRITE(RA, 2); C2_LOAD(RA, 4);
        C2_BAR();
        for (int c = 0; c < NCH; c += 2) {
            if (c + 3 < NCH) { C2_WRITE(RB, c + 3); if (c + 5 < NCH) C2_LOAD(RB, c + 5); }
            C2_BAR();
            if (c + 4 < NCH) { C2_WRITE(RA, c + 4); if (c + 6 < NCH) C2_LOAD(RA, c + 6); }
            C2_BAR();
        }
#undef C2_LOAD
#undef C2_WRITE
    } else if (F.wave == 0) {
        const int vrow = 16 * vb + r16;
        f32x4 sacc[4]; bf16x8_t sb[2];
#pragma unroll
        for (int i = 0; i < 4; ++i) sacc[i] = (f32x4){0.f, 0.f, 0.f, 0.f};
        sb[0] = (bf16x8_t){0, 0, 0, 0, 0, 0, 0, 0}; sb[1] = sb[0];
        f32x4 gln[4];
#pragma unroll
        for (int kt = 0; kt < 4; ++kt) gln[kt] = *(const GAS f32x4*)(src + 49152 + (16 * kt + 4 * q) * 4);
        C2_BAR();
        for (int c = 0; c < NCH; ++c) {
            const LAS unsigned char* st = ring + (c & 3) * C2_STAGE;
            f32x4 glc[4];
#pragma unroll
            for (int kt = 0; kt < 4; ++kt) glc[kt] = gln[kt];
            { const int cn = (c + 1 < NCH) ? c + 1 : c;
#pragma unroll
              for (int kt = 0; kt < 4; ++kt) gln[kt] = *(const GAS f32x4*)(src + (size_t)cn * CH_STRIDE + 49152 + (16 * kt + 4 * q) * 4); }
            { GAS v2u* o = (GAS v2u*)(s0g + (size_t)c * 8192 + (vrow * 64 + 4 * q) * 2);
              const v4u w0 = __builtin_bit_cast(v4u, sb[0]), w1 = __builtin_bit_cast(v4u, sb[1]);
              o[0] = (v2u){w0.x, w0.y}; o[4] = (v2u){w0.z, w0.w}; o[8] = (v2u){w1.x, w1.y}; o[12] = (v2u){w1.z, w1.w}; }
            f32x4 u[4];
#pragma unroll
            for (int tt = 0; tt < 4; ++tt) {
                u[tt] = *(const LAS f32x4*)(st + 26624 + (r16 * 64 + 16 * tt + 4 * q) * 4);
#pragma unroll
                for (int s = 0; s < 2; ++s) { const bf16x8_t a = *(const LAS bf16x8_t*)(st + ((16 * tt + r16) * 64 + 32 * s + 8 * q) * 2); u[tt] = __builtin_amdgcn_mfma_f32_16x16x32_bf16(a, sb[s], u[tt], 0, 0, 0); }
            }
            bf16x8_t ub[2];
            { v4u w0, w1; w0.x = cvtpk(u[0][0], u[0][1]); w0.y = cvtpk(u[0][2], u[0][3]); w0.z = cvtpk(u[1][0], u[1][1]); w0.w = cvtpk(u[1][2], u[1][3]);
              w1.x = cvtpk(u[2][0], u[2][1]); w1.y = cvtpk(u[2][2], u[2][3]); w1.z = cvtpk(u[3][0], u[3][1]); w1.w = cvtpk(u[3][2], u[3][3]);
              ub[0] = __builtin_bit_cast(bf16x8_t, w0); ub[1] = __builtin_bit_cast(bf16x8_t, w1);
              GAS v2u* o = (GAS v2u*)(utg + (size_t)c * 8192 + (vrow * 64 + 4 * q) * 2);
              o[0] = (v2u){w0.x, w0.y}; o[4] = (v2u){w0.z, w0.w}; o[8] = (v2u){w1.x, w1.y}; o[12] = (v2u){w1.z, w1.w}; }
            bf16x8_t vbf[2];
#pragma unroll
            for (int s = 0; s < 2; ++s) vbf[s] = *(const LAS bf16x8_t*)(st + 24576 + (r16 * 64 + 32 * s + 8 * q) * 2);
#pragma unroll
            for (int kt = 0; kt < 4; ++kt) {
#pragma unroll
                for (int s = 0; s < 2; ++s) { const bf16x8_t a = *(const LAS bf16x8_t*)(st + 16384 + ((16 * kt + r16) * 64 + 32 * s + 8 * q) * 2); sacc[kt] = __builtin_amdgcn_mfma_f32_16x16x32_bf16(a, vbf[s], sacc[kt], 0, 0, 0); }
#pragma unroll
                for (int s = 0; s < 2; ++s) { const bf16x8_t a = *(const LAS bf16x8_t*)(st + 8192 + ((16 * kt + r16) * 64 + 32 * s + 8 * q) * 2); sacc[kt] = __builtin_amdgcn_mfma_f32_16x16x32_bf16(a, ub[s], sacc[kt], 0, 0, 0); }
                sacc[kt] = sacc[kt] * glc[kt];
            }
            { v4u w0, w1; w0.x = cvtpk(sacc[0][0], sacc[0][1]); w0.y = cvtpk(sacc[0][2], sacc[0][3]); w0.z = cvtpk(sacc[1][0], sacc[1][1]); w0.w = cvtpk(sacc[1][2], sacc[1][3]);
              w1.x = cvtpk(sacc[2][0], sacc[2][1]); w1.y = cvtpk(sacc[2][2], sacc[2][3]); w1.z = cvtpk(sacc[3][0], sacc[3][1]); w1.w = cvtpk(sacc[3][2], sacc[3][3]);
              sb[0] = __builtin_bit_cast(bf16x8_t, w0); sb[1] = __builtin_bit_cast(bf16x8_t, w1); }
            C2_BAR();
        }
    } else {
        C2_BAR();
        for (int c = 0; c < NCH; ++c) C2_BAR();
    }
#undef C2_BAR
}

__device__ __forceinline__ void mlstm_prep(Frame& F, int l) {
    const GAS float* p = WSP(float, WS_P);
    LAS unsigned char* L = F.lds + RING_OFF;
    lbf* tKW = (lbf*)(L + 0); lbf* tVT = (lbf*)(L + 9216); LAS float* we = (LAS float*)(L + 18432);
    GAS float* kvT = WSP(float, WS_MKV); GAS float* nloc = WSP(float, WS_MNL); GAS float* msc = WSP(float, WS_MSC); GAS float* G = WSP(float, WS_MLG); GAS float* IG = WSP(float, WS_MLI);
    GAS bf16* QC = WSP(bf16, WS_MQC); GAS bf16* KC = WSP(bf16, WS_MKC);
    const int lane = F.lane, r16 = lane & 15, q = lane >> 4, w = F.wave;
    for (int item = F.vcu; item < NITEM; item += F.G) {
        const int h = item % 6, bc = item / 6, c = bc % NCH, b = bc / NCH; const size_t tokb = (size_t)b * SEQ + 64 * c;
        if (w == 0) {
            const size_t tok = tokb + lane;
            const float ig = p[tok * PC + P_ML + 1536 + h] + INP(I_BI)[l * 6 + h];
            const float lf = logsigmoidf_(p[tok * PC + P_ML + 1542 + h] + INP(I_BF)[l * 6 + h]);
            float g = lf;
#pragma unroll
            for (int o = 1; o < 64; o <<= 1) { const float t = __shfl_up(g, o); if (lane >= o) g += t; }
            const float glast = __shfl(g, 63);
            const float e = glast - g + ig; const float mloc = wave_max(e);
            we[lane] = fexp(e - mloc);
            G[item * 64 + lane] = g; IG[item * 64 + lane] = ig;
            if (lane == 0) { msc[item * 4 + 0] = mloc; msc[item * 4 + 1] = glast; }
        }
        __syncthreads();
#pragma unroll 1
        for (int idx = F.tid; idx < 3 * 1024; idx += NWAVES * 64) {
            const int which = idx >> 10, s = (idx >> 4) & 63, d4 = (idx & 15) * 4; const int tl = 64 * c + s; const size_t tok = tokb + s;
            if (which < 2) {
                const GAS float* cw = INP(I_CONVW) + (size_t)l * 4 * 768 + which * 384 + 64 * h + d4; const int pcol = P_ML + which * 384 + 64 * h + d4;
                f32x4 acc = *(const GAS f32x4*)(INP(I_CONVB) + l * 768 + which * 384 + 64 * h + d4);
#pragma unroll
                for (int i = 0; i < 4; ++i) { const int tt = tl - 3 + i; const f32x4 x = *(const GAS f32x4*)(p + (tt >= 0 ? tok - 3 + i : tok) * PC + pcol); const f32x4 wv = *(const GAS f32x4*)(cw + i * 768);
                    if (tt >= 0) acc = acc + wv * x; }
                f32x4 y;
#pragma unroll
                for (int e = 0; e < 4; ++e) y[e] = acc[e] * sigmoidf_(acc[e]);
                if (which == 0) { y = y * 0.125f; *(GAS v2u*)(QC + tok * 384 + 64 * h + d4) = (v2u){pk2(y[0], y[1]), pk2(y[2], y[3])}; }
                else { *(GAS v2u*)(KC + tok * 384 + 64 * h + d4) = (v2u){pk2(y[0], y[1]), pk2(y[2], y[3])}; const float ws_ = we[s];
#pragma unroll
                    for (int e = 0; e < 4; ++e) tKW[(d4 + e) * BP + s] = (unsigned short)f2bf(y[e] * ws_); }
            } else {
                const f32x4 x = *(const GAS f32x4*)(p + tok * PC + P_ML + 768 + 64 * h + d4);
#pragma unroll
                for (int e = 0; e < 4; ++e) tVT[(d4 + e) * BP + s] = (unsigned short)f2bf(x[e]);
            }
        }
        __syncthreads();
#pragma unroll
        for (int n2 = 0; n2 < 2; ++n2) { const int kt = w >> 1, nt = 2 * (w & 1) + n2;
            f32x4 acc = (f32x4){0.f, 0.f, 0.f, 0.f};
            acc = mma_nt64(tKW, 16 * kt, tVT, 16 * nt, r16, q, acc);
            *(GAS f32x4*)(kvT + (size_t)item * 4096 + (16 * nt + r16) * 64 + 16 * kt + 4 * q) = acc; }
        if (F.tid < 64) { float a = 0.f;
#pragma unroll 8
            for (int s = 0; s < 64; ++s) a += bf2f(tKW[F.tid * BP + s]);
            nloc[item * 64 + F.tid] = a; }
        { const int row = F.tid >> 3, sub = F.tid & 7; const int s_ = sub >> 2, q_ = sub & 3; const int i0 = 32 * s_ + 4 * q_, i1 = i0 + 16;
          const v2u a = *(const LAS v2u*)(tVT + row * BP + i0), b2 = *(const LAS v2u*)(tVT + row * BP + i1);
          *(GAS v4u*)(F.ws + WS_MVT + (size_t)item * 8192 + F.tid * 16) = (v4u){a.x, a.y, b2.x, b2.y}; }
        __syncthreads();
    }
}
__device__ __forceinline__ void mlstm_scan2(Frame& F) {
    if (blockIdx.x < 48) return;
    const int gt = ((int)blockIdx.x - 48) * (NWAVES * 64) + F.tid;
    const GAS float* msc = WSP(float, WS_MSC); GAS float* mscw = WSP(float, WS_MSC);
    if (gt < 12 * 2048) {
        const int bh = gt >> 11, el = (gt & 2047) * 2, b = bh / 6, h = bh % 6;
        const GAS float* src = WSP(float, WS_MKV); GAS bf16* dst = WSP(bf16, WS_MCP);
        float C0 = 0.f, C1 = 0.f, m = 0.f;
        for (int c0 = 0; c0 < NCH; c0 += 8) {
            float x0[8], x1[8], ml[8], gl[8];
#pragma unroll
            for (int i = 0; i < 8; ++i) { const int item = (b * NCH + c0 + i) * 6 + h; ml[i] = msc[item * 4 + 0]; gl[i] = msc[item * 4 + 1];
                const GAS float* s2 = src + (size_t)item * 4096 + el; x0[i] = s2[0]; x1[i] = s2[1]; }
#pragma unroll
            for (int i = 0; i < 8; ++i) { const int item = (b * NCH + c0 + i) * 6 + h;
                *(GAS unsigned*)(dst + (size_t)item * 4096 + el) = pk2(C0, C1);
                if (el == 0) mscw[item * 4 + 2] = m;
                const float mn = fmaxf(gl[i] + m, ml[i]); const float ao = fexp(gl[i] + m - mn), an = fexp(ml[i] - mn);
                C0 = ao * C0 + an * x0[i]; C1 = ao * C1 + an * x1[i]; m = mn; }
        }
    } else if (gt < 12 * 2048 + 12 * 64) {
        const int g2 = gt - 12 * 2048; const int bh = g2 >> 6, el = g2 & 63, b = bh / 6, h = bh % 6;
        const GAS float* src = WSP(float, WS_MNL); GAS float* dst = WSP(float, WS_MNP);
        float N = 0.f, m = 0.f;
        for (int c0 = 0; c0 < NCH; c0 += 8) {
            float x[8], ml[8], gl[8];
#pragma unroll
            for (int i = 0; i < 8; ++i) { const int item = (b * NCH + c0 + i) * 6 + h; ml[i] = msc[item * 4 + 0]; gl[i] = msc[item * 4 + 1]; x[i] = src[item * 64 + el]; }
#pragma unroll
            for (int i = 0; i < 8; ++i) { const int item = (b * NCH + c0 + i) * 6 + h;
                dst[item * 64 + el] = N;
                const float mn = fmaxf(gl[i] + m, ml[i]); const float ao = fexp(gl[i] + m - mn), an = fexp(ml[i] - mn);
                N = ao * N + an * x[i]; m = mn; }
        }
    }
}
__device__ __forceinline__ void mlstm_out_mfma(Frame& F, int l) {
    const GAS float* p = WSP(float, WS_P); const GAS bf16* QC = WSP(bf16, WS_MQC); const GAS bf16* KC = WSP(bf16, WS_MKC);
    const GAS float* G = WSP(float, WS_MLG); const GAS float* IG = WSP(float, WS_MLI); const GAS float* msc = WSP(float, WS_MSC); const GAS float* NP = WSP(float, WS_MNP);
    GAS bf16* ycat = WSP(bf16, WS_YCAT);
    const int gw = F.vcu * NWAVES + F.wave, NGW = F.G * NWAVES, lane = F.lane, r16 = lane & 15, q = lane >> 4;
    for (int wi = gw; wi < NITEM * 4; wi += NGW) {
        const int item = wi >> 2, jt = wi & 3;
        const int h = item % 6, bc = item / 6, c = bc % NCH, b = bc / NCH; const size_t tokb = (size_t)b * SEQ + 64 * c;
        const int j = 16 * jt + r16; const size_t tokj = tokb + j;
        const GAS unsigned char* vtp = F.ws + WS_MVT + (size_t)item * 8192; const GAS bf16* cpT = WSP(bf16, WS_MCP) + (size_t)item * 4096;
        bf16x8_t qf[2];
#pragma unroll
        for (int ss = 0; ss < 2; ++ss) qf[ss] = *(const GAS bf16x8_t*)(QC + tokj * 384 + 64 * h + 32 * ss + 8 * q);
        const float gj = G[item * 64 + j]; const float mprev = msc[item * 4 + 2];
        f32x4 sv[4], dl[4]; float mx = -INFINITY;
#pragma unroll
        for (int nt = 0; nt < 4; ++nt) {
            f32x4 acc = (f32x4){0.f, 0.f, 0.f, 0.f};
            if (nt <= jt) {
#pragma unroll
                for (int ss = 0; ss < 2; ++ss) { const bf16x8_t a = *(const GAS bf16x8_t*)(KC + (tokb + 16 * nt + r16) * 384 + 64 * h + 32 * ss + 8 * q); acc = __builtin_amdgcn_mfma_f32_16x16x32_bf16(a, qf[ss], acc, 0, 0, 0); } }
            sv[nt] = acc;
            const f32x4 gs = *(const GAS f32x4*)(G + item * 64 + 16 * nt + 4 * q), is = *(const GAS f32x4*)(IG + item * 64 + 16 * nt + 4 * q);
#pragma unroll
            for (int rg = 0; rg < 4; ++rg) { const int s = 16 * nt + 4 * q + rg; dl[nt][rg] = (s <= j) ? (gj - gs[rg] + is[rg]) : -INFINITY; mx = fmaxf(mx, dl[nt][rg]); }
        }
        mx = fmaxf(mx, __shfl_xor(mx, 16)); mx = fmaxf(mx, __shfl_xor(mx, 32));
        const float il = gj + mprev; const float mj = fmaxf(mx, il);
        float dsum = 0.f;
#pragma unroll
        for (int nt = 0; nt < 4; ++nt)
#pragma unroll
            for (int rg = 0; rg < 4; ++rg) { const float wgt = fexp(dl[nt][rg] - mj) * sv[nt][rg]; sv[nt][rg] = wgt; dsum += wgt; }
        dsum += __shfl_xor(dsum, 16); dsum += __shfl_xor(dsum, 32);
        float qn = 0.f;
#pragma unroll
        for (int ss = 0; ss < 2; ++ss) { const f32x4 n0 = *(const GAS f32x4*)(NP + item * 64 + 32 * ss + 8 * q), n1 = *(const GAS f32x4*)(NP + item * 64 + 32 * ss + 8 * q + 4);
            const v4u qw = __builtin_bit_cast(v4u, qf[ss]);
            qn += bf2f(qw.x & 0xffffu) * n0[0] + bf2f(qw.x >> 16) * n0[1] + bf2f(qw.y & 0xffffu) * n0[2] + bf2f(qw.y >> 16) * n0[3]
                + bf2f(qw.z & 0xffffu) * n1[0] + bf2f(qw.z >> 16) * n1[1] + bf2f(qw.w & 0xffffu) * n1[2] + bf2f(qw.w >> 16) * n1[3]; }
        qn += __shfl_xor(qn, 16); qn += __shfl_xor(qn, 32);
        const float wi_ = fexp(il - mj); const float den = dsum + wi_ * qn; const float dinv = frcp(fmaxf(fabsf(den), fexp(-mj)));
        bf16x8_t wb[2], qs[2];
#pragma unroll
        for (int ss = 0; ss < 2; ++ss) { v4u w_; w_.x = cvtpk(sv[2 * ss][0], sv[2 * ss][1]); w_.y = cvtpk(sv[2 * ss][2], sv[2 * ss][3]); w_.z = cvtpk(sv[2 * ss + 1][0], sv[2 * ss + 1][1]); w_.w = cvtpk(sv[2 * ss + 1][2], sv[2 * ss + 1][3]);
            wb[ss] = __builtin_bit_cast(bf16x8_t, w_);
            const v4u qw = __builtin_bit_cast(v4u, qf[ss]); v4u qo;
            qo.x = cvtpk(bf2f(qw.x & 0xffffu) * wi_, bf2f(qw.x >> 16) * wi_); qo.y = cvtpk(bf2f(qw.y & 0xffffu) * wi_, bf2f(qw.y >> 16) * wi_);
            qo.z = cvtpk(bf2f(qw.z & 0xffffu) * wi_, bf2f(qw.z >> 16) * wi_); qo.w = cvtpk(bf2f(qw.w & 0xffffu) * wi_, bf2f(qw.w >> 16) * wi_);
            qs[ss] = __builtin_bit_cast(bf16x8_t, qo); }
        f32x4 hv[4]; float sum = 0.f;
#pragma unroll
        for (int vt = 0; vt < 4; ++vt) {
            f32x4 acc = (f32x4){0.f, 0.f, 0.f, 0.f};
#pragma unroll
            for (int ss = 0; ss < 2; ++ss) { const bf16x8_t a = *(const GAS bf16x8_t*)(vtp + ((16 * vt + r16) * 64 + 32 * ss + 8 * q) * 2); acc = __builtin_amdgcn_mfma_f32_16x16x32_bf16(a, wb[ss], acc, 0, 0, 0); }
#pragma unroll
            for (int ss = 0; ss < 2; ++ss) { const bf16x8_t a = *(const GAS bf16x8_t*)(cpT + (16 * vt + r16) * 64 + 32 * ss + 8 * q); acc = __builtin_amdgcn_mfma_f32_16x16x32_bf16(a, qs[ss], acc, 0, 0, 0); }
            hv[vt] = acc * dinv; sum += (hv[vt][0] + hv[vt][1]) + (hv[vt][2] + hv[vt][3]);
        }
        sum += __shfl_xor(sum, 16); sum += __shfl_xor(sum, 32);
        const float mean = sum * (1.f / 64.f); float vs = 0.f;
#pragma unroll
        for (int vt = 0; vt < 4; ++vt) { hv[vt] = hv[vt] - mean; vs += (hv[vt][0] * hv[vt][0] + hv[vt][1] * hv[vt][1]) + (hv[vt][2] * hv[vt][2] + hv[vt][3] * hv[vt][3]); }
        vs += __shfl_xor(vs, 16); vs += __shfl_xor(vs, 32);
        const float rstd = frsq(vs * (1.f / 64.f) + LN_EPS);
#pragma unroll
        for (int vt = 0; vt < 4; ++vt) { const int v0 = 16 * vt + 4 * q;
            const f32x4 og = *(const GAS f32x4*)(p + tokj * PC + P_ML + 1152 + 64 * h + v0), ng = *(const GAS f32x4*)(INP(I_NORMG) + l * 384 + 64 * h + v0);
            float o[4];
#pragma unroll
            for (int e = 0; e < 4; ++e) o[e] = sigmoidf_(og[e]) * (hv[vt][e] * rstd * ng[e]);
            *(GAS v2u*)(ycat + tokj * D + 640 + 64 * h + v0) = (v2u){pk2(o[0], o[1]), pk2(o[2], o[3])}; }
    }
}

__device__ __forceinline__ void router2(Frame& F, int l, const GAS float* h1) {
    LAS unsigned* hist = (LAS unsigned*)(F.lds + LDSCTL_OFF);
    const GAS bf16* whi = WSP(bf16, WS_RTW) + (size_t)l * 65536; const GAS bf16* wlo = whi + 32768;
    GAS int* tke = WSP(int, WS_TKE); GAS float* tkg = WSP(float, WS_TKG); GAS int* rnk = WSP(int, WS_RNK);
    const int lane = F.lane, r16 = lane & 15, q = lane >> 4;
    for (int grp = F.vcu; grp < T / 64; grp += F.G) {
        if (F.wave < 4) {
            const int tok = grp * 64 + 16 * F.wave + r16;
            f32x4 acc[2] = {(f32x4){0.f, 0.f, 0.f, 0.f}, (f32x4){0.f, 0.f, 0.f, 0.f}};
            const GAS float* hr = h1 + (size_t)tok * D + 8 * q;
#pragma unroll 4
            for (int ks = 0; ks < 32; ++ks) {
                const f32x4 x0 = *(const GAS f32x4*)(hr + 32 * ks), x1 = *(const GAS f32x4*)(hr + 32 * ks + 4);
                unsigned hi[4], lo[4];
                { const unsigned a0 = f2bf(x0[0]), a1 = f2bf(x0[1]), a2 = f2bf(x0[2]), a3 = f2bf(x0[3]), a4 = f2bf(x1[0]), a5 = f2bf(x1[1]), a6 = f2bf(x1[2]), a7 = f2bf(x1[3]);
                  hi[0] = a0 | (a1 << 16); hi[1] = a2 | (a3 << 16); hi[2] = a4 | (a5 << 16); hi[3] = a6 | (a7 << 16);
                  lo[0] = pk2(x0[0] - bf2f(a0), x0[1] - bf2f(a1)); lo[1] = pk2(x0[2] - bf2f(a2), x0[3] - bf2f(a3)); lo[2] = pk2(x1[0] - bf2f(a4), x1[1] - bf2f(a5)); lo[3] = pk2(x1[2] - bf2f(a6), x1[3] - bf2f(a7)); }
                const bf16x8_t bh = __builtin_bit_cast(bf16x8_t, (v4u){hi[0], hi[1], hi[2], hi[3]}), bl = __builtin_bit_cast(bf16x8_t, (v4u){lo[0], lo[1], lo[2], lo[3]});
#pragma unroll
                for (int nt = 0; nt < 2; ++nt) { const bf16x8_t ah = *(const GAS bf16x8_t*)(whi + (16 * nt + r16) * 1024 + 32 * ks + 8 * q), al = *(const GAS bf16x8_t*)(wlo + (16 * nt + r16) * 1024 + 32 * ks + 8 * q);
                    acc[nt] = __builtin_amdgcn_mfma_f32_16x16x32_bf16(ah, bh, acc[nt], 0, 0, 0); acc[nt] = __builtin_amdgcn_mfma_f32_16x16x32_bf16(ah, bl, acc[nt], 0, 0, 0); acc[nt] = __builtin_amdgcn_mfma_f32_16x16x32_bf16(al, bh, acc[nt], 0, 0, 0); }
            }
            float lv[8];
#pragma unroll
            for (int nt = 0; nt < 2; ++nt) { const f32x4 b4 = *(const GAS f32x4*)(INP(I_RTB) + l * NE + 16 * nt + 4 * q);
#pragma unroll
                for (int rg = 0; rg < 4; ++rg) lv[4 * nt + rg] = acc[nt][rg] + b4[rg]; }
            float tv[4]; int ti[4];
#pragma unroll
            for (int i = 0; i < 4; ++i) {
                float m = lv[0]; int mi = 4 * q;
#pragma unroll
                for (int e = 1; e < 8; ++e) { const int ge = 16 * (e >> 2) + 4 * q + (e & 3); if (lv[e] > m) { m = lv[e]; mi = ge; } }
#pragma unroll
                for (int o = 16; o < 64; o <<= 1) { const float om = __shfl_xor(m, o); const int oi = __shfl_xor(mi, o); if (om > m || (om == m && oi < mi)) { m = om; mi = oi; } }
                tv[i] = m; ti[i] = mi;
#pragma unroll
                for (int e = 0; e < 8; ++e) { const int ge = 16 * (e >> 2) + 4 * q + (e & 3); if (ge == mi) lv[e] = -INFINITY; }
            }
            const float e1 = fexp(tv[1] - tv[0]), e2 = fexp(tv[2] - tv[0]), e3 = fexp(tv[3] - tv[0]); const float inv = frcp(1.0f + e1 + e2 + e3);
            if (q == 0) {
                int rk[4];
#pragma unroll
                for (int i = 0; i < 4; ++i) rk[i] = (int)__hip_atomic_fetch_add(&hist[ti[i]], 1u, __ATOMIC_RELAXED, __HIP_MEMORY_SCOPE_WORKGROUP);
                *(GAS v4u*)(tke + tok * 4) = (v4u){(unsigned)ti[0], (unsigned)ti[1], (unsigned)ti[2], (unsigned)ti[3]};
                *(GAS f32x4*)(tkg + tok * 4) = (f32x4){inv, e1 * inv, e2 * inv, e3 * inv};
                *(GAS v4u*)(rnk + tok * 4) = (v4u){(unsigned)rk[0], (unsigned)rk[1], (unsigned)rk[2], (unsigned)rk[3]};
            }
        }
        __syncthreads();
        if (F.tid < NE) { const unsigned c = hist[F.tid]; const unsigned base = __hip_atomic_fetch_add(F.ctl + CW_CNT + l * NE + F.tid, c, RLX_AGENT);
            WSP(int, WS_WGB)[(l * 256 + grp) * 32 + F.tid] = (int)base; hist[F.tid] = 0u; }
        __syncthreads();
    }
}
__device__ __forceinline__ void assign2(Frame& F, int l) {
    LAS unsigned* pst = (LAS unsigned*)(F.lds + RING_OFF);
    const GAS int* tke = WSP(int, WS_TKE); const GAS float* tkg = WSP(float, WS_TKG); const GAS int* rnk = WSP(int, WS_RNK); GAS int* slot_of = WSP(int, WS_SLOT); GAS float* gsl = WSP(float, WS_GSL);
    const GAS bf16* h16 = WSP(bf16, WS_H16); GAS bf16* xg = WSP(bf16, WS_XG);
    const int lane = F.lane;
    for (int grp = F.vcu; grp < T / 64; grp += F.G) {
        if (F.tid == 0) {
            unsigned run = 0;
            for (int e = 0; e < NE; ++e) { const unsigned c = __hip_atomic_load(F.ctl + CW_CNT + l * NE + e, RLX_AGENT); pst[e] = run; const unsigned nbk = (c + 255u) >> 8;
                if (blockIdx.x == 0 && grp == F.vcu) for (unsigned k = 0; k < nbk; ++k) __hip_atomic_store(F.ctl + CW_BLKE + l * 320 + (run >> 8) + k, (unsigned)e, RLX_AGENT);
                run += nbk << 8; }
            if (blockIdx.x == 0 && grp == F.vcu) __hip_atomic_store(F.ctl + CW_NB + l, run >> 8, RLX_AGENT);
        }
        if (F.tid >= 64 && F.tid < 96) pst[32 + F.tid - 64] = (unsigned)WSP(int, WS_WGB)[(l * 256 + grp) * 32 + F.tid - 64];
        __syncthreads();
#pragma unroll 1
        for (int i = 0; i < 8; ++i) { const int tok = grp * 64 + 8 * F.wave + i;
            int slot = 0;
            if (lane < 4) { const int e = tke[tok * 4 + lane]; slot = (int)(pst[e] + pst[32 + e]) + rnk[tok * 4 + lane]; slot_of[tok * 4 + lane] = slot; gsl[slot] = tkg[tok * 4 + lane]; }
            const GAS v4u* src = (const GAS v4u*)(h16 + (size_t)tok * D) + lane; const v4u a = src[0], b = src[64];
#pragma unroll
            for (int k = 0; k < 4; ++k) { const int s = __shfl(slot, k); GAS v4u* dst = (GAS v4u*)(xg + (size_t)s * D) + lane; dst[0] = a; dst[64] = b; }
        }
        __syncthreads();
    }
}
__device__ __forceinline__ void router_convert(Frame& F) {
    const int gt = F.vcu * (NWAVES * 64) + F.tid, NT_ = F.G * NWAVES * 64;
    for (int i = gt; i < 2 * 32 * 1024; i += NT_) { const int l = i >> 15, e = (i >> 10) & 31, k = i & 1023;
        const float x = INP(I_RTW)[(size_t)l * D * NE + (size_t)k * NE + e]; const unsigned hi = f2bf(x);
        GAS bf16* base = WSP(bf16, WS_RTW) + (size_t)l * 65536; base[e * 1024 + k] = (bf16)hi; base[32768 + e * 1024 + k] = (bf16)f2bf(x - bf2f(hi)); }
}

#ifndef MK_N_LAUNCHES
#define MK_N_LAUNCHES 1
#endif
constexpr int PH_PER_LAYER = 11, N_PHASES = 1 + DEPTH * PH_PER_LAYER;
struct Args { const float* in[34]; float* out; unsigned char* ws; int ph_lo, ph_hi; };
__global__ void __launch_bounds__(NWAVES * 64, 2) mk_fwd(Args args) {
    extern __shared__ __attribute__((aligned(16))) unsigned char lds[];
    Frame F0;
    F0.lds = (LAS unsigned char*)lds;
    F0.MISC = (volatile LAS unsigned*)(F0.lds + MISC_OFF);
    F0.tid = threadIdx.x; F0.lane = F0.tid & 63; F0.wave = __builtin_amdgcn_readfirstlane(F0.tid >> 6);
    F0.G = gridDim.x; { const int bx = blockIdx.x; F0.vcu = (F0.G % 8 == 0) ? (bx % 8) * (F0.G / 8) + bx / 8 : bx; }
    F0.ws = (GAS unsigned char*)args.ws; F0.ctl = (gu32*)(args.ws + WS_CTL); F0.out = (GAS float*)args.out;
    for (int u = F0.tid; u < (LDS_BYTES - LDSCTL_OFF) / 4; u += NWAVES * 64) ((LAS unsigned*)(F0.lds + LDSCTL_OFF))[u] = 0u;
    __syncthreads();
    if (F0.tid < 34) *(LAS unsigned long long*)(F0.lds + PTR_OFF + 8 * F0.tid) = (unsigned long long)args.in[F0.tid];
    __syncthreads();
    XcdBarrier bar; bar.bar = (unsigned*)(F0.ctl + CW_BAR); bar.x = 0; bar.st = nullptr;
    const int lo = args.ph_lo, hi = args.ph_hi;
    if (hi - lo > 1) bar = xcd_barrier_post((unsigned*)(F0.ctl + CW_BAR), F0.MISC + 8);

#ifndef PROBE_KP
#define PROBE_KP (-1)
#define PROBE_REPS 1
#endif
#ifndef PROBE_STOP
#define PROBE_STOP 99
#endif
#ifndef PROBE_SUB
#define PROBE_SUB (-1)
#endif
#define SUBRUN(i) (rep == 0 || PROBE_SUB < 0 || PROBE_SUB == (i))
    for (int ph_ = lo; ph_ < hi; ++ph_) {
    const int ph = launder_s(ph_);
#if PROBE_REPS > 1
    const int nrep = ((ph == 0 && PROBE_KP == 100) || (ph > 0 && (ph - 1) % PH_PER_LAYER == PROBE_KP)) ? PROBE_REPS : 1;
    for (int rep = 0; rep < nrep; ++rep) {
    if (rep > 0) xcd_barrier(bar);
#else
    { constexpr int rep = 0;
#endif
    if (ph == 0) { Frame F = launder(F0);
#ifndef SKIP_CONV
            phase_convert(F);
            { Frame Fb = launder(F0); lora_convert(Fb); }
            { Frame Fc = launder(F0); router_convert(Fc); }
#endif
             }

    else {
        const int l = launder_s((ph - 1) / PH_PER_LAYER); const int kp = launder_s((ph - 1) % PH_PER_LAYER);
        if (kp == 0) { Frame F = launder(F0);
            pg8::Gemm g{(const pg8::bf16_t*)WSP(pg8::bf16_t, WS_H16), (const pg8::bf16_t*)WSP(pg8::bf16_t, WS_WIN + l * WIN_L), T, PC, D, 0};
            pg8::StaticOrder S; S.init(T, PC, F.G, (int)blockIdx.x);
            pg8::EpiF32 E{WSP(float, WS_P), PC};

#ifndef SKIP_G1
            pg8::gemm_phase<pg8::EpiF32, pg8::StaticOrder, true, true>(F.lds + RING_OFF, g, S, E);
#endif

        }
        else if (kp == 1) { Frame F = launder(F0);
#ifndef SKIP_PREP
            if (SUBRUN(0)) { Frame Fa = launder(F0); pool_items(Fa, launder_s(l)); } __syncthreads(); if (SUBRUN(1)) { Frame Fb = launder(F0); rwkv_item_prep(Fb, launder_s(l), (rep > 0) ? PROBE_STOP : 99); } if (SUBRUN(2)) { Frame Fc = launder(F0); mlstm_prep(Fc, launder_s(l)); }
#endif
             }
        else if (kp == 2) { Frame F = launder(F0);
#ifndef SKIP_SCAN
            if (SUBRUN(0)) { Frame Fa = launder(F0); mlstm_scan2(Fa); } if (SUBRUN(1)) { Frame Fb = launder(F0); rwkv_chain2(Fb); }
#endif
             }
        else if (kp == 3) { Frame F = launder(F0);
#ifndef SKIP_FIN
            if (SUBRUN(0)) { Frame Fa = launder(F0); rwkv_chunk_out_mfma(Fa, launder_s(l)); } if (SUBRUN(1)) { Frame Fb = launder(F0); mlstm_out_mfma(Fb, launder_s(l)); }
#endif
             }
        else if (kp == 4) { Frame F = launder(F0);
            pg8::Gemm g{(const pg8::bf16_t*)WSP(pg8::bf16_t, WS_YCAT), (const pg8::bf16_t*)WSP(pg8::bf16_t, WS_WOUT + l * WOUT_L), T, D, D, 0};
            pg8::StaticOrder S; S.init(T, D, F.G, (int)blockIdx.x);
            pg8::EpiF32 E{WSP(float, WS_MIX), D};

#ifndef SKIP_G2
            pg8::gemm_phase<pg8::EpiF32, pg8::StaticOrder, false, true>(F.lds + RING_OFF, g, S, E);
#endif

        }
        else if (kp == 5) { Frame F = launder(F0);
#ifndef SKIP_LN
            ln_rows(F, (l == 0) ? INP(I_X) : WSP(float, WS_HB), WSP(float, WS_MIX), INP(I_LN1G) + l * D, INP(I_LN1B) + l * D, WSP(float, WS_HA), WSP(bf16, WS_H16));
#endif
             }
        else if (kp == 6) { Frame F = launder(F0);
#ifndef SKIP_RT
            router2(F, l, WSP(float, WS_HA));
#endif
             }
        else if (kp == 7) { Frame F = launder(F0);
#ifndef SKIP_AS
            assign2(F, l);
#endif
             }
        else if (kp == 8) { Frame F = launder(F0);
            pg8::Gemm g{(const pg8::bf16_t*)WSP(pg8::bf16_t, WS_XG), (const pg8::bf16_t*)WSP(pg8::bf16_t, WS_WGU + (size_t)l * 32 * WGU_E), NSLOT, 2048, D, WGU_E};
            MoeOrder<8> S; S.nb = (int)__builtin_amdgcn_readfirstlane(__hip_atomic_load(F.ctl + CW_NB + l, RLX_AGENT)); S.c = (int)blockIdx.x; S.blke = F.ctl + CW_BLKE + l * 320;
            pg8::EpiSwiGLU E{WSP(pg8::bf16_t, WS_ACT), INP(I_BGU) + (size_t)l * NE * 2048};

#ifndef SKIP_GU
            pg8::gemm_phase<pg8::EpiSwiGLU, MoeOrder<8>, true, true>(F.lds + RING_OFF, g, S, E);
#endif

        }
        else if (kp == 9) { Frame F = launder(F0);
            pg8::Gemm g{(const pg8::bf16_t*)WSP(pg8::bf16_t, WS_ACT), (const pg8::bf16_t*)WSP(pg8::bf16_t, WS_WDN + (size_t)l * 32 * WDN_E), NSLOT, D, FF, WDN_E};
            MoeOrder<4> S; S.nb = (int)__builtin_amdgcn_readfirstlane(__hip_atomic_load(F.ctl + CW_NB + l, RLX_AGENT)); S.c = (int)blockIdx.x; S.blke = F.ctl + CW_BLKE + l * 320;
            pg8::EpiDown E{WSP(pg8::bf16_t, WS_OSL), INP(I_BDN) + (size_t)l * NE * D, WSP(float, WS_GSL)};

#ifndef SKIP_DN
            pg8::gemm_phase<pg8::EpiDown, MoeOrder<4>, true, true>(F.lds + RING_OFF, g, S, E);
#endif

        }
        else if (kp == 10) { Frame F = launder(F0);
#ifndef SKIP_CB
            combine_phase(F, WSP(float, WS_HA), INP(I_LN2G) + l * D, INP(I_LN2B) + l * D, (l == DEPTH - 1) ? F.out : WSP(float, WS_HB), WSP(bf16, WS_H16));
#endif
             }
    }
    }
    if (ph_ + 1 < hi) xcd_barrier(bar);
    }
#if defined(PROBE_CONV2)
    { xcd_barrier(bar); Frame F = launder(F0); phase_convert(F); }
#endif
}

extern "C" void kernel_launch(void* const* d_in, const int* in_sizes, int n_in, void* d_out, int out_size, void* d_ws, size_t ws_size, hipStream_t stream) {
    static int grid = 0;
    if (grid == 0) {
        if (n_in != 34 || in_sizes[0] != T * D || out_size != T * D || ws_size < WS_END) { fprintf(stderr, "kernel_launch: unexpected shapes / workspace (n_in %d, in0 %d, out %d, ws %zu, need %zu)\n", n_in, n_in > 0 ? in_sizes[0] : -1, out_size, ws_size, (size_t)WS_END); grid = -1; return; }
        int dev = 0, cus = 0, per_cu = 0;
        if (hipGetDevice(&dev) != hipSuccess || hipDeviceGetAttribute(&cus, hipDeviceAttributeMultiprocessorCount, dev) != hipSuccess) { grid = -1; return; }
        if (hipFuncSetAttribute((const void*)mk_fwd, hipFuncAttributeMaxDynamicSharedMemorySize, LDS_BYTES) != hipSuccess) { fprintf(stderr, "kernel_launch: hipFuncSetAttribute failed\n"); grid = -1; return; }
        if (hipOccupancyMaxActiveBlocksPerMultiprocessor(&per_cu, (const void*)mk_fwd, NWAVES * 64, LDS_BYTES) != hipSuccess || per_cu < 1) { fprintf(stderr, "kernel_launch: occupancy query says %d blocks per CU\n", per_cu); }
        (void)hipGetLastError();
        grid = cus;
        if (grid % 8 != 0 || grid > 256) grid = (grid > 256) ? 256 : (grid / 8) * 8;
    }
    if (grid <= 0) return;
    (void)hipMemsetAsync((char*)d_ws + WS_CTL, 0, CTL_ZERO_BYTES, stream);
    Args a{};
    for (int i = 0; i < 34; ++i) a.in[i] = (const float*)d_in[i];
    a.out = (float*)d_out; a.ws = (unsigned char*)d_ws;
#if MK_N_LAUNCHES == 1
    a.ph_lo = 0; a.ph_hi = N_PHASES;
    hipLaunchKernelGGL(mk_fwd, dim3(grid), dim3(NWAVES * 64), LDS_BYTES, stream, a);
#else
    for (int ph = 0; ph < N_PHASES; ++ph) { a.ph_lo = ph; a.ph_hi = ph + 1; hipLaunchKernelGGL(mk_fwd, dim3(grid), dim3(NWAVES * 64), LDS_BYTES, stream, a); }
#endif
}
```

```cpp
#include <hip/hip_runtime.h>
#include <cstdio>
#include <cstdint>
namespace pg8 {
#define PG8_LAS __attribute__((address_space(3)))
typedef unsigned short bf16_t;
typedef short bf16x8 __attribute__((ext_vector_type(8)));
typedef float f32x4 __attribute__((ext_vector_type(4)));
typedef unsigned u32x4 __attribute__((ext_vector_type(4)));
constexpr int BM = 256, BK = 64, HALF = 128, HTB = HALF * BK * 2  , STAGE_BYTES = 8 * HTB, NXCD = 8, WGM = 8;

__host__ __device__ __forceinline__ int lds_byte(int r, int c) { const int st = (r >> 4) * 2 + (c >> 5), rr = r & 15, cc = c & 31, ob = rr * 64 + cc * 2; return st * 1024 + (ob ^ (((ob >> 9) & 1) << 5)); }
__host__ __device__ __forceinline__ void stage_rc(int b, int& R, int& C) { const int st = b / 1024, sb = b % 1024, swz = sb ^ (((sb >> 9) & 1) << 5); R = (st >> 1) * 16 + swz / 64; C = (st & 1) * 32 + (swz % 64) / 2; }
__host__ __device__ __forceinline__ int perm32(int rho) { const int n = rho >> 4, i = rho & 15; return 8 * (i >> 2) + 4 * n + (i & 3); }

struct Unit { int pm, pn, e; };
struct Gemm { const bf16_t* A; const bf16_t* Bt; int M, N, K; size_t bstride; };

struct StaticOrder {
    int nM, nN, nwg, G, c;
    __host__ __device__ void init(int M, int N, int G_, int c_) { nM = M / BM; nN = N / BM; nwg = nM * nN; G = G_; c = c_; }
    __host__ __device__ bool next(int i, Unit& u) const {
        const long L = (long)i * G + c; if (L >= nwg) return false;
        int wgid = (int)L; { const int q = nwg / NXCD, r = nwg % NXCD, xcd = wgid % NXCD, off = wgid / NXCD; wgid = (xcd < r ? xcd * (q + 1) : r * (q + 1) + (xcd - r) * q) + off; }
        const int nig = WGM * nN, gid = wgid / nig, fm = gid * WGM, gsz = (nM - fm) < WGM ? (nM - fm) : WGM;
        u.pm = fm + ((wgid % nig) % gsz); u.pn = (wgid % nig) / gsz; u.e = 0; return true;
    }
    __device__ __forceinline__ void a_ready(const Unit&) const {}
    __device__ __forceinline__ void done(const Unit&) const {}
};

#define GAS_ __attribute__((address_space(1)))
__device__ __forceinline__ unsigned cvt_pk_bf16(float lo, float hi) { unsigned r; asm volatile("v_cvt_pk_bf16_f32 %0, %1, %2" : "=v"(r) : "v"(lo), "v"(hi)); return r; }

struct EpiF32 {
    static constexpr bool PERM = false, AFTER_DRAIN = false;
    GAS_ float* C; int ldc;
    __device__ __forceinline__ void operator()(const f32x4 (&acc)[2][2][4][2], const Unit& u, int wr, int wc, int fr, int fq) const {
        const int row0 = u.pm * BM + wr * 64 + fr, col0 = u.pn * BM + wc * 32 + 4 * fq;
#pragma unroll
        for (int ai = 0; ai < 2; ++ai)
#pragma unroll
            for (int m = 0; m < 4; ++m) { GAS_ float* rowp = C + (size_t)(row0 + ai * HALF + m * 16) * ldc + col0;
#pragma unroll
                for (int bj = 0; bj < 2; ++bj)
#pragma unroll
                    for (int n = 0; n < 2; ++n) *(GAS_ f32x4*)(rowp + bj * HALF + n * 16) = acc[ai][bj][m][n]; }
    }
};
struct EpiSwiGLU {
    static constexpr bool PERM = true, AFTER_DRAIN = false;
    GAS_ bf16_t* O; const GAS_ float* bias;
    __device__ __forceinline__ void operator()(const f32x4 (&acc)[2][2][4][2], const Unit& u, int wr, int wc, int fr, int fq) const {
        const int row0 = u.pm * BM + wr * 64 + fr; const int c0 = u.pn * HALF + wc * 32 + 8 * fq;
        const GAS_ float* bg = bias + (size_t)u.e * 2048 + c0; const GAS_ float* bl = bg + 1024;
        f32x4 bgv[2], blv[2];
#pragma unroll
        for (int n = 0; n < 2; ++n) { bgv[n] = *(const GAS_ f32x4*)(bg + 4 * n); blv[n] = *(const GAS_ f32x4*)(bl + 4 * n); }
#pragma unroll
        for (int ai = 0; ai < 2; ++ai)
#pragma unroll
            for (int m = 0; m < 4; ++m) {
                float o[8];
#pragma unroll
                for (int n = 0; n < 2; ++n) {
                    const f32x4 gv = acc[ai][0][m][n] + bgv[n], lv = acc[ai][1][m][n] + blv[n];
#pragma unroll
                    for (int j = 0; j < 4; ++j) {
                        const float gl = fminf(gv[j], 7.0f); const float li = fminf(fmaxf(lv[j], -7.0f), 7.0f);
                        const float sg = __builtin_amdgcn_rcpf(1.0f + __builtin_amdgcn_exp2f(-1.702f * 1.4426950408889634f * gl));
                        o[4 * n + j] = gl * sg * (li + 1.0f);
                    }
                }
                u32x4 w; w.x = cvt_pk_bf16(o[0], o[1]); w.y = cvt_pk_bf16(o[2], o[3]); w.z = cvt_pk_bf16(o[4], o[5]); w.w = cvt_pk_bf16(o[6], o[7]);
                *(GAS_ u32x4*)(O + (size_t)(row0 + ai * HALF + m * 16) * 1024 + c0) = w;
            }
    }
};
struct EpiDown {
    static constexpr bool PERM = true, AFTER_DRAIN = false;
    GAS_ bf16_t* O; const GAS_ float* bias; const GAS_ float* gate;
    __device__ __forceinline__ void operator()(const f32x4 (&acc)[2][2][4][2], const Unit& u, int wr, int wc, int fr, int fq) const {
        const int row0 = u.pm * BM + wr * 64 + fr; const int c0 = u.pn * BM + wc * 32 + 8 * fq;
        const GAS_ float* bb = bias + (size_t)u.e * 1024 + c0;
        f32x4 bv[2][2];
#pragma unroll
        for (int bj = 0; bj < 2; ++bj)
#pragma unroll
            for (int n = 0; n < 2; ++n) bv[bj][n] = *(const GAS_ f32x4*)(bb + bj * HALF + 4 * n);
#pragma unroll
        for (int ai = 0; ai < 2; ++ai)
#pragma unroll
            for (int m = 0; m < 4; ++m) { const int row = row0 + ai * HALF + m * 16; const float gt = gate[row];
#pragma unroll
                for (int bj = 0; bj < 2; ++bj) { const f32x4 v0 = (acc[ai][bj][m][0] + bv[bj][0]) * gt, v1 = (acc[ai][bj][m][1] + bv[bj][1]) * gt;
                    u32x4 w; w.x = cvt_pk_bf16(v0[0], v0[1]); w.y = cvt_pk_bf16(v0[2], v0[3]); w.z = cvt_pk_bf16(v1[0], v1[1]); w.w = cvt_pk_bf16(v1[2], v1[3]);
                    *(GAS_ u32x4*)(O + (size_t)row * 1024 + c0 + bj * HALF) = w; } }
    }
};

template <class Epi, class Sched, bool ALIGN_EPI = false, bool SP2 = false>
__device__ __forceinline__ void gemm_phase(PG8_LAS unsigned char* lds, const Gemm g, const Sched& S, const Epi& E) {
    int tid_ = threadIdx.x; asm volatile("" : "+v"(tid_));
    const int tid = tid_, wid = __builtin_amdgcn_readfirstlane(tid >> 6), lane = tid & 63, wr = wid >> 2, wc = wid & 3, fr = lane & 15, fq = lane >> 4;
    int K_ = g.K; asm volatile("" : "+s"(K_)); const int K = K_, nt = K / BK;
    unsigned voffA[2], voffB[2];
#pragma unroll
    for (int i = 0; i < 2; ++i) { int R, C; stage_rc(tid * 16 + i * 8192, R, C); const int Rb = Epi::PERM ? ((R & ~31) + perm32(R & 31)) : R;
        voffA[i] = (unsigned)(R * K + C) * 2u; voffB[i] = (unsigned)(Rb * K + C) * 2u; }
    const size_t kstep = (size_t)(BK * 2);
    const size_t hstep = (size_t)HALF * K * 2;
    const size_t tstep = 2 * hstep;
    const unsigned ldsw = (unsigned)wid * 1024u;
    const int aoff = lds_byte(wr * 64 + fr, fq * 8), boff = lds_byte(wc * 32 + fr, fq * 8);
#define PG8_SA(b, h) (((b) * 2 + (h)) * HTB)
#define PG8_SB(b, h) ((4 + (b) * 2 + (h)) * HTB)
#define PG8_STAGE(bufoff, gbase, voff) do { _Pragma("unroll") for (int _i = 0; _i < 2; ++_i) \
        __builtin_amdgcn_global_load_lds((const unsigned*)((const char*)(gbase) + (voff)[_i]), (PG8_LAS unsigned*)(lds + (bufoff) + ldsw + _i * 8192), 16, 0, 0); } while (0)
#define PG8_LDA(dst, b, h) do { _Pragma("unroll") for (int m = 0; m < 4; ++m) _Pragma("unroll") for (int k = 0; k < 2; ++k) dst[m][k] = *(const PG8_LAS bf16x8*)(lds + PG8_SA(b, h) + aoff + m * 2048 + k * 1024); } while (0)
#define PG8_LDB(dst, b, h) do { _Pragma("unroll") for (int n = 0; n < 2; ++n) _Pragma("unroll") for (int k = 0; k < 2; ++k) dst[n][k] = *(const PG8_LAS bf16x8*)(lds + PG8_SB(b, h) + boff + n * 2048 + k * 1024); } while (0)
#define PG8_MMA(ai, bj, At, Bt) do { __builtin_amdgcn_s_setprio(1); _Pragma("unroll") for (int m = 0; m < 4; ++m) _Pragma("unroll") for (int n = 0; n < 2; ++n) _Pragma("unroll") for (int k = 0; k < 2; ++k) \
        acc[ai][bj][m][n] = __builtin_amdgcn_mfma_f32_16x16x32_bf16(Bt[n][k], At[m][k], acc[ai][bj][m][n], 0, 0, 0); __builtin_amdgcn_s_setprio(0); } while (0)
#define PG8_WAIT_V(n) asm volatile("s_waitcnt vmcnt(" #n ")" ::: "memory")
#define PG8_WAIT_L(n) asm volatile("s_waitcnt lgkmcnt(" #n ")" ::: "memory")
#define PG8_BAR __builtin_amdgcn_s_barrier()
#define PG8_SCHED __builtin_amdgcn_sched_barrier(0)
    Unit cur, nxt; int ui = 0;
    if (!S.next(0, cur)) return;
    f32x4 acc[2][2][4][2];
#pragma unroll
    for (int a = 0; a < 2; ++a)
#pragma unroll
        for (int b = 0; b < 2; ++b)
#pragma unroll
            for (int m = 0; m < 4; ++m)
#pragma unroll
                for (int n = 0; n < 2; ++n) acc[a][b][m][n] = (f32x4){0.f, 0.f, 0.f, 0.f};
    bf16x8 At[4][2], B0[2][2], B1[2][2];
    const char* cA = (const char*)g.A + (size_t)cur.pm * tstep; const char* cB = (const char*)g.Bt + (size_t)cur.e * g.bstride + (size_t)cur.pn * tstep;
    S.a_ready(cur);
    if constexpr (SP2) {
        PG8_STAGE(PG8_SB(0, 0), cB, voffB); PG8_STAGE(PG8_SB(0, 1), cB + hstep, voffB); PG8_STAGE(PG8_SA(0, 0), cA, voffA); PG8_STAGE(PG8_SA(0, 1), cA + hstep, voffA);
        if (wr == 1) PG8_BAR;
        PG8_WAIT_V(2); PG8_BAR;
        PG8_STAGE(PG8_SB(1, 0), cB + kstep, voffB); PG8_STAGE(PG8_SA(1, 0), cA + kstep, voffA); PG8_STAGE(PG8_SB(1, 1), cB + hstep + kstep, voffB);
        PG8_WAIT_V(6); PG8_BAR;
    } else {
        PG8_STAGE(PG8_SB(0, 0), cB, voffB); PG8_STAGE(PG8_SA(0, 0), cA, voffA); PG8_STAGE(PG8_SB(0, 1), cB + hstep, voffB); PG8_STAGE(PG8_SA(0, 1), cA + hstep, voffA);
        if (wr == 1) PG8_BAR;
        PG8_WAIT_V(4); PG8_BAR;
        PG8_STAGE(PG8_SB(1, 0), cB + kstep, voffB); PG8_STAGE(PG8_SA(1, 0), cA + kstep, voffA); PG8_STAGE(PG8_SB(1, 1), cB + hstep + kstep, voffB);
        PG8_WAIT_V(6); PG8_BAR;
    }
    for (;;) {
        const bool has_next = S.next(ui + 1, nxt);
        const char* nA = has_next ? (const char*)g.A + (size_t)nxt.pm * tstep : cA; const char* nB = has_next ? (const char*)g.Bt + (size_t)nxt.e * g.bstride + (size_t)nxt.pn * tstep : cB;
        for (int t = 0; t < nt; t += 2) {
            const bool last = (t == nt - 2);
            const char* a1 = cA + (size_t)(t + 1) * kstep;
            const char* a2 = last ? nA : cA + (size_t)(t + 2) * kstep; const char* b2 = last ? nB : cB + (size_t)(t + 2) * kstep;
            const char* a3 = a2 + kstep; const char* b3 = b2 + kstep;
            if (last && has_next) S.a_ready(nxt);
            if constexpr (SP2) {
            PG8_LDB(B0, 0, 0); PG8_LDB(B1, 0, 1); PG8_SCHED; PG8_LDA(At, 0, 0); PG8_STAGE(PG8_SA(1, 1), a1 + hstep, voffA);
            PG8_WAIT_V(8); PG8_WAIT_L(0); PG8_BAR; PG8_MMA(0, 0, At, B0); PG8_MMA(0, 1, At, B1); PG8_BAR; PG8_SCHED;
            PG8_LDA(At, 0, 1); PG8_STAGE(PG8_SB(0, 0), b2, voffB); PG8_STAGE(PG8_SB(0, 1), b2 + hstep, voffB); PG8_STAGE(PG8_SA(0, 0), a2, voffA);
            PG8_WAIT_V(8); PG8_WAIT_L(0); PG8_BAR; PG8_MMA(1, 0, At, B0); PG8_MMA(1, 1, At, B1); PG8_BAR; PG8_SCHED;
            PG8_LDB(B0, 1, 0); PG8_LDB(B1, 1, 1); PG8_SCHED; PG8_LDA(At, 1, 0); PG8_STAGE(PG8_SA(0, 1), a2 + hstep, voffA);
            PG8_WAIT_V(8); PG8_WAIT_L(0); PG8_BAR; PG8_MMA(0, 0, At, B0); PG8_MMA(0, 1, At, B1); PG8_BAR; PG8_SCHED;
            PG8_LDA(At, 1, 1); PG8_STAGE(PG8_SB(1, 0), b3, voffB); PG8_STAGE(PG8_SB(1, 1), b3 + hstep, voffB); PG8_STAGE(PG8_SA(1, 0), a3, voffA);
            PG8_WAIT_V(8); PG8_WAIT_L(0); PG8_BAR; PG8_MMA(1, 0, At, B0); PG8_MMA(1, 1, At, B1); PG8_BAR; PG8_SCHED;
            } else {
            PG8_LDB(B0, 0, 0); PG8_SCHED; PG8_LDA(At, 0, 0); PG8_STAGE(PG8_SA(1, 1), a1 + hstep, voffA);
            PG8_WAIT_L(8); PG8_BAR; PG8_WAIT_L(0); PG8_MMA(0, 0, At, B0); PG8_BAR; PG8_SCHED;
            PG8_LDB(B1, 0, 1); PG8_STAGE(PG8_SB(0, 0), b2, voffB);
            PG8_BAR; PG8_WAIT_L(0); PG8_MMA(0, 1, At, B1); PG8_BAR;
            PG8_LDA(At, 0, 1); PG8_STAGE(PG8_SA(0, 0), a2, voffA);
            PG8_BAR; PG8_WAIT_L(0); PG8_MMA(1, 0, At, B0); PG8_BAR; PG8_SCHED;
            PG8_STAGE(PG8_SB(0, 1), b2 + hstep, voffB);
            PG8_WAIT_V(6); PG8_BAR; PG8_MMA(1, 1, At, B1); PG8_BAR;
            PG8_LDB(B0, 1, 0); PG8_SCHED; PG8_LDA(At, 1, 0); PG8_STAGE(PG8_SA(0, 1), a2 + hstep, voffA);
            PG8_WAIT_L(8); PG8_BAR; PG8_WAIT_L(0); PG8_MMA(0, 0, At, B0); PG8_BAR; PG8_SCHED;
            PG8_LDB(B1, 1, 1); PG8_STAGE(PG8_SB(1, 0), b3, voffB);
            PG8_BAR; PG8_WAIT_L(0); PG8_MMA(0, 1, At, B1); PG8_BAR;
            PG8_LDA(At, 1, 1); PG8_STAGE(PG8_SA(1, 0), a3, voffA);
            PG8_BAR; PG8_WAIT_L(0); PG8_MMA(1, 0, At, B0); PG8_BAR; PG8_SCHED;
            PG8_STAGE(PG8_SB(1, 1), b3 + hstep, voffB);
            PG8_WAIT_V(6); PG8_BAR; PG8_MMA(1, 1, At, B1); PG8_BAR;
            }
        }
        if constexpr (ALIGN_EPI) { if (wr == 0) PG8_BAR; }
        if constexpr (!Epi::AFTER_DRAIN) { E(acc, cur, wr, wc, fr, fq); S.done(cur); }
        if (!has_next) break;
#pragma unroll
        for (int a = 0; a < 2; ++a)
#pragma unroll
            for (int b = 0; b < 2; ++b)
#pragma unroll
                for (int m = 0; m < 4; ++m)
#pragma unroll
                    for (int n = 0; n < 2; ++n) acc[a][b][m][n] = (f32x4){0.f, 0.f, 0.f, 0.f};
        cur = nxt; cA = nA; cB = nB; ++ui;
        if constexpr (ALIGN_EPI) { if (wr == 1) PG8_BAR; }
    }
    PG8_WAIT_V(0);
    if constexpr (!ALIGN_EPI) { if (wr == 0) PG8_BAR; }
    PG8_BAR;
    if constexpr (Epi::AFTER_DRAIN) { E.fused(acc, cur, wr, wc, fr, fq, lds, wid, lane); S.done(cur); }
#undef PG8_SA
#undef PG8_SB
#undef PG8_STAGE
#undef PG8_LDA
#undef PG8_LDB
#undef PG8_MMA
#undef PG8_WAIT_V
#undef PG8_WAIT_L
#undef PG8_BAR
#undef PG8_SCHED
}
}
constexpr int NWAVES = 8;
constexpr int BATCH = 2, SEQ = 8192, D = 1024, T = BATCH * SEQ, DEPTH = 2;
constexpr int PC = 3328;
constexpr int DIN = 3212;
constexpr int P_RW = 256, P_ML = 1664, P_V1 = 3212;
constexpr int RW = 384, RWC = 1408;
constexpr int NE = 32, TOPK = 4, FF = 1024;
constexpr int MAXBLK = T * TOPK / 256 + NE;
constexpr int NSLOT = MAXBLK * 256;
constexpr float LN_EPS = 1e-5f, GN_EPS = 64e-5f;
constexpr float DN_ALPHA = 1.41421356237f;
constexpr int NCH = SEQ / 64;
constexpr int NITEM = BATCH * NCH * 6;

constexpr size_t MiB = 1u << 20;
constexpr size_t WS_CTL = 0, CTL_ZERO_BYTES = 1 * MiB;
constexpr size_t WS_WIN = 1 * MiB;
constexpr size_t WIN_L = (size_t)PC * D * 2;
constexpr size_t WS_WOUT = WS_WIN + 2 * WIN_L;
constexpr size_t WOUT_L = (size_t)D * D * 2;
constexpr size_t WS_WGU = WS_WOUT + 2 * WOUT_L;
constexpr size_t WGU_E = (size_t)2048 * D * 2;
constexpr size_t WS_WDN = WS_WGU + 64 * WGU_E;
constexpr size_t WDN_E = (size_t)D * D * 2;
constexpr size_t WS_H16 = WS_WDN + 64 * WDN_E;
constexpr size_t WS_HA = WS_H16 + (size_t)T * D * 2;
constexpr size_t WS_HB = WS_HA + (size_t)T * D * 4;
constexpr size_t WS_P = WS_HB + (size_t)T * D * 4;
constexpr size_t WS_MIX = WS_P + (size_t)T * PC * 4;
constexpr size_t WS_YCAT = WS_MIX + (size_t)T * D * 4;
constexpr size_t RWARR = (size_t)T * RW * 4;
constexpr size_t WS_VFIRST = WS_YCAT + (size_t)T * D * 2;
constexpr size_t WS_RR = WS_VFIRST + RWARR, WS_RLW = WS_RR + RWARR, WS_RK = WS_RLW + RWARR, WS_RV = WS_RK + RWARR;
constexpr size_t WS_RNA = WS_RV + RWARR, WS_RBB = WS_RNA + RWARR, WS_RG = WS_RBB + RWARR, WS_RY = WS_RG + RWARR;
constexpr size_t WS_RSB = WS_RY + RWARR;
constexpr size_t WS_MKV = WS_RSB + (size_t)T * 8 * 4;
constexpr size_t WS_MCP = WS_MKV + (size_t)NITEM * 4096 * 4;
constexpr size_t WS_MNL = WS_MCP + (size_t)NITEM * 4096 * 4;
constexpr size_t WS_MNP = WS_MNL + (size_t)NITEM * 64 * 4;
constexpr size_t WS_MSC = WS_MNP + (size_t)NITEM * 64 * 4;
constexpr size_t WS_MLG = WS_MSC + (size_t)NITEM * 4 * 4;
constexpr size_t WS_MLI = WS_MLG + (size_t)T * 8 * 4;
constexpr size_t WS_XG = ((WS_MLI + (size_t)T * 8 * 4 + MiB - 1) / MiB) * MiB;
constexpr size_t WS_ACT = WS_XG + (size_t)NSLOT * D * 2;
constexpr size_t WS_OSL = WS_ACT + (size_t)NSLOT * FF * 2;
constexpr size_t WS_TKE = WS_OSL + (size_t)NSLOT * D * 2;
constexpr size_t WS_TKG = WS_TKE + (size_t)T * 4 * 4;
constexpr size_t WS_SLOT = WS_TKG + (size_t)T * 4 * 4;
constexpr size_t WS_GSL = WS_SLOT + (size_t)T * 4 * 4;
constexpr size_t CH_STRIDE = 49408;
constexpr size_t WS_RCH = ((WS_GSL + (size_t)NSLOT * 4 + MiB - 1) / MiB) * MiB;
constexpr size_t CO_STRIDE = 32768;
constexpr size_t WS_RCO = WS_RCH + (size_t)NITEM * CH_STRIDE;
constexpr size_t WS_RS0 = WS_RCO + (size_t)NITEM * CO_STRIDE;
constexpr size_t WS_RUT = WS_RS0 + (size_t)NITEM * 8192;
constexpr size_t WS_LORA = WS_RUT + (size_t)NITEM * 8192;
constexpr size_t WS_MQC = ((WS_LORA + 2 * 221184 + 4095) / 4096) * 4096;
constexpr size_t WS_MKC = WS_MQC + (size_t)T * 384 * 2;
constexpr size_t WS_MVT = WS_MKC + (size_t)T * 384 * 2;
constexpr size_t WS_RTW = WS_MVT + (size_t)NITEM * 8192;
constexpr size_t WS_RNK = WS_RTW + 2 * 2 * 32 * 1024 * 2;
constexpr size_t WS_WGB = WS_RNK + (size_t)T * 4 * 4;
constexpr size_t WS_END = WS_WGB + 2 * 256 * 32 * 4;
constexpr int CW_BAR = 4096;
constexpr int CW_CNT = 8192;
constexpr int CW_CUR = 8192 + 64;
constexpr int CW_NB = 8192 + 128;
constexpr int CW_BLKE = 8192 + 256;
constexpr int CW_SUB = 12288;

constexpr int RING_OFF = 0, RING_BYTES = 131072;
constexpr int LDSCTL_OFF = RING_BYTES, PTR_OFF = LDSCTL_OFF + 512, MISC_OFF = LDSCTL_OFF + 1024;
constexpr int LDS_BYTES = 147456;

#define GAS __attribute__((address_space(1)))
#define LAS __attribute__((address_space(3)))
typedef unsigned short bf16;
typedef unsigned v4u __attribute__((ext_vector_type(4)));
typedef unsigned v2u __attribute__((ext_vector_type(2)));
typedef float f32x4 __attribute__((ext_vector_type(4)));
typedef GAS unsigned gu32;
#define RLX_AGENT __ATOMIC_RELAXED, __HIP_MEMORY_SCOPE_AGENT
#define LDS_WAIT() asm volatile("s_waitcnt lgkmcnt(0)" ::: "memory")
#define VM_WAIT() asm volatile("s_waitcnt vmcnt(0)" ::: "memory")
__device__ __forceinline__ unsigned f2bf(float f) { unsigned u = __builtin_bit_cast(unsigned, f); return (u + 0x7fffu + ((u >> 16) & 1u)) >> 16; }
__device__ __forceinline__ unsigned pk2(float lo, float hi) { return f2bf(lo) | (f2bf(hi) << 16); }
__device__ __forceinline__ float bf2f(unsigned b) { return __builtin_bit_cast(float, b << 16); }
__device__ __forceinline__ float wave_sum(float v) {
#pragma unroll
    for (int o = 1; o < 64; o <<= 1) v += __shfl_xor(v, o);
    return v;
}
__device__ __forceinline__ float wave_max(float v) {
#pragma unroll
    for (int o = 1; o < 64; o <<= 1) v = fmaxf(v, __shfl_xor(v, o));
    return v;
}
__device__ __forceinline__ float fexp(float x) { return __builtin_amdgcn_exp2f(x * 1.4426950408889634f); }
__device__ __forceinline__ float frcp(float x) { return __builtin_amdgcn_rcpf(x); }
__device__ __forceinline__ float flog(float x) { return __builtin_amdgcn_logf(x) * 0.6931471805599453f; }
__device__ __forceinline__ float frsq(float x) { return __builtin_amdgcn_rsqf(x); }
__device__ __forceinline__ float sigmoidf_(float x) { return frcp(1.0f + fexp(-x)); }
__device__ __forceinline__ float tanhf_(float x) { return 1.0f - 2.0f * frcp(1.0f + fexp(2.0f * x)); }
__device__ __forceinline__ float softplusf_(float x) { return fmaxf(x, 0.f) + flog(1.0f + fexp(-fabsf(x))); }
__device__ __forceinline__ float logsigmoidf_(float x) { return fminf(x, 0.f) - flog(1.0f + fexp(-fabsf(x))); }

#define XB_TMO      128
#define XB_XCNT(j)  (256  + 64 * (j))
#define XB_XSUB(j)  (1280 + 64 * (j))
#define XB_XGEN(j)  (2304 + 64 * (j))
#define XB_TOP      3328
#define XB_TOPGEN   3392
#define XCD_BAR_WORDS 3456
#define XB_SPIN_CAP (1u << 18)

__device__ __forceinline__ unsigned xb_ld(unsigned* p)              { return __hip_atomic_load(p, __ATOMIC_RELAXED, __HIP_MEMORY_SCOPE_AGENT); }
__device__ __forceinline__ unsigned xb_add(unsigned* p, unsigned v) { return __hip_atomic_fetch_add(p, v, __ATOMIC_RELAXED, __HIP_MEMORY_SCOPE_AGENT); }
__device__ __forceinline__ unsigned xb_xcc_id() { return (unsigned)__builtin_amdgcn_s_getreg((3 << 11) | 20) & 0xFu; }
#define XB_SPIN(cond, bar) do { unsigned _sp = 0; while (cond) { __builtin_amdgcn_s_sleep(1); \
    if ((++_sp & 255u) == 0u) { if (xb_ld(&(bar)[XB_TMO])) break; if (_sp > XB_SPIN_CAP) { atomicAdd(&(bar)[XB_TMO], 1u); break; } } } } while (0)

struct XcdBarrier {
    unsigned* bar; unsigned x;
    volatile LAS unsigned* st;
};

__device__ __forceinline__ XcdBarrier xcd_barrier_post(unsigned* bar, volatile LAS unsigned* st) {
    XcdBarrier b; b.bar = bar; b.x = xb_xcc_id(); b.st = st;
    if (threadIdx.x == 0) (void)xb_add(&bar[XB_XCNT(b.x)], 1u);
    return b;
}
__device__ __forceinline__ void xcd_barrier_complete(unsigned* bar, unsigned x, unsigned& nloc, unsigned& nx) {
    const unsigned G = gridDim.x * gridDim.y * gridDim.z;
    unsigned sum, cnt, mine, sp = 0u;
    for (;;) {
        sum = 0u; cnt = 0u; mine = 0u;
#pragma unroll
        for (unsigned j = 0; j < 16; ++j) { const unsigned c = xb_ld(&bar[XB_XCNT(j)]); sum += c; cnt += (c > 0u) ? 1u : 0u; mine = (j == x) ? c : mine; }
        if (sum == G) break;
        __builtin_amdgcn_s_sleep(1);
        if ((++sp & 255u) == 0u) { if (xb_ld(&bar[XB_TMO])) break; if (sp > XB_SPIN_CAP) { atomicAdd(&bar[XB_TMO], 1u); break; } }
    }
    nloc = mine > 0u ? mine : 1u; nx = cnt > 0u ? cnt : 1u;
}

__device__ __forceinline__ void xcd_barrier(const XcdBarrier& b) {
    asm volatile("s_waitcnt vmcnt(0)" ::: "memory");
    __syncthreads();
    if (threadIdx.x == 0) {
        unsigned* bar = b.bar;
        __builtin_amdgcn_s_waitcnt(0);
        unsigned nloc = b.st[0], nx = b.st[1];
        if (nloc == 0u) { xcd_barrier_complete(bar, b.x, nloc, nx); b.st[0] = nloc; b.st[1] = nx; }
        const unsigned old = xb_add(&bar[XB_XSUB(b.x)], 1u);
        const unsigned gen = old / nloc;
        if (old + 1u == (gen + 1u) * nloc) {
            __builtin_amdgcn_fence(__ATOMIC_RELEASE, "agent");
            asm volatile("s_waitcnt vmcnt(0)" ::: "memory");
            const unsigned og = xb_add(&bar[XB_TOP], 1u);
            const unsigned tg = og / nx;
            if (og + 1u == (tg + 1u) * nx) xb_add(&bar[XB_TOPGEN], 1u);
            else XB_SPIN(xb_ld(&bar[XB_TOPGEN]) == tg, bar);
            __builtin_amdgcn_fence(__ATOMIC_ACQUIRE, "agent");
            xb_add(&bar[XB_XGEN(b.x)], 1u);
            asm volatile("s_waitcnt vmcnt(0)" ::: "memory");
        } else {
            XB_SPIN(xb_ld(&bar[XB_XGEN(b.x)]) == gen, bar);
            __builtin_amdgcn_fence(__ATOMIC_ACQUIRE, "agent");
            asm volatile("s_waitcnt vmcnt(0)" ::: "memory");
        }
    }
    __syncthreads();
}


struct Frame {
    LAS unsigned char* lds;
    volatile LAS unsigned* MISC;
    gu32* ctl;
    GAS unsigned char* ws;
    GAS float* out;
    int tid, lane, wave;
    int vcu, G;
};
enum { I_X = 0, I_WIN, I_POOLW, I_POOLS, I_MU, I_W0, I_W2, I_A0, I_A2, I_G2, I_KKS, I_KA, I_RK, I_LNXG, I_LNXB, I_V0, I_V1, I_V2,
       I_CONVW, I_CONVB, I_BI, I_BF, I_NORMG, I_WOUT, I_LN1G, I_LN1B, I_RTW, I_RTB, I_WGU, I_BGU, I_WDN, I_BDN, I_LN2G, I_LN2B };

#define WSP(T_, off) ((GAS T_*)(F.ws + (off)))
__device__ __forceinline__ const GAS float* inp_(LAS unsigned char* lds, int i) {
    const unsigned long long v = *(const LAS unsigned long long*)(lds + PTR_OFF + 8 * i);
    const unsigned lo = __builtin_amdgcn_readfirstlane((unsigned)v), hi = __builtin_amdgcn_readfirstlane((unsigned)(v >> 32));
    return (const GAS float*)(((unsigned long long)hi << 32) | lo);
}
#define INP(i) inp_(F.lds, (i))
__device__ __forceinline__ Frame launder(const Frame& G) {
    Frame F = G;
    F.tid = threadIdx.x; asm volatile("" : "+v"(F.tid)); F.lane = F.tid & 63;
    F.wave = __builtin_amdgcn_readfirstlane(F.tid >> 6);
    F.G = gridDim.x; { const int bx = blockIdx.x; F.vcu = (F.G % 8 == 0) ? (bx % 8) * (F.G / 8) + bx / 8 : bx; }
    asm volatile("" : "+s"(F.ws), "+s"(F.out), "+s"(F.vcu), "+s"(F.G));
    F.ctl = (gu32*)(F.ws + WS_CTL);
    return F;
}
__device__ __forceinline__ int launder_s(int x) { asm volatile("" : "+s"(x)); return x; }

template <int NN>
struct MoeOrder {
    int nb, c; const gu32* blke;
    __device__ __forceinline__ bool next(int i, pg8::Unit& u) const {
        constexpr int BPX = 32 / NN;
        const int x = c & 7, j = c >> 3;
        const int blk = i * (8 * BPX) + x * BPX + j / NN;
        if (blk >= nb) return false;
        u.pm = blk; u.pn = j % NN; u.e = (int)__builtin_amdgcn_readfirstlane(__hip_atomic_load(blke + blk, RLX_AGENT));
        return true;
    }
    __device__ __forceinline__ void a_ready(const pg8::Unit&) const {}
    __device__ __forceinline__ void done(const pg8::Unit&) const {}
};

__device__ __forceinline__ void transpose_item(const GAS float* src, int ld, bool valid, int k0, GAS bf16* dst  , LAS float* scr, int lane) {
    const GAS float* s0 = src + (size_t)(k0 + (lane >> 5)) * ld;
#pragma unroll 8
    for (int i = 0; i < 32; ++i) { const int kk = 2 * i + (lane >> 5); scr[kk * 33 + (lane & 31)] = valid ? s0[(size_t)(2 * i) * ld] : 0.f; }
    LDS_WAIT(); asm volatile("" ::: "memory");
    const int c = lane & 7;
#pragma unroll
    for (int j = 0; j < 4; ++j) { const int n = (lane >> 3) + 8 * j; const LAS float* s = scr + (8 * c) * 33 + n;
        v4u o; o.x = pk2(s[0 * 33], s[1 * 33]); o.y = pk2(s[2 * 33], s[3 * 33]); o.z = pk2(s[4 * 33], s[5 * 33]); o.w = pk2(s[6 * 33], s[7 * 33]);
        *(GAS v4u*)(dst + (size_t)n * D + k0 + 8 * c) = o; }
    LDS_WAIT(); asm volatile("" ::: "memory");
}
__device__ __forceinline__ void phase_convert(Frame& F) {
    LAS float* scr = (LAS float*)(F.lds + RING_OFF + F.wave * 16384);
    const int gw = F.vcu * NWAVES + F.wave, NGW = F.G * NWAVES; const int lane = F.lane;
    { const GAS float* x = INP(I_X); GAS bf16* h16 = WSP(bf16, WS_H16);
      for (int m = gw; m < T; m += NGW) { const GAS f32x4* xr = (const GAS f32x4*)(x + (size_t)m * D) + lane; GAS v2u* o = (GAS v2u*)(h16 + (size_t)m * D) + lane;
#pragma unroll
          for (int j = 0; j < 4; ++j) { const f32x4 v = xr[64 * j]; v2u w; w.x = pk2(v.x, v.y); w.y = pk2(v.z, v.w); o[64 * j] = w; } } }
    constexpr int KB = D / 64;
    constexpr int I_IN = 2 * (PC / 32) * KB;
    constexpr int I_OUT = 2 * (D / 32) * KB;
    constexpr int I_GU = 64 * (2048 / 32) * KB;
    constexpr int I_DN = 64 * (D / 32) * KB;
    constexpr int NITEMS = I_IN + I_OUT + I_GU + I_DN;
    for (int it = gw; it < NITEMS; it += NGW) {
        int r = it;
        if (r < I_IN) { const int l = r / ((PC / 32) * KB); r -= l * ((PC / 32) * KB); const int nb = r / KB, kb = r % KB; const int n = nb * 32 + (lane & 31);
            const GAS float* src; int ld; bool valid;
            if (n < DIN) { src = INP(I_WIN) + (size_t)l * D * DIN + n; ld = DIN; valid = true; }
            else if (l == 1 && n < DIN + 32) { src = INP(I_V1) + (n - DIN); ld = 32; valid = true; }
            else { src = INP(I_WIN); ld = 0; valid = false; }
            transpose_item(src, ld, valid, kb * 64, WSP(bf16, WS_WIN + l * WIN_L) + (size_t)(nb * 32) * D, scr, lane); continue; }
        r -= I_IN;
        if (r < I_OUT) { const int l = r / ((D / 32) * KB); r -= l * ((D / 32) * KB); const int nb = r / KB, kb = r % KB;
            transpose_item(INP(I_WOUT) + (size_t)l * D * D + nb * 32 + (lane & 31), D, true, kb * 64, WSP(bf16, WS_WOUT + l * WOUT_L) + (size_t)(nb * 32) * D, scr, lane); continue; }
        r -= I_OUT;
        if (r < I_GU) { const int le = r / (64 * KB); r -= le * (64 * KB); const int nb = r / KB, kb = r % KB; const int n0 = nb * 32;
            const int nn = n0 & 1023; const int drow = 256 * (nn >> 7) + (nn & 127) + ((n0 >= 1024) ? 128 : 0);
            transpose_item(INP(I_WGU) + (size_t)le * D * 2048 + n0 + (lane & 31), 2048, true, kb * 64, WSP(bf16, WS_WGU + le * WGU_E) + (size_t)drow * D, scr, lane); continue; }
        r -= I_GU;
        { const int le = r / (32 * KB); r -= le * (32 * KB); const int nb = r / KB, kb = r % KB;
            transpose_item(INP(I_WDN) + (size_t)le * D * D + nb * 32 + (lane & 31), D, true, kb * 64, WSP(bf16, WS_WDN + le * WDN_E) + (size_t)(nb * 32) * D, scr, lane); }
    }
}

__device__ __forceinline__ void pool_items(Frame& F, int l) {
    const GAS float* p = WSP(float, WS_P); GAS bf16* ycat = WSP(bf16, WS_YCAT);
    LAS float* dt = (LAS float*)(F.lds + RING_OFF + F.wave * 8192);
    const int gw = F.vcu * NWAVES + F.wave, NGW = F.G * NWAVES, lane = F.lane;
    for (int it = gw; it < (T / 32) * 4; it += NGW) {
        const int g = it & 3, tile = it >> 2, tok0 = tile * 32, t0 = tok0 & (SEQ - 1);
        const int win = 2 << g; const int col = 64 * g + lane;
        const GAS float* pc = p + (size_t)tok0 * PC + col;
        float ub[47];
#pragma unroll
        for (int j = 0; j < 47; ++j) { const int rel = j - 15; const int relc = (t0 + rel >= 0) ? rel : 0; const float x = pc[(ptrdiff_t)relc * PC]; ub[j] = (t0 + rel >= 0) ? x : 0.f; }
        float s = 0.f;
#pragma unroll
        for (int j = 1; j < 16; ++j) if (j < win) s += ub[15 - j];
#pragma unroll
        for (int t = 0; t < 32; ++t) {
            const float u = ub[15 + t]; s += u;
            const int cnt = min(t0 + t + 1, win);
            dt[t * 64 + lane] = s * frcp((float)cnt) - u;
            const float d2 = ub[15 + t - 1], d4 = ub[15 + t - 3], d8 = ub[15 + t - 7], d16 = ub[15 + t - 15];
            s -= (g == 0) ? d2 : (g == 1) ? d4 : (g == 2) ? d8 : d16;
        }
        LDS_WAIT(); asm volatile("" ::: "memory");
        float w[64];
        const GAS float* pw = INP(I_POOLW) + ((size_t)(l * 4 + g) * 64) * 64 + lane;
#pragma unroll
        for (int i = 0; i < 64; ++i) w[i] = pw[i * 64];
        const float sc = INP(I_POOLS)[l * 256 + col];
        for (int t = 0; t < 32; ++t) {
            float a0 = 0.f, a1 = 0.f, a2 = 0.f, a3 = 0.f;
#pragma unroll
            for (int i = 0; i < 64; i += 4) { const f32x4 d = *(const LAS f32x4*)(dt + t * 64 + i); a0 += d.x * w[i]; a1 += d.y * w[i + 1]; a2 += d.z * w[i + 2]; a3 += d.w * w[i + 3]; }
            ycat[(size_t)(tok0 + t) * D + col] = (bf16)f2bf(((a0 + a1) + (a2 + a3)) * sc);
        }
        LDS_WAIT(); asm volatile("" ::: "memory");
    }
}

constexpr int XS_PITCH = 1440;
__device__ __forceinline__ void rwkv_prep(Frame& F, int l) {
    const GAS float* p = WSP(float, WS_P);
    LAS float* xs = (LAS float*)(F.lds + RING_OFF);
    const GAS float* mu = INP(I_MU) + l * RWC;
    GAS float* vfirst = WSP(float, WS_VFIRST);
    GAS float* oR = WSP(float, WS_RR), *oLW = WSP(float, WS_RLW), *oK = WSP(float, WS_RK), *oV = WSP(float, WS_RV), *oNA = WSP(float, WS_RNA), *oBB = WSP(float, WS_RBB), *oG = WSP(float, WS_RG), *oSB = WSP(float, WS_RSB);
    for (int grp = F.vcu; grp < T / 8; grp += F.G) {
        const int tok0 = grp * 8;
#pragma unroll 2
        for (int idx = F.tid; idx < 8 * RWC; idx += NWAVES * 64) {
            const int tk = idx / RWC, j = idx - tk * RWC; const int tok = tok0 + tk;
            const bool first = (tok & (SEQ - 1)) == 0;
            const float cur = p[(size_t)tok * PC + P_RW + j];
            const float pv = p[(size_t)(first ? tok : tok - 1) * PC + P_RW + j];
            const float prev = first ? 0.f : pv;
            float x = cur + mu[j] * (prev - cur);
            if (j >= 1152 && j < 1216) x = tanhf_(x);
            else if (j >= 1280) x = sigmoidf_(x);
            xs[tk * XS_PITCH + j] = x;
        }
        if (l == 1) for (int idx = F.tid; idx < 8 * 32; idx += NWAVES * 64) { const int tk = idx >> 5, j = idx & 31; xs[tk * XS_PITCH + RWC + j] = p[(size_t)(tok0 + tk) * PC + P_V1 + j]; }
        __syncthreads();
        if (F.wave < 6) {
            const int h = F.wave, ch = 64 * h + F.lane;
            float dw[8], da[8], dg[8], dv[8];
#pragma unroll
            for (int t = 0; t < 8; ++t) { dw[t] = 0.f; da[t] = 0.f; dg[t] = 0.f; dv[t] = 0.f; }
            const GAS float* w2 = INP(I_W2) + (size_t)l * 64 * RW + ch; const GAS float* a2 = INP(I_A2) + (size_t)l * 64 * RW + ch; const GAS float* g2 = INP(I_G2) + (size_t)l * 128 * RW + ch;
#pragma unroll 1
            for (int j = 0; j < 64; j += 4) {
                float wv[4], av[4];
#pragma unroll
                for (int q = 0; q < 4; ++q) { wv[q] = w2[(size_t)(j + q) * RW]; av[q] = a2[(size_t)(j + q) * RW]; }
#pragma unroll
                for (int t = 0; t < 8; ++t) { const f32x4 xw = *(const LAS f32x4*)(xs + t * XS_PITCH + 1152 + j); const f32x4 xa = *(const LAS f32x4*)(xs + t * XS_PITCH + 1216 + j);
                    dw[t] += xw.x * wv[0] + xw.y * wv[1] + xw.z * wv[2] + xw.w * wv[3]; da[t] += xa.x * av[0] + xa.y * av[1] + xa.z * av[2] + xa.w * av[3]; }
            }
#pragma unroll 1
            for (int j = 0; j < 128; j += 4) {
                float gv[4];
#pragma unroll
                for (int q = 0; q < 4; ++q) gv[q] = g2[(size_t)(j + q) * RW];
#pragma unroll
                for (int t = 0; t < 8; ++t) { const f32x4 xg = *(const LAS f32x4*)(xs + t * XS_PITCH + 1280 + j); dg[t] += xg.x * gv[0] + xg.y * gv[1] + xg.z * gv[2] + xg.w * gv[3]; }
            }
            if (l == 1) { const GAS float* v2 = INP(I_V2) + ch;
#pragma unroll 1
                for (int j = 0; j < 32; j += 4) {
                    float vv[4];
#pragma unroll
                    for (int q = 0; q < 4; ++q) vv[q] = v2[(size_t)(j + q) * RW];
#pragma unroll
                    for (int t = 0; t < 8; ++t) { const f32x4 xv = *(const LAS f32x4*)(xs + t * XS_PITCH + RWC + j); dv[t] += xv.x * vv[0] + xv.y * vv[1] + xv.z * vv[2] + xv.w * vv[3]; }
                } }
            LAS float* accl = (LAS float*)(F.lds + RING_OFF + 49152) + h * 2048;
#pragma unroll
            for (int t = 0; t < 8; ++t) { accl[(0 * 8 + t) * 64 + F.lane] = dw[t]; accl[(1 * 8 + t) * 64 + F.lane] = da[t]; accl[(2 * 8 + t) * 64 + F.lane] = dg[t]; accl[(3 * 8 + t) * 64 + F.lane] = dv[t]; }
            LDS_WAIT(); asm volatile("" ::: "memory");
            const float w0 = INP(I_W0)[l * RW + ch], a0 = INP(I_A0)[l * RW + ch], kks = INP(I_KKS)[l * RW + ch], ka = INP(I_KA)[l * RW + ch], rk = INP(I_RK)[l * RW + ch];
            const float v0 = (l == 1) ? INP(I_V0)[ch] : 0.f;
#pragma unroll 1
            for (int t = 0; t < 8; ++t) {
                const int tok = tok0 + t; const size_t o = (size_t)tok * RW + ch;
                const float dwt = accl[(0 * 8 + t) * 64 + F.lane], dat = accl[(1 * 8 + t) * 64 + F.lane], dgt = accl[(2 * 8 + t) * 64 + F.lane], dvt = accl[(3 * 8 + t) * 64 + F.lane];
                const float r = xs[t * XS_PITCH + ch], k = xs[t * XS_PITCH + 384 + ch]; float v = xs[t * XS_PITCH + 768 + ch];
                const float wlog = -softplusf_(-(w0 + dwt)) - 0.5f; const float lw = -fexp(wlog);
                const float ai = sigmoidf_(a0 + dat);
                if (l == 0) vfirst[o] = v; else { const float vg = sigmoidf_(v0 + dvt); v = v + (vfirst[o] - v) * vg; }
                const float kkv = k * kks; const float nrm = sqrtf(wave_sum(kkv * kkv)); const float kk = kkv / fmaxf(nrm, 1e-12f);
                const float kp = k * (1.0f + (ai - 1.0f) * ka);
                const float sb = wave_sum(r * kp * rk);
                oR[o] = r; oLW[o] = lw; oK[o] = kp; oV[o] = v; oNA[o] = -kk; oBB[o] = kk * ai; oG[o] = dgt;
                if (F.lane == 0) oSB[tok * 8 + h] = sb;
            }
        }
        __syncthreads();
    }
}

__device__ __forceinline__ void mlstm_qk_tile(Frame& F, int l, int b, int c, int h, int which, LAS float* tile) {
    const GAS float* p = WSP(float, WS_P);
    const GAS float* cw = INP(I_CONVW) + (size_t)l * 4 * 768 + which * 384 + 64 * h; const GAS float* cb = INP(I_CONVB) + l * 768 + which * 384 + 64 * h;
    const int pcol = P_ML + which * 384 + 64 * h;
#pragma unroll 4
    for (int idx = F.tid; idx < 4096; idx += NWAVES * 64) {
        const int s = idx >> 6, d = idx & 63; const int tl = 64 * c + s; const size_t tok = (size_t)b * SEQ + tl;
        float acc = cb[d];
#pragma unroll
        for (int i = 0; i < 4; ++i) { const int tt = tl - 3 + i; const float x = p[(tt >= 0 ? tok - 3 + i : tok) * PC + pcol + d]; acc += (tt >= 0 ? cw[i * 768 + d] : 0.f) * x; }
        float y = acc * sigmoidf_(acc); if (which == 0) y *= 0.125f;
        tile[s * 65 + d] = y;
    }
}
__device__ __forceinline__ void mlstm_summ(Frame& F, int l) {
    const GAS float* p = WSP(float, WS_P);
    LAS float* kt = (LAS float*)(F.lds + RING_OFF);
    LAS float* vt = kt + 64 * 65;
    LAS float* we = vt + 64 * 64;
    GAS float* kvloc = WSP(float, WS_MKV); GAS float* nloc = WSP(float, WS_MNL); GAS float* msc = WSP(float, WS_MSC); GAS float* mlg = WSP(float, WS_MLG); GAS float* mli = WSP(float, WS_MLI);
    for (int item = F.vcu; item < NITEM; item += F.G) {
        const int h = item % 6, bc = item / 6, c = bc % NCH, b = bc / NCH;
        const size_t tokb = (size_t)b * SEQ + 64 * c;
        if (F.wave == 0) {
            const size_t tok = tokb + F.lane;
            const float ig = p[tok * PC + P_ML + 1536 + h] + INP(I_BI)[l * 6 + h];
            const float lf = logsigmoidf_(p[tok * PC + P_ML + 1542 + h] + INP(I_BF)[l * 6 + h]);
            float g = lf;
#pragma unroll
            for (int o = 1; o < 64; o <<= 1) { const float t = __shfl_up(g, o); if (F.lane >= o) g += t; }
            const float glast = __shfl(g, 63);
            const float e = glast - g + ig; const float mloc = wave_max(e);
            we[F.lane] = fexp(e - mloc);
            mlg[tok * 8 + h] = g; mli[tok * 8 + h] = ig;
            if (F.lane == 0) { msc[item * 4 + 0] = mloc; msc[item * 4 + 1] = glast; }
        }
        mlstm_qk_tile(F, l, b, c, h, 1, kt);
        for (int idx = F.tid; idx < 4096; idx += NWAVES * 64) { const int s = idx >> 6, d = idx & 63; vt[idx] = p[(tokb + s) * PC + P_ML + 768 + 64 * h + d]; }
        __syncthreads();
        { const int kd = F.tid >> 3, v0 = (F.tid & 7) * 8;
          float acc[8]; float an = 0.f;
#pragma unroll
          for (int j = 0; j < 8; ++j) acc[j] = 0.f;
          for (int s = 0; s < 64; ++s) { const float kw = we[s] * kt[s * 65 + kd]; an += kw; const f32x4 va = *(const LAS f32x4*)(vt + s * 64 + v0), vb = *(const LAS f32x4*)(vt + s * 64 + v0 + 4);
              acc[0] += kw * va.x; acc[1] += kw * va.y; acc[2] += kw * va.z; acc[3] += kw * va.w; acc[4] += kw * vb.x; acc[5] += kw * vb.y; acc[6] += kw * vb.z; acc[7] += kw * vb.w; }
          GAS float* o = kvloc + (size_t)item * 4096 + kd * 64 + v0;
          *(GAS f32x4*)o = (f32x4){acc[0], acc[1], acc[2], acc[3]}; *(GAS f32x4*)(o + 4) = (f32x4){acc[4], acc[5], acc[6], acc[7]};
          if ((F.tid & 7) == 0) nloc[item * 64 + kd] = an; }
        __syncthreads();
    }
}

__device__ __forceinline__ void rwkv_scan_seq(Frame& F) {
    if (F.vcu >= 12) return;
    const int b = F.vcu / 6, h = F.vcu % 6;
    LAS float* L = (LAS float*)(F.lds + RING_OFF);
    LAS float* ybuf = L + 6 * 4096;
    const GAS float* src[6] = {WSP(float, WS_RR), WSP(float, WS_RLW), WSP(float, WS_RK), WSP(float, WS_RV), WSP(float, WS_RNA), WSP(float, WS_RBB)};
    GAS float* yraw = WSP(float, WS_RY);
    const int vrow = (F.tid >> 2) & 63, q = F.tid & 3;
    float S[16];
#pragma unroll
    for (int i = 0; i < 16; ++i) S[i] = 0.f;
    for (int blk = 0; blk < SEQ / 64; ++blk) {
        const size_t tokb = (size_t)b * SEQ + blk * 64;
#pragma unroll
        for (int a = 0; a < 6; ++a)
            for (int idx = F.tid; idx < 4096; idx += NWAVES * 64) { const int s = idx >> 6, d = idx & 63; float x = src[a][(tokb + s) * RW + 64 * h + d]; if (a == 1) x = fexp(x); L[a * 4096 + idx] = x; }
        __syncthreads();
        if (F.tid < 256) {
            for (int t = 0; t < 64; ++t) {
                const LAS float* base = L + t * 64 + 16 * q;
                float sa = 0.f;
#pragma unroll
                for (int i = 0; i < 16; ++i) sa += S[i] * base[4 * 4096 + i];
                sa += __shfl_xor(sa, 1); sa += __shfl_xor(sa, 2);
                const float vv = L[3 * 4096 + t * 64 + vrow];
                float y = 0.f;
#pragma unroll
                for (int i = 0; i < 16; ++i) { S[i] = S[i] * base[1 * 4096 + i] + sa * base[5 * 4096 + i] + vv * base[2 * 4096 + i]; y += S[i] * base[i]; }
                y += __shfl_xor(y, 1); y += __shfl_xor(y, 2);
                if (q == 0) ybuf[t * 64 + vrow] = y;
            }
        }
        __syncthreads();
        for (int idx = F.tid; idx < 4096; idx += NWAVES * 64) { const int s = idx >> 6, d = idx & 63; yraw[(tokb + s) * RW + 64 * h + d] = ybuf[idx]; }
        __syncthreads();
    }
}
__device__ __forceinline__ void mlstm_scan(Frame& F) {
    if (blockIdx.x < 48) return;
    const int gt = ((int)blockIdx.x - 48) * (NWAVES * 64) + F.tid;
    const GAS float* msc = WSP(float, WS_MSC);
    if (gt < 12 * 4096 + 12 * 64) {
        const bool isn = gt >= 12 * 4096;
        const int g2 = isn ? gt - 12 * 4096 : gt;
        const int bh = isn ? (g2 >> 6) : (g2 >> 12), el = isn ? (g2 & 63) : (g2 & 4095), b = bh / 6, h = bh % 6;
        const int es = isn ? 64 : 4096;
        const GAS float* src = isn ? WSP(float, WS_MNL) : WSP(float, WS_MKV); GAS float* dst = isn ? WSP(float, WS_MNP) : WSP(float, WS_MCP); GAS float* mscw = WSP(float, WS_MSC);
        float C = 0.f, m = 0.f;
        for (int c0 = 0; c0 < NCH; c0 += 8) {
            float x[8], ml[8], gl[8];
#pragma unroll
            for (int i = 0; i < 8; ++i) { const int item = (b * NCH + c0 + i) * 6 + h; ml[i] = msc[item * 4 + 0]; gl[i] = msc[item * 4 + 1]; x[i] = src[(size_t)item * es + el]; }
#pragma unroll
            for (int i = 0; i < 8; ++i) { const int item = (b * NCH + c0 + i) * 6 + h;
                dst[(size_t)item * es + el] = C;
                if (!isn && el == 0) mscw[item * 4 + 2] = m;
                const float mn = fmaxf(gl[i] + m, ml[i]); const float ao = fexp(gl[i] + m - mn), an = fexp(ml[i] - mn);
                C = ao * C + an * x[i]; m = mn; }
        }
    }
}

__device__ __forceinline__ void rwkv_finish(Frame& F, int l) {
    const GAS float* yraw = WSP(float, WS_RY); const GAS float* v = WSP(float, WS_RV); const GAS float* g = WSP(float, WS_RG); const GAS float* sb = WSP(float, WS_RSB);
    GAS bf16* ycat = WSP(bf16, WS_YCAT);
    const int gw = F.vcu * NWAVES + F.wave, NGW = F.G * NWAVES, lane = F.lane;
    for (int tok = gw; tok < T; tok += NGW) {
#pragma unroll
        for (int h = 0; h < 6; ++h) {
            const size_t o = (size_t)tok * RW + 64 * h + lane;
            const float y = yraw[o]; const float mean = wave_sum(y) * (1.f / 64.f); const float d = y - mean; const float var = wave_sum(d * d) * (1.f / 64.f);
            float r = d * (frsq(var + GN_EPS)) * INP(I_LNXG)[l * RW + 64 * h + lane] + INP(I_LNXB)[l * RW + 64 * h + lane];
            r += sb[tok * 8 + h] * v[o];
            r *= g[o];
            ycat[(size_t)tok * D + 256 + 64 * h + lane] = (bf16)f2bf(r);
        }
    }
}
__device__ __forceinline__ void mlstm_out(Frame& F, int l) {
    const GAS float* p = WSP(float, WS_P);
    LAS float* qt = (LAS float*)(F.lds + RING_OFF);
    LAS float* kt = qt + 64 * 65;
    LAS float* At = kt + 64 * 65;
    LAS float* vt = At + 64 * 65;
    LAS float* cpt = vt + 4096;
    LAS float* sm = cpt + 4096;
    const GAS float* cp = WSP(float, WS_MCP); const GAS float* np = WSP(float, WS_MNP); const GAS float* msc = WSP(float, WS_MSC); const GAS float* mlg = WSP(float, WS_MLG); const GAS float* mli = WSP(float, WS_MLI);
    GAS bf16* ycat = WSP(bf16, WS_YCAT);
    for (int item = F.vcu; item < NITEM; item += F.G) {
        const int h = item % 6, bc = item / 6, c = bc % NCH, b = bc / NCH;
        const size_t tokb = (size_t)b * SEQ + 64 * c;
        mlstm_qk_tile(F, l, b, c, h, 0, qt);
        mlstm_qk_tile(F, l, b, c, h, 1, kt);
        for (int idx = F.tid; idx < 4096; idx += NWAVES * 64) { const int s = idx >> 6, d = idx & 63; vt[idx] = p[(tokb + s) * PC + P_ML + 768 + 64 * h + d]; cpt[idx] = cp[(size_t)item * 4096 + idx]; }
        if (F.tid < 64) { sm[F.tid] = mlg[(tokb + F.tid) * 8 + h]; sm[64 + F.tid] = mli[(tokb + F.tid) * 8 + h]; sm[128 + F.tid] = np[item * 64 + F.tid]; }
        const float mprev = msc[item * 4 + 2];
        __syncthreads();
        const int j = F.tid >> 3, sub = F.tid & 7;
        { const int s0 = sub * 8;
          float acc[8];
#pragma unroll
          for (int i = 0; i < 8; ++i) acc[i] = 0.f;
          for (int d = 0; d < 64; ++d) { const float qv = qt[j * 65 + d];
#pragma unroll
              for (int i = 0; i < 8; ++i) acc[i] += qv * kt[(s0 + i) * 65 + d]; }
          const float gj = sm[j];
          float dl[8]; float mx = -INFINITY;
#pragma unroll
          for (int i = 0; i < 8; ++i) { const int s = s0 + i; dl[i] = (s <= j) ? (gj - sm[s] + sm[64 + s]) : -INFINITY; mx = fmaxf(mx, dl[i]); }
          mx = fmaxf(mx, __shfl_xor(mx, 1)); mx = fmaxf(mx, __shfl_xor(mx, 2)); mx = fmaxf(mx, __shfl_xor(mx, 4));
          const float il = gj + mprev; const float mj = fmaxf(mx, il);
          float dsum = 0.f;
#pragma unroll
          for (int i = 0; i < 8; ++i) { const int s = s0 + i; const float w = (s <= j) ? fexp(dl[i] - mj) * acc[i] : 0.f; At[j * 65 + s] = w; dsum += w; }
          dsum += __shfl_xor(dsum, 1); dsum += __shfl_xor(dsum, 2); dsum += __shfl_xor(dsum, 4);
          if (sub == 0) { float qn = 0.f; for (int d = 0; d < 64; ++d) qn += qt[j * 65 + d] * sm[128 + d];
              const float wi = fexp(il - mj); const float den = dsum + wi * qn;
              sm[192 + j] = wi; sm[256 + j] = frcp(fmaxf(fabsf(den), fexp(-mj))); } }
        __syncthreads();
        { const int v0 = sub * 8;
          float acc[8];
#pragma unroll
          for (int i = 0; i < 8; ++i) acc[i] = 0.f;
          for (int s = 0; s <= j; ++s) { const float a = At[j * 65 + s]; const f32x4 va = *(const LAS f32x4*)(vt + s * 64 + v0), vb = *(const LAS f32x4*)(vt + s * 64 + v0 + 4);
              acc[0] += a * va.x; acc[1] += a * va.y; acc[2] += a * va.z; acc[3] += a * va.w; acc[4] += a * vb.x; acc[5] += a * vb.y; acc[6] += a * vb.z; acc[7] += a * vb.w; }
          const float wi = sm[192 + j];
          for (int d = 0; d < 64; ++d) { const float a = qt[j * 65 + d] * wi; const f32x4 va = *(const LAS f32x4*)(cpt + d * 64 + v0), vb = *(const LAS f32x4*)(cpt + d * 64 + v0 + 4);
              acc[0] += a * va.x; acc[1] += a * va.y; acc[2] += a * va.z; acc[3] += a * va.w; acc[4] += a * vb.x; acc[5] += a * vb.y; acc[6] += a * vb.z; acc[7] += a * vb.w; }
          const float di = sm[256 + j];
          float sum = 0.f;
#pragma unroll
          for (int i = 0; i < 8; ++i) { acc[i] *= di; sum += acc[i]; }
          sum += __shfl_xor(sum, 1); sum += __shfl_xor(sum, 2); sum += __shfl_xor(sum, 4);
          const float mean = sum * (1.f / 64.f); float vs = 0.f;
#pragma unroll
          for (int i = 0; i < 8; ++i) { acc[i] -= mean; vs += acc[i] * acc[i]; }
          vs += __shfl_xor(vs, 1); vs += __shfl_xor(vs, 2); vs += __shfl_xor(vs, 4);
          const float rstd = frsq(vs * (1.f / 64.f) + LN_EPS);
          const size_t tok = tokb + j;
          const GAS float* og = p + tok * PC + P_ML + 1152 + 64 * h + v0; const GAS float* ng = INP(I_NORMG) + l * 384 + 64 * h + v0;
          float o[8];
#pragma unroll
          for (int i = 0; i < 8; ++i) o[i] = sigmoidf_(og[i]) * (acc[i] * rstd * ng[i]);
          v4u w; w.x = pk2(o[0], o[1]); w.y = pk2(o[2], o[3]); w.z = pk2(o[4], o[5]); w.w = pk2(o[6], o[7]);
          *(GAS v4u*)(ycat + tok * D + 640 + 64 * h + v0) = w; }
        __syncthreads();
    }
}

__device__ __forceinline__ void ln_rows(Frame& F, const GAS float* hin, const GAS float* add, const GAS float* gam, const GAS float* bet, GAS float* out32, GAS bf16* h16) {
    const int gw = F.vcu * NWAVES + F.wave, NGW = F.G * NWAVES, lane = F.lane;
    for (int m = gw; m < T; m += NGW) {
        const GAS f32x4* hr = (const GAS f32x4*)(hin + (size_t)m * D) + lane; const GAS f32x4* ar = (const GAS f32x4*)(add + (size_t)m * D) + lane;
        f32x4 v[4]; float s = 0.f;
#pragma unroll
        for (int j = 0; j < 4; ++j) { v[j] = hr[64 * j] * DN_ALPHA + ar[64 * j]; s += (v[j].x + v[j].y) + (v[j].z + v[j].w); }
        const float mean = wave_sum(s) * (1.f / D); float s2 = 0.f;
#pragma unroll
        for (int j = 0; j < 4; ++j) { v[j] = v[j] - mean; s2 += (v[j].x * v[j].x + v[j].y * v[j].y) + (v[j].z * v[j].z + v[j].w * v[j].w); }
        const float rstd = frsq(wave_sum(s2) * (1.f / D) + LN_EPS);
        GAS f32x4* o4 = (GAS f32x4*)(out32 + (size_t)m * D) + lane; GAS v2u* o2 = (GAS v2u*)(h16 + (size_t)m * D) + lane;
#pragma unroll
        for (int j = 0; j < 4; ++j) { const f32x4 gg = *((const GAS f32x4*)gam + 64 * j + lane), bb = *((const GAS f32x4*)bet + 64 * j + lane);
            const f32x4 r = v[j] * rstd * gg + bb; o4[64 * j] = r; v2u w; w.x = pk2(r.x, r.y); w.y = pk2(r.z, r.w); o2[64 * j] = w; }
    }
}
__device__ __forceinline__ void router_phase(Frame& F, int l, const GAS float* h1) {
    LAS float* xs = (LAS float*)(F.lds + RING_OFF + F.wave * 16384);
    LAS unsigned* hist = (LAS unsigned*)(F.lds + LDSCTL_OFF);
    const GAS float* rw = INP(I_RTW) + (size_t)l * D * NE; const GAS float* rb = INP(I_RTB) + l * NE;
    GAS int* tke = WSP(int, WS_TKE); GAS float* tkg = WSP(float, WS_TKG);
    const int gw = F.vcu * NWAVES + F.wave, NGW = F.G * NWAVES, lane = F.lane;
    const int e = lane & 31, half = lane >> 5;
    for (int grp = gw; grp < T / 4; grp += NGW) {
        const int row0 = grp * 4;
#pragma unroll
        for (int r = 0; r < 4; ++r) { const GAS f32x4* xr = (const GAS f32x4*)(h1 + (size_t)(row0 + r) * D) + lane;
#pragma unroll
            for (int j = 0; j < 4; ++j) *(LAS f32x4*)(xs + r * 1024 + 4 * (64 * j + lane)) = xr[64 * j]; }
        LDS_WAIT(); asm volatile("" ::: "memory");
        float acc[4] = {0.f, 0.f, 0.f, 0.f};
        const GAS float* wp = rw + (size_t)(512 * half) * NE + e;
        for (int k = 0; k < 512; k += 4) {
            const float w0 = wp[(size_t)(k + 0) * NE], w1 = wp[(size_t)(k + 1) * NE], w2 = wp[(size_t)(k + 2) * NE], w3 = wp[(size_t)(k + 3) * NE];
#pragma unroll
            for (int r = 0; r < 4; ++r) { const f32x4 x = *(const LAS f32x4*)(xs + r * 1024 + 512 * half + k); acc[r] += (x.x * w0 + x.y * w1) + (x.z * w2 + x.w * w3); }
        }
        const float bias = rb[e];
#pragma unroll
        for (int r = 0; r < 4; ++r) {
            float lg = acc[r] + __shfl_xor(acc[r], 32) + bias;
            float v = (lane < 32) ? lg : -INFINITY;
            float tv[4]; int ti[4];
#pragma unroll
            for (int i = 0; i < 4; ++i) { const float m = wave_max(v); const unsigned long long bal = __ballot(v == m); const int idx = __ffsll((long long)bal) - 1; tv[i] = m; ti[i] = idx; if (lane == idx) v = -INFINITY; }
            const float e1 = fexp(tv[1] - tv[0]), e2 = fexp(tv[2] - tv[0]), e3 = fexp(tv[3] - tv[0]); const float inv = frcp(1.0f + e1 + e2 + e3);
            if (lane < 4) { const int ee = (lane == 0) ? ti[0] : (lane == 1) ? ti[1] : (lane == 2) ? ti[2] : ti[3]; const float gg = ((lane == 0) ? 1.0f : (lane == 1) ? e1 : (lane == 2) ? e2 : e3) * inv;
                tke[(row0 + r) * 4 + lane] = ee; tkg[(row0 + r) * 4 + lane] = gg; __hip_atomic_fetch_add(&hist[ee], 1u, __ATOMIC_RELAXED, __HIP_MEMORY_SCOPE_WORKGROUP); }
        }
        LDS_WAIT(); asm volatile("" ::: "memory");
    }
    __syncthreads();
    if (F.tid < NE) { const unsigned c = hist[F.tid]; if (c) __hip_atomic_fetch_add(F.ctl + CW_CNT + l * NE + F.tid, c, RLX_AGENT); }
    __syncthreads();
    if (F.tid < NE) hist[F.tid] = 0u;
    __syncthreads();
}
__device__ __forceinline__ void assign_phase(Frame& F, int l) {
    LAS unsigned* pst = (LAS unsigned*)(F.lds + RING_OFF);
    if (F.tid == 0) {
        unsigned run = 0;
        for (int e = 0; e < NE; ++e) { const unsigned c = __hip_atomic_load(F.ctl + CW_CNT + l * NE + e, RLX_AGENT); pst[e] = run; const unsigned nbk = (c + 255u) >> 8;
            if (blockIdx.x == 0) for (unsigned k = 0; k < nbk; ++k) __hip_atomic_store(F.ctl + CW_BLKE + l * 320 + (run >> 8) + k, (unsigned)e, RLX_AGENT);
            run += nbk << 8; }
        if (blockIdx.x == 0) __hip_atomic_store(F.ctl + CW_NB + l, run >> 8, RLX_AGENT);
    }
    __syncthreads();
    const GAS int* tke = WSP(int, WS_TKE); const GAS float* tkg = WSP(float, WS_TKG); GAS int* slot_of = WSP(int, WS_SLOT); GAS float* gsl = WSP(float, WS_GSL);
    const GAS bf16* h16 = WSP(bf16, WS_H16); GAS bf16* xg = WSP(bf16, WS_XG);
    const int gw = F.vcu * NWAVES + F.wave, NGW = F.G * NWAVES, lane = F.lane;
    for (int tok = gw; tok < T; tok += NGW) {
        int slot = 0;
        if (lane < 4) { const int e = tke[tok * 4 + lane]; const unsigned pos = __hip_atomic_fetch_add(F.ctl + CW_CUR + l * NE + e, 1u, RLX_AGENT); slot = (int)(pst[e] + pos);
            slot_of[tok * 4 + lane] = slot; gsl[slot] = tkg[tok * 4 + lane]; }
        const GAS v4u* src = (const GAS v4u*)(h16 + (size_t)tok * D) + lane; const v4u a = src[0], b = src[64];
#pragma unroll
        for (int i = 0; i < 4; ++i) { const int s = __shfl(slot, i); GAS v4u* dst = (GAS v4u*)(xg + (size_t)s * D) + lane; dst[0] = a; dst[64] = b; }
    }
}
__device__ __forceinline__ void combine_phase(Frame& F, const GAS float* h1, const GAS float* gam, const GAS float* bet, GAS float* out32, GAS bf16* h16) {
    const GAS int* slot_of = WSP(int, WS_SLOT); const GAS bf16* osl = WSP(bf16, WS_OSL);
    const int gw = F.vcu * NWAVES + F.wave, NGW = F.G * NWAVES, lane = F.lane;
    for (int m = gw; m < T; m += NGW) {
        const GAS f32x4* hr = (const GAS f32x4*)(h1 + (size_t)m * D) + lane;
        f32x4 v[4];
#pragma unroll
        for (int j = 0; j < 4; ++j) v[j] = hr[64 * j] * DN_ALPHA;
        const int sl = (lane < 4) ? slot_of[m * 4 + lane] : 0;
#pragma unroll
        for (int i = 0; i < 4; ++i) { const int s = __shfl(sl, i); const GAS v2u* orow = (const GAS v2u*)(osl + (size_t)s * D) + lane;
#pragma unroll
            for (int j = 0; j < 4; ++j) { const v2u w = orow[64 * j]; v[j].x += bf2f(w.x & 0xffffu); v[j].y += bf2f(w.x >> 16); v[j].z += bf2f(w.y & 0xffffu); v[j].w += bf2f(w.y >> 16); } }
        float s = 0.f;
#pragma unroll
        for (int j = 0; j < 4; ++j) s += (v[j].x + v[j].y) + (v[j].z + v[j].w);
        const float mean = wave_sum(s) * (1.f / D); float s2 = 0.f;
#pragma unroll
        for (int j = 0; j < 4; ++j) { v[j] = v[j] - mean; s2 += (v[j].x * v[j].x + v[j].y * v[j].y) + (v[j].z * v[j].z + v[j].w * v[j].w); }
        const float rstd = frsq(wave_sum(s2) * (1.f / D) + LN_EPS);
        GAS f32x4* o4 = (GAS f32x4*)(out32 + (size_t)m * D) + lane; GAS v2u* o2 = (GAS v2u*)(h16 + (size_t)m * D) + lane;
#pragma unroll
        for (int j = 0; j < 4; ++j) { const f32x4 gg = *((const GAS f32x4*)gam + 64 * j + lane), bb = *((const GAS f32x4*)bet + 64 * j + lane);
            const f32x4 r = v[j] * rstd * gg + bb; o4[64 * j] = r; v2u w; w.x = pk2(r.x, r.y); w.y = pk2(r.z, r.w); o2[64 * j] = w; }
    }
}

constexpr int TP = 68;
typedef short bf16x8_t __attribute__((ext_vector_type(8)));
typedef float f32x2_t __attribute__((ext_vector_type(2))); typedef __bf16 bf16x2_t __attribute__((ext_vector_type(2)));
__device__ __forceinline__ unsigned cvtpk(float lo, float hi) { f32x2_t v = {lo, hi}; bf16x2_t b = __builtin_convertvector(v, bf16x2_t); return __builtin_bit_cast(unsigned, b); }
__device__ __forceinline__ int perm_idx(int pos) { const int s = pos >> 5, q = (pos >> 3) & 3, j = pos & 7; return 32 * s + 16 * (j >> 2) + 4 * q + (j & 3); }

__device__ __forceinline__ void mm_nt(const LAS float* P, const LAS float* Q, int t, int sub, float (&out)[8]) {
#pragma unroll
    for (int j = 0; j < 8; ++j) out[j] = 0.f;
#pragma unroll 4
    for (int k = 0; k < 64; k += 4) {
        const f32x4 a = *(const LAS f32x4*)(P + t * TP + k);
#pragma unroll
        for (int j = 0; j < 8; ++j) { const f32x4 q = *(const LAS f32x4*)(Q + (sub + 8 * j) * TP + k); out[j] += (a.x * q.x + a.y * q.y) + (a.z * q.z + a.w * q.w); }
    }
}
__device__ __forceinline__ void mm_nn(const LAS float* X, const LAS float* Vt, int t, int sub, float (&out)[8]) {
#pragma unroll
    for (int j = 0; j < 8; ++j) out[j] = 0.f;
#pragma unroll 2
    for (int i = 0; i < 64; i += 4) {
        const f32x4 a = *(const LAS f32x4*)(X + t * TP + i);
#pragma unroll
        for (int e = 0; e < 4; ++e) { const float av = a[e]; const f32x4 v0 = *(const LAS f32x4*)(Vt + (i + e) * TP + 8 * sub), v1 = *(const LAS f32x4*)(Vt + (i + e) * TP + 8 * sub + 4);
            out[0] += av * v0.x; out[1] += av * v0.y; out[2] += av * v0.z; out[3] += av * v0.w; out[4] += av * v1.x; out[5] += av * v1.y; out[6] += av * v1.z; out[7] += av * v1.w; }
    }
}
__device__ __forceinline__ void rwkv_chunk_prep(Frame& F) {
    LAS float* tA = (LAS float*)(F.lds + RING_OFF);
    LAS float* tR = tA + 64 * TP; LAS float* tB = tR + 64 * TP; LAS float* tK = tB + 64 * TP; LAS float* tV = tK + 64 * TP; LAS float* tT = tV + 64 * TP; LAS float* tX = tT + 64 * TP;
    const GAS float* gR = WSP(float, WS_RR), *gLW = WSP(float, WS_RLW), *gK = WSP(float, WS_RK), *gV = WSP(float, WS_RV), *gNA = WSP(float, WS_RNA), *gBB = WSP(float, WS_RBB);
    const int t = F.tid >> 3, sub = F.tid & 7;
    for (int item = F.vcu; item < NITEM; item += F.G) {
        const int h = item % 6, bc = item / 6, c = bc % NCH, b = bc / NCH; const size_t tokb = (size_t)b * SEQ + 64 * c;
        const int ci = (b * 6 + h) * NCH + c;
        GAS unsigned char* chd = F.ws + WS_RCH + (size_t)ci * CH_STRIDE; GAS unsigned char* cod = F.ws + WS_RCO + (size_t)ci * CO_STRIDE;
        for (int idx = F.tid; idx < 4096; idx += NWAVES * 64) { const int s = idx >> 6, d = idx & 63; tX[s * TP + d] = gLW[(tokb + s) * RW + 64 * h + d]; }
        __syncthreads();
        if (F.tid < 64) { float run = 0.f; for (int s = 0; s < 64; ++s) { run += tX[s * TP + F.tid]; tX[s * TP + F.tid] = run; } ((GAS float*)(chd + 49152))[F.tid] = fexp(run); }
        __syncthreads();
        for (int idx = F.tid; idx < 4096; idx += NWAVES * 64) { const int s = idx >> 6, d = idx & 63; const size_t o = (tokb + s) * RW + 64 * h + d;
            const float cw = tX[s * TP + d]; const float lw = gLW[o]; const float ecw = fexp(cw), ecx = fexp(cw - lw), ein = fexp(-cw);
            tA[s * TP + d] = gNA[o] * ecx; tR[s * TP + d] = gR[o] * ecw; tB[s * TP + d] = gBB[o] * ein; tK[s * TP + d] = gK[o] * ein; tV[s * TP + d] = gV[o]; }
        __syncthreads();
        float m[8];
        mm_nt(tA, tK, t, sub, m);
#pragma unroll
        for (int j = 0; j < 8; ++j) { const int i = sub + 8 * j; tX[t * TP + i] = (i < t) ? m[j] : 0.f; }
        __syncthreads();
        mm_nn(tX, tV, t, sub, m);
        *(LAS f32x4*)(tT + t * TP + 8 * sub) = (f32x4){m[0], m[1], m[2], m[3]}; *(LAS f32x4*)(tT + t * TP + 8 * sub + 4) = (f32x4){m[4], m[5], m[6], m[7]};
        __syncthreads();
        mm_nt(tR, tK, t, sub, m);
#pragma unroll
        for (int j = 0; j < 8; ++j) { const int i = sub + 8 * j; tX[t * TP + i] = (i <= t) ? m[j] : 0.f; }
        __syncthreads();
        mm_nn(tX, tV, t, sub, m);
        { GAS float* y0 = (GAS float*)(cod + 16384) + t * 64 + 8 * sub; *(GAS f32x4*)y0 = (f32x4){m[0], m[1], m[2], m[3]}; *(GAS f32x4*)(y0 + 4) = (f32x4){m[4], m[5], m[6], m[7]}; }
        __syncthreads();
        mm_nt(tR, tB, t, sub, m);
#pragma unroll
        for (int j = 0; j < 8; ++j) { const int i = sub + 8 * j; tX[t * TP + i] = (i <= t) ? m[j] : 0.f; }
        __syncthreads();
        { const f32x4 a = *(const LAS f32x4*)(tX + t * TP + 8 * sub), bq = *(const LAS f32x4*)(tX + t * TP + 8 * sub + 4);
          v4u w; w.x = pk2(a.x, a.y); w.y = pk2(a.z, a.w); w.z = pk2(bq.x, bq.y); w.w = pk2(bq.z, bq.w); *(GAS v4u*)(cod + 8192 + (t * 64 + 8 * sub) * 2) = w; }
        __syncthreads();
        mm_nt(tA, tB, t, sub, m);
#pragma unroll
        for (int j = 0; j < 8; ++j) { const int i = sub + 8 * j; tX[i * TP + t] = (i < t) ? m[j] : 0.f; }
        __syncthreads();
        if (F.wave < 2) {
            LAS float* tile = (F.wave == 0) ? tA : tT; const int cidx = F.lane;
            const LAS float* tXv = tX + (F.lane & 0); asm volatile("" : "+v"(tXv));
            float acc[64];
#pragma unroll
            for (int i = 0; i < 64; ++i) acc[i] = tile[i * TP + cidx];
#pragma unroll
            for (int i = 0; i < 63; ++i) {
                const float xi = acc[i];
#pragma unroll
                for (int t4 = ((i + 1) & ~3); t4 < 64; t4 += 4) { const f32x4 mm = *(const LAS f32x4*)(tXv + i * TP + t4);
                    if (t4 + 0 > i) acc[t4 + 0] += mm.x * xi; if (t4 + 1 > i) acc[t4 + 1] += mm.y * xi; if (t4 + 2 > i) acc[t4 + 2] += mm.z * xi; if (t4 + 3 > i) acc[t4 + 3] += mm.w * xi; }
            }
#pragma unroll
            for (int i = 0; i < 64; ++i) tile[i * TP + cidx] = acc[i];
        }
        __syncthreads();
        { const int s_ = sub >> 2, q_ = sub & 3; const int i0 = 32 * s_ + 4 * q_, i1 = i0 + 16;
          { const f32x4 a = *(const LAS f32x4*)(tA + t * TP + i0), bq = *(const LAS f32x4*)(tA + t * TP + i1);
            v4u w; w.x = pk2(a.x, a.y); w.y = pk2(a.z, a.w); w.z = pk2(bq.x, bq.y); w.w = pk2(bq.z, bq.w); *(GAS v4u*)(chd + (t * 64 + 8 * sub) * 2) = w; }
          { float e[8];
#pragma unroll
            for (int j = 0; j < 8; ++j) e[j] = tB[((j < 4 ? i0 : i1) + (j & 3)) * TP + t];
            v4u w; w.x = pk2(e[0], e[1]); w.y = pk2(e[2], e[3]); w.z = pk2(e[4], e[5]); w.w = pk2(e[6], e[7]); *(GAS v4u*)(chd + 8192 + (t * 64 + 8 * sub) * 2) = w;
#pragma unroll
            for (int j = 0; j < 8; ++j) e[j] = tK[((j < 4 ? i0 : i1) + (j & 3)) * TP + t];
            w.x = pk2(e[0], e[1]); w.y = pk2(e[2], e[3]); w.z = pk2(e[4], e[5]); w.w = pk2(e[6], e[7]); *(GAS v4u*)(chd + 16384 + (t * 64 + 8 * sub) * 2) = w;
#pragma unroll
            for (int j = 0; j < 8; ++j) e[j] = tV[((j < 4 ? i0 : i1) + (j & 3)) * TP + t];
            w.x = pk2(e[0], e[1]); w.y = pk2(e[2], e[3]); w.z = pk2(e[4], e[5]); w.w = pk2(e[6], e[7]); *(GAS v4u*)(chd + 24576 + (t * 64 + 8 * sub) * 2) = w;
#pragma unroll
            for (int j = 0; j < 8; ++j) e[j] = tT[(8 * sub + j) * TP + t];
            GAS float* u0 = (GAS float*)(chd + 32768) + t * 64 + 8 * sub; *(GAS f32x4*)u0 = (f32x4){e[0], e[1], e[2], e[3]}; *(GAS f32x4*)(u0 + 4) = (f32x4){e[4], e[5], e[6], e[7]}; }
          { const f32x4 a = *(const LAS f32x4*)(tR + t * TP + 8 * sub), bq = *(const LAS f32x4*)(tR + t * TP + 8 * sub + 4);
            v4u w; w.x = pk2(a.x, a.y); w.y = pk2(a.z, a.w); w.z = pk2(bq.x, bq.y); w.w = pk2(bq.z, bq.w); *(GAS v4u*)(cod + (t * 64 + 8 * sub) * 2) = w; } }
        __syncthreads();
    }
}

constexpr int CH_STAGE = 49152;
constexpr int CH_PIECES = (int)(CH_STRIDE / 16);
#define CH_BAR() do { asm volatile("s_waitcnt lgkmcnt(0)" ::: "memory"); __builtin_amdgcn_s_barrier(); asm volatile("" ::: "memory"); } while (0)
__device__ __forceinline__ void rwkv_chain(Frame& F) {
    if (F.vcu >= 12) return;
    const int bh = F.vcu;
    const GAS unsigned char* src = F.ws + WS_RCH + (size_t)bh * NCH * CH_STRIDE;
    GAS unsigned char* s0g = F.ws + WS_RS0 + (size_t)bh * NCH * 8192; GAS unsigned char* utg = F.ws + WS_RUT + (size_t)bh * NCH * 8192;
    LAS unsigned char* st0 = F.lds + RING_OFF; LAS unsigned char* st1 = st0 + CH_STAGE;
    const int lane = F.lane, q = lane >> 4, r16 = lane & 15;
    if (F.wave >= 4) {
        const int lt = F.tid - 256;
        v4u RA[12], RB[12];
#define CH_LOAD(R, c) do { const GAS v4u* g_ = (const GAS v4u*)(src + (size_t)(c) * CH_STRIDE); _Pragma("unroll") for (int p = 0; p < 12; ++p) R[p] = g_[p * 256 + lt]; } while (0)
#define CH_WRITE(R, st) do { _Pragma("unroll") for (int p = 0; p < 12; ++p) *(LAS v4u*)((st) + (p * 256 + lt) * 16) = R[p]; } while (0)
        CH_LOAD(RA, 0); CH_LOAD(RB, 1);
        CH_WRITE(RA, st0); CH_LOAD(RA, 2);
        CH_BAR();
        for (int c = 0; c < NCH; c += 2) {
            CH_WRITE(RB, st1); if (c + 3 < NCH) CH_LOAD(RB, c + 3);
            CH_BAR();
            if (c + 2 < NCH) { CH_WRITE(RA, st0); if (c + 4 < NCH) CH_LOAD(RA, c + 4); }
            CH_BAR();
        }
#undef CH_LOAD
#undef CH_WRITE
    } else {
        const int w = F.wave; const int vrow = 16 * w + r16;
        f32x4 sacc[4]; bf16x8_t sb[2];
#pragma unroll
        for (int i = 0; i < 4; ++i) sacc[i] = (f32x4){0.f, 0.f, 0.f, 0.f};
        sb[0] = (bf16x8_t){0, 0, 0, 0, 0, 0, 0, 0}; sb[1] = sb[0];
        f32x4 gln[4];
#pragma unroll
        for (int kt = 0; kt < 4; ++kt) gln[kt] = *(const GAS f32x4*)(src + 49152 + (16 * kt + 4 * q) * 4);
        CH_BAR();
        for (int c = 0; c < NCH; ++c) {
            const LAS unsigned char* st = (c & 1) ? st1 : st0;
            f32x4 glc[4];
#pragma unroll
            for (int kt = 0; kt < 4; ++kt) glc[kt] = gln[kt];
            { const int cn = (c + 1 < NCH) ? c + 1 : c;
#pragma unroll
              for (int kt = 0; kt < 4; ++kt) gln[kt] = *(const GAS f32x4*)(src + (size_t)cn * CH_STRIDE + 49152 + (16 * kt + 4 * q) * 4); }
            { GAS v2u* o = (GAS v2u*)(s0g + (size_t)c * 8192 + (vrow * 64 + 4 * q) * 2);
              const v4u w0 = __builtin_bit_cast(v4u, sb[0]), w1 = __builtin_bit_cast(v4u, sb[1]);
              o[0] = (v2u){w0.x, w0.y}; o[4] = (v2u){w0.z, w0.w}; o[8] = (v2u){w1.x, w1.y}; o[12] = (v2u){w1.z, w1.w}; }
            f32x4 u[4];
#pragma unroll
            for (int tt = 0; tt < 4; ++tt) {
                u[tt] = *(const LAS f32x4*)(st + 32768 + (vrow * 64 + 16 * tt + 4 * q) * 4);
#pragma unroll
                for (int s = 0; s < 2; ++s) { const bf16x8_t a = *(const LAS bf16x8_t*)(st + ((16 * tt + r16) * 64 + 32 * s + 8 * q) * 2); u[tt] = __builtin_amdgcn_mfma_f32_16x16x32_bf16(a, sb[s], u[tt], 0, 0, 0); }
            }
            bf16x8_t ub[2];
            { v4u w0, w1; w0.x = cvtpk(u[0][0], u[0][1]); w0.y = cvtpk(u[0][2], u[0][3]); w0.z = cvtpk(u[1][0], u[1][1]); w0.w = cvtpk(u[1][2], u[1][3]);
              w1.x = cvtpk(u[2][0], u[2][1]); w1.y = cvtpk(u[2][2], u[2][3]); w1.z = cvtpk(u[3][0], u[3][1]); w1.w = cvtpk(u[3][2], u[3][3]);
              ub[0] = __builtin_bit_cast(bf16x8_t, w0); ub[1] = __builtin_bit_cast(bf16x8_t, w1);
              GAS v2u* o = (GAS v2u*)(utg + (size_t)c * 8192 + (vrow * 64 + 4 * q) * 2);
              o[0] = (v2u){w0.x, w0.y}; o[4] = (v2u){w0.z, w0.w}; o[8] = (v2u){w1.x, w1.y}; o[12] = (v2u){w1.z, w1.w}; }
            bf16x8_t vb[2];
#pragma unroll
            for (int s = 0; s < 2; ++s) vb[s] = *(const LAS bf16x8_t*)(st + 24576 + (vrow * 64 + 32 * s + 8 * q) * 2);
#pragma unroll
            for (int kt = 0; kt < 4; ++kt) {
#pragma unroll
                for (int s = 0; s < 2; ++s) { const bf16x8_t a = *(const LAS bf16x8_t*)(st + 16384 + ((16 * kt + r16) * 64 + 32 * s + 8 * q) * 2); sacc[kt] = __builtin_amdgcn_mfma_f32_16x16x32_bf16(a, vb[s], sacc[kt], 0, 0, 0); }
#pragma unroll
                for (int s = 0; s < 2; ++s) { const bf16x8_t a = *(const LAS bf16x8_t*)(st + 8192 + ((16 * kt + r16) * 64 + 32 * s + 8 * q) * 2); sacc[kt] = __builtin_amdgcn_mfma_f32_16x16x32_bf16(a, ub[s], sacc[kt], 0, 0, 0); }
                sacc[kt] = sacc[kt] * glc[kt];
            }
            { v4u w0, w1; w0.x = cvtpk(sacc[0][0], sacc[0][1]); w0.y = cvtpk(sacc[0][2], sacc[0][3]); w0.z = cvtpk(sacc[1][0], sacc[1][1]); w0.w = cvtpk(sacc[1][2], sacc[1][3]);
              w1.x = cvtpk(sacc[2][0], sacc[2][1]); w1.y = cvtpk(sacc[2][2], sacc[2][3]); w1.z = cvtpk(sacc[3][0], sacc[3][1]); w1.w = cvtpk(sacc[3][2], sacc[3][3]);
              sb[0] = __builtin_bit_cast(bf16x8_t, w0); sb[1] = __builtin_bit_cast(bf16x8_t, w1); }
            CH_BAR();
        }
    }
}

__device__ __forceinline__ void rwkv_chunk_out(Frame& F, int l) {
    LAS float* tRq = (LAS float*)(F.lds + RING_OFF);
    LAS float* tS = tRq + 64 * TP; LAS float* tM = tS + 64 * TP; LAS float* tU = tM + 64 * TP;
    const GAS float* gv = WSP(float, WS_RV); const GAS float* gg = WSP(float, WS_RG); const GAS float* sbp = WSP(float, WS_RSB);
    GAS bf16* ycat = WSP(bf16, WS_YCAT);
    const int t = F.tid >> 3, sub = F.tid & 7;
    for (int item = F.vcu; item < NITEM; item += F.G) {
        const int h = item % 6, bc = item / 6, c = bc % NCH, b = bc / NCH; const size_t tokb = (size_t)b * SEQ + 64 * c;
        const int ci = (b * 6 + h) * NCH + c;
        const GAS unsigned char* cod = F.ws + WS_RCO + (size_t)ci * CO_STRIDE;
        const GAS bf16* srcs[4] = {(const GAS bf16*)cod, (const GAS bf16*)(F.ws + WS_RS0 + (size_t)ci * 8192), (const GAS bf16*)(cod + 8192), (const GAS bf16*)(F.ws + WS_RUT + (size_t)ci * 8192)};
#pragma unroll
        for (int a = 0; a < 4; ++a) {
            LAS float* dstt = tRq + a * 64 * TP;
            const v4u wv = *(const GAS v4u*)(srcs[a] + t * 64 + 8 * sub);
            *(LAS f32x4*)(dstt + t * TP + 8 * sub) = (f32x4){bf2f(wv.x & 0xffffu), bf2f(wv.x >> 16), bf2f(wv.y & 0xffffu), bf2f(wv.y >> 16)};
            *(LAS f32x4*)(dstt + t * TP + 8 * sub + 4) = (f32x4){bf2f(wv.z & 0xffffu), bf2f(wv.z >> 16), bf2f(wv.w & 0xffffu), bf2f(wv.w >> 16)};
        }
        __syncthreads();
        float y1[8], y2[8];
        mm_nt(tRq, tS, t, sub, y1);
        mm_nt(tM, tU, t, sub, y2);
        const GAS float* y0 = (const GAS float*)(cod + 16384) + t * 64;
        float sum = 0.f;
#pragma unroll
        for (int j = 0; j < 8; ++j) { y1[j] += y2[j] + y0[sub + 8 * j]; sum += y1[j]; }
        sum += __shfl_xor(sum, 1); sum += __shfl_xor(sum, 2); sum += __shfl_xor(sum, 4);
        const float mean = sum * (1.f / 64.f); float vs = 0.f;
#pragma unroll
        for (int j = 0; j < 8; ++j) { y1[j] -= mean; vs += y1[j] * y1[j]; }
        vs += __shfl_xor(vs, 1); vs += __shfl_xor(vs, 2); vs += __shfl_xor(vs, 4);
        const float rstd = frsq(vs * (1.f / 64.f) + GN_EPS);
        const size_t tok = tokb + t; const float sbv = sbp[tok * 8 + h];
        const GAS float* lg = INP(I_LNXG) + l * RW + 64 * h; const GAS float* lb = INP(I_LNXB) + l * RW + 64 * h;
#pragma unroll
        for (int j = 0; j < 8; ++j) { const int v = sub + 8 * j; const size_t o = tok * RW + 64 * h + v;
            float r = y1[j] * rstd * lg[v] + lb[v]; r += sbv * gv[o]; r *= gg[o];
            ycat[tok * D + 256 + 64 * h + v] = (bf16)f2bf(r); }
        __syncthreads();
    }
}

constexpr int BP = 72;
typedef LAS unsigned short lbf;
__device__ __forceinline__ f32x4 mma_nt64(const lbf* P, int p0, const lbf* Q, int q0, int r16, int q, f32x4 acc) {
#pragma unroll
    for (int s = 0; s < 2; ++s) { const bf16x8_t a = *(const LAS bf16x8_t*)(P + (p0 + r16) * BP + 32 * s + 8 * q); const bf16x8_t b = *(const LAS bf16x8_t*)(Q + (q0 + r16) * BP + 32 * s + 8 * q);
        acc = __builtin_amdgcn_mfma_f32_16x16x32_bf16(a, b, acc, 0, 0, 0); }
    return acc;
}
constexpr size_t LORA_L = 221184;

__device__ __forceinline__ void rwkv_item_prep(Frame& F, int l, int stop) {
    LAS unsigned char* L = F.lds + RING_OFF;
    LAS float* fR = (LAS float*)(L + 0); LAS float* fK = (LAS float*)(L + 17408); LAS float* fV = (LAS float*)(L + 34816); LAS float* fL = (LAS float*)(L + 52224);
    LAS float* fA = (LAS float*)(L + 69632); LAS float* fT = (LAS float*)(L + 87040); LAS float* fX = (LAS float*)(L + 104448);
    lbf* Xw = (lbf*)(L + 69632); lbf* Xa = (lbf*)(L + 78848); lbf* Xg = (lbf*)(L + 88064); lbf* Xv = (lbf*)(L + 105472); LAS float* tbb = (LAS float*)(L + 64512); LAS float* tot = (LAS float*)(L + 110592); LAS float* red = (LAS float*)(L + 111616);
    lbf* bA = (lbf*)(L + 0); lbf* bR = (lbf*)(L + 9216); lbf* bB = (lbf*)(L + 18432); lbf* bK = (lbf*)(L + 27648); lbf* bVT = (lbf*)(L + 36864); lbf* bMak = (lbf*)(L + 46080); lbf* bMrk = (lbf*)(L + 55296); lbf* bMrb = (lbf*)(L + 121856);
    const GAS float* p = WSP(float, WS_P); const GAS float* mu = INP(I_MU) + l * RWC;
    GAS float* vfirst = WSP(float, WS_VFIRST); GAS float* oV = WSP(float, WS_RV); GAS float* oG = WSP(float, WS_RG); GAS float* oSB = WSP(float, WS_RSB);
    const GAS unsigned char* lw_ = F.ws + WS_LORA + (size_t)l * LORA_L;
    const int lane = F.lane, r16 = lane & 15, q = lane >> 4, w = F.wave;
    for (int item = F.vcu; item < NITEM; item += F.G) {
        const int h = item % 6, bc = item / 6, c = bc % NCH, b = bc / NCH; const size_t tokb = (size_t)b * SEQ + 64 * c;
        const int ci = (b * 6 + h) * NCH + c;
        GAS unsigned char* chd = F.ws + WS_RCH + (size_t)ci * CH_STRIDE; GAS unsigned char* cod = F.ws + WS_RCO + (size_t)ci * CO_STRIDE;
        const bool first = (c == 0);
#define SHIFT4(colj, s_) \
            const GAS float* pc = p + (tokb + (s_)) * PC + P_RW + (colj); const f32x4 cur = *(const GAS f32x4*)pc; const bool fz = first && (s_) == 0; \
            const f32x4 pv = *(const GAS f32x4*)(pc + (fz ? 0 : -PC)); const f32x4 prev = fz ? (f32x4){0.f, 0.f, 0.f, 0.f} : pv; const f32x4 m4 = *(const GAS f32x4*)(mu + (colj)); \
            const f32x4 x = cur + m4 * (prev - cur);
#pragma unroll 1
        for (int idx = F.tid; idx < 3 * 1024; idx += NWAVES * 64) { const int which = idx >> 10, s = (idx >> 4) & 63, d4 = (idx & 15) * 4; const int j = which * 384 + 64 * h + d4;
            SHIFT4(j, s)
            *(LAS f32x4*)((LAS float*)(L + which * 17408) + s * TP + d4) = x; }
#pragma unroll 1
        for (int idx = F.tid; idx < 2 * 1024; idx += NWAVES * 64) { const int which = idx >> 10, s = (idx >> 4) & 63, d4 = (idx & 15) * 4; const int j = 1152 + which * 64 + d4;
            SHIFT4(j, s)
            f32x4 y = x; if (which == 0) { y.x = tanhf_(x.x); y.y = tanhf_(x.y); y.z = tanhf_(x.z); y.w = tanhf_(x.w); }
            *(LAS v2u*)((which == 0 ? Xw : Xa) + s * BP + d4) = (v2u){pk2(y.x, y.y), pk2(y.z, y.w)}; }
#pragma unroll 1
        for (int idx = F.tid; idx < 2048; idx += NWAVES * 64) { const int s = idx >> 5, d4 = (idx & 31) * 4; const int j = 1280 + d4;
            SHIFT4(j, s)
            *(LAS v2u*)(Xg + s * 136 + d4) = (v2u){pk2(sigmoidf_(x.x), sigmoidf_(x.y)), pk2(sigmoidf_(x.z), sigmoidf_(x.w))}; }
#undef SHIFT4
        if (l == 1) { const int idx = F.tid; const int s = idx >> 3, d4 = (idx & 7) * 4; const f32x4 x = *(const GAS f32x4*)(p + (tokb + s) * PC + P_V1 + d4);
            *(LAS v2u*)(Xv + s * 40 + d4) = (v2u){pk2(x.x, x.y), pk2(x.z, x.w)}; }
        __syncthreads();
        if (stop <= 1) continue;
        float er[8], ena[8], ebb[8], ekp[8], ev[8], elw[8];
        const int mtw = w >> 1, hw = w & 1;
        {
            f32x4 dw[2], da[2], dg[2], dv[2];
#pragma unroll
            for (int n2 = 0; n2 < 2; ++n2) {
                const int chg = 64 * h + 16 * (2 * hw + n2) + r16;
                dw[n2] = (f32x4){0.f, 0.f, 0.f, 0.f}; da[n2] = dw[n2]; dg[n2] = dw[n2]; dv[n2] = dw[n2];
#pragma unroll
                for (int s = 0; s < 2; ++s) { const bf16x8_t a = *(const LAS bf16x8_t*)(Xw + (16 * mtw + r16) * BP + 32 * s + 8 * q); const bf16x8_t bb_ = *(const GAS bf16x8_t*)(lw_ + ((size_t)chg * 64 + 32 * s + 8 * q) * 2);
                    dw[n2] = __builtin_amdgcn_mfma_f32_16x16x32_bf16(a, bb_, dw[n2], 0, 0, 0); }
#pragma unroll
                for (int s = 0; s < 2; ++s) { const bf16x8_t a = *(const LAS bf16x8_t*)(Xa + (16 * mtw + r16) * BP + 32 * s + 8 * q); const bf16x8_t bb_ = *(const GAS bf16x8_t*)(lw_ + 49152 + ((size_t)chg * 64 + 32 * s + 8 * q) * 2);
                    da[n2] = __builtin_amdgcn_mfma_f32_16x16x32_bf16(a, bb_, da[n2], 0, 0, 0); }
#pragma unroll
                for (int s = 0; s < 4; ++s) { const bf16x8_t a = *(const LAS bf16x8_t*)(Xg + (16 * mtw + r16) * 136 + 32 * s + 8 * q); const bf16x8_t bb_ = *(const GAS bf16x8_t*)(lw_ + 98304 + ((size_t)chg * 128 + 32 * s + 8 * q) * 2);
                    dg[n2] = __builtin_amdgcn_mfma_f32_16x16x32_bf16(a, bb_, dg[n2], 0, 0, 0); }
                if (l == 1) { const bf16x8_t a = *(const LAS bf16x8_t*)(Xv + (16 * mtw + r16) * 40 + 8 * q); const bf16x8_t bb_ = *(const GAS bf16x8_t*)(lw_ + 196608 + ((size_t)chg * 32 + 8 * q) * 2);
                    dv[n2] = __builtin_amdgcn_mfma_f32_16x16x32_bf16(a, bb_, dv[n2], 0, 0, 0); }
            }
            float kk2[4] = {0.f, 0.f, 0.f, 0.f}, sbs[4] = {0.f, 0.f, 0.f, 0.f};
#pragma unroll
            for (int n2 = 0; n2 < 2; ++n2) {
                const int chl = 16 * (2 * hw + n2) + r16, chg = l * RW + 64 * h + chl;
                const float w0 = INP(I_W0)[chg], a0 = INP(I_A0)[chg], kks = INP(I_KKS)[chg], ka = INP(I_KA)[chg], rk = INP(I_RK)[chg];
                const float v0 = (l == 1) ? INP(I_V0)[64 * h + chl] : 0.f;
#pragma unroll
                for (int rg = 0; rg < 4; ++rg) {
                    const int e = 4 * n2 + rg; const int tk = 16 * mtw + 4 * q + rg; const size_t o = (tokb + tk) * RW + 64 * h + chl;
                    const float r = fR[tk * TP + chl], k = fK[tk * TP + chl]; float v = fV[tk * TP + chl];
                    const float wlog = -softplusf_(-(w0 + dw[n2][rg])) - 0.5f; elw[e] = -fexp(wlog);
                    const float ai = sigmoidf_(a0 + da[n2][rg]);
                    if (l == 0) vfirst[o] = v; else { const float vg = sigmoidf_(v0 + dv[n2][rg]); v = v + (vfirst[o] - v) * vg; }
                    const float kkv = k * kks; kk2[rg] += kkv * kkv; ena[e] = kkv;
                    const float kp = k * (1.0f + (ai - 1.0f) * ka); sbs[rg] += r * kp * rk;
                    er[e] = r; ekp[e] = kp; ev[e] = v; ebb[e] = ai;
                    oV[o] = v; oG[o] = dg[n2][rg];
                    fL[tk * TP + chl] = elw[e];
                }
            }
#pragma unroll
            for (int rg = 0; rg < 4; ++rg) {
#pragma unroll
                for (int o_ = 1; o_ < 16; o_ <<= 1) { kk2[rg] += __shfl_xor(kk2[rg], o_); sbs[rg] += __shfl_xor(sbs[rg], o_); }
                if (r16 == 0) { red[(hw * 64 + 16 * mtw + 4 * q + rg) * 2 + 0] = kk2[rg]; red[(hw * 64 + 16 * mtw + 4 * q + rg) * 2 + 1] = sbs[rg]; }
            }
        }
        __syncthreads();
#pragma unroll
        for (int rg = 0; rg < 4; ++rg) { const int tk = 16 * mtw + 4 * q + rg;
            const float k2 = red[tk * 2] + red[(64 + tk) * 2]; const float inv = frsq(fmaxf(k2, 1e-24f));
#pragma unroll
            for (int n2 = 0; n2 < 2; ++n2) { const int e = 4 * n2 + rg; const float kk = ena[e] * inv; ena[e] = -kk; ebb[e] = kk * ebb[e]; }
            if (hw == 0 && r16 == 0) oSB[(tokb + tk) * 8 + h] = red[tk * 2 + 1] + red[(64 + tk) * 2 + 1]; }
        if (stop <= 2) continue;
        if (F.tid < 256) { const int ch = F.tid & 63, sg = F.tid >> 6; float run = 0.f;
#pragma unroll
            for (int s = 0; s < 16; ++s) { run += fL[(16 * sg + s) * TP + ch]; fL[(16 * sg + s) * TP + ch] = run; }
            tot[sg * 64 + ch] = run; }
        __syncthreads();
        if (F.tid < 256) { const int ch = F.tid & 63, sg = F.tid >> 6; float off = 0.f;
            for (int s2 = 0; s2 < sg; ++s2) off += tot[s2 * 64 + ch];
            if (sg > 0) {
#pragma unroll
                for (int s = 0; s < 16; ++s) fL[(16 * sg + s) * TP + ch] += off; } }
        __syncthreads();
        if (stop <= 3) continue;
        {
#pragma unroll
            for (int n2 = 0; n2 < 2; ++n2) { const int chl = 16 * (2 * hw + n2) + r16;
                float vv[4];
#pragma unroll
                for (int rg = 0; rg < 4; ++rg) { const int e = 4 * n2 + rg; const int tk = 16 * mtw + 4 * q + rg;
                    const float cw = fL[tk * TP + chl]; const float ecw = fexp(cw), ecx = fexp(cw - elw[e]), ein = fexp(-cw);
                    const float at = ena[e] * ecx;
                    fA[tk * TP + chl] = at; bA[tk * BP + chl] = (unsigned short)f2bf(at); bR[tk * BP + chl] = (unsigned short)f2bf(er[e] * ecw);
                    bB[tk * BP + chl] = (unsigned short)f2bf(ebb[e] * ein); bK[tk * BP + chl] = (unsigned short)f2bf(ekp[e] * ein); vv[rg] = ev[e];
                    if (tk == 63) ((GAS float*)(chd + 49152))[chl] = ecw; }
                *(LAS v2u*)(bVT + chl * BP + 16 * mtw + 4 * q) = (v2u){pk2(vv[0], vv[1]), pk2(vv[2], vv[3])};
            }
        }
        __syncthreads();
        if (stop <= 4) continue;
        { const int kind = w >> 1;
#pragma unroll 1
          for (int tix = 0; tix < 8; ++tix) { const int tile = (w & 1) * 8 + tix; const int mt = tile >> 2, nt = tile & 3;
            f32x4 acc = (f32x4){0.f, 0.f, 0.f, 0.f};
            if (kind == 3) {
                acc = mma_nt64(bA, 16 * mt, bB, 16 * nt, r16, q, acc);
                const int i = 16 * nt + r16;
#pragma unroll
                for (int rg = 0; rg < 4; ++rg) { const int t = 16 * mt + 4 * q + rg; fX[t * TP + i] = (i < t) ? acc[rg] : 0.f; }
            } else {
                const lbf* Pm = (kind == 2) ? bB : bK; const lbf* Qm = (kind == 0) ? bA : bR; lbf* dst = (kind == 0) ? bMak : (kind == 1) ? bMrk : bMrb;
                acc = mma_nt64(Pm, 16 * nt, Qm, 16 * mt, r16, q, acc);
                const int t = 16 * mt + r16; float o[4];
#pragma unroll
                for (int rg = 0; rg < 4; ++rg) { const int i = 16 * nt + 4 * q + rg; o[rg] = ((kind == 0) ? (i < t) : (i <= t)) ? acc[rg] : 0.f; }
                *(LAS v2u*)(dst + t * BP + 16 * nt + 4 * q) = (v2u){pk2(o[0], o[1]), pk2(o[2], o[3])};
            } } }
        __syncthreads();
        if (stop <= 5) continue;
        { const int mt = w & 3;
#pragma unroll 1
          for (int nt = 0; nt < 4; ++nt) {
            f32x4 acc = (f32x4){0.f, 0.f, 0.f, 0.f};
            if (w < 4) { acc = mma_nt64(bMak, 16 * mt, bVT, 16 * nt, r16, q, acc);
#pragma unroll
                for (int rg = 0; rg < 4; ++rg) fT[(16 * mt + 4 * q + rg) * TP + 16 * nt + r16] = acc[rg]; }
            else { acc = mma_nt64(bVT, 16 * nt, bMrk, 16 * mt, r16, q, acc);
                *(GAS f32x4*)((GAS float*)(cod + 16384) + (16 * mt + r16) * 64 + 16 * nt + 4 * q) = acc; } } }
        __syncthreads();
        if (stop <= 6) continue;
        if (w == 0) {
            const int blk = lane >> 4, col = lane & 15; const LAS float* Nb = fX + (16 * blk) * TP + 16 * blk;
            float tv[16];
#pragma unroll
            for (int r = 0; r < 16; ++r) tv[r] = (r == col) ? 1.f : 0.f;
#pragma unroll
            for (int i = 0; i < 15; ++i) {
#pragma unroll
                for (int r = i + 1; r < 16; ++r) tv[r] += Nb[r * TP + i] * tv[i]; }
#pragma unroll
            for (int r = 0; r < 16; ++r) tbb[(blk * 16 + r) * 16 + col] = tv[r];
        } else {
            for (int pz = F.tid - 64; pz < 512; pz += 448) { const int row = pz >> 3, sub = pz & 7; const int s_ = sub >> 2, q_ = sub & 3; const int i0 = 32 * s_ + 4 * q_, i1 = i0 + 16;
                *(GAS v4u*)(cod + pz * 16) = *(const LAS v4u*)(bR + row * BP + 8 * sub);
                *(GAS v4u*)(cod + 8192 + pz * 16) = *(const LAS v4u*)(bMrb + row * BP + 8 * sub);
                { const v2u a = *(const LAS v2u*)(bVT + row * BP + i0), b2 = *(const LAS v2u*)(bVT + row * BP + i1); *(GAS v4u*)(chd + 24576 + pz * 16) = (v4u){a.x, a.y, b2.x, b2.y}; }
                unsigned e[8];
#pragma unroll
                for (int j = 0; j < 8; ++j) e[j] = bB[((j < 4 ? i0 : i1) + (j & 3)) * BP + row];
                *(GAS v4u*)(chd + 8192 + pz * 16) = (v4u){e[0] | (e[1] << 16), e[2] | (e[3] << 16), e[4] | (e[5] << 16), e[6] | (e[7] << 16)};
#pragma unroll
                for (int j = 0; j < 8; ++j) e[j] = bK[((j < 4 ? i0 : i1) + (j & 3)) * BP + row];
                *(GAS v4u*)(chd + 16384 + pz * 16) = (v4u){e[0] | (e[1] << 16), e[2] | (e[3] << 16), e[4] | (e[5] << 16), e[6] | (e[7] << 16)}; }
        }
        __syncthreads();
        { LAS float* tile = (w < 4) ? fA : fT; const int c0 = 16 * (w & 3) + r16;
          f32x4 X[4];
#pragma unroll
          for (int bb = 0; bb < 4; ++bb) {
              f32x4 acc;
#pragma unroll
              for (int rg = 0; rg < 4; ++rg) acc[rg] = tile[(16 * bb + 4 * q + rg) * TP + c0];
#pragma unroll
              for (int b2 = 0; b2 < 4; ++b2) if (b2 < bb) { const f32x4 af = *(const LAS f32x4*)(fX + (16 * bb + r16) * TP + 16 * b2 + 4 * q);
#pragma unroll
                  for (int s = 0; s < 4; ++s) acc = __builtin_amdgcn_mfma_f32_16x16x4f32(af[s], X[b2][s], acc, 0, 0, 0); }
              const f32x4 tf = *(const LAS f32x4*)(tbb + (bb * 16 + r16) * 16 + 4 * q);
              f32x4 xb = (f32x4){0.f, 0.f, 0.f, 0.f};
#pragma unroll
              for (int s = 0; s < 4; ++s) xb = __builtin_amdgcn_mfma_f32_16x16x4f32(tf[s], acc[s], xb, 0, 0, 0);
              X[bb] = xb;
#pragma unroll
              for (int rg = 0; rg < 4; ++rg) tile[(16 * bb + 4 * q + rg) * TP + c0] = xb[rg];
          } }
        __syncthreads();
        if (stop <= 7) continue;
        { const int row = F.tid >> 3, sub = F.tid & 7; const int s_ = sub >> 2, q_ = sub & 3; const int i0 = 32 * s_ + 4 * q_, i1 = i0 + 16;
          const f32x4 a = *(const LAS f32x4*)(fA + row * TP + i0), bq = *(const LAS f32x4*)(fA + row * TP + i1);
          *(GAS v4u*)(chd + F.tid * 16) = (v4u){pk2(a.x, a.y), pk2(a.z, a.w), pk2(bq.x, bq.y), pk2(bq.z, bq.w)};
#pragma unroll
          for (int hh = 0; hh < 2; ++hh) { const int pz = F.tid + 512 * hh; const int v = pz >> 4, t4 = (pz & 15) * 4;
              *(GAS f32x4*)(chd + 32768 + pz * 16) = (f32x4){fT[(t4 + 0) * TP + v], fT[(t4 + 1) * TP + v], fT[(t4 + 2) * TP + v], fT[(t4 + 3) * TP + v]}; } }
        __syncthreads();
    }
}
__device__ __forceinline__ void lora_convert(Frame& F) {
    const int gt = F.vcu * (NWAVES * 64) + F.tid, NT_ = F.G * NWAVES * 64;
    for (int l = 0; l < DEPTH; ++l) {
        bf16* base = (bf16*)(F.ws + WS_LORA + (size_t)l * LORA_L);
        const GAS float* w2 = INP(I_W2) + (size_t)l * 64 * RW; const GAS float* a2 = INP(I_A2) + (size_t)l * 64 * RW; const GAS float* g2 = INP(I_G2) + (size_t)l * 128 * RW; const GAS float* v2 = INP(I_V2);
        for (int i = gt; i < RW * 64; i += NT_) { const int ch = i >> 6, j = i & 63; base[i] = (bf16)f2bf(w2[(size_t)j * RW + ch]); base[24576 + i] = (bf16)f2bf(a2[(size_t)j * RW + ch]); }
        for (int i = gt; i < RW * 128; i += NT_) { const int ch = i >> 7, j = i & 127; base[49152 + i] = (bf16)f2bf(g2[(size_t)j * RW + ch]); }
        if (l == 1) for (int i = gt; i < RW * 32; i += NT_) { const int ch = i >> 5, j = i & 31; base[98304 + i] = (bf16)f2bf(v2[(size_t)j * RW + ch]); }
    }
}

__device__ __forceinline__ void rwkv_chunk_out_mfma(Frame& F, int l) {
    const GAS float* gv = WSP(float, WS_RV); const GAS float* gg = WSP(float, WS_RG); const GAS float* sbp = WSP(float, WS_RSB);
    GAS bf16* ycat = WSP(bf16, WS_YCAT);
    const int gw = F.vcu * NWAVES + F.wave, NGW = F.G * NWAVES, lane = F.lane, r16 = lane & 15, q = lane >> 4;
    for (int wi = gw; wi < NITEM * 4; wi += NGW) {
        const int item = wi >> 2, mt = wi & 3;
        const int h = item % 6, bc = item / 6, c = bc % NCH, b = bc / NCH; const size_t tokb = (size_t)b * SEQ + 64 * c;
        const int ci = (b * 6 + h) * NCH + c;
        const GAS unsigned char* cod = F.ws + WS_RCO + (size_t)ci * CO_STRIDE;
        const GAS unsigned char* s0 = F.ws + WS_RS0 + (size_t)ci * 8192; const GAS unsigned char* ut = F.ws + WS_RUT + (size_t)ci * 8192;
        const int t = 16 * mt + r16; const size_t tok = tokb + t;
        bf16x8_t rq[2], mb[2];
#pragma unroll
        for (int s = 0; s < 2; ++s) { rq[s] = *(const GAS bf16x8_t*)(cod + (t * 64 + 32 * s + 8 * q) * 2); mb[s] = *(const GAS bf16x8_t*)(cod + 8192 + (t * 64 + 32 * s + 8 * q) * 2); }
        f32x4 y[4];
#pragma unroll
        for (int nt = 0; nt < 4; ++nt) {
            y[nt] = *(const GAS f32x4*)(cod + 16384 + (t * 64 + 16 * nt + 4 * q) * 4);
#pragma unroll
            for (int s = 0; s < 2; ++s) { const bf16x8_t a = *(const GAS bf16x8_t*)(s0 + ((16 * nt + r16) * 64 + 32 * s + 8 * q) * 2); y[nt] = __builtin_amdgcn_mfma_f32_16x16x32_bf16(a, rq[s], y[nt], 0, 0, 0); }
#pragma unroll
            for (int s = 0; s < 2; ++s) { const bf16x8_t a = *(const GAS bf16x8_t*)(ut + ((16 * nt + r16) * 64 + 32 * s + 8 * q) * 2); y[nt] = __builtin_amdgcn_mfma_f32_16x16x32_bf16(a, mb[s], y[nt], 0, 0, 0); }
        }
        float sum = 0.f;
#pragma unroll
        for (int nt = 0; nt < 4; ++nt) sum += (y[nt][0] + y[nt][1]) + (y[nt][2] + y[nt][3]);
        sum += __shfl_xor(sum, 16); sum += __shfl_xor(sum, 32);
        const float mean = sum * (1.f / 64.f); float vs = 0.f;
#pragma unroll
        for (int nt = 0; nt < 4; ++nt) { y[nt] = y[nt] - mean; vs += (y[nt][0] * y[nt][0] + y[nt][1] * y[nt][1]) + (y[nt][2] * y[nt][2] + y[nt][3] * y[nt][3]); }
        vs += __shfl_xor(vs, 16); vs += __shfl_xor(vs, 32);
        const float rstd = frsq(vs * (1.f / 64.f) + GN_EPS);
        const float sbv = sbp[tok * 8 + h];
#pragma unroll
        for (int nt = 0; nt < 4; ++nt) { const int v0 = 16 * nt + 4 * q;
            const f32x4 lg = *(const GAS f32x4*)(INP(I_LNXG) + l * RW + 64 * h + v0), lb = *(const GAS f32x4*)(INP(I_LNXB) + l * RW + 64 * h + v0);
            const f32x4 vv = *(const GAS f32x4*)(gv + tok * RW + 64 * h + v0), g4 = *(const GAS f32x4*)(gg + tok * RW + 64 * h + v0);
            const f32x4 r = (y[nt] * rstd * lg + lb + vv * sbv) * g4;
            *(GAS v2u*)(ycat + tok * D + 256 + 64 * h + v0) = (v2u){pk2(r[0], r[1]), pk2(r[2], r[3])}; }
    }
}

constexpr int C2_STAGE = 30720;
__device__ __forceinline__ void rwkv_chain2(Frame& F) {
    const int id = blockIdx.x;
    if (id >= 48) return;
    const int bh = id % 12, vb = id / 12;
    const GAS unsigned char* src = F.ws + WS_RCH + (size_t)bh * NCH * CH_STRIDE;
    GAS unsigned char* s0g = F.ws + WS_RS0 + (size_t)bh * NCH * 8192; GAS unsigned char* utg = F.ws + WS_RUT + (size_t)bh * NCH * 8192;
    LAS unsigned char* ring = F.lds + RING_OFF;
    const int lane = F.lane, q = lane >> 4, r16 = lane & 15;
#define C2_BAR() do { asm volatile("s_waitcnt lgkmcnt(0)" ::: "memory"); __builtin_amdgcn_s_barrier(); asm volatile("" ::: "memory"); } while (0)
    if (F.wave >= 4) {
        const int lt = F.tid - 256;
        const int o6 = (lt < 128) ? (24576 + vb * 2048 + lt * 16) : (32768 + vb * 4096 + (lt - 128) * 16);
        const int d6 = (lt < 128) ? (24576 + lt * 16) : (26624 + (lt - 128) * 16);
        const int l7 = lt & 127; const int o7 = 32768 + vb * 4096 + 2048 + l7 * 16; const int d7 = 26624 + 2048 + l7 * 16;
        v4u RA[8], RB[8];
#define C2_LOAD(R, c) do { const GAS unsigned char* g_ = src + (size_t)(c) * CH_STRIDE; _Pragma("unroll") for (int p = 0; p < 6; ++p) R[p] = *(const GAS v4u*)(g_ + (p * 256 + lt) * 16); \
            R[6] = *(const GAS v4u*)(g_ + o6); R[7] = *(const GAS v4u*)(g_ + o7); } while (0)
#define C2_WRITE(R, c) do { LAS unsigned char* st_ = ring + ((c) & 3) * C2_STAGE; _Pragma("unroll") for (int p = 0; p < 6; ++p) *(LAS v4u*)(st_ + (p * 256 + lt) * 16) = R[p]; \
            *(LAS v4u*)(st_ + d6) = R[6]; *(LAS v4u*)(st_ + d7) = R[7]; } while (0)
        C2_LOAD(RA, 0); C2_LOAD(RB, 1); C2_WRITE(RA, 0); C2_LOAD(RA, 2); C2_WRITE(RB, 1); C2_LOAD(RB, 3); C2_WRITE(RA, 2); C2_LOAD(RA, 4);
        C2_BAR();
        for (int c = 0; c < NCH; c += 2) {
            if (c + 3 < NCH) { C2_WRITE(RB, c + 3); if (c + 5 < NCH) C2_LOAD(RB, c + 5); }
            C2_BAR();
            if (c + 4 < NCH) { C2_WRITE(RA, c + 4); if (c + 6 < NCH) C2_LOAD(RA, c + 6); }
            C2_BAR();
        }
#undef C2_LOAD
#undef C2_WRITE
    } else if (F.wave == 0) {
        const int vrow = 16 * vb + r16;
        f32x4 sacc[4]; bf16x8_t sb[2];
#pragma unroll
        for (int i = 0; i < 4; ++i) sacc[i] = (f32x4){0.f, 0.f, 0.f, 0.f};
        sb[0] = (bf16x8_t){0, 0, 0, 0, 0, 0, 0, 0}; sb[1] = sb[0];
        f32x4 gln[4];
#pragma unroll
        for (int kt = 0; kt < 4; ++kt) gln[kt] = *(const GAS f32x4*)(src + 49152 + (16 * kt + 4 * q) * 4);
        C2_BAR();
        for (int c = 0; c < NCH; ++c) {
            const LAS unsigned char* st = ring + (c & 3) * C2_STAGE;
            f32x4 glc[4];
#pragma unroll
            for (int kt = 0; kt < 4; ++kt) glc[kt] = gln[kt];
            { const int cn = (c + 1 < NCH) ? c + 1 : c;
#pragma unroll
              for (int kt = 0; kt < 4; ++kt) gln[kt] = *(const GAS f32x4*)(src + (size_t)cn * CH_STRIDE + 49152 + (16 * kt + 4 * q) * 4); }
            { GAS v2u* o = (GAS v2u*)(s0g + (size_t)c * 8192 + (vrow * 64 + 4 * q) * 2);
              const v4u w0 = __builtin_bit_cast(v4u, sb[0]), w1 = __builtin_bit_cast(v4u, sb[1]);
              o[0] = (v2u){w0.x, w0.y}; o[4] = (v2u){w0.z, w0.w}; o[8] = (v2u){w1.x, w1.y}; o[12] = (v2u){w1.z, w1.w}; }
            f32x4 u[4];
#pragma unroll
            for (int tt = 0; tt < 4; ++tt) {
                u[tt] = *(const LAS f32x4*)(st + 26624 + (r16 * 64 + 16 * tt + 4 * q) * 4);
#pragma unroll
                for (int s = 0; s < 2; ++s) { const bf16x8_t a = *(const LAS bf16x8_t*)(st + ((16 * tt + r16) * 64 + 32 * s + 8 * q) * 2); u[tt] = __builtin_amdgcn_mfma_f32_16x16x32_bf16(a, sb[s], u[tt], 0, 0, 0); }
            }
            bf16x8_t ub[2];
            { v4u w0, w1; w0.x = cvtpk(u[0][0], u[0][1]); w0.y = cvtpk(u[0][2], u[0][3]); w0.z = cvtpk(u[1][0], u[1][1]); w0.w = cvtpk(u[1][2], u[1][3]);
              w1.x = cvtpk(u[2][0], u[2][1]); w1.y = cvtpk(u[2][2], u[2][3]); w1.z = cvtpk(u[3][0], u[3][1]); w1.w = cvtpk(u[3][2], u[3][3]);
              ub[0] = __builtin_bit_cast(bf16x8_t, w0); ub[1] = __builtin_bit_cast(bf16x8_t, w1);
              GAS v2u* o = (GAS v2u*)(utg + (size_t)c * 8192 + (vrow * 64 + 4 * q) * 2);
              o[0] = (v2u){w0.x, w0.y}; o[4] = (v2u){w0.z, w0.w}; o[8] = (v2u){w1.x, w1.y}; o[12] = (v2u){w1.z, w1.w}; }
            bf16x8_t vbf[2];
#pragma unroll
            for (int s = 0; s < 2; ++s) vbf[s] = *(const LAS bf16x8_t*)(st + 24576 + (r16 * 64 + 32 * s + 8 * q) * 2);
#pragma unroll
            for (int kt = 0; kt < 4; ++kt) {
#pragma unroll
                for (int s = 0; s < 2; ++s) { const bf16x8_t a = *(const LAS bf16x8_t*)(st + 16384 + ((16 * kt + r16) * 64 + 32 * s + 8 * q) * 2); sacc[kt] = __builtin_amdgcn_mfma_f32_16x16x32_bf16(a, vbf[s], sacc[kt], 0, 0, 0); }
#pragma unroll
                for (int s = 0; s < 2; ++s) { const bf16x8_t a = *(const LAS bf16x8_t*)(st + 8192 + ((16 * kt + r16) * 64 + 32 * s + 8 * q) * 2); sacc[kt] = __builtin_amdgcn_mfma_f32_16x16x32_bf16(a, ub[s], sacc[kt], 0, 0, 0); }
                sacc[kt] = sacc[kt] * glc[kt];
            }
            { v4u w0, w1; w0.x = cvtpk(sacc[0][0], sacc[0][1]); w0.y = cvtpk(sacc[0][2], sacc[0][3]); w0.z = cvtpk(sacc[1][0], sacc[1][1]); w0.w = cvtpk(sacc[1][2], sacc[1][3]);
              w1.x = cvtpk(sacc[2][0], sacc[2][1]); w1.y = cvtpk(sacc[2][2], sacc[2][3]); w1.z = cvtpk(sacc[3][0], sacc[3][1]); w1.w = cvtpk(sacc[3][2], sacc[3][3]);
              sb[0] = __builtin_bit_cast(bf16x8_t, w0); sb[1] = __builtin_bit_cast(bf16x8_t, w1); }
            C2_BAR();
        }
    } else {
        C2_BAR();
        for (int c = 0; c < NCH; ++c) C2_BAR();
    }
#undef C2_BAR
}


__device__ __forceinline__ void mlstm_prep(Frame& F, int l) {
    const GAS float* p = WSP(float, WS_P);
    LAS unsigned char* L = F.lds + RING_OFF;
    lbf* tKW = (lbf*)(L + 0); lbf* tVT = (lbf*)(L + 9216); LAS float* we = (LAS float*)(L + 18432);
    GAS float* kvT = WSP(float, WS_MKV); GAS float* nloc = WSP(float, WS_MNL); GAS float* msc = WSP(float, WS_MSC); GAS float* G = WSP(float, WS_MLG); GAS float* IG = WSP(float, WS_MLI);
    GAS bf16* QC = WSP(bf16, WS_MQC); GAS bf16* KC = WSP(bf16, WS_MKC);
    const int lane = F.lane, r16 = lane & 15, q = lane >> 4, w = F.wave;
    for (int item = F.vcu; item < NITEM; item += F.G) {
        const int h = item % 6, bc = item / 6, c = bc % NCH, b = bc / NCH; const size_t tokb = (size_t)b * SEQ + 64 * c;
        if (w == 0) {
            const size_t tok = tokb + lane;
            const float ig = p[tok * PC + P_ML + 1536 + h] + INP(I_BI)[l * 6 + h];
            const float lf = logsigmoidf_(p[tok * PC + P_ML + 1542 + h] + INP(I_BF)[l * 6 + h]);
            float g = lf;
#pragma unroll
            for (int o = 1; o < 64; o <<= 1) { const float t = __shfl_up(g, o); if (lane >= o) g += t; }
            const float glast = __shfl(g, 63);
            const float e = glast - g + ig; const float mloc = wave_max(e);
            we[lane] = fexp(e - mloc);
            G[item * 64 + lane] = g; IG[item * 64 + lane] = ig;
            if (lane == 0) { msc[item * 4 + 0] = mloc; msc[item * 4 + 1] = glast; }
        }
        __syncthreads();
        { const GAS float* cwb = INP(I_CONVW) + (size_t)l * 4 * 768 + 64 * h; const GAS float* cbb = INP(I_CONVB) + l * 768 + 64 * h;
#pragma unroll
          for (int which = 0; which < 2; ++which)
#pragma unroll
            for (int it = 0; it < 2; ++it) { const int idx = F.tid + 512 * it; const int s = idx >> 4, d4 = (idx & 15) * 4; const int tl = 64 * c + s; const size_t tok = tokb + s;
                const int pcol = P_ML + which * 384 + 64 * h + d4;
                f32x4 acc = *(const GAS f32x4*)(cbb + which * 384 + d4);
                f32x4 xs_[4], ws_[4];
#pragma unroll
                for (int i = 0; i < 4; ++i) { const int tt = tl - 3 + i; xs_[i] = *(const GAS f32x4*)(p + (tt >= 0 ? tok - 3 + i : tok) * PC + pcol); ws_[i] = *(const GAS f32x4*)(cwb + i * 768 + which * 384 + d4); }
#pragma unroll
                for (int i = 0; i < 4; ++i) { const int tt = tl - 3 + i; if (tt >= 0) acc = acc + ws_[i] * xs_[i]; }
                f32x4 y;
#pragma unroll
                for (int e = 0; e < 4; ++e) y[e] = acc[e] * sigmoidf_(acc[e]);
                if (which == 0) { y = y * 0.125f; *(GAS v2u*)(QC + tok * 384 + 64 * h + d4) = (v2u){pk2(y[0], y[1]), pk2(y[2], y[3])}; }
                else { *(GAS v2u*)(KC + tok * 384 + 64 * h + d4) = (v2u){pk2(y[0], y[1]), pk2(y[2], y[3])}; const float wsc = we[s];
#pragma unroll
                    for (int e = 0; e < 4; ++e) tKW[(d4 + e) * BP + s] = (unsigned short)f2bf(y[e] * wsc); } }
#pragma unroll
          for (int it = 0; it < 2; ++it) { const int idx = F.tid + 512 * it; const int s = idx >> 4, d4 = (idx & 15) * 4; const size_t tok = tokb + s;
              const f32x4 x = *(const GAS f32x4*)(p + tok * PC + P_ML + 768 + 64 * h + d4);
#pragma unroll
              for (int e = 0; e < 4; ++e) tVT[(d4 + e) * BP + s] = (unsigned short)f2bf(x[e]); } }
        __syncthreads();
#pragma unroll
        for (int n2 = 0; n2 < 2; ++n2) { const int kt = w >> 1, nt = 2 * (w & 1) + n2;
            f32x4 acc = (f32x4){0.f, 0.f, 0.f, 0.f};
            acc = mma_nt64(tKW, 16 * kt, tVT, 16 * nt, r16, q, acc);
            *(GAS f32x4*)(kvT + (size_t)item * 4096 + (16 * nt + r16) * 64 + 16 * kt + 4 * q) = acc; }
        if (F.tid < 64) { float a = 0.f;
#pragma unroll 8
            for (int s = 0; s < 64; ++s) a += bf2f(tKW[F.tid * BP + s]);
            nloc[item * 64 + F.tid] = a; }
        { const int row = F.tid >> 3, sub = F.tid & 7; const int s_ = sub >> 2, q_ = sub & 3; const int i0 = 32 * s_ + 4 * q_, i1 = i0 + 16;
          const v2u a = *(const LAS v2u*)(tVT + row * BP + i0), b2 = *(const LAS v2u*)(tVT + row * BP + i1);
          *(GAS v4u*)(F.ws + WS_MVT + (size_t)item * 8192 + F.tid * 16) = (v4u){a.x, a.y, b2.x, b2.y}; }
        __syncthreads();
    }
}
__device__ __forceinline__ void mlstm_scan2(Frame& F) {
    if (blockIdx.x < 48) return;
    const int gt = ((int)blockIdx.x - 48) * (NWAVES * 64) + F.tid;
    const GAS float* msc = WSP(float, WS_MSC); GAS float* mscw = WSP(float, WS_MSC);
    if (gt < 12 * 2048) {
        const int bh = gt >> 11, el = (gt & 2047) * 2, b = bh / 6, h = bh % 6;
        const GAS float* src = WSP(float, WS_MKV); GAS bf16* dst = WSP(bf16, WS_MCP);
        float C0 = 0.f, C1 = 0.f, m = 0.f;
        for (int c0 = 0; c0 < NCH; c0 += 8) {
            float x0[8], x1[8], ml[8], gl[8];
#pragma unroll
            for (int i = 0; i < 8; ++i) { const int item = (b * NCH + c0 + i) * 6 + h; ml[i] = msc[item * 4 + 0]; gl[i] = msc[item * 4 + 1];
                const GAS float* s2 = src + (size_t)item * 4096 + el; x0[i] = s2[0]; x1[i] = s2[1]; }
#pragma unroll
            for (int i = 0; i < 8; ++i) { const int item = (b * NCH + c0 + i) * 6 + h;
                *(GAS unsigned*)(dst + (size_t)item * 4096 + el) = pk2(C0, C1);
                if (el == 0) mscw[item * 4 + 2] = m;
                const float mn = fmaxf(gl[i] + m, ml[i]); const float ao = fexp(gl[i] + m - mn), an = fexp(ml[i] - mn);
                C0 = ao * C0 + an * x0[i]; C1 = ao * C1 + an * x1[i]; m = mn; }
        }
    } else if (gt < 12 * 2048 + 12 * 64) {
        const int g2 = gt - 12 * 2048; const int bh = g2 >> 6, el = g2 & 63, b = bh / 6, h = bh % 6;
        const GAS float* src = WSP(float, WS_MNL); GAS float* dst = WSP(float, WS_MNP);
        float N = 0.f, m = 0.f;
        for (int c0 = 0; c0 < NCH; c0 += 8) {
            float x[8], ml[8], gl[8];
#pragma unroll
            for (int i = 0; i < 8; ++i) { const int item = (b * NCH + c0 + i) * 6 + h; ml[i] = msc[item * 4 + 0]; gl[i] = msc[item * 4 + 1]; x[i] = src[item * 64 + el]; }
#pragma unroll
            for (int i = 0; i < 8; ++i) { const int item = (b * NCH + c0 + i) * 6 + h;
                dst[item * 64 + el] = N;
                const float mn = fmaxf(gl[i] + m, ml[i]); const float ao = fexp(gl[i] + m - mn), an = fexp(ml[i] - mn);
                N = ao * N + an * x[i]; m = mn; }
        }
    }
}
__device__ __forceinline__ void mlstm_out_mfma(Frame& F, int l) {
    const GAS float* p = WSP(float, WS_P); const GAS bf16* QC = WSP(bf16, WS_MQC); const GAS bf16* KC = WSP(bf16, WS_MKC);
    const GAS float* G = WSP(float, WS_MLG); const GAS float* IG = WSP(float, WS_MLI); const GAS float* msc = WSP(float, WS_MSC); const GAS float* NP = WSP(float, WS_MNP);
    GAS bf16* ycat = WSP(bf16, WS_YCAT);
    const int gw = F.vcu * NWAVES + F.wave, NGW = F.G * NWAVES, lane = F.lane, r16 = lane & 15, q = lane >> 4;
    for (int wi = gw; wi < NITEM * 4; wi += NGW) {
        const int item = wi >> 2, jt = wi & 3;
        const int h = item % 6, bc = item / 6, c = bc % NCH, b = bc / NCH; const size_t tokb = (size_t)b * SEQ + 64 * c;
        const int j = 16 * jt + r16; const size_t tokj = tokb + j;
        const GAS unsigned char* vtp = F.ws + WS_MVT + (size_t)item * 8192; const GAS bf16* cpT = WSP(bf16, WS_MCP) + (size_t)item * 4096;
        bf16x8_t qf[2];
#pragma unroll
        for (int ss = 0; ss < 2; ++ss) qf[ss] = *(const GAS bf16x8_t*)(QC + tokj * 384 + 64 * h + 32 * ss + 8 * q);
        const float gj = G[item * 64 + j]; const float mprev = msc[item * 4 + 2];
        f32x4 sv[4], dl[4]; float mx = -INFINITY;
#pragma unroll
        for (int nt = 0; nt < 4; ++nt) {
            f32x4 acc = (f32x4){0.f, 0.f, 0.f, 0.f};
            if (nt <= jt) {
#pragma unroll
                for (int ss = 0; ss < 2; ++ss) { const bf16x8_t a = *(const GAS bf16x8_t*)(KC + (tokb + 16 * nt + r16) * 384 + 64 * h + 32 * ss + 8 * q); acc = __builtin_amdgcn_mfma_f32_16x16x32_bf16(a, qf[ss], acc, 0, 0, 0); } }
            sv[nt] = acc;
            const f32x4 gs = *(const GAS f32x4*)(G + item * 64 + 16 * nt + 4 * q), is = *(const GAS f32x4*)(IG + item * 64 + 16 * nt + 4 * q);
#pragma unroll
            for (int rg = 0; rg < 4; ++rg) { const int s = 16 * nt + 4 * q + rg; dl[nt][rg] = (s <= j) ? (gj - gs[rg] + is[rg]) : -INFINITY; mx = fmaxf(mx, dl[nt][rg]); }
        }
        mx = fmaxf(mx, __shfl_xor(mx, 16)); mx = fmaxf(mx, __shfl_xor(mx, 32));
        const float il = gj + mprev; const float mj = fmaxf(mx, il);
        float dsum = 0.f;
#pragma unroll
        for (int nt = 0; nt < 4; ++nt)
#pragma unroll
            for (int rg = 0; rg < 4; ++rg) { const float wgt = fexp(dl[nt][rg] - mj) * sv[nt][rg]; sv[nt][rg] = wgt; dsum += wgt; }
        dsum += __shfl_xor(dsum, 16); dsum += __shfl_xor(dsum, 32);
        float qn = 0.f;
#pragma unroll
        for (int ss = 0; ss < 2; ++ss) { const f32x4 n0 = *(const GAS f32x4*)(NP + item * 64 + 32 * ss + 8 * q), n1 = *(const GAS f32x4*)(NP + item * 64 + 32 * ss + 8 * q + 4);
            const v4u qw = __builtin_bit_cast(v4u, qf[ss]);
            qn += bf2f(qw.x & 0xffffu) * n0[0] + bf2f(qw.x >> 16) * n0[1] + bf2f(qw.y & 0xffffu) * n0[2] + bf2f(qw.y >> 16) * n0[3]
                + bf2f(qw.z & 0xffffu) * n1[0] + bf2f(qw.z >> 16) * n1[1] + bf2f(qw.w & 0xffffu) * n1[2] + bf2f(qw.w >> 16) * n1[3]; }
        qn += __shfl_xor(qn, 16); qn += __shfl_xor(qn, 32);
        const float wi_ = fexp(il - mj); const float den = dsum + wi_ * qn; const float dinv = frcp(fmaxf(fabsf(den), fexp(-mj)));
        bf16x8_t wb[2], qs[2];
#pragma unroll
        for (int ss = 0; ss < 2; ++ss) { v4u w_; w_.x = cvtpk(sv[2 * ss][0], sv[2 * ss][1]); w_.y = cvtpk(sv[2 * ss][2], sv[2 * ss][3]); w_.z = cvtpk(sv[2 * ss + 1][0], sv[2 * ss + 1][1]); w_.w = cvtpk(sv[2 * ss + 1][2], sv[2 * ss + 1][3]);
            wb[ss] = __builtin_bit_cast(bf16x8_t, w_);
            const v4u qw = __builtin_bit_cast(v4u, qf[ss]); v4u qo;
            qo.x = cvtpk(bf2f(qw.x & 0xffffu) * wi_, bf2f(qw.x >> 16) * wi_); qo.y = cvtpk(bf2f(qw.y & 0xffffu) * wi_, bf2f(qw.y >> 16) * wi_);
            qo.z = cvtpk(bf2f(qw.z & 0xffffu) * wi_, bf2f(qw.z >> 16) * wi_); qo.w = cvtpk(bf2f(qw.w & 0xffffu) * wi_, bf2f(qw.w >> 16) * wi_);
            qs[ss] = __builtin_bit_cast(bf16x8_t, qo); }
        f32x4 hv[4]; float sum = 0.f;
#pragma unroll
        for (int vt = 0; vt < 4; ++vt) {
            f32x4 acc = (f32x4){0.f, 0.f, 0.f, 0.f};
#pragma unroll
            for (int ss = 0; ss < 2; ++ss) { const bf16x8_t a = *(const GAS bf16x8_t*)(vtp + ((16 * vt + r16) * 64 + 32 * ss + 8 * q) * 2); acc = __builtin_amdgcn_mfma_f32_16x16x32_bf16(a, wb[ss], acc, 0, 0, 0); }
#pragma unroll
            for (int ss = 0; ss < 2; ++ss) { const bf16x8_t a = *(const GAS bf16x8_t*)(cpT + (16 * vt + r16) * 64 + 32 * ss + 8 * q); acc = __builtin_amdgcn_mfma_f32_16x16x32_bf16(a, qs[ss], acc, 0, 0, 0); }
            hv[vt] = acc * dinv; sum += (hv[vt][0] + hv[vt][1]) + (hv[vt][2] + hv[vt][3]);
        }
        sum += __shfl_xor(sum, 16); sum += __shfl_xor(sum, 32);
        const float mean = sum * (1.f / 64.f); float vs = 0.f;
#pragma unroll
        for (int vt = 0; vt < 4; ++vt) { hv[vt] = hv[vt] - mean; vs += (hv[vt][0] * hv[vt][0] + hv[vt][1] * hv[vt][1]) + (hv[vt][2] * hv[vt][2] + hv[vt][3] * hv[vt][3]); }
        vs += __shfl_xor(vs, 16); vs += __shfl_xor(vs, 32);
        const float rstd = frsq(vs * (1.f / 64.f) + LN_EPS);
#pragma unroll
        for (int vt = 0; vt < 4; ++vt) { const int v0 = 16 * vt + 4 * q;
            const f32x4 og = *(const GAS f32x4*)(p + tokj * PC + P_ML + 1152 + 64 * h + v0), ng = *(const GAS f32x4*)(INP(I_NORMG) + l * 384 + 64 * h + v0);
            float o[4];
#pragma unroll
            for (int e = 0; e < 4; ++e) o[e] = sigmoidf_(og[e]) * (hv[vt][e] * rstd * ng[e]);
            *(GAS v2u*)(ycat + tokj * D + 640 + 64 * h + v0) = (v2u){pk2(o[0], o[1]), pk2(o[2], o[3])}; }
    }
}

__device__ __forceinline__ void sub_barrier(gu32* cnt, unsigned target) {
    asm volatile("s_waitcnt vmcnt(0)" ::: "memory");
    __syncthreads();
    if (threadIdx.x == 0) {
        __builtin_amdgcn_fence(__ATOMIC_RELEASE, "agent");
        asm volatile("s_waitcnt vmcnt(0)" ::: "memory");
        __hip_atomic_fetch_add(cnt, 1u, RLX_AGENT);
        unsigned sp = 0;
        while (__hip_atomic_load(cnt, RLX_AGENT) < target) { __builtin_amdgcn_s_sleep(2); if (++sp > (1u << 22)) break; }
        __builtin_amdgcn_fence(__ATOMIC_ACQUIRE, "agent");
        asm volatile("s_waitcnt vmcnt(0)" ::: "memory");
    }
    __syncthreads();
}

__device__ __forceinline__ void router2(Frame& F, int l, const GAS float* h1) {
    LAS unsigned* hist = (LAS unsigned*)(F.lds + LDSCTL_OFF);
    const GAS bf16* whi = WSP(bf16, WS_RTW) + (size_t)l * 65536; const GAS bf16* wlo = whi + 32768;
    GAS int* tke = WSP(int, WS_TKE); GAS float* tkg = WSP(float, WS_TKG); GAS int* rnk = WSP(int, WS_RNK);
    const int lane = F.lane, r16 = lane & 15, q = lane >> 4;
    for (int grp = F.vcu; grp < T / 64; grp += F.G) {
        if (F.wave < 4) {
            const int tok = grp * 64 + 16 * F.wave + r16;
            f32x4 acc[2] = {(f32x4){0.f, 0.f, 0.f, 0.f}, (f32x4){0.f, 0.f, 0.f, 0.f}};
            const GAS float* hr = h1 + (size_t)tok * D + 8 * q;
#pragma unroll 4
            for (int ks = 0; ks < 32; ++ks) {
                const f32x4 x0 = *(const GAS f32x4*)(hr + 32 * ks), x1 = *(const GAS f32x4*)(hr + 32 * ks + 4);
                unsigned hi[4], lo[4];
                { const unsigned a0 = f2bf(x0[0]), a1 = f2bf(x0[1]), a2 = f2bf(x0[2]), a3 = f2bf(x0[3]), a4 = f2bf(x1[0]), a5 = f2bf(x1[1]), a6 = f2bf(x1[2]), a7 = f2bf(x1[3]);
                  hi[0] = a0 | (a1 << 16); hi[1] = a2 | (a3 << 16); hi[2] = a4 | (a5 << 16); hi[3] = a6 | (a7 << 16);
                  lo[0] = pk2(x0[0] - bf2f(a0), x0[1] - bf2f(a1)); lo[1] = pk2(x0[2] - bf2f(a2), x0[3] - bf2f(a3)); lo[2] = pk2(x1[0] - bf2f(a4), x1[1] - bf2f(a5)); lo[3] = pk2(x1[2] - bf2f(a6), x1[3] - bf2f(a7)); }
                const bf16x8_t bh = __builtin_bit_cast(bf16x8_t, (v4u){hi[0], hi[1], hi[2], hi[3]}), bl = __builtin_bit_cast(bf16x8_t, (v4u){lo[0], lo[1], lo[2], lo[3]});
#pragma unroll
                for (int nt = 0; nt < 2; ++nt) { const bf16x8_t ah = *(const GAS bf16x8_t*)(whi + (16 * nt + r16) * 1024 + 32 * ks + 8 * q), al = *(const GAS bf16x8_t*)(wlo + (16 * nt + r16) * 1024 + 32 * ks + 8 * q);
                    acc[nt] = __builtin_amdgcn_mfma_f32_16x16x32_bf16(ah, bh, acc[nt], 0, 0, 0); acc[nt] = __builtin_amdgcn_mfma_f32_16x16x32_bf16(ah, bl, acc[nt], 0, 0, 0); acc[nt] = __builtin_amdgcn_mfma_f32_16x16x32_bf16(al, bh, acc[nt], 0, 0, 0); }
            }
            float lv[8];
#pragma unroll
            for (int nt = 0; nt < 2; ++nt) { const f32x4 b4 = *(const GAS f32x4*)(INP(I_RTB) + l * NE + 16 * nt + 4 * q);
#pragma unroll
                for (int rg = 0; rg < 4; ++rg) lv[4 * nt + rg] = acc[nt][rg] + b4[rg]; }
            float tv[4]; int ti[4];
#pragma unroll
            for (int i = 0; i < 4; ++i) {
                float m = lv[0]; int mi = 4 * q;
#pragma unroll
                for (int e = 1; e < 8; ++e) { const int ge = 16 * (e >> 2) + 4 * q + (e & 3); if (lv[e] > m) { m = lv[e]; mi = ge; } }
#pragma unroll
                for (int o = 16; o < 64; o <<= 1) { const float om = __shfl_xor(m, o); const int oi = __shfl_xor(mi, o); if (om > m || (om == m && oi < mi)) { m = om; mi = oi; } }
                tv[i] = m; ti[i] = mi;
#pragma unroll
                for (int e = 0; e < 8; ++e) { const int ge = 16 * (e >> 2) + 4 * q + (e & 3); if (ge == mi) lv[e] = -INFINITY; }
            }
            const float e1 = fexp(tv[1] - tv[0]), e2 = fexp(tv[2] - tv[0]), e3 = fexp(tv[3] - tv[0]); const float inv = frcp(1.0f + e1 + e2 + e3);
            if (q == 0) {
                int rk[4];
#pragma unroll
                for (int i = 0; i < 4; ++i) rk[i] = (int)__hip_atomic_fetch_add(&hist[ti[i]], 1u, __ATOMIC_RELAXED, __HIP_MEMORY_SCOPE_WORKGROUP);
                *(GAS v4u*)(tke + tok * 4) = (v4u){(unsigned)ti[0], (unsigned)ti[1], (unsigned)ti[2], (unsigned)ti[3]};
                *(GAS f32x4*)(tkg + tok * 4) = (f32x4){inv, e1 * inv, e2 * inv, e3 * inv};
                *(GAS v4u*)(rnk + tok * 4) = (v4u){(unsigned)rk[0], (unsigned)rk[1], (unsigned)rk[2], (unsigned)rk[3]};
            }
        }
        __syncthreads();
        if (F.tid < NE) { const unsigned c = hist[F.tid]; const unsigned base = __hip_atomic_fetch_add(F.ctl + CW_CNT + l * NE + F.tid, c, RLX_AGENT);
            WSP(int, WS_WGB)[(l * 256 + grp) * 32 + F.tid] = (int)base; hist[F.tid] = 0u; }
        __syncthreads();
    }
}
__device__ __forceinline__ void assign2(Frame& F, int l) {
    LAS unsigned* pst = (LAS unsigned*)(F.lds + RING_OFF);
    const GAS int* tke = WSP(int, WS_TKE); const GAS float* tkg = WSP(float, WS_TKG); const GAS int* rnk = WSP(int, WS_RNK); GAS int* slot_of = WSP(int, WS_SLOT); GAS float* gsl = WSP(float, WS_GSL);
    const GAS bf16* h16 = WSP(bf16, WS_H16); GAS bf16* xg = WSP(bf16, WS_XG);
    const int lane = F.lane;
    for (int grp = F.vcu; grp < T / 64; grp += F.G) {
        if (F.tid == 0) {
            unsigned run = 0;
            for (int e = 0; e < NE; ++e) { const unsigned c = __hip_atomic_load(F.ctl + CW_CNT + l * NE + e, RLX_AGENT); pst[e] = run; const unsigned nbk = (c + 255u) >> 8;
                if (blockIdx.x == 0 && grp == F.vcu) for (unsigned k = 0; k < nbk; ++k) __hip_atomic_store(F.ctl + CW_BLKE + l * 320 + (run >> 8) + k, (unsigned)e, RLX_AGENT);
                run += nbk << 8; }
            if (blockIdx.x == 0 && grp == F.vcu) __hip_atomic_store(F.ctl + CW_NB + l, run >> 8, RLX_AGENT);
        }
        if (F.tid >= 64 && F.tid < 96) pst[32 + F.tid - 64] = (unsigned)WSP(int, WS_WGB)[(l * 256 + grp) * 32 + F.tid - 64];
        __syncthreads();
#pragma unroll 1
        for (int i = 0; i < 8; ++i) { const int tok = grp * 64 + 8 * F.wave + i;
            int slot = 0;
            if (lane < 4) { const int e = tke[tok * 4 + lane]; slot = (int)(pst[e] + pst[32 + e]) + rnk[tok * 4 + lane]; slot_of[tok * 4 + lane] = slot; gsl[slot] = tkg[tok * 4 + lane]; }
            const GAS v4u* src = (const GAS v4u*)(h16 + (size_t)tok * D) + lane; const v4u a = src[0], b = src[64];
#pragma unroll
            for (int k = 0; k < 4; ++k) { const int s = __shfl(slot, k); GAS v4u* dst = (GAS v4u*)(xg + (size_t)s * D) + lane; dst[0] = a; dst[64] = b; }
        }
        __syncthreads();
    }
}
__device__ __forceinline__ void router_convert(Frame& F) {
    const int gt = F.vcu * (NWAVES * 64) + F.tid, NT_ = F.G * NWAVES * 64;
    for (int i = gt; i < 2 * 32 * 1024; i += NT_) { const int l = i >> 15, e = (i >> 10) & 31, k = i & 1023;
        const float x = INP(I_RTW)[(size_t)l * D * NE + (size_t)k * NE + e]; const unsigned hi = f2bf(x);
        GAS bf16* base = WSP(bf16, WS_RTW) + (size_t)l * 65536; base[e * 1024 + k] = (bf16)hi; base[32768 + e * 1024 + k] = (bf16)f2bf(x - bf2f(hi)); }
}

#ifndef MK_N_LAUNCHES
#define MK_N_LAUNCHES 1
#endif
constexpr int PH_PER_LAYER = 11, N_PHASES = 1 + DEPTH * PH_PER_LAYER;
struct Args { const float* in[34]; float* out; unsigned char* ws; int ph_lo, ph_hi; };
__global__ void __launch_bounds__(NWAVES * 64, 2) mk_fwd(Args args) {
    extern __shared__ __attribute__((aligned(16))) unsigned char lds[];
    Frame F0;
    F0.lds = (LAS unsigned char*)lds;
    F0.MISC = (volatile LAS unsigned*)(F0.lds + MISC_OFF);
    F0.tid = threadIdx.x; F0.lane = F0.tid & 63; F0.wave = __builtin_amdgcn_readfirstlane(F0.tid >> 6);
    F0.G = gridDim.x; { const int bx = blockIdx.x; F0.vcu = (F0.G % 8 == 0) ? (bx % 8) * (F0.G / 8) + bx / 8 : bx; }
    F0.ws = (GAS unsigned char*)args.ws; F0.ctl = (gu32*)(args.ws + WS_CTL); F0.out = (GAS float*)args.out;
    for (int u = F0.tid; u < (LDS_BYTES - LDSCTL_OFF) / 4; u += NWAVES * 64) ((LAS unsigned*)(F0.lds + LDSCTL_OFF))[u] = 0u;
    __syncthreads();
    if (F0.tid < 34) *(LAS unsigned long long*)(F0.lds + PTR_OFF + 8 * F0.tid) = (unsigned long long)args.in[F0.tid];
    __syncthreads();
    XcdBarrier bar; bar.bar = (unsigned*)(F0.ctl + CW_BAR); bar.x = 0; bar.st = nullptr;
    const int lo = args.ph_lo, hi = args.ph_hi;
    if (hi - lo > 1) bar = xcd_barrier_post((unsigned*)(F0.ctl + CW_BAR), F0.MISC + 8);

#ifndef PROBE_KP
#define PROBE_KP (-1)
#define PROBE_REPS 1
#endif
#ifndef PROBE_STOP
#define PROBE_STOP 99
#endif
#ifndef PROBE_SUB
#define PROBE_SUB (-1)
#endif
#define SUBRUN(i) (rep == 0 || PROBE_SUB < 0 || PROBE_SUB == (i))
    for (int ph_ = lo; ph_ < hi; ++ph_) {
    const int ph = launder_s(ph_);
#if PROBE_REPS > 1
    const int nrep = ((ph == 0 && PROBE_KP == 100) || (ph > 0 && (ph - 1) % PH_PER_LAYER == PROBE_KP)) ? PROBE_REPS : 1;
    for (int rep = 0; rep < nrep; ++rep) {
    if (rep > 0) xcd_barrier(bar);
#else
    { constexpr int rep = 0;
#endif
    if (ph == 0) { Frame F = launder(F0);
#ifndef SKIP_CONV
            phase_convert(F);
            { Frame Fb = launder(F0); lora_convert(Fb); }
            { Frame Fc = launder(F0); router_convert(Fc); }
#endif
             }

    else {
        const int l = launder_s((ph - 1) / PH_PER_LAYER); const int kp = launder_s((ph - 1) % PH_PER_LAYER);
        if (kp == 0) { Frame F = launder(F0);
            pg8::Gemm g{(const pg8::bf16_t*)WSP(pg8::bf16_t, WS_H16), (const pg8::bf16_t*)WSP(pg8::bf16_t, WS_WIN + l * WIN_L), T, PC, D, 0};
            pg8::StaticOrder S; S.init(T, PC, F.G, (int)blockIdx.x);
            pg8::EpiF32 E{WSP(float, WS_P), PC};

#ifndef SKIP_G1
            pg8::gemm_phase<pg8::EpiF32, pg8::StaticOrder, true, true>(F.lds + RING_OFF, g, S, E);
#endif

        }
        else if (kp == 1) { Frame F = launder(F0);
#ifndef SKIP_PREP
            if (SUBRUN(1)) { Frame Fb = launder(F0); rwkv_item_prep(Fb, launder_s(l), (rep > 0) ? PROBE_STOP : 99); }
#endif
             }
        else if (kp == 2) { Frame F = launder(F0);
#ifndef SKIP_SCAN
            if (blockIdx.x >= 48) {
                const unsigned nsub = gridDim.x - 48;
                { Frame Fa = launder(F0); Fa.vcu = (int)blockIdx.x - 48; Fa.G = (int)nsub; pool_items(Fa, launder_s(l)); __syncthreads(); }
                { Frame Fa = launder(F0); Fa.vcu = (int)blockIdx.x - 48; Fa.G = (int)nsub; mlstm_prep(Fa, launder_s(l)); }
                sub_barrier(F0.ctl + CW_SUB + (l * 2 + 0) * 64, nsub);
                { Frame Fa = launder(F0); mlstm_scan2(Fa); }
                sub_barrier(F0.ctl + CW_SUB + (l * 2 + 1) * 64, nsub);
                { Frame Fa = launder(F0); Fa.vcu = (int)blockIdx.x - 48; Fa.G = (int)nsub; mlstm_out_mfma(Fa, launder_s(l)); }
            } else { Frame Fb = launder(F0); rwkv_chain2(Fb); }
#endif
             }
        else if (kp == 3) { Frame F = launder(F0);
#ifndef SKIP_FIN
            if (SUBRUN(0)) { Frame Fa = launder(F0); rwkv_chunk_out_mfma(Fa, launder_s(l)); }
#endif
             }
        else if (kp == 4) { Frame F = launder(F0);
            pg8::Gemm g{(const pg8::bf16_t*)WSP(pg8::bf16_t, WS_YCAT), (const pg8::bf16_t*)WSP(pg8::bf16_t, WS_WOUT + l * WOUT_L), T, D, D, 0};
            pg8::StaticOrder S; S.init(T, D, F.G, (int)blockIdx.x);
            pg8::EpiF32 E{WSP(float, WS_MIX), D};

#ifndef SKIP_G2
            pg8::gemm_phase<pg8::EpiF32, pg8::StaticOrder, false, true>(F.lds + RING_OFF, g, S, E);
#endif

        }
        else if (kp == 5) { Frame F = launder(F0);
#ifndef SKIP_LN
            ln_rows(F, (l == 0) ? INP(I_X) : WSP(float, WS_HB), WSP(float, WS_MIX), INP(I_LN1G) + l * D, INP(I_LN1B) + l * D, WSP(float, WS_HA), WSP(bf16, WS_H16));
#endif
             }
        else if (kp == 6) { Frame F = launder(F0);
#ifndef SKIP_RT
            router2(F, l, WSP(float, WS_HA));
#endif
             }
        else if (kp == 7) { Frame F = launder(F0);
#ifndef SKIP_AS
            assign2(F, l);
#endif
             }
        else if (kp == 8) { Frame F = launder(F0);
            pg8::Gemm g{(const pg8::bf16_t*)WSP(pg8::bf16_t, WS_XG), (const pg8::bf16_t*)WSP(pg8::bf16_t, WS_WGU + (size_t)l * 32 * WGU_E), NSLOT, 2048, D, WGU_E};
            MoeOrder<8> S; S.nb = (int)__builtin_amdgcn_readfirstlane(__hip_atomic_load(F.ctl + CW_NB + l, RLX_AGENT)); S.c = (int)blockIdx.x; S.blke = F.ctl + CW_BLKE + l * 320;
            pg8::EpiSwiGLU E{WSP(pg8::bf16_t, WS_ACT), INP(I_BGU) + (size_t)l * NE * 2048};

#ifndef SKIP_GU
            pg8::gemm_phase<pg8::EpiSwiGLU, MoeOrder<8>, true, true>(F.lds + RING_OFF, g, S, E);
#endif

        }
        else if (kp == 9) { Frame F = launder(F0);
            pg8::Gemm g{(const pg8::bf16_t*)WSP(pg8::bf16_t, WS_ACT), (const pg8::bf16_t*)WSP(pg8::bf16_t, WS_WDN + (size_t)l * 32 * WDN_E), NSLOT, D, FF, WDN_E};
            MoeOrder<4> S; S.nb = (int)__builtin_amdgcn_readfirstlane(__hip_atomic_load(F.ctl + CW_NB + l, RLX_AGENT)); S.c = (int)blockIdx.x; S.blke = F.ctl + CW_BLKE + l * 320;
            pg8::EpiDown E{WSP(pg8::bf16_t, WS_OSL), INP(I_BDN) + (size_t)l * NE * D, WSP(float, WS_GSL)};

#ifndef SKIP_DN
            pg8::gemm_phase<pg8::EpiDown, MoeOrder<4>, true, true>(F.lds + RING_OFF, g, S, E);
#endif

        }
        else if (kp == 10) { Frame F = launder(F0);
#ifndef SKIP_CB
            combine_phase(F, WSP(float, WS_HA), INP(I_LN2G) + l * D, INP(I_LN2B) + l * D, (l == DEPTH - 1) ? F.out : WSP(float, WS_HB), WSP(bf16, WS_H16));
#endif
             }
    }
    }
    if (ph_ + 1 < hi) xcd_barrier(bar);
    }
#if defined(PROBE_CONV2)
    { xcd_barrier(bar); Frame F = launder(F0); phase_convert(F); }
#endif
}

extern "C" void kernel_launch(void* const* d_in, const int* in_sizes, int n_in, void* d_out, int out_size, void* d_ws, size_t ws_size, hipStream_t stream) {
    static int grid = 0;
    if (grid == 0) {
        if (n_in != 34 || in_sizes[0] != T * D || out_size != T * D || ws_size < WS_END) { fprintf(stderr, "kernel_launch: unexpected shapes / workspace (n_in %d, in0 %d, out %d, ws %zu, need %zu)\n", n_in, n_in > 0 ? in_sizes[0] : -1, out_size, ws_size, (size_t)WS_END); grid = -1; return; }
        int dev = 0, cus = 0, per_cu = 0;
        if (hipGetDevice(&dev) != hipSuccess || hipDeviceGetAttribute(&cus, hipDeviceAttributeMultiprocessorCount, dev) != hipSuccess) { grid = -1; return; }
        if (hipFuncSetAttribute((const void*)mk_fwd, hipFuncAttributeMaxDynamicSharedMemorySize, LDS_BYTES) != hipSuccess) { fprintf(stderr, "kernel_launch: hipFuncSetAttribute failed\n"); grid = -1; return; }
        if (hipOccupancyMaxActiveBlocksPerMultiprocessor(&per_cu, (const void*)mk_fwd, NWAVES * 64, LDS_BYTES) != hipSuccess || per_cu < 1) { fprintf(stderr, "kernel_launch: occupancy query says %d blocks per CU\n", per_cu); }
        (void)hipGetLastError();
        grid = cus;
        if (grid % 8 != 0 || grid > 256) grid = (grid > 256) ? 256 : (grid / 8) * 8;
    }
    if (grid <= 0) return;
    (void)hipMemsetAsync((char*)d_ws + WS_CTL, 0, CTL_ZERO_BYTES, stream);
    Args a{};
    for (int i = 0; i < 34; ++i) a.in[i] = (const float*)d_in[i];
    a.out = (float*)d_out; a.ws = (unsigned char*)d_ws;
#if MK_N_LAUNCHES == 1
    a.ph_lo = 0; a.ph_hi = N_PHASES;
    hipLaunchKernelGGL(mk_fwd, dim3(grid), dim3(NWAVES * 64), LDS_BYTES, stream, a);
#else
    for (int ph = 0; ph < N_PHASES; ++ph) { a.ph_lo = ph; a.ph_hi = ph + 1; hipLaunchKernelGGL(mk_fwd, dim3(grid), dim3(NWAVES * 64), LDS_BYTES, stream, a); }
#endif
}
```

```cpp
#include <hip/hip_runtime.h>
#include <cstdio>
#include <cstdint>
namespace pg8 {
#define PG8_LAS __attribute__((address_space(3)))
typedef unsigned short bf16_t;
typedef short bf16x8 __attribute__((ext_vector_type(8)));
typedef float f32x4 __attribute__((ext_vector_type(4)));
typedef unsigned u32x4 __attribute__((ext_vector_type(4)));
constexpr int BM = 256, BK = 64, HALF = 128, HTB = HALF * BK * 2  , STAGE_BYTES = 8 * HTB, NXCD = 8, WGM = 8;

__host__ __device__ __forceinline__ int lds_byte(int r, int c) { const int st = (r >> 4) * 2 + (c >> 5), rr = r & 15, cc = c & 31, ob = rr * 64 + cc * 2; return st * 1024 + (ob ^ (((ob >> 9) & 1) << 5)); }
__host__ __device__ __forceinline__ void stage_rc(int b, int& R, int& C) { const int st = b / 1024, sb = b % 1024, swz = sb ^ (((sb >> 9) & 1) << 5); R = (st >> 1) * 16 + swz / 64; C = (st & 1) * 32 + (swz % 64) / 2; }
__host__ __device__ __forceinline__ int perm32(int rho) { const int n = rho >> 4, i = rho & 15; return 8 * (i >> 2) + 4 * n + (i & 3); }

struct Unit { int pm, pn, e; };
struct Gemm { const bf16_t* A; const bf16_t* Bt; int M, N, K; size_t bstride; };

struct StaticOrder {
    int nM, nN, nwg, G, c;
    __host__ __device__ void init(int M, int N, int G_, int c_) { nM = M / BM; nN = N / BM; nwg = nM * nN; G = G_; c = c_; }
    __host__ __device__ bool next(int i, Unit& u) const {
        const long L = (long)i * G + c; if (L >= nwg) return false;
        int wgid = (int)L; { const int q = nwg / NXCD, r = nwg % NXCD, xcd = wgid % NXCD, off = wgid / NXCD; wgid = (xcd < r ? xcd * (q + 1) : r * (q + 1) + (xcd - r) * q) + off; }
        const int nig = WGM * nN, gid = wgid / nig, fm = gid * WGM, gsz = (nM - fm) < WGM ? (nM - fm) : WGM;
        u.pm = fm + ((wgid % nig) % gsz); u.pn = (wgid % nig) / gsz; u.e = 0; return true;
    }
    __device__ __forceinline__ void a_ready(const Unit&) const {}
    __device__ __forceinline__ void done(const Unit&) const {}
};

#define GAS_ __attribute__((address_space(1)))
__device__ __forceinline__ unsigned cvt_pk_bf16(float lo, float hi) { unsigned r; asm volatile("v_cvt_pk_bf16_f32 %0, %1, %2" : "=v"(r) : "v"(lo), "v"(hi)); return r; }

struct EpiF32 {
    static constexpr bool PERM = false, AFTER_DRAIN = false;
    GAS_ float* C; int ldc;
    __device__ __forceinline__ void operator()(const f32x4 (&acc)[2][2][4][2], const Unit& u, int wr, int wc, int fr, int fq) const {
        const int row0 = u.pm * BM + wr * 64 + fr, col0 = u.pn * BM + wc * 32 + 4 * fq;
#pragma unroll
        for (int ai = 0; ai < 2; ++ai)
#pragma unroll
            for (int m = 0; m < 4; ++m) { GAS_ float* rowp = C + (size_t)(row0 + ai * HALF + m * 16) * ldc + col0;
#pragma unroll
                for (int bj = 0; bj < 2; ++bj)
#pragma unroll
                    for (int n = 0; n < 2; ++n) *(GAS_ f32x4*)(rowp + bj * HALF + n * 16) = acc[ai][bj][m][n]; }
    }
};
struct EpiSwiGLU {
    static constexpr bool PERM = true, AFTER_DRAIN = false;
    GAS_ bf16_t* O; const GAS_ float* bias;
    __device__ __forceinline__ void operator()(const f32x4 (&acc)[2][2][4][2], const Unit& u, int wr, int wc, int fr, int fq) const {
        const int row0 = u.pm * BM + wr * 64 + fr; const int c0 = u.pn * HALF + wc * 32 + 8 * fq;
        const GAS_ float* bg = bias + (size_t)u.e * 2048 + c0; const GAS_ float* bl = bg + 1024;
        f32x4 bgv[2], blv[2];
#pragma unroll
        for (int n = 0; n < 2; ++n) { bgv[n] = *(const GAS_ f32x4*)(bg + 4 * n); blv[n] = *(const GAS_ f32x4*)(bl + 4 * n); }
#pragma unroll
        for (int ai = 0; ai < 2; ++ai)
#pragma unroll
            for (int m = 0; m < 4; ++m) {
                float o[8];
#pragma unroll
                for (int n = 0; n < 2; ++n) {
                    const f32x4 gv = acc[ai][0][m][n] + bgv[n], lv = acc[ai][1][m][n] + blv[n];
#pragma unroll
                    for (int j = 0; j < 4; ++j) {
                        const float gl = fminf(gv[j], 7.0f); const float li = fminf(fmaxf(lv[j], -7.0f), 7.0f);
                        const float sg = __builtin_amdgcn_rcpf(1.0f + __builtin_amdgcn_exp2f(-1.702f * 1.4426950408889634f * gl));
                        o[4 * n + j] = gl * sg * (li + 1.0f);
                    }
                }
                u32x4 w; w.x = cvt_pk_bf16(o[0], o[1]); w.y = cvt_pk_bf16(o[2], o[3]); w.z = cvt_pk_bf16(o[4], o[5]); w.w = cvt_pk_bf16(o[6], o[7]);
                *(GAS_ u32x4*)(O + (size_t)(row0 + ai * HALF + m * 16) * 1024 + c0) = w;
            }
    }
};
struct EpiDown {
    static constexpr bool PERM = true, AFTER_DRAIN = false;
    GAS_ bf16_t* O; const GAS_ float* bias; const GAS_ float* gate;
    __device__ __forceinline__ void operator()(const f32x4 (&acc)[2][2][4][2], const Unit& u, int wr, int wc, int fr, int fq) const {
        const int row0 = u.pm * BM + wr * 64 + fr; const int c0 = u.pn * BM + wc * 32 + 8 * fq;
        const GAS_ float* bb = bias + (size_t)u.e * 1024 + c0;
        f32x4 bv[2][2];
#pragma unroll
        for (int bj = 0; bj < 2; ++bj)
#pragma unroll
            for (int n = 0; n < 2; ++n) bv[bj][n] = *(const GAS_ f32x4*)(bb + bj * HALF + 4 * n);
#pragma unroll
        for (int ai = 0; ai < 2; ++ai)
#pragma unroll
            for (int m = 0; m < 4; ++m) { const int row = row0 + ai * HALF + m * 16; const float gt = gate[row];
#pragma unroll
                for (int bj = 0; bj < 2; ++bj) { const f32x4 v0 = (acc[ai][bj][m][0] + bv[bj][0]) * gt, v1 = (acc[ai][bj][m][1] + bv[bj][1]) * gt;
                    u32x4 w; w.x = cvt_pk_bf16(v0[0], v0[1]); w.y = cvt_pk_bf16(v0[2], v0[3]); w.z = cvt_pk_bf16(v1[0], v1[1]); w.w = cvt_pk_bf16(v1[2], v1[3]);
                    *(GAS_ u32x4*)(O + (size_t)row * 1024 + c0 + bj * HALF) = w; } }
    }
};

typedef float f32x2_ __attribute__((ext_vector_type(2))); typedef __bf16 bf16x2_ __attribute__((ext_vector_type(2)));
__device__ __forceinline__ unsigned cvt_pk_safe(float lo, float hi) { f32x2_ v = {lo, hi}; bf16x2_ b = __builtin_convertvector(v, bf16x2_); return __builtin_bit_cast(unsigned, b); }
struct EpiProj {
    static constexpr bool PERM = true, AFTER_DRAIN = false;
    GAS_ bf16_t* O; int ldc; GAS_ float* G;
    __device__ __forceinline__ void operator()(const f32x4 (&acc)[2][2][4][2], const Unit& u, int wr, int wc, int fr, int fq) const {
        const int row0 = u.pm * BM + wr * 64 + fr; const int c0 = u.pn * BM + wc * 32 + 8 * fq;
#pragma unroll
        for (int ai = 0; ai < 2; ++ai)
#pragma unroll
            for (int m = 0; m < 4; ++m) { const int row = row0 + ai * HALF + m * 16;
#pragma unroll
                for (int bj = 0; bj < 2; ++bj) { const f32x4 v0 = acc[ai][bj][m][0], v1 = acc[ai][bj][m][1];
                    u32x4 w; w.x = cvt_pk_safe(v0[0], v0[1]); w.y = cvt_pk_safe(v0[2], v0[3]); w.z = cvt_pk_safe(v1[0], v1[1]); w.w = cvt_pk_safe(v1[2], v1[3]);
                    *(GAS_ u32x4*)(O + (size_t)row * ldc + c0 + bj * HALF) = w; }
                if (u.pn == 12 && wc == 0 && fq < 2) { GAS_ float* g = G + (size_t)row * 16 + 8 * fq; *(GAS_ f32x4*)g = acc[ai][1][m][0]; if (fq == 0) *(GAS_ f32x4*)(g + 4) = acc[ai][1][m][1]; } }
    }
};

template <class Epi, class Sched, bool ALIGN_EPI = false, bool SP2 = false>
__device__ __forceinline__ void gemm_phase(PG8_LAS unsigned char* lds, const Gemm g, const Sched& S, const Epi& E) {
    int tid_ = threadIdx.x; asm volatile("" : "+v"(tid_));
    const int tid = tid_, wid = __builtin_amdgcn_readfirstlane(tid >> 6), lane = tid & 63, wr = wid >> 2, wc = wid & 3, fr = lane & 15, fq = lane >> 4;
    int K_ = g.K; asm volatile("" : "+s"(K_)); const int K = K_, nt = K / BK;
    unsigned voffA[2], voffB[2];
#pragma unroll
    for (int i = 0; i < 2; ++i) { int R, C; stage_rc(tid * 16 + i * 8192, R, C); const int Rb = Epi::PERM ? ((R & ~31) + perm32(R & 31)) : R;
        voffA[i] = (unsigned)(R * K + C) * 2u; voffB[i] = (unsigned)(Rb * K + C) * 2u; }
    const size_t kstep = (size_t)(BK * 2);
    const size_t hstep = (size_t)HALF * K * 2;
    const size_t tstep = 2 * hstep;
    const unsigned ldsw = (unsigned)wid * 1024u;
    const int aoff = lds_byte(wr * 64 + fr, fq * 8), boff = lds_byte(wc * 32 + fr, fq * 8);
#define PG8_SA(b, h) (((b) * 2 + (h)) * HTB)
#define PG8_SB(b, h) ((4 + (b) * 2 + (h)) * HTB)
#define PG8_STAGE(bufoff, gbase, voff) do { _Pragma("unroll") for (int _i = 0; _i < 2; ++_i) \
        __builtin_amdgcn_global_load_lds((const unsigned*)((const char*)(gbase) + (voff)[_i]), (PG8_LAS unsigned*)(lds + (bufoff) + ldsw + _i * 8192), 16, 0, 0); } while (0)
#define PG8_LDA(dst, b, h) do { _Pragma("unroll") for (int m = 0; m < 4; ++m) _Pragma("unroll") for (int k = 0; k < 2; ++k) dst[m][k] = *(const PG8_LAS bf16x8*)(lds + PG8_SA(b, h) + aoff + m * 2048 + k * 1024); } while (0)
#define PG8_LDB(dst, b, h) do { _Pragma("unroll") for (int n = 0; n < 2; ++n) _Pragma("unroll") for (int k = 0; k < 2; ++k) dst[n][k] = *(const PG8_LAS bf16x8*)(lds + PG8_SB(b, h) + boff + n * 2048 + k * 1024); } while (0)
#define PG8_MMA(ai, bj, At, Bt) do { __builtin_amdgcn_s_setprio(1); _Pragma("unroll") for (int m = 0; m < 4; ++m) _Pragma("unroll") for (int n = 0; n < 2; ++n) _Pragma("unroll") for (int k = 0; k < 2; ++k) \
        acc[ai][bj][m][n] = __builtin_amdgcn_mfma_f32_16x16x32_bf16(Bt[n][k], At[m][k], acc[ai][bj][m][n], 0, 0, 0); __builtin_amdgcn_s_setprio(0); } while (0)
#define PG8_WAIT_V(n) asm volatile("s_waitcnt vmcnt(" #n ")" ::: "memory")
#define PG8_WAIT_L(n) asm volatile("s_waitcnt lgkmcnt(" #n ")" ::: "memory")
#define PG8_BAR __builtin_amdgcn_s_barrier()
#define PG8_SCHED __builtin_amdgcn_sched_barrier(0)
    Unit cur, nxt; int ui = 0;
    if (!S.next(0, cur)) return;
    f32x4 acc[2][2][4][2];
#pragma unroll
    for (int a = 0; a < 2; ++a)
#pragma unroll
        for (int b = 0; b < 2; ++b)
#pragma unroll
            for (int m = 0; m < 4; ++m)
#pragma unroll
                for (int n = 0; n < 2; ++n) acc[a][b][m][n] = (f32x4){0.f, 0.f, 0.f, 0.f};
    bf16x8 At[4][2], B0[2][2], B1[2][2];
    const char* cA = (const char*)g.A + (size_t)cur.pm * tstep; const char* cB = (const char*)g.Bt + (size_t)cur.e * g.bstride + (size_t)cur.pn * tstep;
    S.a_ready(cur);
    if constexpr (SP2) {
        PG8_STAGE(PG8_SB(0, 0), cB, voffB); PG8_STAGE(PG8_SB(0, 1), cB + hstep, voffB); PG8_STAGE(PG8_SA(0, 0), cA, voffA); PG8_STAGE(PG8_SA(0, 1), cA + hstep, voffA);
        if (wr == 1) PG8_BAR;
        PG8_WAIT_V(2); PG8_BAR;
        PG8_STAGE(PG8_SB(1, 0), cB + kstep, voffB); PG8_STAGE(PG8_SA(1, 0), cA + kstep, voffA); PG8_STAGE(PG8_SB(1, 1), cB + hstep + kstep, voffB);
        PG8_WAIT_V(6); PG8_BAR;
    } else {
        PG8_STAGE(PG8_SB(0, 0), cB, voffB); PG8_STAGE(PG8_SA(0, 0), cA, voffA); PG8_STAGE(PG8_SB(0, 1), cB + hstep, voffB); PG8_STAGE(PG8_SA(0, 1), cA + hstep, voffA);
        if (wr == 1) PG8_BAR;
        PG8_WAIT_V(4); PG8_BAR;
        PG8_STAGE(PG8_SB(1, 0), cB + kstep, voffB); PG8_STAGE(PG8_SA(1, 0), cA + kstep, voffA); PG8_STAGE(PG8_SB(1, 1), cB + hstep + kstep, voffB);
        PG8_WAIT_V(6); PG8_BAR;
    }
    for (;;) {
        const bool has_next = S.next(ui + 1, nxt);
        const char* nA = has_next ? (const char*)g.A + (size_t)nxt.pm * tstep : cA; const char* nB = has_next ? (const char*)g.Bt + (size_t)nxt.e * g.bstride + (size_t)nxt.pn * tstep : cB;
        for (int t = 0; t < nt; t += 2) {
            const bool last = (t == nt - 2);
            const char* a1 = cA + (size_t)(t + 1) * kstep;
            const char* a2 = last ? nA : cA + (size_t)(t + 2) * kstep; const char* b2 = last ? nB : cB + (size_t)(t + 2) * kstep;
            const char* a3 = a2 + kstep; const char* b3 = b2 + kstep;
            if (last && has_next) S.a_ready(nxt);
            if constexpr (SP2) {
            PG8_LDB(B0, 0, 0); PG8_LDB(B1, 0, 1); PG8_SCHED; PG8_LDA(At, 0, 0); PG8_STAGE(PG8_SA(1, 1), a1 + hstep, voffA);
            PG8_WAIT_V(8); PG8_WAIT_L(0); PG8_BAR; PG8_MMA(0, 0, At, B0); PG8_MMA(0, 1, At, B1); PG8_BAR; PG8_SCHED;
            PG8_LDA(At, 0, 1); PG8_STAGE(PG8_SB(0, 0), b2, voffB); PG8_STAGE(PG8_SB(0, 1), b2 + hstep, voffB); PG8_STAGE(PG8_SA(0, 0), a2, voffA);
            PG8_WAIT_V(8); PG8_WAIT_L(0); PG8_BAR; PG8_MMA(1, 0, At, B0); PG8_MMA(1, 1, At, B1); PG8_BAR; PG8_SCHED;
            PG8_LDB(B0, 1, 0); PG8_LDB(B1, 1, 1); PG8_SCHED; PG8_LDA(At, 1, 0); PG8_STAGE(PG8_SA(0, 1), a2 + hstep, voffA);
            PG8_WAIT_V(8); PG8_WAIT_L(0); PG8_BAR; PG8_MMA(0, 0, At, B0); PG8_MMA(0, 1, At, B1); PG8_BAR; PG8_SCHED;
            PG8_LDA(At, 1, 1); PG8_STAGE(PG8_SB(1, 0), b3, voffB); PG8_STAGE(PG8_SB(1, 1), b3 + hstep, voffB); PG8_STAGE(PG8_SA(1, 0), a3, voffA);
            PG8_WAIT_V(8); PG8_WAIT_L(0); PG8_BAR; PG8_MMA(1, 0, At, B0); PG8_MMA(1, 1, At, B1); PG8_BAR; PG8_SCHED;
            } else {
            PG8_LDB(B0, 0, 0); PG8_SCHED; PG8_LDA(At, 0, 0); PG8_STAGE(PG8_SA(1, 1), a1 + hstep, voffA);
            PG8_WAIT_L(8); PG8_BAR; PG8_WAIT_L(0); PG8_MMA(0, 0, At, B0); PG8_BAR; PG8_SCHED;
            PG8_LDB(B1, 0, 1); PG8_STAGE(PG8_SB(0, 0), b2, voffB);
            PG8_BAR; PG8_WAIT_L(0); PG8_MMA(0, 1, At, B1); PG8_BAR;
            PG8_LDA(At, 0, 1); PG8_STAGE(PG8_SA(0, 0), a2, voffA);
            PG8_BAR; PG8_WAIT_L(0); PG8_MMA(1, 0, At, B0); PG8_BAR; PG8_SCHED;
            PG8_STAGE(PG8_SB(0, 1), b2 + hstep, voffB);
            PG8_WAIT_V(6); PG8_BAR; PG8_MMA(1, 1, At, B1); PG8_BAR;
            PG8_LDB(B0, 1, 0); PG8_SCHED; PG8_LDA(At, 1, 0); PG8_STAGE(PG8_SA(0, 1), a2 + hstep, voffA);
            PG8_WAIT_L(8); PG8_BAR; PG8_WAIT_L(0); PG8_MMA(0, 0, At, B0); PG8_BAR; PG8_SCHED;
            PG8_LDB(B1, 1, 1); PG8_STAGE(PG8_SB(1, 0), b3, voffB);
            PG8_BAR; PG8_WAIT_L(0); PG8_MMA(0, 1, At, B1); PG8_BAR;
            PG8_LDA(At, 1, 1); PG8_STAGE(PG8_SA(1, 0), a3, voffA);
            PG8_BAR; PG8_WAIT_L(0); PG8_MMA(1, 0, At, B0); PG8_BAR; PG8_SCHED;
            PG8_STAGE(PG8_SB(1, 1), b3 + hstep, voffB);
            PG8_WAIT_V(6); PG8_BAR; PG8_MMA(1, 1, At, B1); PG8_BAR;
            }
        }
        if constexpr (ALIGN_EPI) { if (wr == 0) PG8_BAR; }
        if constexpr (!Epi::AFTER_DRAIN) { E(acc, cur, wr, wc, fr, fq); S.done(cur); }
        if (!has_next) break;
#pragma unroll
        for (int a = 0; a < 2; ++a)
#pragma unroll
            for (int b = 0; b < 2; ++b)
#pragma unroll
                for (int m = 0; m < 4; ++m)
#pragma unroll
                    for (int n = 0; n < 2; ++n) acc[a][b][m][n] = (f32x4){0.f, 0.f, 0.f, 0.f};
        cur = nxt; cA = nA; cB = nB; ++ui;
        if constexpr (ALIGN_EPI) { if (wr == 1) PG8_BAR; }
    }
    PG8_WAIT_V(0);
    if constexpr (!ALIGN_EPI) { if (wr == 0) PG8_BAR; }
    PG8_BAR;
    if constexpr (Epi::AFTER_DRAIN) { E.fused(acc, cur, wr, wc, fr, fq, lds, wid, lane); S.done(cur); }
#undef PG8_SA
#undef PG8_SB
#undef PG8_STAGE
#undef PG8_LDA
#undef PG8_LDB
#undef PG8_MMA
#undef PG8_WAIT_V
#undef PG8_WAIT_L
#undef PG8_BAR
#undef PG8_SCHED
}
}
constexpr int NWAVES = 8;
constexpr int BATCH = 2, SEQ = 8192, D = 1024, T = BATCH * SEQ, DEPTH = 2;
constexpr int PC = 3328;
constexpr int DIN = 3212;
constexpr int P_RW = 256, P_ML = 1664, P_V1 = 3212;
constexpr int RW = 384, RWC = 1408;
constexpr int NE = 32, TOPK = 4, FF = 1024;
constexpr int MAXBLK = T * TOPK / 256 + NE;
constexpr int NSLOT = MAXBLK * 256;
constexpr float LN_EPS = 1e-5f, GN_EPS = 64e-5f;
constexpr float DN_ALPHA = 1.41421356237f;
constexpr int NCH = SEQ / 64;
constexpr int NITEM = BATCH * NCH * 6;

constexpr size_t MiB = 1u << 20;
constexpr size_t WS_CTL = 0, CTL_ZERO_BYTES = 1 * MiB;
constexpr size_t WS_WIN = 1 * MiB;
constexpr size_t WIN_L = (size_t)PC * D * 2;
constexpr size_t WS_WOUT = WS_WIN + 2 * WIN_L;
constexpr size_t WOUT_L = (size_t)D * D * 2;
constexpr size_t WS_WGU = WS_WOUT + 2 * WOUT_L;
constexpr size_t WGU_E = (size_t)2048 * D * 2;
constexpr size_t WS_WDN = WS_WGU + 64 * WGU_E;
constexpr size_t WDN_E = (size_t)D * D * 2;
constexpr size_t WS_H16 = WS_WDN + 64 * WDN_E;
constexpr size_t WS_HA = WS_H16 + (size_t)T * D * 2;
constexpr size_t WS_HB = WS_HA + (size_t)T * D * 4;
constexpr size_t WS_P = WS_HB + (size_t)T * D * 4;
constexpr size_t WS_MIX = WS_P + (size_t)T * PC * 4;
constexpr size_t WS_YCAT = WS_MIX + (size_t)T * D * 4;
constexpr size_t RWARR = (size_t)T * RW * 4;
constexpr size_t WS_VFIRST = WS_YCAT + (size_t)T * D * 2;
constexpr size_t WS_RR = WS_VFIRST + RWARR, WS_RLW = WS_RR + RWARR, WS_RK = WS_RLW + RWARR, WS_RV = WS_RK + RWARR;
constexpr size_t WS_RNA = WS_RV + RWARR, WS_RBB = WS_RNA + RWARR, WS_RG = WS_RBB + RWARR, WS_RY = WS_RG + RWARR;
constexpr size_t WS_RSB = WS_RY + RWARR;
constexpr size_t WS_MKV = WS_RSB + (size_t)T * 8 * 4;
constexpr size_t WS_MCP = WS_MKV + (size_t)NITEM * 4096 * 4;
constexpr size_t WS_MNL = WS_MCP + (size_t)NITEM * 4096 * 4;
constexpr size_t WS_MNP = WS_MNL + (size_t)NITEM * 64 * 4;
constexpr size_t WS_MSC = WS_MNP + (size_t)NITEM * 64 * 4;
constexpr size_t WS_MLG = WS_MSC + (size_t)NITEM * 4 * 4;
constexpr size_t WS_MLI = WS_MLG + (size_t)T * 8 * 4;
constexpr size_t WS_XG = ((WS_MLI + (size_t)T * 8 * 4 + MiB - 1) / MiB) * MiB;
constexpr size_t WS_ACT = WS_XG + (size_t)NSLOT * D * 2;
constexpr size_t WS_OSL = WS_ACT + (size_t)NSLOT * FF * 2;
constexpr size_t WS_TKE = WS_OSL + (size_t)NSLOT * D * 2;
constexpr size_t WS_TKG = WS_TKE + (size_t)T * 4 * 4;
constexpr size_t WS_SLOT = WS_TKG + (size_t)T * 4 * 4;
constexpr size_t WS_GSL = WS_SLOT + (size_t)T * 4 * 4;
constexpr size_t CH_STRIDE = 49408;
constexpr size_t WS_RCH = ((WS_GSL + (size_t)NSLOT * 4 + MiB - 1) / MiB) * MiB;
constexpr size_t CO_STRIDE = 32768;
constexpr size_t WS_RCO = WS_RCH + (size_t)NITEM * CH_STRIDE;
constexpr size_t WS_RS0 = WS_RCO + (size_t)NITEM * CO_STRIDE;
constexpr size_t WS_RUT = WS_RS0 + (size_t)NITEM * 8192;
constexpr size_t WS_LORA = WS_RUT + (size_t)NITEM * 8192;
constexpr size_t WS_MQC = ((WS_LORA + 2 * 221184 + 4095) / 4096) * 4096;
constexpr size_t WS_MKC = WS_MQC + (size_t)T * 384 * 2;
constexpr size_t WS_MVT = WS_MKC + (size_t)T * 384 * 2;
constexpr size_t WS_RTW = WS_MVT + (size_t)NITEM * 8192;
constexpr size_t WS_RNK = WS_RTW + 2 * 2 * 32 * 1024 * 2;
constexpr size_t WS_WGB = WS_RNK + (size_t)T * 4 * 4;
constexpr size_t WS_PG = WS_WGB + 2 * 256 * 32 * 4;
constexpr size_t WS_END = WS_PG + (size_t)T * 16 * 4;
constexpr int CW_BAR = 4096;
constexpr int CW_CNT = 8192;
constexpr int CW_CUR = 8192 + 64;
constexpr int CW_NB = 8192 + 128;
constexpr int CW_BLKE = 8192 + 256;
constexpr int CW_SUB = 12288;

constexpr int RING_OFF = 0, RING_BYTES = 131072;
constexpr int LDSCTL_OFF = RING_BYTES, PTR_OFF = LDSCTL_OFF + 512, MISC_OFF = LDSCTL_OFF + 1024;
constexpr int LDS_BYTES = 147456;

#define GAS __attribute__((address_space(1)))
#define LAS __attribute__((address_space(3)))
typedef unsigned short bf16;
typedef unsigned v4u __attribute__((ext_vector_type(4)));
typedef unsigned v2u __attribute__((ext_vector_type(2)));
typedef float f32x4 __attribute__((ext_vector_type(4)));
typedef GAS unsigned gu32;
#define RLX_AGENT __ATOMIC_RELAXED, __HIP_MEMORY_SCOPE_AGENT
#define LDS_WAIT() asm volatile("s_waitcnt lgkmcnt(0)" ::: "memory")
#define VM_WAIT() asm volatile("s_waitcnt vmcnt(0)" ::: "memory")
__device__ __forceinline__ unsigned f2bf(float f) { unsigned u = __builtin_bit_cast(unsigned, f); return (u + 0x7fffu + ((u >> 16) & 1u)) >> 16; }
__device__ __forceinline__ unsigned pk2(float lo, float hi) { return f2bf(lo) | (f2bf(hi) << 16); }
__device__ __forceinline__ float bf2f(unsigned b) { return __builtin_bit_cast(float, b << 16); }
__device__ __forceinline__ float wave_sum(float v) {
#pragma unroll
    for (int o = 1; o < 64; o <<= 1) v += __shfl_xor(v, o);
    return v;
}
__device__ __forceinline__ float wave_max(float v) {
#pragma unroll
    for (int o = 1; o < 64; o <<= 1) v = fmaxf(v, __shfl_xor(v, o));
    return v;
}
__device__ __forceinline__ f32x4 ldp4(const GAS bf16* p) { const v2u w = *(const GAS v2u*)p; return (f32x4){bf2f(w.x & 0xffffu), bf2f(w.x >> 16), bf2f(w.y & 0xffffu), bf2f(w.y >> 16)}; }
__device__ __forceinline__ void ldp8(const GAS bf16* p, f32x4& a, f32x4& b) { const v4u w = *(const GAS v4u*)p; a = (f32x4){bf2f(w.x & 0xffffu), bf2f(w.x >> 16), bf2f(w.y & 0xffffu), bf2f(w.y >> 16)}; b = (f32x4){bf2f(w.z & 0xffffu), bf2f(w.z >> 16), bf2f(w.w & 0xffffu), bf2f(w.w >> 16)}; }
__device__ __forceinline__ float fexp(float x) { return __builtin_amdgcn_exp2f(x * 1.4426950408889634f); }
__device__ __forceinline__ float frcp(float x) { return __builtin_amdgcn_rcpf(x); }
__device__ __forceinline__ float flog(float x) { return __builtin_amdgcn_logf(x) * 0.6931471805599453f; }
__device__ __forceinline__ float frsq(float x) { return __builtin_amdgcn_rsqf(x); }
__device__ __forceinline__ float sigmoidf_(float x) { return frcp(1.0f + fexp(-x)); }
__device__ __forceinline__ float tanhf_(float x) { return 1.0f - 2.0f * frcp(1.0f + fexp(2.0f * x)); }
__device__ __forceinline__ float softplusf_(float x) { return fmaxf(x, 0.f) + flog(1.0f + fexp(-fabsf(x))); }
__device__ __forceinline__ float logsigmoidf_(float x) { return fminf(x, 0.f) - flog(1.0f + fexp(-fabsf(x))); }

#define XB_TMO      128
#define XB_XCNT(j)  (256  + 64 * (j))
#define XB_XSUB(j)  (1280 + 64 * (j))
#define XB_XGEN(j)  (2304 + 64 * (j))
#define XB_TOP      3328
#define XB_TOPGEN   3392
#define XCD_BAR_WORDS 3456
#define XB_SPIN_CAP (1u << 18)

__device__ __forceinline__ unsigned xb_ld(unsigned* p)              { return __hip_atomic_load(p, __ATOMIC_RELAXED, __HIP_MEMORY_SCOPE_AGENT); }
__device__ __forceinline__ unsigned xb_add(unsigned* p, unsigned v) { return __hip_atomic_fetch_add(p, v, __ATOMIC_RELAXED, __HIP_MEMORY_SCOPE_AGENT); }
__device__ __forceinline__ unsigned xb_xcc_id() { return (unsigned)__builtin_amdgcn_s_getreg((3 << 11) | 20) & 0xFu; }
#define XB_SPIN(cond, bar) do { unsigned _sp = 0; while (cond) { __builtin_amdgcn_s_sleep(1); \
    if ((++_sp & 255u) == 0u) { if (xb_ld(&(bar)[XB_TMO])) break; if (_sp > XB_SPIN_CAP) { atomicAdd(&(bar)[XB_TMO], 1u); break; } } } } while (0)

struct XcdBarrier {
    unsigned* bar; unsigned x;
    volatile LAS unsigned* st;
};

__device__ __forceinline__ XcdBarrier xcd_barrier_post(unsigned* bar, volatile LAS unsigned* st) {
    XcdBarrier b; b.bar = bar; b.x = xb_xcc_id(); b.st = st;
    if (threadIdx.x == 0) (void)xb_add(&bar[XB_XCNT(b.x)], 1u);
    return b;
}
__device__ __forceinline__ void xcd_barrier_complete(unsigned* bar, unsigned x, unsigned& nloc, unsigned& nx) {
    const unsigned G = gridDim.x * gridDim.y * gridDim.z;
    unsigned sum, cnt, mine, sp = 0u;
    for (;;) {
        sum = 0u; cnt = 0u; mine = 0u;
#pragma unroll
        for (unsigned j = 0; j < 16; ++j) { const unsigned c = xb_ld(&bar[XB_XCNT(j)]); sum += c; cnt += (c > 0u) ? 1u : 0u; mine = (j == x) ? c : mine; }
        if (sum == G) break;
        __builtin_amdgcn_s_sleep(1);
        if ((++sp & 255u) == 0u) { if (xb_ld(&bar[XB_TMO])) break; if (sp > XB_SPIN_CAP) { atomicAdd(&bar[XB_TMO], 1u); break; } }
    }
    nloc = mine > 0u ? mine : 1u; nx = cnt > 0u ? cnt : 1u;
}

__device__ __forceinline__ void xcd_barrier(const XcdBarrier& b) {
    asm volatile("s_waitcnt vmcnt(0)" ::: "memory");
    __syncthreads();
    if (threadIdx.x == 0) {
        unsigned* bar = b.bar;
        __builtin_amdgcn_s_waitcnt(0);
        unsigned nloc = b.st[0], nx = b.st[1];
        if (nloc == 0u) { xcd_barrier_complete(bar, b.x, nloc, nx); b.st[0] = nloc; b.st[1] = nx; }
        const unsigned old = xb_add(&bar[XB_XSUB(b.x)], 1u);
        const unsigned gen = old / nloc;
        if (old + 1u == (gen + 1u) * nloc) {
            __builtin_amdgcn_fence(__ATOMIC_RELEASE, "agent");
            asm volatile("s_waitcnt vmcnt(0)" ::: "memory");
            const unsigned og = xb_add(&bar[XB_TOP], 1u);
            const unsigned tg = og / nx;
            if (og + 1u == (tg + 1u) * nx) xb_add(&bar[XB_TOPGEN], 1u);
            else XB_SPIN(xb_ld(&bar[XB_TOPGEN]) == tg, bar);
            __builtin_amdgcn_fence(__ATOMIC_ACQUIRE, "agent");
            xb_add(&bar[XB_XGEN(b.x)], 1u);
            asm volatile("s_waitcnt vmcnt(0)" ::: "memory");
        } else {
            XB_SPIN(xb_ld(&bar[XB_XGEN(b.x)]) == gen, bar);
            __builtin_amdgcn_fence(__ATOMIC_ACQUIRE, "agent");
            asm volatile("s_waitcnt vmcnt(0)" ::: "memory");
        }
    }
    __syncthreads();
}


struct Frame {
    LAS unsigned char* lds;
    volatile LAS unsigned* MISC;
    gu32* ctl;
    GAS unsigned char* ws;
    GAS float* out;
    int tid, lane, wave;
    int vcu, G;
};
enum { I_X = 0, I_WIN, I_POOLW, I_POOLS, I_MU, I_W0, I_W2, I_A0, I_A2, I_G2, I_KKS, I_KA, I_RK, I_LNXG, I_LNXB, I_V0, I_V1, I_V2,
       I_CONVW, I_CONVB, I_BI, I_BF, I_NORMG, I_WOUT, I_LN1G, I_LN1B, I_RTW, I_RTB, I_WGU, I_BGU, I_WDN, I_BDN, I_LN2G, I_LN2B };

#define WSP(T_, off) ((GAS T_*)(F.ws + (off)))
__device__ __forceinline__ const GAS float* inp_(LAS unsigned char* lds, int i) {
    const unsigned long long v = *(const LAS unsigned long long*)(lds + PTR_OFF + 8 * i);
    const unsigned lo = __builtin_amdgcn_readfirstlane((unsigned)v), hi = __builtin_amdgcn_readfirstlane((unsigned)(v >> 32));
    return (const GAS float*)(((unsigned long long)hi << 32) | lo);
}
#define INP(i) inp_(F.lds, (i))
__device__ __forceinline__ Frame launder(const Frame& G) {
    Frame F = G;
    F.tid = threadIdx.x; asm volatile("" : "+v"(F.tid)); F.lane = F.tid & 63;
    F.wave = __builtin_amdgcn_readfirstlane(F.tid >> 6);
    F.G = gridDim.x; { const int bx = blockIdx.x; F.vcu = (F.G % 8 == 0) ? (bx % 8) * (F.G / 8) + bx / 8 : bx; }
    asm volatile("" : "+s"(F.ws), "+s"(F.out), "+s"(F.vcu), "+s"(F.G));
    F.ctl = (gu32*)(F.ws + WS_CTL);
    return F;
}
__device__ __forceinline__ int launder_s(int x) { asm volatile("" : "+s"(x)); return x; }

template <int NN>
struct MoeOrder {
    int nb, c; const gu32* blke;
    __device__ __forceinline__ bool next(int i, pg8::Unit& u) const {
        constexpr int BPX = 32 / NN;
        const int x = c & 7, j = c >> 3;
        const int blk = i * (8 * BPX) + x * BPX + j / NN;
        if (blk >= nb) return false;
        u.pm = blk; u.pn = j % NN; u.e = (int)__builtin_amdgcn_readfirstlane(__hip_atomic_load(blke + blk, RLX_AGENT));
        return true;
    }
    __device__ __forceinline__ void a_ready(const pg8::Unit&) const {}
    __device__ __forceinline__ void done(const pg8::Unit&) const {}
};

__device__ __forceinline__ void transpose_item(const GAS float* src, int ld, bool valid, int k0, GAS bf16* dst  , LAS float* scr, int lane) {
    const GAS float* s0 = src + (size_t)(k0 + (lane >> 5)) * ld;
#pragma unroll 8
    for (int i = 0; i < 32; ++i) { const int kk = 2 * i + (lane >> 5); scr[kk * 33 + (lane & 31)] = valid ? s0[(size_t)(2 * i) * ld] : 0.f; }
    LDS_WAIT(); asm volatile("" ::: "memory");
    const int c = lane & 7;
#pragma unroll
    for (int j = 0; j < 4; ++j) { const int n = (lane >> 3) + 8 * j; const LAS float* s = scr + (8 * c) * 33 + n;
        v4u o; o.x = pk2(s[0 * 33], s[1 * 33]); o.y = pk2(s[2 * 33], s[3 * 33]); o.z = pk2(s[4 * 33], s[5 * 33]); o.w = pk2(s[6 * 33], s[7 * 33]);
        *(GAS v4u*)(dst + (size_t)n * D + k0 + 8 * c) = o; }
    LDS_WAIT(); asm volatile("" ::: "memory");
}
__device__ __forceinline__ void phase_convert(Frame& F) {
    LAS float* scr = (LAS float*)(F.lds + RING_OFF + F.wave * 16384);
    const int gw = F.vcu * NWAVES + F.wave, NGW = F.G * NWAVES; const int lane = F.lane;
    { const GAS float* x = INP(I_X); GAS bf16* h16 = WSP(bf16, WS_H16);
      for (int m = gw; m < T; m += NGW) { const GAS f32x4* xr = (const GAS f32x4*)(x + (size_t)m * D) + lane; GAS v2u* o = (GAS v2u*)(h16 + (size_t)m * D) + lane;
#pragma unroll
          for (int j = 0; j < 4; ++j) { const f32x4 v = xr[64 * j]; v2u w; w.x = pk2(v.x, v.y); w.y = pk2(v.z, v.w); o[64 * j] = w; } } }
    constexpr int KB = D / 64;
    constexpr int I_IN = 2 * (PC / 32) * KB;
    constexpr int I_OUT = 2 * (D / 32) * KB;
    constexpr int I_GU = 64 * (2048 / 32) * KB;
    constexpr int I_DN = 64 * (D / 32) * KB;
    constexpr int NITEMS = I_IN + I_OUT + I_GU + I_DN;
    for (int it = gw; it < NITEMS; it += NGW) {
        int r = it;
        if (r < I_IN) { const int l = r / ((PC / 32) * KB); r -= l * ((PC / 32) * KB); const int nb = r / KB, kb = r % KB; const int n = nb * 32 + (lane & 31);
            const GAS float* src; int ld; bool valid;
            if (n < DIN) { src = INP(I_WIN) + (size_t)l * D * DIN + n; ld = DIN; valid = true; }
            else if (l == 1 && n < DIN + 32) { src = INP(I_V1) + (n - DIN); ld = 32; valid = true; }
            else { src = INP(I_WIN); ld = 0; valid = false; }
            transpose_item(src, ld, valid, kb * 64, WSP(bf16, WS_WIN + l * WIN_L) + (size_t)(nb * 32) * D, scr, lane); continue; }
        r -= I_IN;
        if (r < I_OUT) { const int l = r / ((D / 32) * KB); r -= l * ((D / 32) * KB); const int nb = r / KB, kb = r % KB;
            transpose_item(INP(I_WOUT) + (size_t)l * D * D + nb * 32 + (lane & 31), D, true, kb * 64, WSP(bf16, WS_WOUT + l * WOUT_L) + (size_t)(nb * 32) * D, scr, lane); continue; }
        r -= I_OUT;
        if (r < I_GU) { const int le = r / (64 * KB); r -= le * (64 * KB); const int nb = r / KB, kb = r % KB; const int n0 = nb * 32;
            const int nn = n0 & 1023; const int drow = 256 * (nn >> 7) + (nn & 127) + ((n0 >= 1024) ? 128 : 0);
            transpose_item(INP(I_WGU) + (size_t)le * D * 2048 + n0 + (lane & 31), 2048, true, kb * 64, WSP(bf16, WS_WGU + le * WGU_E) + (size_t)drow * D, scr, lane); continue; }
        r -= I_GU;
        { const int le = r / (32 * KB); r -= le * (32 * KB); const int nb = r / KB, kb = r % KB;
            transpose_item(INP(I_WDN) + (size_t)le * D * D + nb * 32 + (lane & 31), D, true, kb * 64, WSP(bf16, WS_WDN + le * WDN_E) + (size_t)(nb * 32) * D, scr, lane); }
    }
}

__device__ __forceinline__ void pool_items(Frame& F, int l) {
    const GAS bf16* p = WSP(bf16, WS_P); GAS bf16* ycat = WSP(bf16, WS_YCAT);
    LAS float* dt = (LAS float*)(F.lds + RING_OFF + F.wave * 8192);
    const int gw = F.vcu * NWAVES + F.wave, NGW = F.G * NWAVES, lane = F.lane;
    for (int it = gw; it < (T / 32) * 4; it += NGW) {
        const int g = it & 3, tile = it >> 2, tok0 = tile * 32, t0 = tok0 & (SEQ - 1);
        const int win = 2 << g; const int col = 64 * g + lane;
        const GAS bf16* pc = p + (size_t)tok0 * PC + col;
        float ub[47];
#pragma unroll
        for (int j = 0; j < 47; ++j) { const int rel = j - 15; const int relc = (t0 + rel >= 0) ? rel : 0; const float x = bf2f(pc[(ptrdiff_t)relc * PC]); ub[j] = (t0 + rel >= 0) ? x : 0.f; }
        float s = 0.f;
#pragma unroll
        for (int j = 1; j < 16; ++j) if (j < win) s += ub[15 - j];
#pragma unroll
        for (int t = 0; t < 32; ++t) {
            const float u = ub[15 + t]; s += u;
            const int cnt = min(t0 + t + 1, win);
            dt[t * 64 + lane] = s * frcp((float)cnt) - u;
            const float d2 = ub[15 + t - 1], d4 = ub[15 + t - 3], d8 = ub[15 + t - 7], d16 = ub[15 + t - 15];
            s -= (g == 0) ? d2 : (g == 1) ? d4 : (g == 2) ? d8 : d16;
        }
        LDS_WAIT(); asm volatile("" ::: "memory");
        float w[64];
        const GAS float* pw = INP(I_POOLW) + ((size_t)(l * 4 + g) * 64) * 64 + lane;
#pragma unroll
        for (int i = 0; i < 64; ++i) w[i] = pw[i * 64];
        const float sc = INP(I_POOLS)[l * 256 + col];
        for (int t = 0; t < 32; ++t) {
            float a0 = 0.f, a1 = 0.f, a2 = 0.f, a3 = 0.f;
#pragma unroll
            for (int i = 0; i < 64; i += 4) { const f32x4 d = *(const LAS f32x4*)(dt + t * 64 + i); a0 += d.x * w[i]; a1 += d.y * w[i + 1]; a2 += d.z * w[i + 2]; a3 += d.w * w[i + 3]; }
            ycat[(size_t)(tok0 + t) * D + col] = (bf16)f2bf(((a0 + a1) + (a2 + a3)) * sc);
        }
        LDS_WAIT(); asm volatile("" ::: "memory");
    }
}

constexpr int XS_PITCH = 1440;
__device__ __forceinline__ void rwkv_prep(Frame& F, int l) {
    const GAS float* p = WSP(float, WS_P);
    LAS float* xs = (LAS float*)(F.lds + RING_OFF);
    const GAS float* mu = INP(I_MU) + l * RWC;
    GAS float* vfirst = WSP(float, WS_VFIRST);
    GAS float* oR = WSP(float, WS_RR), *oLW = WSP(float, WS_RLW), *oK = WSP(float, WS_RK), *oV = WSP(float, WS_RV), *oNA = WSP(float, WS_RNA), *oBB = WSP(float, WS_RBB), *oG = WSP(float, WS_RG), *oSB = WSP(float, WS_RSB);
    for (int grp = F.vcu; grp < T / 8; grp += F.G) {
        const int tok0 = grp * 8;
#pragma unroll 2
        for (int idx = F.tid; idx < 8 * RWC; idx += NWAVES * 64) {
            const int tk = idx / RWC, j = idx - tk * RWC; const int tok = tok0 + tk;
            const bool first = (tok & (SEQ - 1)) == 0;
            const float cur = p[(size_t)tok * PC + P_RW + j];
            const float pv = p[(size_t)(first ? tok : tok - 1) * PC + P_RW + j];
            const float prev = first ? 0.f : pv;
            float x = cur + mu[j] * (prev - cur);
            if (j >= 1152 && j < 1216) x = tanhf_(x);
            else if (j >= 1280) x = sigmoidf_(x);
            xs[tk * XS_PITCH + j] = x;
        }
        if (l == 1) for (int idx = F.tid; idx < 8 * 32; idx += NWAVES * 64) { const int tk = idx >> 5, j = idx & 31; xs[tk * XS_PITCH + RWC + j] = p[(size_t)(tok0 + tk) * PC + P_V1 + j]; }
        __syncthreads();
        if (F.wave < 6) {
            const int h = F.wave, ch = 64 * h + F.lane;
            float dw[8], da[8], dg[8], dv[8];
#pragma unroll
            for (int t = 0; t < 8; ++t) { dw[t] = 0.f; da[t] = 0.f; dg[t] = 0.f; dv[t] = 0.f; }
            const GAS float* w2 = INP(I_W2) + (size_t)l * 64 * RW + ch; const GAS float* a2 = INP(I_A2) + (size_t)l * 64 * RW + ch; const GAS float* g2 = INP(I_G2) + (size_t)l * 128 * RW + ch;
#pragma unroll 1
            for (int j = 0; j < 64; j += 4) {
                float wv[4], av[4];
#pragma unroll
                for (int q = 0; q < 4; ++q) { wv[q] = w2[(size_t)(j + q) * RW]; av[q] = a2[(size_t)(j + q) * RW]; }
#pragma unroll
                for (int t = 0; t < 8; ++t) { const f32x4 xw = *(const LAS f32x4*)(xs + t * XS_PITCH + 1152 + j); const f32x4 xa = *(const LAS f32x4*)(xs + t * XS_PITCH + 1216 + j);
                    dw[t] += xw.x * wv[0] + xw.y * wv[1] + xw.z * wv[2] + xw.w * wv[3]; da[t] += xa.x * av[0] + xa.y * av[1] + xa.z * av[2] + xa.w * av[3]; }
            }
#pragma unroll 1
            for (int j = 0; j < 128; j += 4) {
                float gv[4];
#pragma unroll
                for (int q = 0; q < 4; ++q) gv[q] = g2[(size_t)(j + q) * RW];
#pragma unroll
                for (int t = 0; t < 8; ++t) { const f32x4 xg = *(const LAS f32x4*)(xs + t * XS_PITCH + 1280 + j); dg[t] += xg.x * gv[0] + xg.y * gv[1] + xg.z * gv[2] + xg.w * gv[3]; }
            }
            if (l == 1) { const GAS float* v2 = INP(I_V2) + ch;
#pragma unroll 1
                for (int j = 0; j < 32; j += 4) {
                    float vv[4];
#pragma unroll
                    for (int q = 0; q < 4; ++q) vv[q] = v2[(size_t)(j + q) * RW];
#pragma unroll
                    for (int t = 0; t < 8; ++t) { const f32x4 xv = *(const LAS f32x4*)(xs + t * XS_PITCH + RWC + j); dv[t] += xv.x * vv[0] + xv.y * vv[1] + xv.z * vv[2] + xv.w * vv[3]; }
                } }
            LAS float* accl = (LAS float*)(F.lds + RING_OFF + 49152) + h * 2048;
#pragma unroll
            for (int t = 0; t < 8; ++t) { accl[(0 * 8 + t) * 64 + F.lane] = dw[t]; accl[(1 * 8 + t) * 64 + F.lane] = da[t]; accl[(2 * 8 + t) * 64 + F.lane] = dg[t]; accl[(3 * 8 + t) * 64 + F.lane] = dv[t]; }
            LDS_WAIT(); asm volatile("" ::: "memory");
            const float w0 = INP(I_W0)[l * RW + ch], a0 = INP(I_A0)[l * RW + ch], kks = INP(I_KKS)[l * RW + ch], ka = INP(I_KA)[l * RW + ch], rk = INP(I_RK)[l * RW + ch];
            const float v0 = (l == 1) ? INP(I_V0)[ch] : 0.f;
#pragma unroll 1
            for (int t = 0; t < 8; ++t) {
                const int tok = tok0 + t; const size_t o = (size_t)tok * RW + ch;
                const float dwt = accl[(0 * 8 + t) * 64 + F.lane], dat = accl[(1 * 8 + t) * 64 + F.lane], dgt = accl[(2 * 8 + t) * 64 + F.lane], dvt = accl[(3 * 8 + t) * 64 + F.lane];
                const float r = xs[t * XS_PITCH + ch], k = xs[t * XS_PITCH + 384 + ch]; float v = xs[t * XS_PITCH + 768 + ch];
                const float wlog = -softplusf_(-(w0 + dwt)) - 0.5f; const float lw = -fexp(wlog);
                const float ai = sigmoidf_(a0 + dat);
                if (l == 0) vfirst[o] = v; else { const float vg = sigmoidf_(v0 + dvt); v = v + (vfirst[o] - v) * vg; }
                const float kkv = k * kks; const float nrm = sqrtf(wave_sum(kkv * kkv)); const float kk = kkv / fmaxf(nrm, 1e-12f);
                const float kp = k * (1.0f + (ai - 1.0f) * ka);
                const float sb = wave_sum(r * kp * rk);
                oR[o] = r; oLW[o] = lw; oK[o] = kp; oV[o] = v; oNA[o] = -kk; oBB[o] = kk * ai; oG[o] = dgt;
                if (F.lane == 0) oSB[tok * 8 + h] = sb;
            }
        }
        __syncthreads();
    }
}

__device__ __forceinline__ void mlstm_qk_tile(Frame& F, int l, int b, int c, int h, int which, LAS float* tile) {
    const GAS float* p = WSP(float, WS_P);
    const GAS float* cw = INP(I_CONVW) + (size_t)l * 4 * 768 + which * 384 + 64 * h; const GAS float* cb = INP(I_CONVB) + l * 768 + which * 384 + 64 * h;
    const int pcol = P_ML + which * 384 + 64 * h;
#pragma unroll 4
    for (int idx = F.tid; idx < 4096; idx += NWAVES * 64) {
        const int s = idx >> 6, d = idx & 63; const int tl = 64 * c + s; const size_t tok = (size_t)b * SEQ + tl;
        float acc = cb[d];
#pragma unroll
        for (int i = 0; i < 4; ++i) { const int tt = tl - 3 + i; const float x = p[(tt >= 0 ? tok - 3 + i : tok) * PC + pcol + d]; acc += (tt >= 0 ? cw[i * 768 + d] : 0.f) * x; }
        float y = acc * sigmoidf_(acc); if (which == 0) y *= 0.125f;
        tile[s * 65 + d] = y;
    }
}
__device__ __forceinline__ void mlstm_summ(Frame& F, int l) {
    const GAS float* p = WSP(float, WS_P);
    LAS float* kt = (LAS float*)(F.lds + RING_OFF);
    LAS float* vt = kt + 64 * 65;
    LAS float* we = vt + 64 * 64;
    GAS float* kvloc = WSP(float, WS_MKV); GAS float* nloc = WSP(float, WS_MNL); GAS float* msc = WSP(float, WS_MSC); GAS float* mlg = WSP(float, WS_MLG); GAS float* mli = WSP(float, WS_MLI);
    for (int item = F.vcu; item < NITEM; item += F.G) {
        const int h = item % 6, bc = item / 6, c = bc % NCH, b = bc / NCH;
        const size_t tokb = (size_t)b * SEQ + 64 * c;
        if (F.wave == 0) {
            const size_t tok = tokb + F.lane;
            const float ig = p[tok * PC + P_ML + 1536 + h] + INP(I_BI)[l * 6 + h];
            const float lf = logsigmoidf_(p[tok * PC + P_ML + 1542 + h] + INP(I_BF)[l * 6 + h]);
            float g = lf;
#pragma unroll
            for (int o = 1; o < 64; o <<= 1) { const float t = __shfl_up(g, o); if (F.lane >= o) g += t; }
            const float glast = __shfl(g, 63);
            const float e = glast - g + ig; const float mloc = wave_max(e);
            we[F.lane] = fexp(e - mloc);
            mlg[tok * 8 + h] = g; mli[tok * 8 + h] = ig;
            if (F.lane == 0) { msc[item * 4 + 0] = mloc; msc[item * 4 + 1] = glast; }
        }
        mlstm_qk_tile(F, l, b, c, h, 1, kt);
        for (int idx = F.tid; idx < 4096; idx += NWAVES * 64) { const int s = idx >> 6, d = idx & 63; vt[idx] = p[(tokb + s) * PC + P_ML + 768 + 64 * h + d]; }
        __syncthreads();
        { const int kd = F.tid >> 3, v0 = (F.tid & 7) * 8;
          float acc[8]; float an = 0.f;
#pragma unroll
          for (int j = 0; j < 8; ++j) acc[j] = 0.f;
          for (int s = 0; s < 64; ++s) { const float kw = we[s] * kt[s * 65 + kd]; an += kw; const f32x4 va = *(const LAS f32x4*)(vt + s * 64 + v0), vb = *(const LAS f32x4*)(vt + s * 64 + v0 + 4);
              acc[0] += kw * va.x; acc[1] += kw * va.y; acc[2] += kw * va.z; acc[3] += kw * va.w; acc[4] += kw * vb.x; acc[5] += kw * vb.y; acc[6] += kw * vb.z; acc[7] += kw * vb.w; }
          GAS float* o = kvloc + (size_t)item * 4096 + kd * 64 + v0;
          *(GAS f32x4*)o = (f32x4){acc[0], acc[1], acc[2], acc[3]}; *(GAS f32x4*)(o + 4) = (f32x4){acc[4], acc[5], acc[6], acc[7]};
          if ((F.tid & 7) == 0) nloc[item * 64 + kd] = an; }
        __syncthreads();
    }
}

__device__ __forceinline__ void rwkv_scan_seq(Frame& F) {
    if (F.vcu >= 12) return;
    const int b = F.vcu / 6, h = F.vcu % 6;
    LAS float* L = (LAS float*)(F.lds + RING_OFF);
    LAS float* ybuf = L + 6 * 4096;
    const GAS float* src[6] = {WSP(float, WS_RR), WSP(float, WS_RLW), WSP(float, WS_RK), WSP(float, WS_RV), WSP(float, WS_RNA), WSP(float, WS_RBB)};
    GAS float* yraw = WSP(float, WS_RY);
    const int vrow = (F.tid >> 2) & 63, q = F.tid & 3;
    float S[16];
#pragma unroll
    for (int i = 0; i < 16; ++i) S[i] = 0.f;
    for (int blk = 0; blk < SEQ / 64; ++blk) {
        const size_t tokb = (size_t)b * SEQ + blk * 64;
#pragma unroll
        for (int a = 0; a < 6; ++a)
            for (int idx = F.tid; idx < 4096; idx += NWAVES * 64) { const int s = idx >> 6, d = idx & 63; float x = src[a][(tokb + s) * RW + 64 * h + d]; if (a == 1) x = fexp(x); L[a * 4096 + idx] = x; }
        __syncthreads();
        if (F.tid < 256) {
            for (int t = 0; t < 64; ++t) {
                const LAS float* base = L + t * 64 + 16 * q;
                float sa = 0.f;
#pragma unroll
                for (int i = 0; i < 16; ++i) sa += S[i] * base[4 * 4096 + i];
                sa += __shfl_xor(sa, 1); sa += __shfl_xor(sa, 2);
                const float vv = L[3 * 4096 + t * 64 + vrow];
                float y = 0.f;
#pragma unroll
                for (int i = 0; i < 16; ++i) { S[i] = S[i] * base[1 * 4096 + i] + sa * base[5 * 4096 + i] + vv * base[2 * 4096 + i]; y += S[i] * base[i]; }
                y += __shfl_xor(y, 1); y += __shfl_xor(y, 2);
                if (q == 0) ybuf[t * 64 + vrow] = y;
            }
        }
        __syncthreads();
        for (int idx = F.tid; idx < 4096; idx += NWAVES * 64) { const int s = idx >> 6, d = idx & 63; yraw[(tokb + s) * RW + 64 * h + d] = ybuf[idx]; }
        __syncthreads();
    }
}
__device__ __forceinline__ void mlstm_scan(Frame& F) {
    if (blockIdx.x < 48) return;
    const int gt = ((int)blockIdx.x - 48) * (NWAVES * 64) + F.tid;
    const GAS float* msc = WSP(float, WS_MSC);
    if (gt < 12 * 4096 + 12 * 64) {
        const bool isn = gt >= 12 * 4096;
        const int g2 = isn ? gt - 12 * 4096 : gt;
        const int bh = isn ? (g2 >> 6) : (g2 >> 12), el = isn ? (g2 & 63) : (g2 & 4095), b = bh / 6, h = bh % 6;
        const int es = isn ? 64 : 4096;
        const GAS float* src = isn ? WSP(float, WS_MNL) : WSP(float, WS_MKV); GAS float* dst = isn ? WSP(float, WS_MNP) : WSP(float, WS_MCP); GAS float* mscw = WSP(float, WS_MSC);
        float C = 0.f, m = 0.f;
        for (int c0 = 0; c0 < NCH; c0 += 8) {
            float x[8], ml[8], gl[8];
#pragma unroll
            for (int i = 0; i < 8; ++i) { const int item = (b * NCH + c0 + i) * 6 + h; ml[i] = msc[item * 4 + 0]; gl[i] = msc[item * 4 + 1]; x[i] = src[(size_t)item * es + el]; }
#pragma unroll
            for (int i = 0; i < 8; ++i) { const int item = (b * NCH + c0 + i) * 6 + h;
                dst[(size_t)item * es + el] = C;
                if (!isn && el == 0) mscw[item * 4 + 2] = m;
                const float mn = fmaxf(gl[i] + m, ml[i]); const float ao = fexp(gl[i] + m - mn), an = fexp(ml[i] - mn);
                C = ao * C + an * x[i]; m = mn; }
        }
    }
}

__device__ __forceinline__ void rwkv_finish(Frame& F, int l) {
    const GAS float* yraw = WSP(float, WS_RY); const GAS float* v = WSP(float, WS_RV); const GAS float* g = WSP(float, WS_RG); const GAS float* sb = WSP(float, WS_RSB);
    GAS bf16* ycat = WSP(bf16, WS_YCAT);
    const int gw = F.vcu * NWAVES + F.wave, NGW = F.G * NWAVES, lane = F.lane;
    for (int tok = gw; tok < T; tok += NGW) {
#pragma unroll
        for (int h = 0; h < 6; ++h) {
            const size_t o = (size_t)tok * RW + 64 * h + lane;
            const float y = yraw[o]; const float mean = wave_sum(y) * (1.f / 64.f); const float d = y - mean; const float var = wave_sum(d * d) * (1.f / 64.f);
            float r = d * (frsq(var + GN_EPS)) * INP(I_LNXG)[l * RW + 64 * h + lane] + INP(I_LNXB)[l * RW + 64 * h + lane];
            r += sb[tok * 8 + h] * v[o];
            r *= g[o];
            ycat[(size_t)tok * D + 256 + 64 * h + lane] = (bf16)f2bf(r);
        }
    }
}
__device__ __forceinline__ void mlstm_out(Frame& F, int l) {
    const GAS float* p = WSP(float, WS_P);
    LAS float* qt = (LAS float*)(F.lds + RING_OFF);
    LAS float* kt = qt + 64 * 65;
    LAS float* At = kt + 64 * 65;
    LAS float* vt = At + 64 * 65;
    LAS float* cpt = vt + 4096;
    LAS float* sm = cpt + 4096;
    const GAS float* cp = WSP(float, WS_MCP); const GAS float* np = WSP(float, WS_MNP); const GAS float* msc = WSP(float, WS_MSC); const GAS float* mlg = WSP(float, WS_MLG); const GAS float* mli = WSP(float, WS_MLI);
    GAS bf16* ycat = WSP(bf16, WS_YCAT);
    for (int item = F.vcu; item < NITEM; item += F.G) {
        const int h = item % 6, bc = item / 6, c = bc % NCH, b = bc / NCH;
        const size_t tokb = (size_t)b * SEQ + 64 * c;
        mlstm_qk_tile(F, l, b, c, h, 0, qt);
        mlstm_qk_tile(F, l, b, c, h, 1, kt);
        for (int idx = F.tid; idx < 4096; idx += NWAVES * 64) { const int s = idx >> 6, d = idx & 63; vt[idx] = p[(tokb + s) * PC + P_ML + 768 + 64 * h + d]; cpt[idx] = cp[(size_t)item * 4096 + idx]; }
        if (F.tid < 64) { sm[F.tid] = mlg[(tokb + F.tid) * 8 + h]; sm[64 + F.tid] = mli[(tokb + F.tid) * 8 + h]; sm[128 + F.tid] = np[item * 64 + F.tid]; }
        const float mprev = msc[item * 4 + 2];
        __syncthreads();
        const int j = F.tid >> 3, sub = F.tid & 7;
        { const int s0 = sub * 8;
          float acc[8];
#pragma unroll
          for (int i = 0; i < 8; ++i) acc[i] = 0.f;
          for (int d = 0; d < 64; ++d) { const float qv = qt[j * 65 + d];
#pragma unroll
              for (int i = 0; i < 8; ++i) acc[i] += qv * kt[(s0 + i) * 65 + d]; }
          const float gj = sm[j];
          float dl[8]; float mx = -INFINITY;
#pragma unroll
          for (int i = 0; i < 8; ++i) { const int s = s0 + i; dl[i] = (s <= j) ? (gj - sm[s] + sm[64 + s]) : -INFINITY; mx = fmaxf(mx, dl[i]); }
          mx = fmaxf(mx, __shfl_xor(mx, 1)); mx = fmaxf(mx, __shfl_xor(mx, 2)); mx = fmaxf(mx, __shfl_xor(mx, 4));
          const float il = gj + mprev; const float mj = fmaxf(mx, il);
          float dsum = 0.f;
#pragma unroll
          for (int i = 0; i < 8; ++i) { const int s = s0 + i; const float w = (s <= j) ? fexp(dl[i] - mj) * acc[i] : 0.f; At[j * 65 + s] = w; dsum += w; }
          dsum += __shfl_xor(dsum, 1); dsum += __shfl_xor(dsum, 2); dsum += __shfl_xor(dsum, 4);
          if (sub == 0) { float qn = 0.f; for (int d = 0; d < 64; ++d) qn += qt[j * 65 + d] * sm[128 + d];
              const float wi = fexp(il - mj); const float den = dsum + wi * qn;
              sm[192 + j] = wi; sm[256 + j] = frcp(fmaxf(fabsf(den), fexp(-mj))); } }
        __syncthreads();
        { const int v0 = sub * 8;
          float acc[8];
#pragma unroll
          for (int i = 0; i < 8; ++i) acc[i] = 0.f;
          for (int s = 0; s <= j; ++s) { const float a = At[j * 65 + s]; const f32x4 va = *(const LAS f32x4*)(vt + s * 64 + v0), vb = *(const LAS f32x4*)(vt + s * 64 + v0 + 4);
              acc[0] += a * va.x; acc[1] += a * va.y; acc[2] += a * va.z; acc[3] += a * va.w; acc[4] += a * vb.x; acc[5] += a * vb.y; acc[6] += a * vb.z; acc[7] += a * vb.w; }
          const float wi = sm[192 + j];
          for (int d = 0; d < 64; ++d) { const float a = qt[j * 65 + d] * wi; const f32x4 va = *(const LAS f32x4*)(cpt + d * 64 + v0), vb = *(const LAS f32x4*)(cpt + d * 64 + v0 + 4);
              acc[0] += a * va.x; acc[1] += a * va.y; acc[2] += a * va.z; acc[3] += a * va.w; acc[4] += a * vb.x; acc[5] += a * vb.y; acc[6] += a * vb.z; acc[7] += a * vb.w; }
          const float di = sm[256 + j];
          float sum = 0.f;
#pragma unroll
          for (int i = 0; i < 8; ++i) { acc[i] *= di; sum += acc[i]; }
          sum += __shfl_xor(sum, 1); sum += __shfl_xor(sum, 2); sum += __shfl_xor(sum, 4);
          const float mean = sum * (1.f / 64.f); float vs = 0.f;
#pragma unroll
          for (int i = 0; i < 8; ++i) { acc[i] -= mean; vs += acc[i] * acc[i]; }
          vs += __shfl_xor(vs, 1); vs += __shfl_xor(vs, 2); vs += __shfl_xor(vs, 4);
          const float rstd = frsq(vs * (1.f / 64.f) + LN_EPS);
          const size_t tok = tokb + j;
          const GAS float* og = p + tok * PC + P_ML + 1152 + 64 * h + v0; const GAS float* ng = INP(I_NORMG) + l * 384 + 64 * h + v0;
          float o[8];
#pragma unroll
          for (int i = 0; i < 8; ++i) o[i] = sigmoidf_(og[i]) * (acc[i] * rstd * ng[i]);
          v4u w; w.x = pk2(o[0], o[1]); w.y = pk2(o[2], o[3]); w.z = pk2(o[4], o[5]); w.w = pk2(o[6], o[7]);
          *(GAS v4u*)(ycat + tok * D + 640 + 64 * h + v0) = w; }
        __syncthreads();
    }
}

__device__ __forceinline__ void ln_rows(Frame& F, const GAS float* hin, const GAS float* add, const GAS float* gam, const GAS float* bet, GAS float* out32, GAS bf16* h16) {
    const int gw = F.vcu * NWAVES + F.wave, NGW = F.G * NWAVES, lane = F.lane;
    for (int m = gw; m < T; m += NGW) {
        const GAS f32x4* hr = (const GAS f32x4*)(hin + (size_t)m * D) + lane; const GAS f32x4* ar = (const GAS f32x4*)(add + (size_t)m * D) + lane;
        f32x4 v[4]; float s = 0.f;
#pragma unroll
        for (int j = 0; j < 4; ++j) { v[j] = hr[64 * j] * DN_ALPHA + ar[64 * j]; s += (v[j].x + v[j].y) + (v[j].z + v[j].w); }
        const float mean = wave_sum(s) * (1.f / D); float s2 = 0.f;
#pragma unroll
        for (int j = 0; j < 4; ++j) { v[j] = v[j] - mean; s2 += (v[j].x * v[j].x + v[j].y * v[j].y) + (v[j].z * v[j].z + v[j].w * v[j].w); }
        const float rstd = frsq(wave_sum(s2) * (1.f / D) + LN_EPS);
        GAS f32x4* o4 = (GAS f32x4*)(out32 + (size_t)m * D) + lane; GAS v2u* o2 = (GAS v2u*)(h16 + (size_t)m * D) + lane;
#pragma unroll
        for (int j = 0; j < 4; ++j) { const f32x4 gg = *((const GAS f32x4*)gam + 64 * j + lane), bb = *((const GAS f32x4*)bet + 64 * j + lane);
            const f32x4 r = v[j] * rstd * gg + bb; o4[64 * j] = r; v2u w; w.x = pk2(r.x, r.y); w.y = pk2(r.z, r.w); o2[64 * j] = w; }
    }
}
__device__ __forceinline__ void router_phase(Frame& F, int l, const GAS float* h1) {
    LAS float* xs = (LAS float*)(F.lds + RING_OFF + F.wave * 16384);
    LAS unsigned* hist = (LAS unsigned*)(F.lds + LDSCTL_OFF);
    const GAS float* rw = INP(I_RTW) + (size_t)l * D * NE; const GAS float* rb = INP(I_RTB) + l * NE;
    GAS int* tke = WSP(int, WS_TKE); GAS float* tkg = WSP(float, WS_TKG);
    const int gw = F.vcu * NWAVES + F.wave, NGW = F.G * NWAVES, lane = F.lane;
    const int e = lane & 31, half = lane >> 5;
    for (int grp = gw; grp < T / 4; grp += NGW) {
        const int row0 = grp * 4;
#pragma unroll
        for (int r = 0; r < 4; ++r) { const GAS f32x4* xr = (const GAS f32x4*)(h1 + (size_t)(row0 + r) * D) + lane;
#pragma unroll
            for (int j = 0; j < 4; ++j) *(LAS f32x4*)(xs + r * 1024 + 4 * (64 * j + lane)) = xr[64 * j]; }
        LDS_WAIT(); asm volatile("" ::: "memory");
        float acc[4] = {0.f, 0.f, 0.f, 0.f};
        const GAS float* wp = rw + (size_t)(512 * half) * NE + e;
        for (int k = 0; k < 512; k += 4) {
            const float w0 = wp[(size_t)(k + 0) * NE], w1 = wp[(size_t)(k + 1) * NE], w2 = wp[(size_t)(k + 2) * NE], w3 = wp[(size_t)(k + 3) * NE];
#pragma unroll
            for (int r = 0; r < 4; ++r) { const f32x4 x = *(const LAS f32x4*)(xs + r * 1024 + 512 * half + k); acc[r] += (x.x * w0 + x.y * w1) + (x.z * w2 + x.w * w3); }
        }
        const float bias = rb[e];
#pragma unroll
        for (int r = 0; r < 4; ++r) {
            float lg = acc[r] + __shfl_xor(acc[r], 32) + bias;
            float v = (lane < 32) ? lg : -INFINITY;
            float tv[4]; int ti[4];
#pragma unroll
            for (int i = 0; i < 4; ++i) { const float m = wave_max(v); const unsigned long long bal = __ballot(v == m); const int idx = __ffsll((long long)bal) - 1; tv[i] = m; ti[i] = idx; if (lane == idx) v = -INFINITY; }
            const float e1 = fexp(tv[1] - tv[0]), e2 = fexp(tv[2] - tv[0]), e3 = fexp(tv[3] - tv[0]); const float inv = frcp(1.0f + e1 + e2 + e3);
            if (lane < 4) { const int ee = (lane == 0) ? ti[0] : (lane == 1) ? ti[1] : (lane == 2) ? ti[2] : ti[3]; const float gg = ((lane == 0) ? 1.0f : (lane == 1) ? e1 : (lane == 2) ? e2 : e3) * inv;
                tke[(row0 + r) * 4 + lane] = ee; tkg[(row0 + r) * 4 + lane] = gg; __hip_atomic_fetch_add(&hist[ee], 1u, __ATOMIC_RELAXED, __HIP_MEMORY_SCOPE_WORKGROUP); }
        }
        LDS_WAIT(); asm volatile("" ::: "memory");
    }
    __syncthreads();
    if (F.tid < NE) { const unsigned c = hist[F.tid]; if (c) __hip_atomic_fetch_add(F.ctl + CW_CNT + l * NE + F.tid, c, RLX_AGENT); }
    __syncthreads();
    if (F.tid < NE) hist[F.tid] = 0u;
    __syncthreads();
}
__device__ __forceinline__ void assign_phase(Frame& F, int l) {
    LAS unsigned* pst = (LAS unsigned*)(F.lds + RING_OFF);
    if (F.tid == 0) {
        unsigned run = 0;
        for (int e = 0; e < NE; ++e) { const unsigned c = __hip_atomic_load(F.ctl + CW_CNT + l * NE + e, RLX_AGENT); pst[e] = run; const unsigned nbk = (c + 255u) >> 8;
            if (blockIdx.x == 0) for (unsigned k = 0; k < nbk; ++k) __hip_atomic_store(F.ctl + CW_BLKE + l * 320 + (run >> 8) + k, (unsigned)e, RLX_AGENT);
            run += nbk << 8; }
        if (blockIdx.x == 0) __hip_atomic_store(F.ctl + CW_NB + l, run >> 8, RLX_AGENT);
    }
    __syncthreads();
    const GAS int* tke = WSP(int, WS_TKE); const GAS float* tkg = WSP(float, WS_TKG); GAS int* slot_of = WSP(int, WS_SLOT); GAS float* gsl = WSP(float, WS_GSL);
    const GAS bf16* h16 = WSP(bf16, WS_H16); GAS bf16* xg = WSP(bf16, WS_XG);
    const int gw = F.vcu * NWAVES + F.wave, NGW = F.G * NWAVES, lane = F.lane;
    for (int tok = gw; tok < T; tok += NGW) {
        int slot = 0;
        if (lane < 4) { const int e = tke[tok * 4 + lane]; const unsigned pos = __hip_atomic_fetch_add(F.ctl + CW_CUR + l * NE + e, 1u, RLX_AGENT); slot = (int)(pst[e] + pos);
            slot_of[tok * 4 + lane] = slot; gsl[slot] = tkg[tok * 4 + lane]; }
        const GAS v4u* src = (const GAS v4u*)(h16 + (size_t)tok * D) + lane; const v4u a = src[0], b = src[64];
#pragma unroll
        for (int i = 0; i < 4; ++i) { const int s = __shfl(slot, i); GAS v4u* dst = (GAS v4u*)(xg + (size_t)s * D) + lane; dst[0] = a; dst[64] = b; }
    }
}
__device__ __forceinline__ void combine_phase(Frame& F, const GAS float* h1, const GAS float* gam, const GAS float* bet, GAS float* out32, GAS bf16* h16) {
    const GAS int* slot_of = WSP(int, WS_SLOT); const GAS bf16* osl = WSP(bf16, WS_OSL);
    const int gw = F.vcu * NWAVES + F.wave, NGW = F.G * NWAVES, lane = F.lane;
    for (int m = gw; m < T; m += NGW) {
        const GAS f32x4* hr = (const GAS f32x4*)(h1 + (size_t)m * D) + lane;
        f32x4 v[4];
#pragma unroll
        for (int j = 0; j < 4; ++j) v[j] = hr[64 * j] * DN_ALPHA;
        const int sl = (lane < 4) ? slot_of[m * 4 + lane] : 0;
#pragma unroll
        for (int i = 0; i < 4; ++i) { const int s = __shfl(sl, i); const GAS v2u* orow = (const GAS v2u*)(osl + (size_t)s * D) + lane;
#pragma unroll
            for (int j = 0; j < 4; ++j) { const v2u w = orow[64 * j]; v[j].x += bf2f(w.x & 0xffffu); v[j].y += bf2f(w.x >> 16); v[j].z += bf2f(w.y & 0xffffu); v[j].w += bf2f(w.y >> 16); } }
        float s = 0.f;
#pragma unroll
        for (int j = 0; j < 4; ++j) s += (v[j].x + v[j].y) + (v[j].z + v[j].w);
        const float mean = wave_sum(s) * (1.f / D); float s2 = 0.f;
#pragma unroll
        for (int j = 0; j < 4; ++j) { v[j] = v[j] - mean; s2 += (v[j].x * v[j].x + v[j].y * v[j].y) + (v[j].z * v[j].z + v[j].w * v[j].w); }
        const float rstd = frsq(wave_sum(s2) * (1.f / D) + LN_EPS);
        GAS f32x4* o4 = (GAS f32x4*)(out32 + (size_t)m * D) + lane; GAS v2u* o2 = (GAS v2u*)(h16 + (size_t)m * D) + lane;
#pragma unroll
        for (int j = 0; j < 4; ++j) { const f32x4 gg = *((const GAS f32x4*)gam + 64 * j + lane), bb = *((const GAS f32x4*)bet + 64 * j + lane);
            const f32x4 r = v[j] * rstd * gg + bb; o4[64 * j] = r; v2u w; w.x = pk2(r.x, r.y); w.y = pk2(r.z, r.w); o2[64 * j] = w; }
    }
}

constexpr int TP = 68;
typedef short bf16x8_t __attribute__((ext_vector_type(8)));
typedef float f32x2_t __attribute__((ext_vector_type(2))); typedef __bf16 bf16x2_t __attribute__((ext_vector_type(2)));
__device__ __forceinline__ unsigned cvtpk(float lo, float hi) { f32x2_t v = {lo, hi}; bf16x2_t b = __builtin_convertvector(v, bf16x2_t); return __builtin_bit_cast(unsigned, b); }
__device__ __forceinline__ int perm_idx(int pos) { const int s = pos >> 5, q = (pos >> 3) & 3, j = pos & 7; return 32 * s + 16 * (j >> 2) + 4 * q + (j & 3); }

__device__ __forceinline__ void mm_nt(const LAS float* P, const LAS float* Q, int t, int sub, float (&out)[8]) {
#pragma unroll
    for (int j = 0; j < 8; ++j) out[j] = 0.f;
#pragma unroll 4
    for (int k = 0; k < 64; k += 4) {
        const f32x4 a = *(const LAS f32x4*)(P + t * TP + k);
#pragma unroll
        for (int j = 0; j < 8; ++j) { const f32x4 q = *(const LAS f32x4*)(Q + (sub + 8 * j) * TP + k); out[j] += (a.x * q.x + a.y * q.y) + (a.z * q.z + a.w * q.w); }
    }
}
__device__ __forceinline__ void mm_nn(const LAS float* X, const LAS float* Vt, int t, int sub, float (&out)[8]) {
#pragma unroll
    for (int j = 0; j < 8; ++j) out[j] = 0.f;
#pragma unroll 2
    for (int i = 0; i < 64; i += 4) {
        const f32x4 a = *(const LAS f32x4*)(X + t * TP + i);
#pragma unroll
        for (int e = 0; e < 4; ++e) { const float av = a[e]; const f32x4 v0 = *(const LAS f32x4*)(Vt + (i + e) * TP + 8 * sub), v1 = *(const LAS f32x4*)(Vt + (i + e) * TP + 8 * sub + 4);
            out[0] += av * v0.x; out[1] += av * v0.y; out[2] += av * v0.z; out[3] += av * v0.w; out[4] += av * v1.x; out[5] += av * v1.y; out[6] += av * v1.z; out[7] += av * v1.w; }
    }
}
__device__ __forceinline__ void rwkv_chunk_prep(Frame& F) {
    LAS float* tA = (LAS float*)(F.lds + RING_OFF);
    LAS float* tR = tA + 64 * TP; LAS float* tB = tR + 64 * TP; LAS float* tK = tB + 64 * TP; LAS float* tV = tK + 64 * TP; LAS float* tT = tV + 64 * TP; LAS float* tX = tT + 64 * TP;
    const GAS float* gR = WSP(float, WS_RR), *gLW = WSP(float, WS_RLW), *gK = WSP(float, WS_RK), *gV = WSP(float, WS_RV), *gNA = WSP(float, WS_RNA), *gBB = WSP(float, WS_RBB);
    const int t = F.tid >> 3, sub = F.tid & 7;
    for (int item = F.vcu; item < NITEM; item += F.G) {
        const int h = item % 6, bc = item / 6, c = bc % NCH, b = bc / NCH; const size_t tokb = (size_t)b * SEQ + 64 * c;
        const int ci = (b * 6 + h) * NCH + c;
        GAS unsigned char* chd = F.ws + WS_RCH + (size_t)ci * CH_STRIDE; GAS unsigned char* cod = F.ws + WS_RCO + (size_t)ci * CO_STRIDE;
        for (int idx = F.tid; idx < 4096; idx += NWAVES * 64) { const int s = idx >> 6, d = idx & 63; tX[s * TP + d] = gLW[(tokb + s) * RW + 64 * h + d]; }
        __syncthreads();
        if (F.tid < 64) { float run = 0.f; for (int s = 0; s < 64; ++s) { run += tX[s * TP + F.tid]; tX[s * TP + F.tid] = run; } ((GAS float*)(chd + 49152))[F.tid] = fexp(run); }
        __syncthreads();
        for (int idx = F.tid; idx < 4096; idx += NWAVES * 64) { const int s = idx >> 6, d = idx & 63; const size_t o = (tokb + s) * RW + 64 * h + d;
            const float cw = tX[s * TP + d]; const float lw = gLW[o]; const float ecw = fexp(cw), ecx = fexp(cw - lw), ein = fexp(-cw);
            tA[s * TP + d] = gNA[o] * ecx; tR[s * TP + d] = gR[o] * ecw; tB[s * TP + d] = gBB[o] * ein; tK[s * TP + d] = gK[o] * ein; tV[s * TP + d] = gV[o]; }
        __syncthreads();
        float m[8];
        mm_nt(tA, tK, t, sub, m);
#pragma unroll
        for (int j = 0; j < 8; ++j) { const int i = sub + 8 * j; tX[t * TP + i] = (i < t) ? m[j] : 0.f; }
        __syncthreads();
        mm_nn(tX, tV, t, sub, m);
        *(LAS f32x4*)(tT + t * TP + 8 * sub) = (f32x4){m[0], m[1], m[2], m[3]}; *(LAS f32x4*)(tT + t * TP + 8 * sub + 4) = (f32x4){m[4], m[5], m[6], m[7]};
        __syncthreads();
        mm_nt(tR, tK, t, sub, m);
#pragma unroll
        for (int j = 0; j < 8; ++j) { const int i = sub + 8 * j; tX[t * TP + i] = (i <= t) ? m[j] : 0.f; }
        __syncthreads();
        mm_nn(tX, tV, t, sub, m);
        { GAS float* y0 = (GAS float*)(cod + 16384) + t * 64 + 8 * sub; *(GAS f32x4*)y0 = (f32x4){m[0], m[1], m[2], m[3]}; *(GAS f32x4*)(y0 + 4) = (f32x4){m[4], m[5], m[6], m[7]}; }
        __syncthreads();
        mm_nt(tR, tB, t, sub, m);
#pragma unroll
        for (int j = 0; j < 8; ++j) { const int i = sub + 8 * j; tX[t * TP + i] = (i <= t) ? m[j] : 0.f; }
        __syncthreads();
        { const f32x4 a = *(const LAS f32x4*)(tX + t * TP + 8 * sub), bq = *(const LAS f32x4*)(tX + t * TP + 8 * sub + 4);
          v4u w; w.x = pk2(a.x, a.y); w.y = pk2(a.z, a.w); w.z = pk2(bq.x, bq.y); w.w = pk2(bq.z, bq.w); *(GAS v4u*)(cod + 8192 + (t * 64 + 8 * sub) * 2) = w; }
        __syncthreads();
        mm_nt(tA, tB, t, sub, m);
#pragma unroll
        for (int j = 0; j < 8; ++j) { const int i = sub + 8 * j; tX[i * TP + t] = (i < t) ? m[j] : 0.f; }
        __syncthreads();
        if (F.wave < 2) {
            LAS float* tile = (F.wave == 0) ? tA : tT; const int cidx = F.lane;
            const LAS float* tXv = tX + (F.lane & 0); asm volatile("" : "+v"(tXv));
            float acc[64];
#pragma unroll
            for (int i = 0; i < 64; ++i) acc[i] = tile[i * TP + cidx];
#pragma unroll
            for (int i = 0; i < 63; ++i) {
                const float xi = acc[i];
#pragma unroll
                for (int t4 = ((i + 1) & ~3); t4 < 64; t4 += 4) { const f32x4 mm = *(const LAS f32x4*)(tXv + i * TP + t4);
                    if (t4 + 0 > i) acc[t4 + 0] += mm.x * xi; if (t4 + 1 > i) acc[t4 + 1] += mm.y * xi; if (t4 + 2 > i) acc[t4 + 2] += mm.z * xi; if (t4 + 3 > i) acc[t4 + 3] += mm.w * xi; }
            }
#pragma unroll
            for (int i = 0; i < 64; ++i) tile[i * TP + cidx] = acc[i];
        }
        __syncthreads();
        { const int s_ = sub >> 2, q_ = sub & 3; const int i0 = 32 * s_ + 4 * q_, i1 = i0 + 16;
          { const f32x4 a = *(const LAS f32x4*)(tA + t * TP + i0), bq = *(const LAS f32x4*)(tA + t * TP + i1);
            v4u w; w.x = pk2(a.x, a.y); w.y = pk2(a.z, a.w); w.z = pk2(bq.x, bq.y); w.w = pk2(bq.z, bq.w); *(GAS v4u*)(chd + (t * 64 + 8 * sub) * 2) = w; }
          { float e[8];
#pragma unroll
            for (int j = 0; j < 8; ++j) e[j] = tB[((j < 4 ? i0 : i1) + (j & 3)) * TP + t];
            v4u w; w.x = pk2(e[0], e[1]); w.y = pk2(e[2], e[3]); w.z = pk2(e[4], e[5]); w.w = pk2(e[6], e[7]); *(GAS v4u*)(chd + 8192 + (t * 64 + 8 * sub) * 2) = w;
#pragma unroll
            for (int j = 0; j < 8; ++j) e[j] = tK[((j < 4 ? i0 : i1) + (j & 3)) * TP + t];
            w.x = pk2(e[0], e[1]); w.y = pk2(e[2], e[3]); w.z = pk2(e[4], e[5]); w.w = pk2(e[6], e[7]); *(GAS v4u*)(chd + 16384 + (t * 64 + 8 * sub) * 2) = w;
#pragma unroll
            for (int j = 0; j < 8; ++j) e[j] = tV[((j < 4 ? i0 : i1) + (j & 3)) * TP + t];
            w.x = pk2(e[0], e[1]); w.y = pk2(e[2], e[3]); w.z = pk2(e[4], e[5]); w.w = pk2(e[6], e[7]); *(GAS v4u*)(chd + 24576 + (t * 64 + 8 * sub) * 2) = w;
#pragma unroll
            for (int j = 0; j < 8; ++j) e[j] = tT[(8 * sub + j) * TP + t];
            GAS float* u0 = (GAS float*)(chd + 32768) + t * 64 + 8 * sub; *(GAS f32x4*)u0 = (f32x4){e[0], e[1], e[2], e[3]}; *(GAS f32x4*)(u0 + 4) = (f32x4){e[4], e[5], e[6], e[7]}; }
          { const f32x4 a = *(const LAS f32x4*)(tR + t * TP + 8 * sub), bq = *(const LAS f32x4*)(tR + t * TP + 8 * sub + 4);
            v4u w; w.x = pk2(a.x, a.y); w.y = pk2(a.z, a.w); w.z = pk2(bq.x, bq.y); w.w = pk2(bq.z, bq.w); *(GAS v4u*)(cod + (t * 64 + 8 * sub) * 2) = w; } }
        __syncthreads();
    }
}

constexpr int CH_STAGE = 49152;
constexpr int CH_PIECES = (int)(CH_STRIDE / 16);
#define CH_BAR() do { asm volatile("s_waitcnt lgkmcnt(0)" ::: "memory"); __builtin_amdgcn_s_barrier(); asm volatile("" ::: "memory"); } while (0)
__device__ __forceinline__ void rwkv_chain(Frame& F) {
    if (F.vcu >= 12) return;
    const int bh = F.vcu;
    const GAS unsigned char* src = F.ws + WS_RCH + (size_t)bh * NCH * CH_STRIDE;
    GAS unsigned char* s0g = F.ws + WS_RS0 + (size_t)bh * NCH * 8192; GAS unsigned char* utg = F.ws + WS_RUT + (size_t)bh * NCH * 8192;
    LAS unsigned char* st0 = F.lds + RING_OFF; LAS unsigned char* st1 = st0 + CH_STAGE;
    const int lane = F.lane, q = lane >> 4, r16 = lane & 15;
    if (F.wave >= 4) {
        const int lt = F.tid - 256;
        v4u RA[12], RB[12];
#define CH_LOAD(R, c) do { const GAS v4u* g_ = (const GAS v4u*)(src + (size_t)(c) * CH_STRIDE); _Pragma("unroll") for (int p = 0; p < 12; ++p) R[p] = g_[p * 256 + lt]; } while (0)
#define CH_WRITE(R, st) do { _Pragma("unroll") for (int p = 0; p < 12; ++p) *(LAS v4u*)((st) + (p * 256 + lt) * 16) = R[p]; } while (0)
        CH_LOAD(RA, 0); CH_LOAD(RB, 1);
        CH_WRITE(RA, st0); CH_LOAD(RA, 2);
        CH_BAR();
        for (int c = 0; c < NCH; c += 2) {
            CH_WRITE(RB, st1); if (c + 3 < NCH) CH_LOAD(RB, c + 3);
            CH_BAR();
            if (c + 2 < NCH) { CH_WRITE(RA, st0); if (c + 4 < NCH) CH_LOAD(RA, c + 4); }
            CH_BAR();
        }
#undef CH_LOAD
#undef CH_WRITE
    } else {
        const int w = F.wave; const int vrow = 16 * w + r16;
        f32x4 sacc[4]; bf16x8_t sb[2];
#pragma unroll
        for (int i = 0; i < 4; ++i) sacc[i] = (f32x4){0.f, 0.f, 0.f, 0.f};
        sb[0] = (bf16x8_t){0, 0, 0, 0, 0, 0, 0, 0}; sb[1] = sb[0];
        f32x4 gln[4];
#pragma unroll
        for (int kt = 0; kt < 4; ++kt) gln[kt] = *(const GAS f32x4*)(src + 49152 + (16 * kt + 4 * q) * 4);
        CH_BAR();
        for (int c = 0; c < NCH; ++c) {
            const LAS unsigned char* st = (c & 1) ? st1 : st0;
            f32x4 glc[4];
#pragma unroll
            for (int kt = 0; kt < 4; ++kt) glc[kt] = gln[kt];
            { const int cn = (c + 1 < NCH) ? c + 1 : c;
#pragma unroll
              for (int kt = 0; kt < 4; ++kt) gln[kt] = *(const GAS f32x4*)(src + (size_t)cn * CH_STRIDE + 49152 + (16 * kt + 4 * q) * 4); }
            { GAS v2u* o = (GAS v2u*)(s0g + (size_t)c * 8192 + (vrow * 64 + 4 * q) * 2);
              const v4u w0 = __builtin_bit_cast(v4u, sb[0]), w1 = __builtin_bit_cast(v4u, sb[1]);
              o[0] = (v2u){w0.x, w0.y}; o[4] = (v2u){w0.z, w0.w}; o[8] = (v2u){w1.x, w1.y}; o[12] = (v2u){w1.z, w1.w}; }
            f32x4 u[4];
#pragma unroll
            for (int tt = 0; tt < 4; ++tt) {
                u[tt] = *(const LAS f32x4*)(st + 32768 + (vrow * 64 + 16 * tt + 4 * q) * 4);
#pragma unroll
                for (int s = 0; s < 2; ++s) { const bf16x8_t a = *(const LAS bf16x8_t*)(st + ((16 * tt + r16) * 64 + 32 * s + 8 * q) * 2); u[tt] = __builtin_amdgcn_mfma_f32_16x16x32_bf16(a, sb[s], u[tt], 0, 0, 0); }
            }
            bf16x8_t ub[2];
            { v4u w0, w1; w0.x = cvtpk(u[0][0], u[0][1]); w0.y = cvtpk(u[0][2], u[0][3]); w0.z = cvtpk(u[1][0], u[1][1]); w0.w = cvtpk(u[1][2], u[1][3]);
              w1.x = cvtpk(u[2][0], u[2][1]); w1.y = cvtpk(u[2][2], u[2][3]); w1.z = cvtpk(u[3][0], u[3][1]); w1.w = cvtpk(u[3][2], u[3][3]);
              ub[0] = __builtin_bit_cast(bf16x8_t, w0); ub[1] = __builtin_bit_cast(bf16x8_t, w1);
              GAS v2u* o = (GAS v2u*)(utg + (size_t)c * 8192 + (vrow * 64 + 4 * q) * 2);
              o[0] = (v2u){w0.x, w0.y}; o[4] = (v2u){w0.z, w0.w}; o[8] = (v2u){w1.x, w1.y}; o[12] = (v2u){w1.z, w1.w}; }
            bf16x8_t vb[2];
#pragma unroll
            for (int s = 0; s < 2; ++s) vb[s] = *(const LAS bf16x8_t*)(st + 24576 + (vrow * 64 + 32 * s + 8 * q) * 2);
#pragma unroll
            for (int kt = 0; kt < 4; ++kt) {
#pragma unroll
                for (int s = 0; s < 2; ++s) { const bf16x8_t a = *(const LAS bf16x8_t*)(st + 16384 + ((16 * kt + r16) * 64 + 32 * s + 8 * q) * 2); sacc[kt] = __builtin_amdgcn_mfma_f32_16x16x32_bf16(a, vb[s], sacc[kt], 0, 0, 0); }
#pragma unroll
                for (int s = 0; s < 2; ++s) { const bf16x8_t a = *(const LAS bf16x8_t*)(st + 8192 + ((16 * kt + r16) * 64 + 32 * s + 8 * q) * 2); sacc[kt] = __builtin_amdgcn_mfma_f32_16x16x32_bf16(a, ub[s], sacc[kt], 0, 0, 0); }
                sacc[kt] = sacc[kt] * glc[kt];
            }
            { v4u w0, w1; w0.x = cvtpk(sacc[0][0], sacc[0][1]); w0.y = cvtpk(sacc[0][2], sacc[0][3]); w0.z = cvtpk(sacc[1][0], sacc[1][1]); w0.w = cvtpk(sacc[1][2], sacc[1][3]);
              w1.x = cvtpk(sacc[2][0], sacc[2][1]); w1.y = cvtpk(sacc[2][2], sacc[2][3]); w1.z = cvtpk(sacc[3][0], sacc[3][1]); w1.w = cvtpk(sacc[3][2], sacc[3][3]);
              sb[0] = __builtin_bit_cast(bf16x8_t, w0); sb[1] = __builtin_bit_cast(bf16x8_t, w1); }
            CH_BAR();
        }
    }
}

__device__ __forceinline__ void rwkv_chunk_out(Frame& F, int l) {
    LAS float* tRq = (LAS float*)(F.lds + RING_OFF);
    LAS float* tS = tRq + 64 * TP; LAS float* tM = tS + 64 * TP; LAS float* tU = tM + 64 * TP;
    const GAS float* gv = WSP(float, WS_RV); const GAS float* gg = WSP(float, WS_RG); const GAS float* sbp = WSP(float, WS_RSB);
    GAS bf16* ycat = WSP(bf16, WS_YCAT);
    const int t = F.tid >> 3, sub = F.tid & 7;
    for (int item = F.vcu; item < NITEM; item += F.G) {
        const int h = item % 6, bc = item / 6, c = bc % NCH, b = bc / NCH; const size_t tokb = (size_t)b * SEQ + 64 * c;
        const int ci = (b * 6 + h) * NCH + c;
        const GAS unsigned char* cod = F.ws + WS_RCO + (size_t)ci * CO_STRIDE;
        const GAS bf16* srcs[4] = {(const GAS bf16*)cod, (const GAS bf16*)(F.ws + WS_RS0 + (size_t)ci * 8192), (const GAS bf16*)(cod + 8192), (const GAS bf16*)(F.ws + WS_RUT + (size_t)ci * 8192)};
#pragma unroll
        for (int a = 0; a < 4; ++a) {
            LAS float* dstt = tRq + a * 64 * TP;
            const v4u wv = *(const GAS v4u*)(srcs[a] + t * 64 + 8 * sub);
            *(LAS f32x4*)(dstt + t * TP + 8 * sub) = (f32x4){bf2f(wv.x & 0xffffu), bf2f(wv.x >> 16), bf2f(wv.y & 0xffffu), bf2f(wv.y >> 16)};
            *(LAS f32x4*)(dstt + t * TP + 8 * sub + 4) = (f32x4){bf2f(wv.z & 0xffffu), bf2f(wv.z >> 16), bf2f(wv.w & 0xffffu), bf2f(wv.w >> 16)};
        }
        __syncthreads();
        float y1[8], y2[8];
        mm_nt(tRq, tS, t, sub, y1);
        mm_nt(tM, tU, t, sub, y2);
        const GAS float* y0 = (const GAS float*)(cod + 16384) + t * 64;
        float sum = 0.f;
#pragma unroll
        for (int j = 0; j < 8; ++j) { y1[j] += y2[j] + y0[sub + 8 * j]; sum += y1[j]; }
        sum += __shfl_xor(sum, 1); sum += __shfl_xor(sum, 2); sum += __shfl_xor(sum, 4);
        const float mean = sum * (1.f / 64.f); float vs = 0.f;
#pragma unroll
        for (int j = 0; j < 8; ++j) { y1[j] -= mean; vs += y1[j] * y1[j]; }
        vs += __shfl_xor(vs, 1); vs += __shfl_xor(vs, 2); vs += __shfl_xor(vs, 4);
        const float rstd = frsq(vs * (1.f / 64.f) + GN_EPS);
        const size_t tok = tokb + t; const float sbv = sbp[tok * 8 + h];
        const GAS float* lg = INP(I_LNXG) + l * RW + 64 * h; const GAS float* lb = INP(I_LNXB) + l * RW + 64 * h;
#pragma unroll
        for (int j = 0; j < 8; ++j) { const int v = sub + 8 * j; const size_t o = tok * RW + 64 * h + v;
            float r = y1[j] * rstd * lg[v] + lb[v]; r += sbv * gv[o]; r *= gg[o];
            ycat[tok * D + 256 + 64 * h + v] = (bf16)f2bf(r); }
        __syncthreads();
    }
}

constexpr int BP = 72;
typedef LAS unsigned short lbf;
__device__ __forceinline__ f32x4 mma_nt64(const lbf* P, int p0, const lbf* Q, int q0, int r16, int q, f32x4 acc) {
#pragma unroll
    for (int s = 0; s < 2; ++s) { const bf16x8_t a = *(const LAS bf16x8_t*)(P + (p0 + r16) * BP + 32 * s + 8 * q); const bf16x8_t b = *(const LAS bf16x8_t*)(Q + (q0 + r16) * BP + 32 * s + 8 * q);
        acc = __builtin_amdgcn_mfma_f32_16x16x32_bf16(a, b, acc, 0, 0, 0); }
    return acc;
}
constexpr size_t LORA_L = 221184;

__device__ __forceinline__ void rwkv_item_prep(Frame& F, int l, int stop) {
    LAS unsigned char* L = F.lds + RING_OFF;
    LAS float* fR = (LAS float*)(L + 0); LAS float* fK = (LAS float*)(L + 17408); LAS float* fV = (LAS float*)(L + 34816); LAS float* fL = (LAS float*)(L + 52224);
    LAS float* fA = (LAS float*)(L + 69632); LAS float* fT = (LAS float*)(L + 87040); LAS float* fX = (LAS float*)(L + 104448);
    lbf* Xw = (lbf*)(L + 69632); lbf* Xa = (lbf*)(L + 78848); lbf* Xg = (lbf*)(L + 88064); lbf* Xv = (lbf*)(L + 105472); LAS float* tbb = (LAS float*)(L + 64512); LAS float* tot = (LAS float*)(L + 110592); LAS float* red = (LAS float*)(L + 111616);
    lbf* bA = (lbf*)(L + 0); lbf* bR = (lbf*)(L + 9216); lbf* bB = (lbf*)(L + 18432); lbf* bK = (lbf*)(L + 27648); lbf* bVT = (lbf*)(L + 36864); lbf* bMak = (lbf*)(L + 46080); lbf* bMrk = (lbf*)(L + 55296); lbf* bMrb = (lbf*)(L + 121856);
    const GAS bf16* p = WSP(bf16, WS_P); const GAS float* mu = INP(I_MU) + l * RWC;
    GAS float* vfirst = WSP(float, WS_VFIRST); GAS float* oV = WSP(float, WS_RV); GAS float* oG = WSP(float, WS_RG); GAS float* oSB = WSP(float, WS_RSB);
    const GAS unsigned char* lw_ = F.ws + WS_LORA + (size_t)l * LORA_L;
    const int lane = F.lane, r16 = lane & 15, q = lane >> 4, w = F.wave;
    for (int item = F.vcu; item < NITEM; item += F.G) {
        const int h = item % 6, bc = item / 6, c = bc % NCH, b = bc / NCH; const size_t tokb = (size_t)b * SEQ + 64 * c;
        const int ci = (b * 6 + h) * NCH + c;
        GAS unsigned char* chd = F.ws + WS_RCH + (size_t)ci * CH_STRIDE; GAS unsigned char* cod = F.ws + WS_RCO + (size_t)ci * CO_STRIDE;
        const bool first = (c == 0);
        const int mtw = w >> 1, hw = w & 1;
        bf16x8_t fbw[2][2], fba[2][2], fbg[2][4], fbv[2];
#pragma unroll
        for (int n2 = 0; n2 < 2; ++n2) { const int chg = 64 * h + 16 * (2 * hw + n2) + r16;
#pragma unroll
            for (int s = 0; s < 2; ++s) { fbw[n2][s] = *(const GAS bf16x8_t*)(lw_ + ((size_t)chg * 64 + 32 * s + 8 * q) * 2); fba[n2][s] = *(const GAS bf16x8_t*)(lw_ + 49152 + ((size_t)chg * 64 + 32 * s + 8 * q) * 2); }
#pragma unroll
            for (int s = 0; s < 4; ++s) fbg[n2][s] = *(const GAS bf16x8_t*)(lw_ + 98304 + ((size_t)chg * 128 + 32 * s + 8 * q) * 2);
            fbv[n2] = *(const GAS bf16x8_t*)(lw_ + 196608 + ((size_t)chg * 32 + 8 * q) * 2 * (l == 1 ? 1 : 0)); }
#define SHIFT8(colj, s_) \
            const GAS bf16* pc = p + (tokb + (s_)) * PC + P_RW + (colj); f32x4 ca, cb, pa, pb; ldp8(pc, ca, cb); const bool fz = first && (s_) == 0; ldp8(pc + (fz ? 0 : -PC), pa, pb); \
            if (fz) { pa = (f32x4){0.f, 0.f, 0.f, 0.f}; pb = pa; } const f32x4 ma = *(const GAS f32x4*)(mu + (colj)), mb = *(const GAS f32x4*)(mu + (colj) + 4); \
            const f32x4 xa = ca + ma * (pa - ca), xb = cb + mb * (pb - cb);
#pragma unroll
        for (int it_ = 0; it_ < 3; ++it_) { const int idx = F.tid + 512 * it_; const int which = idx >> 9, s = (idx >> 3) & 63, d8 = (idx & 7) * 8; const int j = which * 384 + 64 * h + d8;
            SHIFT8(j, s)
            LAS float* dst_ = (LAS float*)(L + which * 17408) + s * TP + d8; *(LAS f32x4*)dst_ = xa; *(LAS f32x4*)(dst_ + 4) = xb; }
#pragma unroll
        for (int it_ = 0; it_ < 2; ++it_) { const int idx = F.tid + 512 * it_; const int which = idx >> 9, s = (idx >> 3) & 63, d8 = (idx & 7) * 8; const int j = 1152 + which * 64 + d8;
            SHIFT8(j, s)
            f32x4 ya = xa, yb = xb; if (which == 0) {
#pragma unroll
                for (int e = 0; e < 4; ++e) { ya[e] = tanhf_(xa[e]); yb[e] = tanhf_(xb[e]); } }
            *(LAS v4u*)((which == 0 ? Xw : Xa) + s * BP + d8) = (v4u){pk2(ya.x, ya.y), pk2(ya.z, ya.w), pk2(yb.x, yb.y), pk2(yb.z, yb.w)}; }
#pragma unroll
        for (int it_ = 0; it_ < 2; ++it_) { const int idx = F.tid + 512 * it_; const int s = idx >> 4, d8 = (idx & 15) * 8; const int j = 1280 + d8;
            SHIFT8(j, s)
            *(LAS v4u*)(Xg + s * 136 + d8) = (v4u){pk2(sigmoidf_(xa.x), sigmoidf_(xa.y)), pk2(sigmoidf_(xa.z), sigmoidf_(xa.w)), pk2(sigmoidf_(xb.x), sigmoidf_(xb.y)), pk2(sigmoidf_(xb.z), sigmoidf_(xb.w))}; }
#undef SHIFT8
        if (l == 1 && F.tid < 256) { const int s = F.tid >> 2, d8 = (F.tid & 3) * 8; *(LAS v4u*)(Xv + s * 40 + d8) = *(const GAS v4u*)(p + (tokb + s) * PC + P_V1 + d8); }
        __syncthreads();
        if (stop <= 1) continue;
        float er[8], ena[8], ebb[8], ekp[8], ev[8], elw[8];
        {
            f32x4 dw[2], da[2], dg[2], dv[2];
#pragma unroll
            for (int n2 = 0; n2 < 2; ++n2) {
                const int chg = 64 * h + 16 * (2 * hw + n2) + r16;
                dw[n2] = (f32x4){0.f, 0.f, 0.f, 0.f}; da[n2] = dw[n2]; dg[n2] = dw[n2]; dv[n2] = dw[n2];
#pragma unroll
                for (int s = 0; s < 2; ++s) { const bf16x8_t a = *(const LAS bf16x8_t*)(Xw + (16 * mtw + r16) * BP + 32 * s + 8 * q); const bf16x8_t bb_ = fbw[n2][s];
                    dw[n2] = __builtin_amdgcn_mfma_f32_16x16x32_bf16(a, bb_, dw[n2], 0, 0, 0); }
#pragma unroll
                for (int s = 0; s < 2; ++s) { const bf16x8_t a = *(const LAS bf16x8_t*)(Xa + (16 * mtw + r16) * BP + 32 * s + 8 * q); const bf16x8_t bb_ = fba[n2][s];
                    da[n2] = __builtin_amdgcn_mfma_f32_16x16x32_bf16(a, bb_, da[n2], 0, 0, 0); }
#pragma unroll
                for (int s = 0; s < 4; ++s) { const bf16x8_t a = *(const LAS bf16x8_t*)(Xg + (16 * mtw + r16) * 136 + 32 * s + 8 * q); const bf16x8_t bb_ = fbg[n2][s];
                    dg[n2] = __builtin_amdgcn_mfma_f32_16x16x32_bf16(a, bb_, dg[n2], 0, 0, 0); }
                if (l == 1) { const bf16x8_t a = *(const LAS bf16x8_t*)(Xv + (16 * mtw + r16) * 40 + 8 * q); const bf16x8_t bb_ = fbv[n2];
                    dv[n2] = __builtin_amdgcn_mfma_f32_16x16x32_bf16(a, bb_, dv[n2], 0, 0, 0); }
            }
            float kk2[4] = {0.f, 0.f, 0.f, 0.f}, sbs[4] = {0.f, 0.f, 0.f, 0.f};
#pragma unroll
            for (int n2 = 0; n2 < 2; ++n2) {
                const int chl = 16 * (2 * hw + n2) + r16, chg = l * RW + 64 * h + chl;
                const float w0 = INP(I_W0)[chg], a0 = INP(I_A0)[chg], kks = INP(I_KKS)[chg], ka = INP(I_KA)[chg], rk = INP(I_RK)[chg];
                const float v0 = (l == 1) ? INP(I_V0)[64 * h + chl] : 0.f;
#pragma unroll
                for (int rg = 0; rg < 4; ++rg) {
                    const int e = 4 * n2 + rg; const int tk = 16 * mtw + 4 * q + rg; const size_t o = (tokb + tk) * RW + 64 * h + chl;
                    const float r = fR[tk * TP + chl], k = fK[tk * TP + chl]; float v = fV[tk * TP + chl];
                    const float wlog = -softplusf_(-(w0 + dw[n2][rg])) - 0.5f; elw[e] = -fexp(wlog);
                    const float ai = sigmoidf_(a0 + da[n2][rg]);
                    if (l == 0) vfirst[o] = v; else { const float vg = sigmoidf_(v0 + dv[n2][rg]); v = v + (vfirst[o] - v) * vg; }
                    const float kkv = k * kks; kk2[rg] += kkv * kkv; ena[e] = kkv;
                    const float kp = k * (1.0f + (ai - 1.0f) * ka); sbs[rg] += r * kp * rk;
                    er[e] = r; ekp[e] = kp; ev[e] = v; ebb[e] = ai;
                    oV[o] = v; oG[o] = dg[n2][rg];
                    fL[tk * TP + chl] = elw[e];
                }
            }
#pragma unroll
            for (int rg = 0; rg < 4; ++rg) {
#pragma unroll
                for (int o_ = 1; o_ < 16; o_ <<= 1) { kk2[rg] += __shfl_xor(kk2[rg], o_); sbs[rg] += __shfl_xor(sbs[rg], o_); }
                if (r16 == 0) { red[(hw * 64 + 16 * mtw + 4 * q + rg) * 2 + 0] = kk2[rg]; red[(hw * 64 + 16 * mtw + 4 * q + rg) * 2 + 1] = sbs[rg]; }
            }
        }
        __syncthreads();
#pragma unroll
        for (int rg = 0; rg < 4; ++rg) { const int tk = 16 * mtw + 4 * q + rg;
            const float k2 = red[tk * 2] + red[(64 + tk) * 2]; const float inv = frsq(fmaxf(k2, 1e-24f));
#pragma unroll
            for (int n2 = 0; n2 < 2; ++n2) { const int e = 4 * n2 + rg; const float kk = ena[e] * inv; ena[e] = -kk; ebb[e] = kk * ebb[e]; }
            if (hw == 0 && r16 == 0) oSB[(tokb + tk) * 8 + h] = red[tk * 2 + 1] + red[(64 + tk) * 2 + 1]; }
        if (stop <= 2) continue;
        if (F.tid < 256) { const int ch = F.tid & 63, sg = F.tid >> 6; float run = 0.f;
#pragma unroll
            for (int s = 0; s < 16; ++s) { run += fL[(16 * sg + s) * TP + ch]; fL[(16 * sg + s) * TP + ch] = run; }
            tot[sg * 64 + ch] = run; }
        __syncthreads();
        if (F.tid < 256) { const int ch = F.tid & 63, sg = F.tid >> 6; float off = 0.f;
            for (int s2 = 0; s2 < sg; ++s2) off += tot[s2 * 64 + ch];
            if (sg > 0) {
#pragma unroll
                for (int s = 0; s < 16; ++s) fL[(16 * sg + s) * TP + ch] += off; } }
        __syncthreads();
        if (stop <= 3) continue;
        {
#pragma unroll
            for (int n2 = 0; n2 < 2; ++n2) { const int chl = 16 * (2 * hw + n2) + r16;
                float vv[4];
#pragma unroll
                for (int rg = 0; rg < 4; ++rg) { const int e = 4 * n2 + rg; const int tk = 16 * mtw + 4 * q + rg;
                    const float cw = fL[tk * TP + chl]; const float ecw = fexp(cw), ecx = fexp(cw - elw[e]), ein = fexp(-cw);
                    const float at = ena[e] * ecx;
                    fA[tk * TP + chl] = at; bA[tk * BP + chl] = (unsigned short)f2bf(at); bR[tk * BP + chl] = (unsigned short)f2bf(er[e] * ecw);
                    bB[tk * BP + chl] = (unsigned short)f2bf(ebb[e] * ein); bK[tk * BP + chl] = (unsigned short)f2bf(ekp[e] * ein); vv[rg] = ev[e];
                    if (tk == 63) ((GAS float*)(chd + 49152))[chl] = ecw; }
                *(LAS v2u*)(bVT + chl * BP + 16 * mtw + 4 * q) = (v2u){pk2(vv[0], vv[1]), pk2(vv[2], vv[3])};
            }
        }
        __syncthreads();
        if (stop <= 4) continue;
        { const int kind = w >> 1;
#pragma unroll 1
          for (int tix = 0; tix < 8; ++tix) { const int tile = (w & 1) * 8 + tix; const int mt = tile >> 2, nt = tile & 3;
            f32x4 acc = (f32x4){0.f, 0.f, 0.f, 0.f};
            if (kind == 3) {
                acc = mma_nt64(bA, 16 * mt, bB, 16 * nt, r16, q, acc);
                const int i = 16 * nt + r16;
#pragma unroll
                for (int rg = 0; rg < 4; ++rg) { const int t = 16 * mt + 4 * q + rg; fX[t * TP + i] = (i < t) ? acc[rg] : 0.f; }
            } else {
                const lbf* Pm = (kind == 2) ? bB : bK; const lbf* Qm = (kind == 0) ? bA : bR; lbf* dst = (kind == 0) ? bMak : (kind == 1) ? bMrk : bMrb;
                acc = mma_nt64(Pm, 16 * nt, Qm, 16 * mt, r16, q, acc);
                const int t = 16 * mt + r16; float o[4];
#pragma unroll
                for (int rg = 0; rg < 4; ++rg) { const int i = 16 * nt + 4 * q + rg; o[rg] = ((kind == 0) ? (i < t) : (i <= t)) ? acc[rg] : 0.f; }
                *(LAS v2u*)(dst + t * BP + 16 * nt + 4 * q) = (v2u){pk2(o[0], o[1]), pk2(o[2], o[3])};
            } } }
        __syncthreads();
        if (stop <= 5) continue;
        { const int mt = w & 3;
#pragma unroll 1
          for (int nt = 0; nt < 4; ++nt) {
            f32x4 acc = (f32x4){0.f, 0.f, 0.f, 0.f};
            if (w < 4) { acc = mma_nt64(bMak, 16 * mt, bVT, 16 * nt, r16, q, acc);
#pragma unroll
                for (int rg = 0; rg < 4; ++rg) fT[(16 * mt + 4 * q + rg) * TP + 16 * nt + r16] = acc[rg]; }
            else { acc = mma_nt64(bVT, 16 * nt, bMrk, 16 * mt, r16, q, acc);
                *(GAS f32x4*)((GAS float*)(cod + 16384) + (16 * mt + r16) * 64 + 16 * nt + 4 * q) = acc; } } }
        __syncthreads();
        if (stop <= 6) continue;
        if (w == 0) {
            const int blk = lane >> 4, col = lane & 15; const LAS float* Nb = fX + (16 * blk) * TP + 16 * blk;
            float tv[16];
#pragma unroll
            for (int r = 0; r < 16; ++r) tv[r] = (r == col) ? 1.f : 0.f;
#pragma unroll
            for (int i = 0; i < 15; ++i) {
#pragma unroll
                for (int r = i + 1; r < 16; ++r) tv[r] += Nb[r * TP + i] * tv[i]; }
#pragma unroll
            for (int r = 0; r < 16; ++r) tbb[(blk * 16 + r) * 16 + col] = tv[r];
        } else {
            for (int pz = F.tid - 64; pz < 512; pz += 448) { const int row = pz >> 3, sub = pz & 7; const int s_ = sub >> 2, q_ = sub & 3; const int i0 = 32 * s_ + 4 * q_, i1 = i0 + 16;
                *(GAS v4u*)(cod + pz * 16) = *(const LAS v4u*)(bR + row * BP + 8 * sub);
                *(GAS v4u*)(cod + 8192 + pz * 16) = *(const LAS v4u*)(bMrb + row * BP + 8 * sub);
                { const v2u a = *(const LAS v2u*)(bVT + row * BP + i0), b2 = *(const LAS v2u*)(bVT + row * BP + i1); *(GAS v4u*)(chd + 24576 + pz * 16) = (v4u){a.x, a.y, b2.x, b2.y}; }
                unsigned e[8];
#pragma unroll
                for (int j = 0; j < 8; ++j) e[j] = bB[((j < 4 ? i0 : i1) + (j & 3)) * BP + row];
                *(GAS v4u*)(chd + 8192 + pz * 16) = (v4u){e[0] | (e[1] << 16), e[2] | (e[3] << 16), e[4] | (e[5] << 16), e[6] | (e[7] << 16)};
#pragma unroll
                for (int j = 0; j < 8; ++j) e[j] = bK[((j < 4 ? i0 : i1) + (j & 3)) * BP + row];
                *(GAS v4u*)(chd + 16384 + pz * 16) = (v4u){e[0] | (e[1] << 16), e[2] | (e[3] << 16), e[4] | (e[5] << 16), e[6] | (e[7] << 16)}; }
        }
        __syncthreads();
        { LAS float* tile = (w < 4) ? fA : fT; const int c0 = 16 * (w & 3) + r16;
          f32x4 X[4];
#pragma unroll
          for (int bb = 0; bb < 4; ++bb) {
              f32x4 acc;
#pragma unroll
              for (int rg = 0; rg < 4; ++rg) acc[rg] = tile[(16 * bb + 4 * q + rg) * TP + c0];
#pragma unroll
              for (int b2 = 0; b2 < 4; ++b2) if (b2 < bb) { const f32x4 af = *(const LAS f32x4*)(fX + (16 * bb + r16) * TP + 16 * b2 + 4 * q);
#pragma unroll
                  for (int s = 0; s < 4; ++s) acc = __builtin_amdgcn_mfma_f32_16x16x4f32(af[s], X[b2][s], acc, 0, 0, 0); }
              const f32x4 tf = *(const LAS f32x4*)(tbb + (bb * 16 + r16) * 16 + 4 * q);
              f32x4 xb = (f32x4){0.f, 0.f, 0.f, 0.f};
#pragma unroll
              for (int s = 0; s < 4; ++s) xb = __builtin_amdgcn_mfma_f32_16x16x4f32(tf[s], acc[s], xb, 0, 0, 0);
              X[bb] = xb;
#pragma unroll
              for (int rg = 0; rg < 4; ++rg) tile[(16 * bb + 4 * q + rg) * TP + c0] = xb[rg];
          } }
        __syncthreads();
        if (stop <= 7) continue;
        { const int row = F.tid >> 3, sub = F.tid & 7; const int s_ = sub >> 2, q_ = sub & 3; const int i0 = 32 * s_ + 4 * q_, i1 = i0 + 16;
          const f32x4 a = *(const LAS f32x4*)(fA + row * TP + i0), bq = *(const LAS f32x4*)(fA + row * TP + i1);
          *(GAS v4u*)(chd + F.tid * 16) = (v4u){pk2(a.x, a.y), pk2(a.z, a.w), pk2(bq.x, bq.y), pk2(bq.z, bq.w)};
#pragma unroll
          for (int hh = 0; hh < 2; ++hh) { const int pz = F.tid + 512 * hh; const int v = pz >> 4, t4 = (pz & 15) * 4;
              *(GAS f32x4*)(chd + 32768 + pz * 16) = (f32x4){fT[(t4 + 0) * TP + v], fT[(t4 + 1) * TP + v], fT[(t4 + 2) * TP + v], fT[(t4 + 3) * TP + v]}; } }
        __syncthreads();
    }
}
__device__ __forceinline__ void lora_convert(Frame& F) {
    const int gt = F.vcu * (NWAVES * 64) + F.tid, NT_ = F.G * NWAVES * 64;
    for (int l = 0; l < DEPTH; ++l) {
        bf16* base = (bf16*)(F.ws + WS_LORA + (size_t)l * LORA_L);
        const GAS float* w2 = INP(I_W2) + (size_t)l * 64 * RW; const GAS float* a2 = INP(I_A2) + (size_t)l * 64 * RW; const GAS float* g2 = INP(I_G2) + (size_t)l * 128 * RW; const GAS float* v2 = INP(I_V2);
        for (int i = gt; i < RW * 64; i += NT_) { const int ch = i >> 6, j = i & 63; base[i] = (bf16)f2bf(w2[(size_t)j * RW + ch]); base[24576 + i] = (bf16)f2bf(a2[(size_t)j * RW + ch]); }
        for (int i = gt; i < RW * 128; i += NT_) { const int ch = i >> 7, j = i & 127; base[49152 + i] = (bf16)f2bf(g2[(size_t)j * RW + ch]); }
        if (l == 1) for (int i = gt; i < RW * 32; i += NT_) { const int ch = i >> 5, j = i & 31; base[98304 + i] = (bf16)f2bf(v2[(size_t)j * RW + ch]); }
    }
}

__device__ __forceinline__ void rwkv_chunk_out_mfma(Frame& F, int l) {
    const GAS float* gv = WSP(float, WS_RV); const GAS float* gg = WSP(float, WS_RG); const GAS float* sbp = WSP(float, WS_RSB);
    GAS bf16* ycat = WSP(bf16, WS_YCAT);
    const int gw = F.vcu * NWAVES + F.wave, NGW = F.G * NWAVES, lane = F.lane, r16 = lane & 15, q = lane >> 4;
    for (int wi = gw; wi < NITEM * 4; wi += NGW) {
        const int item = wi >> 2, mt = wi & 3;
        const int h = item % 6, bc = item / 6, c = bc % NCH, b = bc / NCH; const size_t tokb = (size_t)b * SEQ + 64 * c;
        const int ci = (b * 6 + h) * NCH + c;
        const GAS unsigned char* cod = F.ws + WS_RCO + (size_t)ci * CO_STRIDE;
        const GAS unsigned char* s0 = F.ws + WS_RS0 + (size_t)ci * 8192; const GAS unsigned char* ut = F.ws + WS_RUT + (size_t)ci * 8192;
        const int t = 16 * mt + r16; const size_t tok = tokb + t;
        bf16x8_t rq[2], mb[2];
#pragma unroll
        for (int s = 0; s < 2; ++s) { rq[s] = *(const GAS bf16x8_t*)(cod + (t * 64 + 32 * s + 8 * q) * 2); mb[s] = *(const GAS bf16x8_t*)(cod + 8192 + (t * 64 + 32 * s + 8 * q) * 2); }
        f32x4 y[4];
#pragma unroll
        for (int nt = 0; nt < 4; ++nt) {
            y[nt] = *(const GAS f32x4*)(cod + 16384 + (t * 64 + 16 * nt + 4 * q) * 4);
#pragma unroll
            for (int s = 0; s < 2; ++s) { const bf16x8_t a = *(const GAS bf16x8_t*)(s0 + ((16 * nt + r16) * 64 + 32 * s + 8 * q) * 2); y[nt] = __builtin_amdgcn_mfma_f32_16x16x32_bf16(a, rq[s], y[nt], 0, 0, 0); }
#pragma unroll
            for (int s = 0; s < 2; ++s) { const bf16x8_t a = *(const GAS bf16x8_t*)(ut + ((16 * nt + r16) * 64 + 32 * s + 8 * q) * 2); y[nt] = __builtin_amdgcn_mfma_f32_16x16x32_bf16(a, mb[s], y[nt], 0, 0, 0); }
        }
        float sum = 0.f;
#pragma unroll
        for (int nt = 0; nt < 4; ++nt) sum += (y[nt][0] + y[nt][1]) + (y[nt][2] + y[nt][3]);
        sum += __shfl_xor(sum, 16); sum += __shfl_xor(sum, 32);
        const float mean = sum * (1.f / 64.f); float vs = 0.f;
#pragma unroll
        for (int nt = 0; nt < 4; ++nt) { y[nt] = y[nt] - mean; vs += (y[nt][0] * y[nt][0] + y[nt][1] * y[nt][1]) + (y[nt][2] * y[nt][2] + y[nt][3] * y[nt][3]); }
        vs += __shfl_xor(vs, 16); vs += __shfl_xor(vs, 32);
        const float rstd = frsq(vs * (1.f / 64.f) + GN_EPS);
        const float sbv = sbp[tok * 8 + h];
#pragma unroll
        for (int nt = 0; nt < 4; ++nt) { const int v0 = 16 * nt + 4 * q;
            const f32x4 lg = *(const GAS f32x4*)(INP(I_LNXG) + l * RW + 64 * h + v0), lb = *(const GAS f32x4*)(INP(I_LNXB) + l * RW + 64 * h + v0);
            const f32x4 vv = *(const GAS f32x4*)(gv + tok * RW + 64 * h + v0), g4 = *(const GAS f32x4*)(gg + tok * RW + 64 * h + v0);
            const f32x4 r = (y[nt] * rstd * lg + lb + vv * sbv) * g4;
            *(GAS v2u*)(ycat + tok * D + 256 + 64 * h + v0) = (v2u){pk2(r[0], r[1]), pk2(r[2], r[3])}; }
    }
}

__device__ __forceinline__ int chain_bh() { const int id = blockIdx.x; return (id & 7) + 8 * (id >> 5); }
__device__ __forceinline__ bool is_chain_wg() { return blockIdx.x < 64 && chain_bh() < 12; }
__device__ __forceinline__ int side_index() { const int id = blockIdx.x; return (id < 32) ? -1 : (id < 64) ? ((id - 32) >> 3) * 4 + ((id & 7) - 4) : id - 48; }
constexpr int C2_STAGE = 34560;
template <int VAR>
__device__ __forceinline__ void rwkv_chain2(Frame& F) {
    if (!is_chain_wg()) return;
    const int bh = chain_bh(), vb = ((int)blockIdx.x >> 3) & 3;
    const GAS unsigned char* src = F.ws + WS_RCH + (size_t)bh * NCH * CH_STRIDE;
    GAS unsigned char* s0g = F.ws + (VAR == 0 ? WS_RS0 : WS_XG) + (size_t)bh * NCH * 8192; GAS unsigned char* utg = F.ws + (VAR == 0 ? WS_RUT : WS_ACT) + (size_t)bh * NCH * 8192;
    LAS unsigned char* ring = F.lds + RING_OFF;
    const int lane = F.lane, q = lane >> 4, r16 = lane & 15;
#define C2_BAR() do { asm volatile("s_waitcnt lgkmcnt(0)" ::: "memory"); __builtin_amdgcn_s_barrier(); asm volatile("" ::: "memory"); } while (0)
    if (F.wave >= 2) {
        const int pr = (F.wave - 2) >> 1, lp = ((F.wave - 2) & 1) * 64 + lane;
        int go[16], lo[16];
#pragma unroll
        for (int k = 0; k < 16; ++k) { const int pi = k * 128 + lp;
            if (k < 12) { go[k] = pi * 16; lo[k] = (pi >> 9) * 9216 + ((pi & 511) >> 3) * 144 + (pi & 7) * 16; }
            else if (k == 12) { const int j = pi - 1536; go[k] = 24576 + vb * 2048 + j * 16; lo[k] = 27648 + (j >> 3) * 144 + (j & 7) * 16; }
            else if (k < 15) { const int j = pi - 1664; go[k] = 32768 + vb * 4096 + j * 16; lo[k] = 29952 + (j >> 4) * 272 + (j & 15) * 16; }
            else { const int j = lp & 15; go[k] = 49152 + j * 16; lo[k] = 34304 + j * 16; } }
        v4u R[16];
#define C2_LOAD(c) do { const GAS unsigned char* g_ = src + (size_t)(c) * CH_STRIDE; _Pragma("unroll") for (int k = 0; k < 16; ++k) R[k] = *(const GAS v4u*)(g_ + go[k]); } while (0)
#define C2_WRITE(c) do { LAS unsigned char* st_ = ring + ((c) % 3) * C2_STAGE; _Pragma("unroll") for (int k = 0; k < 16; ++k) *(LAS v4u*)(st_ + lo[k]) = R[k]; } while (0)
        C2_LOAD(pr);
        if (pr < 2) { C2_WRITE(pr); if (VAR < 3) C2_LOAD(pr + 3); }
        C2_BAR();
        for (int c = 0; c < NCH; ++c) {
            if ((c + 2) % 3 == pr && c + 2 < NCH) { C2_WRITE(c + 2); if (VAR < 3) C2_LOAD((c + 5 < NCH) ? c + 5 : NCH - 1); }
            C2_BAR();
        }
#undef C2_LOAD
#undef C2_WRITE
    } else if (F.wave == 0) {
        const int vrow = 16 * vb + r16;
        f32x4 sacc[4]; bf16x8_t sb[2];
#pragma unroll
        for (int i = 0; i < 4; ++i) sacc[i] = (f32x4){0.f, 0.f, 0.f, 0.f};
        sb[0] = (bf16x8_t){0, 0, 0, 0, 0, 0, 0, 0}; sb[1] = sb[0];
        C2_BAR();
        for (int c = 0; c < NCH; ++c) {
            const LAS unsigned char* st = ring + (c % 3) * C2_STAGE;
            if (VAR != 2 && VAR != 4) { GAS v2u* o = (GAS v2u*)(s0g + (size_t)c * 8192 + (vrow * 64 + 4 * q) * 2);
              const v4u w0 = __builtin_bit_cast(v4u, sb[0]), w1 = __builtin_bit_cast(v4u, sb[1]);
              o[0] = (v2u){w0.x, w0.y}; o[4] = (v2u){w0.z, w0.w}; o[8] = (v2u){w1.x, w1.y}; o[12] = (v2u){w1.z, w1.w}; }
            f32x4 u[4], gl4[4]; bf16x8_t wa[4][2], ka[4][2], ba[4][2], vbf[2];
#pragma unroll
            for (int tt = 0; tt < 4; ++tt) { u[tt] = *(const LAS f32x4*)(st + 29952 + r16 * 272 + (16 * tt + 4 * q) * 4);
#pragma unroll
                for (int s = 0; s < 2; ++s) wa[tt][s] = *(const LAS bf16x8_t*)(st + (16 * tt + r16) * 144 + (32 * s + 8 * q) * 2); }
#pragma unroll
            for (int s = 0; s < 2; ++s) vbf[s] = *(const LAS bf16x8_t*)(st + 27648 + r16 * 144 + (32 * s + 8 * q) * 2);
#pragma unroll
            for (int kt = 0; kt < 4; ++kt) {
#pragma unroll
                for (int s = 0; s < 2; ++s) { ka[kt][s] = *(const LAS bf16x8_t*)(st + 18432 + (16 * kt + r16) * 144 + (32 * s + 8 * q) * 2); ba[kt][s] = *(const LAS bf16x8_t*)(st + 9216 + (16 * kt + r16) * 144 + (32 * s + 8 * q) * 2); }
                gl4[kt] = *(const LAS f32x4*)(st + 34304 + (16 * kt + 4 * q) * 4); }
            __builtin_amdgcn_sched_barrier(0);
#pragma unroll
            for (int tt = 0; tt < 4; ++tt)
#pragma unroll
                for (int s = 0; s < 2; ++s) u[tt] = __builtin_amdgcn_mfma_f32_16x16x32_bf16(wa[tt][s], sb[s], u[tt], 0, 0, 0);
#pragma unroll
            for (int kt = 0; kt < 4; ++kt)
#pragma unroll
                for (int s = 0; s < 2; ++s) sacc[kt] = __builtin_amdgcn_mfma_f32_16x16x32_bf16(ka[kt][s], vbf[s], sacc[kt], 0, 0, 0);
            bf16x8_t ub[2];
            { v4u w0, w1; w0.x = cvtpk(u[0][0], u[0][1]); w0.y = cvtpk(u[0][2], u[0][3]); w0.z = cvtpk(u[1][0], u[1][1]); w0.w = cvtpk(u[1][2], u[1][3]);
              w1.x = cvtpk(u[2][0], u[2][1]); w1.y = cvtpk(u[2][2], u[2][3]); w1.z = cvtpk(u[3][0], u[3][1]); w1.w = cvtpk(u[3][2], u[3][3]);
              ub[0] = __builtin_bit_cast(bf16x8_t, w0); ub[1] = __builtin_bit_cast(bf16x8_t, w1);
              if (VAR != 2 && VAR != 4) { GAS v2u* o = (GAS v2u*)(utg + (size_t)c * 8192 + (vrow * 64 + 4 * q) * 2);
              o[0] = (v2u){w0.x, w0.y}; o[4] = (v2u){w0.z, w0.w}; o[8] = (v2u){w1.x, w1.y}; o[12] = (v2u){w1.z, w1.w}; } }
#pragma unroll
            for (int kt = 0; kt < 4; ++kt) {
#pragma unroll
                for (int s = 0; s < 2; ++s) sacc[kt] = __builtin_amdgcn_mfma_f32_16x16x32_bf16(ba[kt][s], ub[s], sacc[kt], 0, 0, 0);
                sacc[kt] = sacc[kt] * gl4[kt];
            }
            { v4u w0, w1; w0.x = cvtpk(sacc[0][0], sacc[0][1]); w0.y = cvtpk(sacc[0][2], sacc[0][3]); w0.z = cvtpk(sacc[1][0], sacc[1][1]); w0.w = cvtpk(sacc[1][2], sacc[1][3]);
              w1.x = cvtpk(sacc[2][0], sacc[2][1]); w1.y = cvtpk(sacc[2][2], sacc[2][3]); w1.z = cvtpk(sacc[3][0], sacc[3][1]); w1.w = cvtpk(sacc[3][2], sacc[3][3]);
              sb[0] = __builtin_bit_cast(bf16x8_t, w0); sb[1] = __builtin_bit_cast(bf16x8_t, w1); }
            C2_BAR();
        }
        if (VAR != 0) asm volatile("" :: "v"(sacc[0]), "v"(sacc[1]), "v"(sacc[2]), "v"(sacc[3]));
    } else {
        C2_BAR();
        for (int c = 0; c < NCH; ++c) C2_BAR();
    }
#undef C2_BAR
}

__device__ __forceinline__ void mlstm_prep(Frame& F, int l) {
    const GAS bf16* p = WSP(bf16, WS_P); const GAS float* pg = WSP(float, WS_PG);
    LAS unsigned char* L = F.lds + RING_OFF;
    lbf* tKW = (lbf*)(L + 0); lbf* tVT = (lbf*)(L + 9216); LAS float* we = (LAS float*)(L + 18432);
    GAS float* kvT = WSP(float, WS_MKV); GAS float* nloc = WSP(float, WS_MNL); GAS float* msc = WSP(float, WS_MSC); GAS float* G = WSP(float, WS_MLG); GAS float* IG = WSP(float, WS_MLI);
    GAS bf16* QC = WSP(bf16, WS_MQC); GAS bf16* KC = WSP(bf16, WS_MKC);
    const int lane = F.lane, r16 = lane & 15, q = lane >> 4, w = F.wave;
    for (int item = F.vcu; item < NITEM; item += F.G) {
        const int h = item % 6, bc = item / 6, c = bc % NCH, b = bc / NCH; const size_t tokb = (size_t)b * SEQ + 64 * c;
        if (w == 0) {
            const size_t tok = tokb + lane;
            const float ig = pg[tok * 16 + h] + INP(I_BI)[l * 6 + h];
            const float lf = logsigmoidf_(pg[tok * 16 + 6 + h] + INP(I_BF)[l * 6 + h]);
            float g = lf;
#pragma unroll
            for (int o = 1; o < 64; o <<= 1) { const float t = __shfl_up(g, o); if (lane >= o) g += t; }
            const float glast = __shfl(g, 63);
            const float e = glast - g + ig; const float mloc = wave_max(e);
            we[lane] = fexp(e - mloc);
            G[item * 64 + lane] = g; IG[item * 64 + lane] = ig;
            if (lane == 0) { msc[item * 4 + 0] = mloc; msc[item * 4 + 1] = glast; }
        }
        __syncthreads();
        { const GAS float* cwb = INP(I_CONVW) + (size_t)l * 4 * 768 + 64 * h; const GAS float* cbb = INP(I_CONVB) + l * 768 + 64 * h;
#pragma unroll
          for (int which = 0; which < 2; ++which)
#pragma unroll
            for (int it = 0; it < 2; ++it) { const int idx = F.tid + 512 * it; const int s = idx >> 4, d4 = (idx & 15) * 4; const int tl = 64 * c + s; const size_t tok = tokb + s;
                const int pcol = P_ML + which * 384 + 64 * h + d4;
                f32x4 acc = *(const GAS f32x4*)(cbb + which * 384 + d4);
                f32x4 xs_[4], ws_[4];
#pragma unroll
                for (int i = 0; i < 4; ++i) { const int tt = tl - 3 + i; xs_[i] = ldp4(p + (tt >= 0 ? tok - 3 + i : tok) * PC + pcol); ws_[i] = *(const GAS f32x4*)(cwb + i * 768 + which * 384 + d4); }
#pragma unroll
                for (int i = 0; i < 4; ++i) { const int tt = tl - 3 + i; if (tt >= 0) acc = acc + ws_[i] * xs_[i]; }
                f32x4 y;
#pragma unroll
                for (int e = 0; e < 4; ++e) y[e] = acc[e] * sigmoidf_(acc[e]);
                if (which == 0) { y = y * 0.125f; *(GAS v2u*)(QC + tok * 384 + 64 * h + d4) = (v2u){pk2(y[0], y[1]), pk2(y[2], y[3])}; }
                else { *(GAS v2u*)(KC + tok * 384 + 64 * h + d4) = (v2u){pk2(y[0], y[1]), pk2(y[2], y[3])}; const float wsc = we[s];
#pragma unroll
                    for (int e = 0; e < 4; ++e) tKW[(d4 + e) * BP + s] = (unsigned short)f2bf(y[e] * wsc); } }
#pragma unroll
          for (int it = 0; it < 2; ++it) { const int idx = F.tid + 512 * it; const int s = idx >> 4, d4 = (idx & 15) * 4; const size_t tok = tokb + s;
              const f32x4 x = ldp4(p + tok * PC + P_ML + 768 + 64 * h + d4);
#pragma unroll
              for (int e = 0; e < 4; ++e) tVT[(d4 + e) * BP + s] = (unsigned short)f2bf(x[e]); } }
        __syncthreads();
#pragma unroll
        for (int n2 = 0; n2 < 2; ++n2) { const int kt = w >> 1, nt = 2 * (w & 1) + n2;
            f32x4 acc = (f32x4){0.f, 0.f, 0.f, 0.f};
            acc = mma_nt64(tKW, 16 * kt, tVT, 16 * nt, r16, q, acc);
            *(GAS f32x4*)(kvT + (size_t)item * 4096 + (16 * nt + r16) * 64 + 16 * kt + 4 * q) = acc; }
        if (F.tid < 64) { float a = 0.f;
#pragma unroll 8
            for (int s = 0; s < 64; ++s) a += bf2f(tKW[F.tid * BP + s]);
            nloc[item * 64 + F.tid] = a; }
        { const int row = F.tid >> 3, sub = F.tid & 7; const int s_ = sub >> 2, q_ = sub & 3; const int i0 = 32 * s_ + 4 * q_, i1 = i0 + 16;
          const v2u a = *(const LAS v2u*)(tVT + row * BP + i0), b2 = *(const LAS v2u*)(tVT + row * BP + i1);
          *(GAS v4u*)(F.ws + WS_MVT + (size_t)item * 8192 + F.tid * 16) = (v4u){a.x, a.y, b2.x, b2.y}; }
        __syncthreads();
    }
}
__device__ __forceinline__ void mlstm_scan2(Frame& F) {
    if (is_chain_wg()) return;
    const int gt = side_index() * (NWAVES * 64) + F.tid;
    const GAS float* msc = WSP(float, WS_MSC); GAS float* mscw = WSP(float, WS_MSC);
    if (gt < 12 * 2048) {
        const int bh = gt >> 11, el = (gt & 2047) * 2, b = bh / 6, h = bh % 6;
        const GAS float* src = WSP(float, WS_MKV); GAS bf16* dst = WSP(bf16, WS_MCP);
        float C0 = 0.f, C1 = 0.f, m = 0.f;
        for (int c0 = 0; c0 < NCH; c0 += 8) {
            float x0[8], x1[8], ml[8], gl[8];
#pragma unroll
            for (int i = 0; i < 8; ++i) { const int item = (b * NCH + c0 + i) * 6 + h; ml[i] = msc[item * 4 + 0]; gl[i] = msc[item * 4 + 1];
                const GAS float* s2 = src + (size_t)item * 4096 + el; x0[i] = s2[0]; x1[i] = s2[1]; }
#pragma unroll
            for (int i = 0; i < 8; ++i) { const int item = (b * NCH + c0 + i) * 6 + h;
                *(GAS unsigned*)(dst + (size_t)item * 4096 + el) = pk2(C0, C1);
                if (el == 0) mscw[item * 4 + 2] = m;
                const float mn = fmaxf(gl[i] + m, ml[i]); const float ao = fexp(gl[i] + m - mn), an = fexp(ml[i] - mn);
                C0 = ao * C0 + an * x0[i]; C1 = ao * C1 + an * x1[i]; m = mn; }
        }
    } else if (gt < 12 * 2048 + 12 * 64) {
        const int g2 = gt - 12 * 2048; const int bh = g2 >> 6, el = g2 & 63, b = bh / 6, h = bh % 6;
        const GAS float* src = WSP(float, WS_MNL); GAS float* dst = WSP(float, WS_MNP);
        float N = 0.f, m = 0.f;
        for (int c0 = 0; c0 < NCH; c0 += 8) {
            float x[8], ml[8], gl[8];
#pragma unroll
            for (int i = 0; i < 8; ++i) { const int item = (b * NCH + c0 + i) * 6 + h; ml[i] = msc[item * 4 + 0]; gl[i] = msc[item * 4 + 1]; x[i] = src[item * 64 + el]; }
#pragma unroll
            for (int i = 0; i < 8; ++i) { const int item = (b * NCH + c0 + i) * 6 + h;
                dst[item * 64 + el] = N;
                const float mn = fmaxf(gl[i] + m, ml[i]); const float ao = fexp(gl[i] + m - mn), an = fexp(ml[i] - mn);
                N = ao * N + an * x[i]; m = mn; }
        }
    }
}
__device__ __forceinline__ void mlstm_out_mfma(Frame& F, int l) {
    const GAS bf16* p = WSP(bf16, WS_P); const GAS bf16* QC = WSP(bf16, WS_MQC); const GAS bf16* KC = WSP(bf16, WS_MKC);
    const GAS float* G = WSP(float, WS_MLG); const GAS float* IG = WSP(float, WS_MLI); const GAS float* msc = WSP(float, WS_MSC); const GAS float* NP = WSP(float, WS_MNP);
    GAS bf16* ycat = WSP(bf16, WS_YCAT);
    const int gw = F.vcu * NWAVES + F.wave, NGW = F.G * NWAVES, lane = F.lane, r16 = lane & 15, q = lane >> 4;
    for (int wi = gw; wi < NITEM * 4; wi += NGW) {
        const int item = wi >> 2, jt = wi & 3;
        const int h = item % 6, bc = item / 6, c = bc % NCH, b = bc / NCH; const size_t tokb = (size_t)b * SEQ + 64 * c;
        const int j = 16 * jt + r16; const size_t tokj = tokb + j;
        const GAS unsigned char* vtp = F.ws + WS_MVT + (size_t)item * 8192; const GAS bf16* cpT = WSP(bf16, WS_MCP) + (size_t)item * 4096;
        bf16x8_t qf[2];
#pragma unroll
        for (int ss = 0; ss < 2; ++ss) qf[ss] = *(const GAS bf16x8_t*)(QC + tokj * 384 + 64 * h + 32 * ss + 8 * q);
        const float gj = G[item * 64 + j]; const float mprev = msc[item * 4 + 2];
        f32x4 sv[4], dl[4]; float mx = -INFINITY;
#pragma unroll
        for (int nt = 0; nt < 4; ++nt) {
            f32x4 acc = (f32x4){0.f, 0.f, 0.f, 0.f};
            if (nt <= jt) {
#pragma unroll
                for (int ss = 0; ss < 2; ++ss) { const bf16x8_t a = *(const GAS bf16x8_t*)(KC + (tokb + 16 * nt + r16) * 384 + 64 * h + 32 * ss + 8 * q); acc = __builtin_amdgcn_mfma_f32_16x16x32_bf16(a, qf[ss], acc, 0, 0, 0); } }
            sv[nt] = acc;
            const f32x4 gs = *(const GAS f32x4*)(G + item * 64 + 16 * nt + 4 * q), is = *(const GAS f32x4*)(IG + item * 64 + 16 * nt + 4 * q);
#pragma unroll
            for (int rg = 0; rg < 4; ++rg) { const int s = 16 * nt + 4 * q + rg; dl[nt][rg] = (s <= j) ? (gj - gs[rg] + is[rg]) : -INFINITY; mx = fmaxf(mx, dl[nt][rg]); }
        }
        mx = fmaxf(mx, __shfl_xor(mx, 16)); mx = fmaxf(mx, __shfl_xor(mx, 32));
        const float il = gj + mprev; const float mj = fmaxf(mx, il);
        float dsum = 0.f;
#pragma unroll
        for (int nt = 0; nt < 4; ++nt)
#pragma unroll
            for (int rg = 0; rg < 4; ++rg) { const float wgt = fexp(dl[nt][rg] - mj) * sv[nt][rg]; sv[nt][rg] = wgt; dsum += wgt; }
        dsum += __shfl_xor(dsum, 16); dsum += __shfl_xor(dsum, 32);
        float qn = 0.f;
#pragma unroll
        for (int ss = 0; ss < 2; ++ss) { const f32x4 n0 = *(const GAS f32x4*)(NP + item * 64 + 32 * ss + 8 * q), n1 = *(const GAS f32x4*)(NP + item * 64 + 32 * ss + 8 * q + 4);
            const v4u qw = __builtin_bit_cast(v4u, qf[ss]);
            qn += bf2f(qw.x & 0xffffu) * n0[0] + bf2f(qw.x >> 16) * n0[1] + bf2f(qw.y & 0xffffu) * n0[2] + bf2f(qw.y >> 16) * n0[3]
                + bf2f(qw.z & 0xffffu) * n1[0] + bf2f(qw.z >> 16) * n1[1] + bf2f(qw.w & 0xffffu) * n1[2] + bf2f(qw.w >> 16) * n1[3]; }
        qn += __shfl_xor(qn, 16); qn += __shfl_xor(qn, 32);
        const float wi_ = fexp(il - mj); const float den = dsum + wi_ * qn; const float dinv = frcp(fmaxf(fabsf(den), fexp(-mj)));
        bf16x8_t wb[2], qs[2];
#pragma unroll
        for (int ss = 0; ss < 2; ++ss) { v4u w_; w_.x = cvtpk(sv[2 * ss][0], sv[2 * ss][1]); w_.y = cvtpk(sv[2 * ss][2], sv[2 * ss][3]); w_.z = cvtpk(sv[2 * ss + 1][0], sv[2 * ss + 1][1]); w_.w = cvtpk(sv[2 * ss + 1][2], sv[2 * ss + 1][3]);
            wb[ss] = __builtin_bit_cast(bf16x8_t, w_);
            const v4u qw = __builtin_bit_cast(v4u, qf[ss]); v4u qo;
            qo.x = cvtpk(bf2f(qw.x & 0xffffu) * wi_, bf2f(qw.x >> 16) * wi_); qo.y = cvtpk(bf2f(qw.y & 0xffffu) * wi_, bf2f(qw.y >> 16) * wi_);
            qo.z = cvtpk(bf2f(qw.z & 0xffffu) * wi_, bf2f(qw.z >> 16) * wi_); qo.w = cvtpk(bf2f(qw.w & 0xffffu) * wi_, bf2f(qw.w >> 16) * wi_);
            qs[ss] = __builtin_bit_cast(bf16x8_t, qo); }
        f32x4 hv[4]; float sum = 0.f;
#pragma unroll
        for (int vt = 0; vt < 4; ++vt) {
            f32x4 acc = (f32x4){0.f, 0.f, 0.f, 0.f};
#pragma unroll
            for (int ss = 0; ss < 2; ++ss) { const bf16x8_t a = *(const GAS bf16x8_t*)(vtp + ((16 * vt + r16) * 64 + 32 * ss + 8 * q) * 2); acc = __builtin_amdgcn_mfma_f32_16x16x32_bf16(a, wb[ss], acc, 0, 0, 0); }
#pragma unroll
            for (int ss = 0; ss < 2; ++ss) { const bf16x8_t a = *(const GAS bf16x8_t*)(cpT + (16 * vt + r16) * 64 + 32 * ss + 8 * q); acc = __builtin_amdgcn_mfma_f32_16x16x32_bf16(a, qs[ss], acc, 0, 0, 0); }
            hv[vt] = acc * dinv; sum += (hv[vt][0] + hv[vt][1]) + (hv[vt][2] + hv[vt][3]);
        }
        sum += __shfl_xor(sum, 16); sum += __shfl_xor(sum, 32);
        const float mean = sum * (1.f / 64.f); float vs = 0.f;
#pragma unroll
        for (int vt = 0; vt < 4; ++vt) { hv[vt] = hv[vt] - mean; vs += (hv[vt][0] * hv[vt][0] + hv[vt][1] * hv[vt][1]) + (hv[vt][2] * hv[vt][2] + hv[vt][3] * hv[vt][3]); }
        vs += __shfl_xor(vs, 16); vs += __shfl_xor(vs, 32);
        const float rstd = frsq(vs * (1.f / 64.f) + LN_EPS);
#pragma unroll
        for (int vt = 0; vt < 4; ++vt) { const int v0 = 16 * vt + 4 * q;
            const f32x4 og = ldp4(p + tokj * PC + P_ML + 1152 + 64 * h + v0), ng = *(const GAS f32x4*)(INP(I_NORMG) + l * 384 + 64 * h + v0);
            float o[4];
#pragma unroll
            for (int e = 0; e < 4; ++e) o[e] = sigmoidf_(og[e]) * (hv[vt][e] * rstd * ng[e]);
            *(GAS v2u*)(ycat + tokj * D + 640 + 64 * h + v0) = (v2u){pk2(o[0], o[1]), pk2(o[2], o[3])}; }
    }
}

__device__ __forceinline__ void sub_barrier(gu32* cnt, unsigned target) {
    asm volatile("s_waitcnt vmcnt(0)" ::: "memory");
    __syncthreads();
    if (threadIdx.x == 0) {
        __builtin_amdgcn_fence(__ATOMIC_RELEASE, "agent");
        asm volatile("s_waitcnt vmcnt(0)" ::: "memory");
        __hip_atomic_fetch_add(cnt, 1u, RLX_AGENT);
        unsigned sp = 0;
        while (__hip_atomic_load(cnt, RLX_AGENT) < target) { __builtin_amdgcn_s_sleep(2); if (++sp > (1u << 22)) break; }
        __builtin_amdgcn_fence(__ATOMIC_ACQUIRE, "agent");
        asm volatile("s_waitcnt vmcnt(0)" ::: "memory");
    }
    __syncthreads();
}

__device__ __forceinline__ void router2(Frame& F, int l, const GAS float* h1) {
    LAS unsigned* hist = (LAS unsigned*)(F.lds + LDSCTL_OFF);
    const GAS bf16* whi = WSP(bf16, WS_RTW) + (size_t)l * 65536; const GAS bf16* wlo = whi + 32768;
    GAS int* tke = WSP(int, WS_TKE); GAS float* tkg = WSP(float, WS_TKG); GAS int* rnk = WSP(int, WS_RNK);
    const int lane = F.lane, r16 = lane & 15, q = lane >> 4;
    for (int grp = F.vcu; grp < T / 64; grp += F.G) {
        if (F.wave < 4) {
            const int tok = grp * 64 + 16 * F.wave + r16;
            f32x4 acc[2] = {(f32x4){0.f, 0.f, 0.f, 0.f}, (f32x4){0.f, 0.f, 0.f, 0.f}};
            const GAS float* hr = h1 + (size_t)tok * D + 8 * q;
#pragma unroll 4
            for (int ks = 0; ks < 32; ++ks) {
                const f32x4 x0 = *(const GAS f32x4*)(hr + 32 * ks), x1 = *(const GAS f32x4*)(hr + 32 * ks + 4);
                unsigned hi[4], lo[4];
                { const unsigned a0 = f2bf(x0[0]), a1 = f2bf(x0[1]), a2 = f2bf(x0[2]), a3 = f2bf(x0[3]), a4 = f2bf(x1[0]), a5 = f2bf(x1[1]), a6 = f2bf(x1[2]), a7 = f2bf(x1[3]);
                  hi[0] = a0 | (a1 << 16); hi[1] = a2 | (a3 << 16); hi[2] = a4 | (a5 << 16); hi[3] = a6 | (a7 << 16);
                  lo[0] = pk2(x0[0] - bf2f(a0), x0[1] - bf2f(a1)); lo[1] = pk2(x0[2] - bf2f(a2), x0[3] - bf2f(a3)); lo[2] = pk2(x1[0] - bf2f(a4), x1[1] - bf2f(a5)); lo[3] = pk2(x1[2] - bf2f(a6), x1[3] - bf2f(a7)); }
                const bf16x8_t bh = __builtin_bit_cast(bf16x8_t, (v4u){hi[0], hi[1], hi[2], hi[3]}), bl = __builtin_bit_cast(bf16x8_t, (v4u){lo[0], lo[1], lo[2], lo[3]});
#pragma unroll
                for (int nt = 0; nt < 2; ++nt) { const bf16x8_t ah = *(const GAS bf16x8_t*)(whi + (16 * nt + r16) * 1024 + 32 * ks + 8 * q), al = *(const GAS bf16x8_t*)(wlo + (16 * nt + r16) * 1024 + 32 * ks + 8 * q);
                    acc[nt] = __builtin_amdgcn_mfma_f32_16x16x32_bf16(ah, bh, acc[nt], 0, 0, 0); acc[nt] = __builtin_amdgcn_mfma_f32_16x16x32_bf16(ah, bl, acc[nt], 0, 0, 0); acc[nt] = __builtin_amdgcn_mfma_f32_16x16x32_bf16(al, bh, acc[nt], 0, 0, 0); }
            }
            float lv[8];
#pragma unroll
            for (int nt = 0; nt < 2; ++nt) { const f32x4 b4 = *(const GAS f32x4*)(INP(I_RTB) + l * NE + 16 * nt + 4 * q);
#pragma unroll
                for (int rg = 0; rg < 4; ++rg) lv[4 * nt + rg] = acc[nt][rg] + b4[rg]; }
            float tv[4]; int ti[4];
#pragma unroll
            for (int i = 0; i < 4; ++i) {
                float m = lv[0]; int mi = 4 * q;
#pragma unroll
                for (int e = 1; e < 8; ++e) { const int ge = 16 * (e >> 2) + 4 * q + (e & 3); if (lv[e] > m) { m = lv[e]; mi = ge; } }
#pragma unroll
                for (int o = 16; o < 64; o <<= 1) { const float om = __shfl_xor(m, o); const int oi = __shfl_xor(mi, o); if (om > m || (om == m && oi < mi)) { m = om; mi = oi; } }
                tv[i] = m; ti[i] = mi;
#pragma unroll
                for (int e = 0; e < 8; ++e) { const int ge = 16 * (e >> 2) + 4 * q + (e & 3); if (ge == mi) lv[e] = -INFINITY; }
            }
            const float e1 = fexp(tv[1] - tv[0]), e2 = fexp(tv[2] - tv[0]), e3 = fexp(tv[3] - tv[0]); const float inv = frcp(1.0f + e1 + e2 + e3);
            if (q == 0) {
                int rk[4];
#pragma unroll
                for (int i = 0; i < 4; ++i) rk[i] = (int)__hip_atomic_fetch_add(&hist[ti[i]], 1u, __ATOMIC_RELAXED, __HIP_MEMORY_SCOPE_WORKGROUP);
                *(GAS v4u*)(tke + tok * 4) = (v4u){(unsigned)ti[0], (unsigned)ti[1], (unsigned)ti[2], (unsigned)ti[3]};
                *(GAS f32x4*)(tkg + tok * 4) = (f32x4){inv, e1 * inv, e2 * inv, e3 * inv};
                *(GAS v4u*)(rnk + tok * 4) = (v4u){(unsigned)rk[0], (unsigned)rk[1], (unsigned)rk[2], (unsigned)rk[3]};
            }
        }
        __syncthreads();
        if (F.tid < NE) { const unsigned c = hist[F.tid]; const unsigned base = __hip_atomic_fetch_add(F.ctl + CW_CNT + l * NE + F.tid, c, RLX_AGENT);
            WSP(int, WS_WGB)[(l * 256 + grp) * 32 + F.tid] = (int)base; hist[F.tid] = 0u; }
        __syncthreads();
    }
}
__device__ __forceinline__ void assign2(Frame& F, int l) {
    LAS unsigned* pst = (LAS unsigned*)(F.lds + RING_OFF);
    const GAS int* tke = WSP(int, WS_TKE); const GAS float* tkg = WSP(float, WS_TKG); const GAS int* rnk = WSP(int, WS_RNK); GAS int* slot_of = WSP(int, WS_SLOT); GAS float* gsl = WSP(float, WS_GSL);
    const GAS bf16* h16 = WSP(bf16, WS_H16); GAS bf16* xg = WSP(bf16, WS_XG);
    const int lane = F.lane;
    for (int grp = F.vcu; grp < T / 64; grp += F.G) {
        if (F.tid == 0) {
            unsigned run = 0;
            for (int e = 0; e < NE; ++e) { const unsigned c = __hip_atomic_load(F.ctl + CW_CNT + l * NE + e, RLX_AGENT); pst[e] = run; const unsigned nbk = (c + 255u) >> 8;
                if (blockIdx.x == 0 && grp == F.vcu) for (unsigned k = 0; k < nbk; ++k) __hip_atomic_store(F.ctl + CW_BLKE + l * 320 + (run >> 8) + k, (unsigned)e, RLX_AGENT);
                run += nbk << 8; }
            if (blockIdx.x == 0 && grp == F.vcu) __hip_atomic_store(F.ctl + CW_NB + l, run >> 8, RLX_AGENT);
        }
        if (F.tid >= 64 && F.tid < 96) pst[32 + F.tid - 64] = (unsigned)WSP(int, WS_WGB)[(l * 256 + grp) * 32 + F.tid - 64];
        __syncthreads();
#pragma unroll 1
        for (int i = 0; i < 8; ++i) { const int tok = grp * 64 + 8 * F.wave + i;
            int slot = 0;
            if (lane < 4) { const int e = tke[tok * 4 + lane]; slot = (int)(pst[e] + pst[32 + e]) + rnk[tok * 4 + lane]; slot_of[tok * 4 + lane] = slot; gsl[slot] = tkg[tok * 4 + lane]; }
            const GAS v4u* src = (const GAS v4u*)(h16 + (size_t)tok * D) + lane; const v4u a = src[0], b = src[64];
#pragma unroll
            for (int k = 0; k < 4; ++k) { const int s = __shfl(slot, k); GAS v4u* dst = (GAS v4u*)(xg + (size_t)s * D) + lane; dst[0] = a; dst[64] = b; }
        }
        __syncthreads();
    }
}
__device__ __forceinline__ void router_convert(Frame& F) {
    const int gt = F.vcu * (NWAVES * 64) + F.tid, NT_ = F.G * NWAVES * 64;
    for (int i = gt; i < 2 * 32 * 1024; i += NT_) { const int l = i >> 15, e = (i >> 10) & 31, k = i & 1023;
        const float x = INP(I_RTW)[(size_t)l * D * NE + (size_t)k * NE + e]; const unsigned hi = f2bf(x);
        GAS bf16* base = WSP(bf16, WS_RTW) + (size_t)l * 65536; base[e * 1024 + k] = (bf16)hi; base[32768 + e * 1024 + k] = (bf16)f2bf(x - bf2f(hi)); }
}

#ifndef MK_N_LAUNCHES
#define MK_N_LAUNCHES 1
#endif
constexpr int PH_PER_LAYER = 11, N_PHASES = 1 + DEPTH * PH_PER_LAYER;
struct Args { const float* in[34]; float* out; unsigned char* ws; int ph_lo, ph_hi; };
__global__ void __launch_bounds__(NWAVES * 64, 2) mk_fwd(Args args) {
    extern __shared__ __attribute__((aligned(16))) unsigned char lds[];
    Frame F0;
    F0.lds = (LAS unsigned char*)lds;
    F0.MISC = (volatile LAS unsigned*)(F0.lds + MISC_OFF);
    F0.tid = threadIdx.x; F0.lane = F0.tid & 63; F0.wave = __builtin_amdgcn_readfirstlane(F0.tid >> 6);
    F0.G = gridDim.x; { const int bx = blockIdx.x; F0.vcu = (F0.G % 8 == 0) ? (bx % 8) * (F0.G / 8) + bx / 8 : bx; }
    F0.ws = (GAS unsigned char*)args.ws; F0.ctl = (gu32*)(args.ws + WS_CTL); F0.out = (GAS float*)args.out;
    for (int u = F0.tid; u < (LDS_BYTES - LDSCTL_OFF) / 4; u += NWAVES * 64) ((LAS unsigned*)(F0.lds + LDSCTL_OFF))[u] = 0u;
    __syncthreads();
    if (F0.tid < 34) *(LAS unsigned long long*)(F0.lds + PTR_OFF + 8 * F0.tid) = (unsigned long long)args.in[F0.tid];
    __syncthreads();
    XcdBarrier bar; bar.bar = (unsigned*)(F0.ctl + CW_BAR); bar.x = 0; bar.st = nullptr;
    const int lo = args.ph_lo, hi = args.ph_hi;
    if (hi - lo > 1) bar = xcd_barrier_post((unsigned*)(F0.ctl + CW_BAR), F0.MISC + 8);

#ifndef PROBE_KP
#define PROBE_KP (-1)
#define PROBE_REPS 1
#endif
#ifndef PROBE_STOP
#define PROBE_STOP 99
#endif
#ifndef PROBE_SUB
#define PROBE_SUB (-1)
#endif
#define SUBRUN(i) (rep == 0 || PROBE_SUB < 0 || PROBE_SUB == (i))
    for (int ph_ = lo; ph_ < hi; ++ph_) {
    const int ph = launder_s(ph_);
#if defined(PROBE_TS)
    if (blockIdx.x == 0 && threadIdx.x == 0) ((GAS unsigned long long*)(F0.ctl + 65536))[ph_] = __builtin_amdgcn_s_memrealtime();
#endif
#if PROBE_REPS > 1
    const int nrep = ((ph == 0 && PROBE_KP == 100) || (ph > 0 && (ph - 1) % PH_PER_LAYER == PROBE_KP)) ? PROBE_REPS : 1;
    for (int rep = 0; rep < nrep; ++rep) {
    if (rep > 0) xcd_barrier(bar);
#else
    { constexpr int rep = 0;
#endif
    if (ph == 0) { Frame F = launder(F0);
#ifndef SKIP_CONV
            phase_convert(F);
            { Frame Fb = launder(F0); lora_convert(Fb); }
            { Frame Fc = launder(F0); router_convert(Fc); }
#endif
             }

    else {
        const int l = launder_s((ph - 1) / PH_PER_LAYER); const int kp = launder_s((ph - 1) % PH_PER_LAYER);
        if (kp == 0) { Frame F = launder(F0);
            pg8::Gemm g{(const pg8::bf16_t*)WSP(pg8::bf16_t, WS_H16), (const pg8::bf16_t*)WSP(pg8::bf16_t, WS_WIN + l * WIN_L), T, PC, D, 0};
            pg8::StaticOrder S; S.init(T, PC, F.G, (int)blockIdx.x);
            pg8::EpiProj E{WSP(pg8::bf16_t, WS_P), PC, WSP(float, WS_PG)};

#ifndef SKIP_G1
            pg8::gemm_phase<pg8::EpiProj, pg8::StaticOrder, true, true>(F.lds + RING_OFF, g, S, E);
#endif

        }
        else if (kp == 1) { Frame F = launder(F0);
#ifndef SKIP_PREP
            if (SUBRUN(1)) { Frame Fb = launder(F0); rwkv_item_prep(Fb, launder_s(l), (rep > 0) ? PROBE_STOP : 99); }
#endif
             }
        else if (kp == 2) { Frame F = launder(F0);
#ifndef SKIP_SCAN
            if (!is_chain_wg()) {
                const unsigned nsub = gridDim.x - 48;
#if defined(PROBE_TS)
#define MSTAMP(i) do { if (blockIdx.x == 100 && threadIdx.x == 0) ((GAS unsigned long long*)(F0.ctl + 65536))[48 + 8 * l + (i)] = __builtin_amdgcn_s_memrealtime(); } while (0)
#else
#define MSTAMP(i) do { } while (0)
#endif
                MSTAMP(0);
                MSTAMP(1);
                { Frame Fa = launder(F0); Fa.vcu = side_index(); Fa.G = (int)nsub; mlstm_prep(Fa, launder_s(l)); }
                MSTAMP(2);
                sub_barrier(F0.ctl + CW_SUB + (l * 2 + 0) * 64, nsub);
                MSTAMP(3);
                { Frame Fa = launder(F0); mlstm_scan2(Fa); }
                MSTAMP(4);
                sub_barrier(F0.ctl + CW_SUB + (l * 2 + 1) * 64, nsub);
                MSTAMP(5);
                { Frame Fa = launder(F0); Fa.vcu = side_index(); Fa.G = (int)nsub; mlstm_out_mfma(Fa, launder_s(l)); }
                MSTAMP(6);
            } else { Frame Fb = launder(F0); rwkv_chain2<0>(Fb);
#if defined(PROBE_TS)
                if (blockIdx.x == 0 && threadIdx.x == 0) ((GAS unsigned long long*)(F0.ctl + 65536))[40 + l] = __builtin_amdgcn_s_memrealtime();
#if defined(PROBE_CHAINVAR)
                __syncthreads(); { Frame Fx = launder(F0); rwkv_chain2<PROBE_CHAINVAR>(Fx); }
                if (blockIdx.x == 0 && threadIdx.x == 0) ((GAS unsigned long long*)(F0.ctl + 65536))[44 + l] = __builtin_amdgcn_s_memrealtime();
#endif
#endif
            }
#endif
             }
        else if (kp == 3) { Frame F = launder(F0);
#ifndef SKIP_FIN
            if (SUBRUN(0)) { Frame Fa = launder(F0); rwkv_chunk_out_mfma(Fa, launder_s(l)); } { Frame Fb = launder(F0); pool_items(Fb, launder_s(l)); }
#endif
             }
        else if (kp == 4) { Frame F = launder(F0);
            pg8::Gemm g{(const pg8::bf16_t*)WSP(pg8::bf16_t, WS_YCAT), (const pg8::bf16_t*)WSP(pg8::bf16_t, WS_WOUT + l * WOUT_L), T, D, D, 0};
            pg8::StaticOrder S; S.init(T, D, F.G, (int)blockIdx.x);
            pg8::EpiF32 E{WSP(float, WS_MIX), D};

#ifndef SKIP_G2
            pg8::gemm_phase<pg8::EpiF32, pg8::StaticOrder, false, true>(F.lds + RING_OFF, g, S, E);
#endif

        }
        else if (kp == 5) { Frame F = launder(F0);
#ifndef SKIP_LN
            ln_rows(F, (l == 0) ? INP(I_X) : WSP(float, WS_HB), WSP(float, WS_MIX), INP(I_LN1G) + l * D, INP(I_LN1B) + l * D, WSP(float, WS_HA), WSP(bf16, WS_H16));
#endif
             }
        else if (kp == 6) { Frame F = launder(F0);
#ifndef SKIP_RT
            router2(F, l, WSP(float, WS_HA));
#endif
             }
        else if (kp == 7) { Frame F = launder(F0);
#ifndef SKIP_AS
            assign2(F, l);
#endif
             }
        else if (kp == 8) { Frame F = launder(F0);
            pg8::Gemm g{(const pg8::bf16_t*)WSP(pg8::bf16_t, WS_XG), (const pg8::bf16_t*)WSP(pg8::bf16_t, WS_WGU + (size_t)l * 32 * WGU_E), NSLOT, 2048, D, WGU_E};
            MoeOrder<8> S; S.nb = (int)__builtin_amdgcn_readfirstlane(__hip_atomic_load(F.ctl + CW_NB + l, RLX_AGENT)); S.c = (int)blockIdx.x; S.blke = F.ctl + CW_BLKE + l * 320;
            pg8::EpiSwiGLU E{WSP(pg8::bf16_t, WS_ACT), INP(I_BGU) + (size_t)l * NE * 2048};

#ifndef SKIP_GU
            pg8::gemm_phase<pg8::EpiSwiGLU, MoeOrder<8>, true, true>(F.lds + RING_OFF, g, S, E);
#endif

        }
        else if (kp == 9) { Frame F = launder(F0);
            pg8::Gemm g{(const pg8::bf16_t*)WSP(pg8::bf16_t, WS_ACT), (const pg8::bf16_t*)WSP(pg8::bf16_t, WS_WDN + (size_t)l * 32 * WDN_E), NSLOT, D, FF, WDN_E};
            MoeOrder<4> S; S.nb = (int)__builtin_amdgcn_readfirstlane(__hip_atomic_load(F.ctl + CW_NB + l, RLX_AGENT)); S.c = (int)blockIdx.x; S.blke = F.ctl + CW_BLKE + l * 320;
            pg8::EpiDown E{WSP(pg8::bf16_t, WS_OSL), INP(I_BDN) + (size_t)l * NE * D, WSP(float, WS_GSL)};

#ifndef SKIP_DN
            pg8::gemm_phase<pg8::EpiDown, MoeOrder<4>, true, true>(F.lds + RING_OFF, g, S, E);
#endif

        }
        else if (kp == 10) { Frame F = launder(F0);
#ifndef SKIP_CB
            combine_phase(F, WSP(float, WS_HA), INP(I_LN2G) + l * D, INP(I_LN2B) + l * D, (l == DEPTH - 1) ? F.out : WSP(float, WS_HB), WSP(bf16, WS_H16));
#endif
             }
    }
    }
    if (ph_ + 1 < hi) xcd_barrier(bar);
    }
#if defined(PROBE_TS)
    if (blockIdx.x == 0 && threadIdx.x < 64) {
        asm volatile("s_waitcnt vmcnt(0)" ::: "memory");
        GAS unsigned long long* ts = (GAS unsigned long long*)(F0.ctl + 65536);
        if (threadIdx.x == 0) ts[hi] = __builtin_amdgcn_s_memrealtime();
        asm volatile("s_waitcnt vmcnt(0)" ::: "memory");
        unsigned long long dt = 0;
        if (PROBE_TS == 100) dt = ts[1] - ts[0];
        else if (PROBE_TS == 200) dt = ts[hi] - ts[0];
        else if (PROBE_TS == 300) dt = 100000;
        else if (PROBE_TS >= 600 && PROBE_TS < 606) { const int i_ = PROBE_TS - 600; for (int l = 0; l < DEPTH; ++l) dt += ts[48 + 8 * l + i_ + 1] - ts[48 + 8 * l + i_]; }
        else if (PROBE_TS == 500) { for (int l = 0; l < DEPTH; ++l) dt += ts[44 + l] - ts[40 + l]; }
        else if (PROBE_TS == 400) { for (int l = 0; l < DEPTH; ++l) dt += ts[40 + l] - ts[1 + PH_PER_LAYER * l + 2]; }
        else for (int l = 0; l < DEPTH; ++l) dt += ts[1 + PH_PER_LAYER * l + PROBE_TS + 1] - ts[1 + PH_PER_LAYER * l + PROBE_TS];
        const float us = (float)dt * 0.01f; const float V = sqrtf(us / (float)PROBE_TS_DIV);
#pragma unroll
        for (int i = 0; i < 4; ++i) { const int e = threadIdx.x + 64 * i; F0.out[e] = (e & 1) ? -V : V; }
    }
#endif
#if defined(PROBE_CONV2)
    { xcd_barrier(bar); Frame F = launder(F0); phase_convert(F); }
#endif
}

extern "C" void kernel_launch(void* const* d_in, const int* in_sizes, int n_in, void* d_out, int out_size, void* d_ws, size_t ws_size, hipStream_t stream) {
    static int grid = 0;
    if (grid == 0) {
        if (n_in != 34 || in_sizes[0] != T * D || out_size != T * D || ws_size < WS_END) { fprintf(stderr, "kernel_launch: unexpected shapes / workspace (n_in %d, in0 %d, out %d, ws %zu, need %zu)\n", n_in, n_in > 0 ? in_sizes[0] : -1, out_size, ws_size, (size_t)WS_END); grid = -1; return; }
        int dev = 0, cus = 0, per_cu = 0;
        if (hipGetDevice(&dev) != hipSuccess || hipDeviceGetAttribute(&cus, hipDeviceAttributeMultiprocessorCount, dev) != hipSuccess) { grid = -1; return; }
        if (hipFuncSetAttribute((const void*)mk_fwd, hipFuncAttributeMaxDynamicSharedMemorySize, LDS_BYTES) != hipSuccess) { fprintf(stderr, "kernel_launch: hipFuncSetAttribute failed\n"); grid = -1; return; }
        if (hipOccupancyMaxActiveBlocksPerMultiprocessor(&per_cu, (const void*)mk_fwd, NWAVES * 64, LDS_BYTES) != hipSuccess || per_cu < 1) { fprintf(stderr, "kernel_launch: occupancy query says %d blocks per CU\n", per_cu); }
        (void)hipGetLastError();
        grid = cus;
        if (grid % 8 != 0 || grid > 256) grid = (grid > 256) ? 256 : (grid / 8) * 8;
    }
    if (grid <= 0) return;
    (void)hipMemsetAsync((char*)d_ws + WS_CTL, 0, CTL_ZERO_BYTES, stream);
    Args a{};
    for (int i = 0; i < 34; ++i) a.in[i] = (const float*)d_in[i];
    a.out = (float*)d_out; a.ws = (unsigned char*)d_ws;
#if MK_N_LAUNCHES == 1
    a.ph_lo = 0; a.ph_hi = N_PHASES;
    hipLaunchKernelGGL(mk_fwd, dim3(grid), dim3(NWAVES * 64), LDS_BYTES, stream, a);
#else
    for (int ph = 0; ph < N_PHASES; ++ph) { a.ph_lo = ph; a.ph_hi = ph + 1; hipLaunchKernelGGL(mk_fwd, dim3(grid), dim3(NWAVES * 64), LDS_BYTES, stream, a); }
#endif
}
```
